# Optimizing an MI355X kernel written in HIP

```python
import numpy as np
import jax, jax.numpy as jnp
from jax import lax

D_MODEL = 1024
BATCH = 4
SEQ = 4096
DEPTH = 2

MEM_LEN = 256
MIX_WIDTH = D_MODEL
NSA_WIDTH = MIX_WIDTH // 2
POOL_WIDTH = MIX_WIDTH - NSA_WIDTH
HEAD_DIM = 64
N_HEADS = NSA_WIDTH // HEAD_DIM
N_KV_HEADS = 2
GROUP = N_HEADS // N_KV_HEADS
KV_WIDTH = N_KV_HEADS * HEAD_DIM
ROPE_DIM = HEAD_DIM // 4
ROPE_THETA = 500000.0
CMP_LEN = 32
CMP_STRIDE = 16
CMP_HIDDEN = 256
SEL_BLOCK = 64
SEL_TOP_N = 16
N_LOCAL_BLOCKS = 2
WINDOW = 512
Q_BLOCK = 128
N_BRANCH = 3
POOL_WINDOWS = (2, 4, 8, 16)
N_POOL_GROUPS = len(POOL_WINDOWS)
POOL_GROUP = POOL_WIDTH // N_POOL_GROUPS
IN_WIDTH = NSA_WIDTH + 6 * KV_WIDTH + N_HEADS * N_BRANCH + POOL_WIDTH
X_HEADS = 4
X_HEAD_DIM = D_MODEL // X_HEADS
D_FF = 2816
N_EXPERTS = 8
TOP_K = 2
D_FF_EXPERT = 3584
N_DENSE = (DEPTH + 1) // 2
N_MOE = DEPTH // 2
EPS = 1e-6

kernel_name = "hybrid_nsa_pool_moe_block"


def rms_norm(x, g):
    xf = x.astype(jnp.float32)
    y = xf * lax.rsqrt(jnp.mean(xf * xf, axis=-1, keepdims=True) + EPS)
    return (y * g.astype(jnp.float32)).astype(x.dtype)


def partial_rope(x, pos):
    half = ROPE_DIM // 2
    inv = ROPE_THETA ** (-jnp.arange(half, dtype=jnp.float32) / half)
    ang = pos.astype(jnp.float32)[:, None] * inv[None, :]
    cos = jnp.cos(ang)[None, :, None, :]
    sin = jnp.sin(ang)[None, :, None, :]
    xr = x[..., :ROPE_DIM].astype(jnp.float32)
    x1, x2 = xr[..., :half], xr[..., half:]
    rot = jnp.concatenate([x1 * cos - x2 * sin, x2 * cos + x1 * sin], axis=-1)
    return jnp.concatenate([rot.astype(x.dtype), x[..., ROPE_DIM:]], axis=-1)


def masked_softmax(logits, mask):
    lf = jnp.where(mask, logits.astype(jnp.float32), -jnp.inf)
    m = jnp.max(lf, axis=-1, keepdims=True)
    m = jnp.where(jnp.isfinite(m), m, 0.0)
    e = jnp.where(mask, jnp.exp(lf - m), 0.0)
    s = jnp.sum(e, axis=-1, keepdims=True)
    return e / jnp.maximum(s, jnp.finfo(jnp.float32).tiny)


def compress_blocks(kv, pe, w1, b1, w2):
    B, S, G, dh = kv.shape
    n_cmp = (S - CMP_LEN) // CMP_STRIDE + 1
    idx = np.arange(n_cmp)[:, None] * CMP_STRIDE + np.arange(CMP_LEN)[None, :]
    blk = kv[:, idx] + pe[None, None, :, None, :]
    blk = jnp.transpose(blk, (0, 1, 3, 2, 4)).reshape(B, n_cmp, G, CMP_LEN * dh)
    hid = jax.nn.gelu(jnp.einsum('bcgf,fh->bcgh', blk, w1) + b1)
    return jnp.einsum('bcgh,hd->bcgd', hid, w2)


def nsa_attention(q, k_cmp_raw, v_cmp_raw, k_slc, v_slc, k_win, v_win, gates,
                  pe_k, w1_k, b1_k, w2_k, pe_v, w1_v, b1_v, w2_v):
    B, S, H, dh = q.shape
    scale = dh ** -0.5
    pos = jnp.arange(S)
    q_rot = partial_rope(q, pos)
    k_slc = partial_rope(k_slc, pos)
    k_win = partial_rope(k_win, pos)
    k_cmp = compress_blocks(k_cmp_raw, pe_k, w1_k, b1_k, w2_k)
    v_cmp = compress_blocks(v_cmp_raw, pe_v, w1_v, b1_v, w2_v)
    n_cmp = k_cmp.shape[1]
    cmp_start = np.arange(n_cmp) * CMP_STRIDE
    cmp_end = jnp.asarray(cmp_start + CMP_LEN - 1)
    n_blk = S // SEL_BLOCK
    n_top = min(SEL_TOP_N, n_blk)
    sel_start = np.arange(n_blk) * SEL_BLOCK
    cover = jnp.asarray(((cmp_start[:, None] < sel_start[None, :] + SEL_BLOCK) &
                         (cmp_start[:, None] + CMP_LEN > sel_start[None, :])).astype(np.float32))
    ks_blocks = jnp.transpose(k_slc.reshape(B, n_blk, SEL_BLOCK, N_KV_HEADS, dh), (0, 3, 1, 2, 4))
    vs_blocks = jnp.transpose(v_slc.reshape(B, n_blk, SEL_BLOCK, N_KV_HEADS, dh), (0, 3, 1, 2, 4))
    pad = ((0, 0), (WINDOW, 0), (0, 0), (0, 0))
    k_win_pad = jnp.pad(k_win, pad)
    v_win_pad = jnp.pad(v_win, pad)
    blk_id = jnp.arange(n_blk)
    b_idx = jnp.arange(B)[:, None, None, None]
    g_idx = jnp.arange(N_KV_HEADS)[None, :, None, None]

    def one_block(qi):
        q0 = qi * Q_BLOCK
        t = q0 + jnp.arange(Q_BLOCK)
        qb = lax.dynamic_slice_in_dim(q, q0, Q_BLOCK, axis=1).reshape(B, Q_BLOCK, N_KV_HEADS, GROUP, dh)
        qrb = lax.dynamic_slice_in_dim(q_rot, q0, Q_BLOCK, axis=1).reshape(B, Q_BLOCK, N_KV_HEADS, GROUP, dh)
        lc = jnp.einsum('bqgrd,bcgd->bgrqc', qb, k_cmp) * scale
        pc = masked_softmax(lc, cmp_end[None, :] <= t[:, None])
        oc = jnp.einsum('bgrqc,bcgd->bqgrd', pc.astype(v_cmp.dtype), v_cmp)
        imp = jnp.einsum('bgrqc,cn->bgqn', pc, cover)
        tb = t // SEL_BLOCK
        future = blk_id[None, :] > tb[:, None]
        dist = tb[:, None] - blk_id[None, :]
        forced = (blk_id[None, :] == 0) | ((dist >= 0) & (dist < N_LOCAL_BLOCKS))
        score = jnp.where(future, -jnp.inf, jnp.where(forced, jnp.inf, imp))
        _, sel = lax.top_k(score, n_top)
        ksel = ks_blocks[b_idx, g_idx, sel].reshape(B, N_KV_HEADS, Q_BLOCK, n_top * SEL_BLOCK, dh)
        vsel = vs_blocks[b_idx, g_idx, sel].reshape(B, N_KV_HEADS, Q_BLOCK, n_top * SEL_BLOCK, dh)
        kpos = (sel[..., None] * SEL_BLOCK + jnp.arange(SEL_BLOCK)).reshape(B, N_KV_HEADS, Q_BLOCK, n_top * SEL_BLOCK)
        ls = jnp.einsum('bqgrd,bgqkd->bgrqk', qrb, ksel) * scale
        ps = masked_softmax(ls, (kpos <= t[None, None, :, None])[:, :, None])
        osl = jnp.einsum('bgrqk,bgqkd->bqgrd', ps.astype(vsel.dtype), vsel)
        kw = lax.dynamic_slice_in_dim(k_win_pad, q0, Q_BLOCK + WINDOW, axis=1)
        vw = lax.dynamic_slice_in_dim(v_win_pad, q0, Q_BLOCK + WINDOW, axis=1)
        wpos = q0 - WINDOW + jnp.arange(Q_BLOCK + WINDOW)
        diff = t[:, None] - wpos[None, :]
        mw = (diff >= 0) & (diff < WINDOW) & (wpos[None, :] >= 0)
        lw = jnp.einsum('bqgrd,bkgd->bgrqk', qrb, kw) * scale
        pw = masked_softmax(lw, mw)
        ow = jnp.einsum('bgrqk,bkgd->bqgrd', pw.astype(vw.dtype), vw)
        gb = lax.dynamic_slice_in_dim(gates, q0, Q_BLOCK, axis=1).reshape(B, Q_BLOCK, N_KV_HEADS, GROUP, N_BRANCH)
        o = gb[..., 0:1] * oc + gb[..., 1:2] * osl + gb[..., 2:3] * ow
        return o.reshape(B, Q_BLOCK, H * dh)

    out = lax.map(one_block, jnp.arange(S // Q_BLOCK))
    return jnp.transpose(out, (1, 0, 2, 3)).reshape(B, S, H * dh)


def pool_mixer(u, w_pool, pool_scale):
    B, S, _ = u.shape
    ug = u.reshape(B, S, N_POOL_GROUPS, POOL_GROUP).astype(jnp.float32)
    c = jnp.pad(jnp.cumsum(ug, axis=1), ((0, 0), (1, 0), (0, 0), (0, 0)))
    outs = []
    for g, w in enumerate(POOL_WINDOWS):
        cg = c[:, :, g]
        hi = cg[:, 1:]
        lo = jnp.pad(cg[:, :S + 1 - w], ((0, 0), (w - 1, 0), (0, 0)))
        cnt = jnp.minimum(jnp.arange(1, S + 1), w).astype(jnp.float32)[None, :, None]
        outs.append((hi - lo) / cnt - ug[:, :, g])
    d = jnp.stack(outs, axis=2).astype(u.dtype)
    y = jnp.einsum('bsgc,gce->bsge', d, w_pool).reshape(B, S, POOL_WIDTH)
    return y * pool_scale


def hybrid_mixer(h, w_in, pe_k, w1_k, b1_k, w2_k, pe_v, w1_v, b1_v, w2_v, w_pool, pool_scale, w_out):
    B, S, _ = h.shape
    z = h @ w_in
    o1 = NSA_WIDTH
    o2 = o1 + 6 * KV_WIDTH
    o3 = o2 + N_HEADS * N_BRANCH
    q = z[..., :o1].reshape(B, S, N_HEADS, HEAD_DIM)
    kv = z[..., o1:o2].reshape(B, S, 6, N_KV_HEADS, HEAD_DIM)
    gates = jax.nn.sigmoid(z[..., o2:o3]).reshape(B, S, N_HEADS, N_BRANCH)
    u = z[..., o3:]
    a = nsa_attention(q, kv[:, :, 0], kv[:, :, 1], kv[:, :, 2], kv[:, :, 3], kv[:, :, 4], kv[:, :, 5], gates,
                      pe_k, w1_k, b1_k, w2_k, pe_v, w1_v, b1_v, w2_v)
    p = pool_mixer(u, w_pool, pool_scale)
    return jnp.concatenate([a, p], axis=-1) @ w_out


def memory_cross_attention(h, m, wq, wk, wv, wo):
    B, S, _ = h.shape
    M = m.shape[1]
    q = (h @ wq).reshape(B, S, X_HEADS, X_HEAD_DIM)
    k = (m @ wk).reshape(B, M, X_HEADS, X_HEAD_DIM)
    v = (m @ wv).reshape(B, M, X_HEADS, X_HEAD_DIM)
    logits = jnp.einsum('bshd,bmhd->bhsm', q, k).astype(jnp.float32) * (X_HEAD_DIM ** -0.5)
    p = jax.nn.softmax(logits, axis=-1).astype(v.dtype)
    o = jnp.einsum('bhsm,bmhd->bshd', p, v).reshape(B, S, X_HEADS * X_HEAD_DIM)
    return o @ wo


def swiglu(h, wg, wu, wd):
    return (jax.nn.silu(h @ wg) * (h @ wu)) @ wd


def moe_swiglu(h, w_router, wg, wu, wd):
    logits = (h @ w_router).astype(jnp.float32)
    top_v, top_i = lax.top_k(logits, TOP_K)
    gate = jax.nn.softmax(top_v, axis=-1)
    comb = jnp.sum(jax.nn.one_hot(top_i, N_EXPERTS, dtype=jnp.float32) * gate[..., None], axis=-2)
    out = jnp.zeros_like(h)
    for e in range(N_EXPERTS):
        out = out + comb[..., e:e + 1].astype(h.dtype) * swiglu(h, wg[e], wu[e], wd[e])
    return out


def setup_inputs(seed: int = 0) -> dict:
    key = jax.random.key(seed)
    ks = iter(jax.random.split(key, 40))

    def nrm(shape, std):
        return jax.random.normal(next(ks), shape, jnp.float32) * std

    def gain(shape):
        return 1.0 + nrm(shape, 0.02)

    L = DEPTH
    return {
        "x": nrm((BATCH, SEQ, D_MODEL), 1.0),
        "mem": nrm((BATCH, MEM_LEN, D_MODEL), 1.0),
        "norm_mix": gain((L, D_MODEL)),
        "w_in": nrm((L, D_MODEL, IN_WIDTH), D_MODEL ** -0.5),
        "cmp_pe_k": nrm((L, CMP_LEN, HEAD_DIM), 0.02),
        "cmp_w1_k": nrm((L, CMP_LEN * HEAD_DIM, CMP_HIDDEN), (CMP_LEN * HEAD_DIM) ** -0.5),
        "cmp_b1_k": nrm((L, CMP_HIDDEN), 0.02),
        "cmp_w2_k": nrm((L, CMP_HIDDEN, HEAD_DIM), CMP_HIDDEN ** -0.5),
        "cmp_pe_v": nrm((L, CMP_LEN, HEAD_DIM), 0.02),
        "cmp_w1_v": nrm((L, CMP_LEN * HEAD_DIM, CMP_HIDDEN), (CMP_LEN * HEAD_DIM) ** -0.5),
        "cmp_b1_v": nrm((L, CMP_HIDDEN), 0.02),
        "cmp_w2_v": nrm((L, CMP_HIDDEN, HEAD_DIM), CMP_HIDDEN ** -0.5),
        "w_pool": nrm((L, N_POOL_GROUPS, POOL_GROUP, POOL_GROUP), POOL_GROUP ** -0.5),
        "pool_scale": gain((L, POOL_WIDTH)),
        "w_out": nrm((L, MIX_WIDTH, D_MODEL), MIX_WIDTH ** -0.5),
        "norm_x": gain((L, D_MODEL)),
        "norm_mem": gain((L, D_MODEL)),
        "wq_x": nrm((L, D_MODEL, X_HEADS * X_HEAD_DIM), D_MODEL ** -0.5),
        "wk_x": nrm((L, D_MODEL, X_HEADS * X_HEAD_DIM), D_MODEL ** -0.5),
        "wv_x": nrm((L, D_MODEL, X_HEADS * X_HEAD_DIM), D_MODEL ** -0.5),
        "wo_x": nrm((L, X_HEADS * X_HEAD_DIM, D_MODEL), D_MODEL ** -0.5),
        "norm_ffn": gain((L, D_MODEL)),
        "ffn_wg": nrm((N_DENSE, D_MODEL, D_FF), D_MODEL ** -0.5),
        "ffn_wu": nrm((N_DENSE, D_MODEL, D_FF), D_MODEL ** -0.5),
        "ffn_wd": nrm((N_DENSE, D_FF, D_MODEL), D_FF ** -0.5),
        "moe_router": nrm((N_MOE, D_MODEL, N_EXPERTS), D_MODEL ** -0.5),
        "moe_wg": nrm((N_MOE, N_EXPERTS, D_MODEL, D_FF_EXPERT), D_MODEL ** -0.5),
        "moe_wu": nrm((N_MOE, N_EXPERTS, D_MODEL, D_FF_EXPERT), D_MODEL ** -0.5),
        "moe_wd": nrm((N_MOE, N_EXPERTS, D_FF_EXPERT, D_MODEL), D_FF_EXPERT ** -0.5),
        "norm_final": gain((D_MODEL,)),
    }


def reference(x, mem, norm_mix, w_in, cmp_pe_k, cmp_w1_k, cmp_b1_k, cmp_w2_k,
              cmp_pe_v, cmp_w1_v, cmp_b1_v, cmp_w2_v, w_pool, pool_scale, w_out,
              norm_x, norm_mem, wq_x, wk_x, wv_x, wo_x, norm_ffn,
              ffn_wg, ffn_wu, ffn_wd, moe_router, moe_wg, moe_wu, moe_wd, norm_final):
    for layer in range(DEPTH):
        h = rms_norm(x, norm_mix[layer])
        x = x + hybrid_mixer(h, w_in[layer],
                             cmp_pe_k[layer], cmp_w1_k[layer], cmp_b1_k[layer], cmp_w2_k[layer],
                             cmp_pe_v[layer], cmp_w1_v[layer], cmp_b1_v[layer], cmp_w2_v[layer],
                             w_pool[layer], pool_scale[layer], w_out[layer])
        h = rms_norm(x, norm_x[layer])
        m = rms_norm(mem, norm_mem[layer])
        x = x + memory_cross_attention(h, m, wq_x[layer], wk_x[layer], wv_x[layer], wo_x[layer])
        h = rms_norm(x, norm_ffn[layer])
        j = layer // 2
        if layer % 2 == 0:
            x = x + swiglu(h, ffn_wg[j], ffn_wu[j], ffn_wd[j])
        else:
            x = x + moe_swiglu(h, moe_router[j], moe_wg[j], moe_wu[j], moe_wd[j])
    return rms_norm(x, norm_final)
```

```cpp
#include <hip/hip_runtime.h>
#include <cstdio>
#include <cstdint>
#include <cmath>

#ifndef DBG
#define DBG 0
#endif
#ifndef MK_PER_PHASE
#define MK_PER_PHASE 0
#endif

#define LAS __attribute__((address_space(3)))
#define GAS __attribute__((address_space(1)))
typedef unsigned short bf16_t;
typedef short bf16x8 __attribute__((ext_vector_type(8)));
typedef short s16x4 __attribute__((ext_vector_type(4)));
typedef float f32x2 __attribute__((ext_vector_type(2)));
typedef float f32x4 __attribute__((ext_vector_type(4)));
typedef float f32x16 __attribute__((ext_vector_type(16)));
typedef unsigned u32x4 __attribute__((ext_vector_type(4)));
typedef unsigned u32x2 __attribute__((ext_vector_type(2)));

constexpr int NB = 4, SEQ = 4096, DM = 1024, T = NB * SEQ, NL = 2;
constexpr int ZW = 2048;
constexpr int DFF = 2816, DFFE = 3584, NE = 8;
constexpr int MAXT = 136, HALFT = 68;
constexpr float EPS = 1e-6f;
constexpr float C2 = 0.125f * 1.4426950408889634f;
constexpr float CX = 0.0625f * 1.4426950408889634f;

constexpr size_t MiB = 1u << 20;
constexpr size_t WS_CTL = 0, CTL_ZERO_BYTES = 1 * MiB;
constexpr size_t WS_ROPE = 1 * MiB;
constexpr size_t WS_BIAS = 1 * MiB + 512 * 1024;
constexpr size_t WS_ROUTE = 2 * MiB;
constexpr size_t WS_CNTG = 2 * MiB + 512 * 1024;
constexpr size_t WS_TILE = 2 * MiB + 640 * 1024;
constexpr size_t WS_SLOT = 3 * MiB;
constexpr size_t WS_GATES = 4 * MiB;
constexpr size_t WS_KCMP = 6 * MiB;
constexpr size_t WS_HID = 7 * MiB;
constexpr size_t WS_MN = 9 * MiB;
constexpr size_t WS_KX = 13 * MiB;
constexpr size_t WS_VXT = 17 * MiB;
constexpr size_t WS_WIN = 21 * MiB;
constexpr size_t WS_WOUT = 29 * MiB;
constexpr size_t WS_WQ = 33 * MiB, WS_WO = 37 * MiB, WS_WK = 41 * MiB, WS_WV = 45 * MiB;
constexpr size_t WS_CW1 = 49 * MiB;
constexpr size_t WS_CW2 = 53 * MiB;
constexpr size_t WS_FGU = 54 * MiB;
constexpr size_t WS_FD = 65 * MiB;
constexpr size_t WS_MGU = 71 * MiB;
constexpr size_t WS_MD = 183 * MiB;
constexpr size_t WS_HB = 239 * MiB;
constexpr size_t WS_R = 271 * MiB;
constexpr size_t WS_QRAW = WS_R, WS_QROT = WS_R + 16 * MiB, WS_KV = WS_R + 32 * MiB  , WS_U = WS_R + 57 * MiB, WS_AB = WS_R + 73 * MiB;
constexpr size_t WS_QX = WS_R, WS_PB = WS_R + 32 * MiB, WS_OX = WS_R + 73 * MiB;
constexpr size_t WS_ACT0 = WS_R;
constexpr size_t WS_HP = WS_HB;
constexpr size_t WS_ACTC = 307 * MiB;
constexpr size_t WS_END = 427 * MiB;
constexpr size_t KVSZ = (size_t)NB * 2 * SEQ * 64;
static_assert(WS_HP + (size_t)MAXT * 256 * 1024 * 2 <= WS_ACTC && WS_ACTC + (size_t)HALFT * 256 * DFFE * 2 <= WS_END, "ws map");
static_assert(WS_MGU + (size_t)NE * 7168 * 1024 * 2 <= WS_MD && WS_MD + (size_t)NE * 1024 * DFFE * 2 <= WS_HB, "ws map");

constexpr int CW_TMO = 0, CW_BAR = 4096;

constexpr int RING_BYTES = 131072;
constexpr int XTRA_OFF = RING_BYTES, XTRA_BYTES = 24576;
constexpr int LDSCTL_OFF = XTRA_OFF + XTRA_BYTES, LDS_BYTES = LDSCTL_OFF + 512;
constexpr int NWAVES = 8;

#define LDS_WAIT() asm volatile("s_waitcnt lgkmcnt(0)" ::: "memory")
#define VM_WAIT() asm volatile("s_waitcnt vmcnt(0)" ::: "memory")
#define RLX_AGENT __ATOMIC_RELAXED, __HIP_MEMORY_SCOPE_AGENT

__device__ __forceinline__ unsigned f2bf(float f) { unsigned u = __builtin_bit_cast(unsigned, f); return (u + 0x7fffu + ((u >> 16) & 1u)) >> 16; }
__device__ __forceinline__ unsigned pk2(float lo, float hi) { return f2bf(lo) | (f2bf(hi) << 16); }
__device__ __forceinline__ float bf2f(unsigned short h) { return __builtin_bit_cast(float, (unsigned)h << 16); }
__device__ __forceinline__ unsigned cvt_pk_bf16(float lo, float hi) { unsigned r; asm volatile("v_cvt_pk_bf16_f32 %0, %1, %2" : "=v"(r) : "v"(lo), "v"(hi)); return r; }
template <int M> __device__ __forceinline__ float xor_get(float v) {
    static_assert(M > 0 && M < 32, "xor_get: within 32 lanes");
    return __builtin_bit_cast(float, __builtin_amdgcn_ds_swizzle(__builtin_bit_cast(int, v), (M << 10) | 0x1f));
}
__device__ __forceinline__ void half_swap(float v, float& lo, float& hi) {
    unsigned a = __builtin_bit_cast(unsigned, v), b = a;
    asm volatile("s_nop 1\n\tv_permlane32_swap_b32 %0, %1\n\ts_nop 1" : "+v"(a), "+v"(b));
    lo = __builtin_bit_cast(float, a); hi = __builtin_bit_cast(float, b);
}
__device__ __forceinline__ float xor32_sum(float v) { float lo, hi; half_swap(v, lo, hi); return lo + hi; }
__device__ __forceinline__ float xor32_max(float v) { float lo, hi; half_swap(v, lo, hi); return fmaxf(lo, hi); }
__device__ __forceinline__ float wave_sum(float v) {
    v += xor_get<1>(v); v += xor_get<2>(v); v += xor_get<4>(v); v += xor_get<8>(v); v += xor_get<16>(v);
    return xor32_sum(v);
}
__device__ __forceinline__ float fast_exp2(float x) { return __builtin_amdgcn_exp2f(x); }

namespace pg8 {
constexpr int BM = 256, BK = 64, HALF = 128, HTB = HALF * BK * 2, NXCD = 8, WGM = 8;
__host__ __device__ __forceinline__ int lds_byte(int r, int c) { const int st = (r >> 4) * 2 + (c >> 5), rr = r & 15, cc = c & 31, ob = rr * 64 + cc * 2; return st * 1024 + (ob ^ (((ob >> 9) & 1) << 5)); }
__host__ __device__ __forceinline__ void stage_rc(int b, int& R, int& C) { const int st = b / 1024, sb = b % 1024, swz = sb ^ (((sb >> 9) & 1) << 5); R = (st >> 1) * 16 + swz / 64; C = (st & 1) * 32 + (swz % 64) / 2; }
__host__ __device__ __forceinline__ int perm32(int rho) { const int n = rho >> 4, i = rho & 15; return 8 * (i >> 2) + 4 * n + (i & 3); }

struct Unit { int pm, pn; long aoff, boff, coff; };
struct Gemm { const char* A; const char* Bt; int K, lda, ldb; };

struct TileOrder {
    int nM, nN, nwg, G, c;
    __device__ void init(int nM_, int nN_, int G_, int c_) { nM = nM_; nN = nN_; nwg = nM * nN; G = G_; c = c_; }
    __device__ bool tile(int i, int& pm, int& pn) const {
        const long L = (long)i * G + c; if (L >= nwg) return false;
        int wgid = (int)L; { const int q = nwg / NXCD, r = nwg % NXCD, xcd = wgid % NXCD, off = wgid / NXCD; wgid = (xcd < r ? xcd * (q + 1) : r * (q + 1) + (xcd - r) * q) + off; }
        const int nig = WGM * nN, gid = wgid / nig, fm = gid * WGM, gsz = (nM - fm) < WGM ? (nM - fm) : WGM;
        pm = fm + ((wgid % nig) % gsz); pn = (wgid % nig) / gsz; return true;
    }
};

template <class Epi, class Sched, bool ALIGN_EPI, bool SP2>
__device__ __forceinline__ void gemm_phase(LAS unsigned char* lds, const Gemm g, const Sched& S, const Epi& E, int tid_in) {
    int tid_ = tid_in; asm volatile("" : "+v"(tid_));
    const int tid = tid_, wid = __builtin_amdgcn_readfirstlane(tid >> 6), lane = tid & 63, wr = wid >> 2, wc = wid & 3, fr = lane & 15, fq = lane >> 4;
    const int K = g.K, nt = K / BK;
    unsigned voffA[2], voffB[2];
#pragma unroll
    for (int i = 0; i < 2; ++i) { int R, C; stage_rc(tid * 16 + i * 8192, R, C); const int Rb = Epi::PERM ? ((R & ~31) + perm32(R & 31)) : R;
        voffA[i] = (unsigned)(R * g.lda + C) * 2u; voffB[i] = (unsigned)(Rb * g.ldb + C) * 2u; }
    const size_t kstep = (size_t)(BK * 2);
    const size_t hstepA = (size_t)HALF * g.lda * 2, hstepB = (size_t)HALF * g.ldb * 2;
    const unsigned ldsw = (unsigned)wid * 1024u;
    const int aoff = lds_byte(wr * 64 + fr, fq * 8), boff = lds_byte(wc * 32 + fr, fq * 8);
#define PG8_SA(b, h) (((b) * 2 + (h)) * HTB)
#define PG8_SB(b, h) ((4 + (b) * 2 + (h)) * HTB)
#define PG8_STAGE(bufoff, gbase, voff) do { _Pragma("unroll") for (int _i = 0; _i < 2; ++_i) \
        __builtin_amdgcn_global_load_lds((const unsigned*)((const char*)(gbase) + (voff)[_i]), (LAS unsigned*)(lds + (bufoff) + ldsw + _i * 8192), 16, 0, 0); } while (0)
#define PG8_LDA(dst, b, h) do { _Pragma("unroll") for (int m = 0; m < 4; ++m) _Pragma("unroll") for (int k = 0; k < 2; ++k) dst[m][k] = *(const LAS bf16x8*)(lds + PG8_SA(b, h) + aoff + m * 2048 + k * 1024); } while (0)
#define PG8_LDB(dst, b, h) do { _Pragma("unroll") for (int n = 0; n < 2; ++n) _Pragma("unroll") for (int k = 0; k < 2; ++k) dst[n][k] = *(const LAS bf16x8*)(lds + PG8_SB(b, h) + boff + n * 2048 + k * 1024); } while (0)
#define PG8_MMA(ai, bj, At, Bt) do { __builtin_amdgcn_s_setprio(1); _Pragma("unroll") for (int m = 0; m < 4; ++m) _Pragma("unroll") for (int n = 0; n < 2; ++n) _Pragma("unroll") for (int k = 0; k < 2; ++k) \
        acc[ai][bj][m][n] = __builtin_amdgcn_mfma_f32_16x16x32_bf16(Bt[n][k], At[m][k], acc[ai][bj][m][n], 0, 0, 0); __builtin_amdgcn_s_setprio(0); } while (0)
#define PG8_WAIT_V(n) asm volatile("s_waitcnt vmcnt(" #n ")" ::: "memory")
#define PG8_WAIT_L(n) asm volatile("s_waitcnt lgkmcnt(" #n ")" ::: "memory")
#define PG8_BAR __builtin_amdgcn_s_barrier()
#define PG8_SCHED __builtin_amdgcn_sched_barrier(0)
    Unit cur, nxt; int ui = 0;
    if (!S.next(0, cur)) return;
    f32x4 acc[2][2][4][2];
    float zero_ = 0.f; asm volatile("" : "+v"(zero_));
#pragma unroll
    for (int a = 0; a < 2; ++a)
#pragma unroll
        for (int b = 0; b < 2; ++b)
#pragma unroll
            for (int m = 0; m < 4; ++m)
#pragma unroll
                for (int n = 0; n < 2; ++n) acc[a][b][m][n] = (f32x4){zero_, zero_, zero_, zero_};
    bf16x8 At[4][2], B0[2][2], B1[2][2];
    const char* cA = g.A + cur.aoff; const char* cB = g.Bt + cur.boff;
    if constexpr (SP2) {
        PG8_STAGE(PG8_SB(0, 0), cB, voffB); PG8_STAGE(PG8_SB(0, 1), cB + hstepB, voffB); PG8_STAGE(PG8_SA(0, 0), cA, voffA); PG8_STAGE(PG8_SA(0, 1), cA + hstepA, voffA);
        if (wr == 1) PG8_BAR;
        PG8_WAIT_V(2); PG8_BAR;
        PG8_STAGE(PG8_SB(1, 0), cB + kstep, voffB); PG8_STAGE(PG8_SA(1, 0), cA + kstep, voffA); PG8_STAGE(PG8_SB(1, 1), cB + hstepB + kstep, voffB);
        PG8_WAIT_V(6); PG8_BAR;
    } else {
        PG8_STAGE(PG8_SB(0, 0), cB, voffB); PG8_STAGE(PG8_SA(0, 0), cA, voffA); PG8_STAGE(PG8_SB(0, 1), cB + hstepB, voffB); PG8_STAGE(PG8_SA(0, 1), cA + hstepA, voffA);
        if (wr == 1) PG8_BAR;
        PG8_WAIT_V(4); PG8_BAR;
        PG8_STAGE(PG8_SB(1, 0), cB + kstep, voffB); PG8_STAGE(PG8_SA(1, 0), cA + kstep, voffA); PG8_STAGE(PG8_SB(1, 1), cB + hstepB + kstep, voffB);
        PG8_WAIT_V(6); PG8_BAR;
    }
    for (;;) {
        const bool has_next = S.next(ui + 1, nxt);
        const char* nA = has_next ? g.A + nxt.aoff : cA; const char* nB = has_next ? g.Bt + nxt.boff : cB;
#pragma unroll 1
        for (int t = 0; t < nt; t += 2) {
            const bool last = (t == nt - 2);
            const char* a1 = cA + (size_t)(t + 1) * kstep;
            const char* a2 = last ? nA : cA + (size_t)(t + 2) * kstep; const char* b2 = last ? nB : cB + (size_t)(t + 2) * kstep;
            const char* a3 = a2 + kstep; const char* b3 = b2 + kstep;
            if constexpr (SP2) {
            PG8_LDB(B0, 0, 0); PG8_LDB(B1, 0, 1); PG8_SCHED; PG8_LDA(At, 0, 0); PG8_STAGE(PG8_SA(1, 1), a1 + hstepA, voffA);
            PG8_WAIT_V(8); PG8_WAIT_L(0); PG8_BAR; PG8_MMA(0, 0, At, B0); PG8_MMA(0, 1, At, B1); PG8_BAR; PG8_SCHED;
            PG8_LDA(At, 0, 1); PG8_STAGE(PG8_SB(0, 0), b2, voffB); PG8_STAGE(PG8_SB(0, 1), b2 + hstepB, voffB); PG8_STAGE(PG8_SA(0, 0), a2, voffA);
            PG8_WAIT_V(8); PG8_WAIT_L(0); PG8_BAR; PG8_MMA(1, 0, At, B0); PG8_MMA(1, 1, At, B1); PG8_BAR; PG8_SCHED;
            PG8_LDB(B0, 1, 0); PG8_LDB(B1, 1, 1); PG8_SCHED; PG8_LDA(At, 1, 0); PG8_STAGE(PG8_SA(0, 1), a2 + hstepA, voffA);
            PG8_WAIT_V(8); PG8_WAIT_L(0); PG8_BAR; PG8_MMA(0, 0, At, B0); PG8_MMA(0, 1, At, B1); PG8_BAR; PG8_SCHED;
            PG8_LDA(At, 1, 1); PG8_STAGE(PG8_SB(1, 0), b3, voffB); PG8_STAGE(PG8_SB(1, 1), b3 + hstepB, voffB); PG8_STAGE(PG8_SA(1, 0), a3, voffA);
            PG8_WAIT_V(8); PG8_WAIT_L(0); PG8_BAR; PG8_MMA(1, 0, At, B0); PG8_MMA(1, 1, At, B1); PG8_BAR; PG8_SCHED;
            } else {
            PG8_LDB(B0, 0, 0); PG8_SCHED; PG8_LDA(At, 0, 0); PG8_STAGE(PG8_SA(1, 1), a1 + hstepA, voffA);
            PG8_WAIT_L(8); PG8_BAR; PG8_WAIT_L(0); PG8_MMA(0, 0, At, B0); PG8_BAR; PG8_SCHED;
            PG8_LDB(B1, 0, 1); PG8_STAGE(PG8_SB(0, 0), b2, voffB);
            PG8_BAR; PG8_WAIT_L(0); PG8_MMA(0, 1, At, B1); PG8_BAR;
            PG8_LDA(At, 0, 1); PG8_STAGE(PG8_SA(0, 0), a2, voffA);
            PG8_BAR; PG8_WAIT_L(0); PG8_MMA(1, 0, At, B0); PG8_BAR; PG8_SCHED;
            PG8_STAGE(PG8_SB(0, 1), b2 + hstepB, voffB);
            PG8_WAIT_V(6); PG8_BAR; PG8_MMA(1, 1, At, B1); PG8_BAR;
            PG8_LDB(B0, 1, 0); PG8_SCHED; PG8_LDA(At, 1, 0); PG8_STAGE(PG8_SA(0, 1), a2 + hstepA, voffA);
            PG8_WAIT_L(8); PG8_BAR; PG8_WAIT_L(0); PG8_MMA(0, 0, At, B0); PG8_BAR; PG8_SCHED;
            PG8_LDB(B1, 1, 1); PG8_STAGE(PG8_SB(1, 0), b3, voffB);
            PG8_BAR; PG8_WAIT_L(0); PG8_MMA(0, 1, At, B1); PG8_BAR;
            PG8_LDA(At, 1, 1); PG8_STAGE(PG8_SA(1, 0), a3, voffA);
            PG8_BAR; PG8_WAIT_L(0); PG8_MMA(1, 0, At, B0); PG8_BAR; PG8_SCHED;
            PG8_STAGE(PG8_SB(1, 1), b3 + hstepB, voffB);
            PG8_WAIT_V(6); PG8_BAR; PG8_MMA(1, 1, At, B1); PG8_BAR;
            }
        }
        if constexpr (ALIGN_EPI) { if (wr == 0) PG8_BAR; }
        if constexpr (!Epi::AFTER_DRAIN) { E(acc, cur, wr, wc, fr, fq); }
        if (!has_next) break;
#pragma unroll
        for (int a = 0; a < 2; ++a)
#pragma unroll
            for (int b = 0; b < 2; ++b)
#pragma unroll
                for (int m = 0; m < 4; ++m)
#pragma unroll
                    for (int n = 0; n < 2; ++n) acc[a][b][m][n] = (f32x4){zero_, zero_, zero_, zero_};
        cur = nxt; cA = nA; cB = nB; ++ui;
        if constexpr (ALIGN_EPI) { if (wr == 1) PG8_BAR; }
    }
    PG8_WAIT_V(0);
    if constexpr (!ALIGN_EPI) { if (wr == 0) PG8_BAR; }
    PG8_BAR;
    if constexpr (Epi::AFTER_DRAIN) { E.fused(acc, cur, wr, wc, fr, fq, lds, wid, lane); }
#undef PG8_SA
#undef PG8_SB
#undef PG8_STAGE
#undef PG8_LDA
#undef PG8_LDB
#undef PG8_MMA
#undef PG8_WAIT_V
#undef PG8_WAIT_L
#undef PG8_BAR
#undef PG8_SCHED
}
}
using pg8::Unit;
typedef const f32x4 (&AccRef)[2][2][4][2];

struct SchedPlain {
    pg8::TileOrder o; long astep, bstep;
    __device__ void init(int nM, int nN, int lda, int ldb, int G, int c) { o.init(nM, nN, G, c); astep = (long)256 * lda * 2; bstep = (long)256 * ldb * 2; }
    __device__ bool next(int i, Unit& u) const { if (!o.tile(i, u.pm, u.pn)) return false; u.aoff = u.pm * astep; u.boff = u.pn * bstep; u.coff = 0; return true; }
};
struct SchedOne { Unit u; __device__ bool next(int i, Unit& out) const { if (i > 0) return false; out = u; return true; } };
struct SchedKV {
    int G, c;
    __device__ bool next(int i, Unit& u) const {
        const int L = i * G + c; if (L >= 64) return false;
        const int job = L >> 4, l = job >> 1, isv = job & 1; u.pm = (L >> 2) & 3; u.pn = L & 3;
        const long mn = (long)WS_MN + (long)l * 2 * MiB, wk = (long)WS_WK + (long)l * 2 * MiB, wv = (long)WS_WV + (long)l * 2 * MiB;
        const long ts = 256L * 1024 * 2;
        if (!isv) { u.aoff = mn + u.pm * ts; u.boff = wk + u.pn * ts; u.coff = ((long)WS_KX + (long)l * 2 * MiB) / 2; }
        else { u.aoff = wv + u.pm * ts; u.boff = mn + u.pn * ts; u.coff = ((long)WS_VXT + (long)l * 2 * MiB) / 2; }
        return true;
    }
};
template <int MODE> struct SchedX {
    pg8::TileOrder o;
    __device__ void init(int G, int c) { o.init(64, 4, G, c); }
    __device__ bool next(int i, Unit& u) const {
        if (!o.tile(i, u.pm, u.pn)) return false;
        const int b = u.pm >> 4, h = u.pn;
        u.aoff = ((long)u.pm * 256 * 1024 + h * 256) * 2;
        u.boff = MODE == 0 ? ((long)b * 256 * 1024 + h * 256) * 2 : ((long)h * 256 * 1024 + b * 256) * 2;
        u.coff = 0; return true;
    }
};
struct SchedMoe {
    pg8::TileOrder o; const unsigned* texp; int t0; long astep, bstep, estep, cstep;
    __device__ bool next(int i, Unit& u) const {
        int pm, pn; if (!o.tile(i, pm, pn)) return false;
        const int rt = t0 + pm; const int e = (int)texp[rt];
        u.pm = rt; u.pn = pn; u.aoff = pm * astep; u.boff = e * estep + pn * bstep; u.coff = -(long)t0 * cstep; return true;
    }
};

struct EpiPlain {
    static constexpr bool PERM = true, AFTER_DRAIN = false;
    bf16_t* O; int ldc;
    __device__ __forceinline__ void operator()(AccRef acc, const Unit& u, int wr, int wc, int fr, int fq) const {
        bf16_t* base = O + u.coff + (size_t)(u.pm * 256 + wr * 64 + fr) * ldc + u.pn * 256 + wc * 32 + 8 * fq;
#pragma unroll
        for (int ai = 0; ai < 2; ++ai)
#pragma unroll
            for (int m = 0; m < 4; ++m)
#pragma unroll
                for (int bj = 0; bj < 2; ++bj) { const f32x4 v0 = acc[ai][bj][m][0], v1 = acc[ai][bj][m][1];
                    u32x4 w; w.x = cvt_pk_bf16(v0[0], v0[1]); w.y = cvt_pk_bf16(v0[2], v0[3]); w.z = cvt_pk_bf16(v1[0], v1[1]); w.w = cvt_pk_bf16(v1[2], v1[3]);
                    *(u32x4*)(base + (size_t)(ai * 128 + m * 16) * ldc + bj * 128) = w; }
    }
};
#ifndef ABL
#define ABL 0
#endif
struct EpiRes {
    static constexpr bool PERM = false, AFTER_DRAIN = false;
    const float* src; float* out; float sc = 1.f;
    __device__ __forceinline__ void operator()(AccRef acc, const Unit& u, int wr, int wc, int fr, int fq) const {
        const size_t off0 = (size_t)(u.pm * 256 + wr * 64 + fr) * DM + u.pn * 256 + wc * 32 + 4 * fq;
#pragma unroll
        for (int ai = 0; ai < 2; ++ai)
#pragma unroll
            for (int m = 0; m < 4; ++m)
#pragma unroll
                for (int bj = 0; bj < 2; ++bj)
#pragma unroll
                    for (int n = 0; n < 2; ++n) { const size_t off = off0 + (size_t)(ai * 128 + m * 16) * DM + bj * 128 + n * 16;
                        const f32x4 s = *(const f32x4*)(src + off); *(f32x4*)(out + off) = s + acc[ai][bj][m][n] * sc; }
    }
};
__device__ __forceinline__ float gelu_tanh(float x) {
    const float y = 0.7978845608028654f * (x + 0.044715f * x * x * x);
    const float e = fast_exp2(y * 2.8853900817779268f);
    const float th = 1.f - 2.f * __builtin_amdgcn_rcpf(e + 1.f);
    return 0.5f * x * (1.f + th);
}
struct EpiHid {
    static constexpr bool PERM = true, AFTER_DRAIN = false;
    bf16_t* O; const float* bias;
    __device__ __forceinline__ void operator()(AccRef acc, const Unit& u, int wr, int wc, int fr, int fq) const {
        bf16_t* base = O + (size_t)(u.pm * 256 + wr * 64 + fr) * 256 + wc * 32 + 8 * fq;
#pragma unroll
        for (int bj = 0; bj < 2; ++bj) { const float* bp = bias + bj * 128 + wc * 32 + 8 * fq; const f32x4 b0 = *(const f32x4*)bp, b1 = *(const f32x4*)(bp + 4);
#pragma unroll
            for (int ai = 0; ai < 2; ++ai)
#pragma unroll
                for (int m = 0; m < 4; ++m) { const f32x4 v0 = acc[ai][bj][m][0] + b0, v1 = acc[ai][bj][m][1] + b1;
                    u32x4 w; w.x = cvt_pk_bf16(gelu_tanh(v0[0]), gelu_tanh(v0[1])); w.y = cvt_pk_bf16(gelu_tanh(v0[2]), gelu_tanh(v0[3]));
                    w.z = cvt_pk_bf16(gelu_tanh(v1[0]), gelu_tanh(v1[1])); w.w = cvt_pk_bf16(gelu_tanh(v1[2]), gelu_tanh(v1[3]));
                    *(u32x4*)(base + (size_t)(ai * 128 + m * 16) * 256 + bj * 128) = w; } }
    }
};
struct EpiCmp2 {
    static constexpr bool PERM = true, AFTER_DRAIN = false;
    bf16_t* O;
    __device__ __forceinline__ void operator()(AccRef acc, const Unit& u, int wr, int wc, int fr, int fq) const {
        if (wc >= 2) return;
#pragma unroll
        for (int ai = 0; ai < 2; ++ai)
#pragma unroll
            for (int m = 0; m < 4; ++m) { const int row = u.pm * 256 + ai * 128 + wr * 64 + m * 16 + fr; const f32x4 v0 = acc[ai][0][m][0], v1 = acc[ai][0][m][1];
                u32x4 w; w.x = cvt_pk_bf16(v0[0], v0[1]); w.y = cvt_pk_bf16(v0[2], v0[3]); w.z = cvt_pk_bf16(v1[0], v1[1]); w.w = cvt_pk_bf16(v1[2], v1[3]);
                if ((row & 255) == 255) w = (u32x4){0u, 0u, 0u, 0u};
                *(u32x4*)(O + (size_t)row * 64 + wc * 32 + 8 * fq) = w; }
    }
};
__device__ __forceinline__ float silu_mul(float g, float u) { return g * __builtin_amdgcn_rcpf(1.f + fast_exp2(-1.4426950408889634f * g)) * u; }
struct EpiSwiglu {
    static constexpr bool PERM = true, AFTER_DRAIN = false;
    bf16_t* O; int ldc;
    __device__ __forceinline__ void operator()(AccRef acc, const Unit& u, int wr, int wc, int fr, int fq) const {
        bf16_t* base = O + u.coff + (size_t)(u.pm * 256 + wr * 64 + fr) * ldc + u.pn * 128 + wc * 32 + 8 * fq;
#pragma unroll
        for (int ai = 0; ai < 2; ++ai)
#pragma unroll
            for (int m = 0; m < 4; ++m) { const f32x4 g0 = acc[ai][0][m][0], g1 = acc[ai][0][m][1], u0 = acc[ai][1][m][0], u1 = acc[ai][1][m][1];
                u32x4 w; w.x = cvt_pk_bf16(silu_mul(g0[0], u0[0]), silu_mul(g0[1], u0[1])); w.y = cvt_pk_bf16(silu_mul(g0[2], u0[2]), silu_mul(g0[3], u0[3]));
                w.z = cvt_pk_bf16(silu_mul(g1[0], u1[0]), silu_mul(g1[1], u1[1])); w.w = cvt_pk_bf16(silu_mul(g1[2], u1[2]), silu_mul(g1[3], u1[3]));
                *(u32x4*)(base + (size_t)(ai * 128 + m * 16) * ldc) = w; }
    }
};
struct EpiWin {
    static constexpr bool PERM = true, AFTER_DRAIN = false;
    bf16_t *qraw, *qrot, *kv, *ub; float* gates; const float* rope;
    __device__ __forceinline__ void operator()(AccRef acc, const Unit& u, int wr, int wc, int fr, int fq) const {
        const int pn = u.pn;
#pragma unroll
        for (int ai = 0; ai < 2; ++ai)
#pragma unroll
            for (int m = 0; m < 4; ++m) {
                const int row = u.pm * 256 + ai * 128 + wr * 64 + m * 16 + fr, b = row >> 12, t = row & 4095;
#pragma unroll
                for (int bj = 0; bj < 2; ++bj) {
                    float v[8];
#pragma unroll
                    for (int j = 0; j < 4; ++j) { v[j] = acc[ai][bj][m][0][j]; v[4 + j] = acc[ai][bj][m][1][j]; }
                    if (pn < 2) {
                        const size_t idx = ((size_t)(b * 2 + pn) * SEQ + t) * 256 + bj * 128 + wc * 32 + 8 * fq;
                        u32x4 w; w.x = cvt_pk_bf16(v[0] * C2, v[1] * C2); w.y = cvt_pk_bf16(v[2] * C2, v[3] * C2); w.z = cvt_pk_bf16(v[4] * C2, v[5] * C2); w.w = cvt_pk_bf16(v[6] * C2, v[7] * C2);
                        *(u32x4*)(qraw + idx) = w;
                        if ((wc & 1) == 0) {
                            float p[8];
#pragma unroll
                            for (int j = 0; j < 8; ++j) p[j] = xor_get<16>(v[j]);
                            if (fq < 2) { const float* rp = rope + (size_t)t * 16;
#pragma unroll
                                for (int j = 0; j < 8; ++j) { const float cs = rp[2 * j], sn = rp[2 * j + 1]; v[j] = fq == 0 ? v[j] * cs - p[j] * sn : v[j] * cs + p[j] * sn; } }
                            w.x = cvt_pk_bf16(v[0] * C2, v[1] * C2); w.y = cvt_pk_bf16(v[2] * C2, v[3] * C2); w.z = cvt_pk_bf16(v[4] * C2, v[5] * C2); w.w = cvt_pk_bf16(v[6] * C2, v[7] * C2);
                        }
                        *(u32x4*)(qrot + idx) = w;
                    } else if (pn < 5) {
                        const int i = 2 * (pn - 2) + bj, g = wc >> 1;
                        if (bj == 0 && pn >= 3 && (wc & 1) == 0) {
                            float p[8];
#pragma unroll
                            for (int j = 0; j < 8; ++j) p[j] = xor_get<16>(v[j]);
                            if (fq < 2) { const float* rp = rope + (size_t)t * 16;
#pragma unroll
                                for (int j = 0; j < 8; ++j) { const float cs = rp[2 * j], sn = rp[2 * j + 1]; v[j] = fq == 0 ? v[j] * cs - p[j] * sn : v[j] * cs + p[j] * sn; } }
                        }
                        u32x4 w; w.x = cvt_pk_bf16(v[0], v[1]); w.y = cvt_pk_bf16(v[2], v[3]); w.z = cvt_pk_bf16(v[4], v[5]); w.w = cvt_pk_bf16(v[6], v[7]);
                        *(u32x4*)(kv + (size_t)i * KVSZ + ((size_t)(b * 2 + g) * SEQ + t) * 64 + (wc & 1) * 32 + 8 * fq) = w;
                    } else if (pn < 7) {
                        u32x4 w; w.x = cvt_pk_bf16(v[0], v[1]); w.y = cvt_pk_bf16(v[2], v[3]); w.z = cvt_pk_bf16(v[4], v[5]); w.w = cvt_pk_bf16(v[6], v[7]);
                        *(u32x4*)(ub + (size_t)row * 512 + (pn - 5) * 256 + bj * 128 + wc * 32 + 8 * fq) = w;
                    } else {
                        if (bj == 0 && wc == 0 && fq < 3) { float* gp = gates + (size_t)row * 24 + 8 * fq;
#pragma unroll
                            for (int j = 0; j < 8; ++j) gp[j] = __builtin_amdgcn_rcpf(1.f + fast_exp2(-1.4426950408889634f * v[j])); }
                    }
                }
            }
    }
};
struct EpiSoftmax {
    static constexpr bool PERM = true, AFTER_DRAIN = true;
    bf16_t* P;
    __device__ __forceinline__ void operator()(AccRef, const Unit&, int, int, int, int) const {}
    __device__ __forceinline__ void fused(f32x4 (&acc)[2][2][4][2], const Unit& u, int wr, int wc, int fr, int fq, LAS unsigned char* lds, int wid, int lane) const {
        LAS float* RM = (LAS float*)lds;
        LAS float* RS = (LAS float*)(lds + 4096);
        float mx[2][4];
#pragma unroll
        for (int ai = 0; ai < 2; ++ai)
#pragma unroll
            for (int m = 0; m < 4; ++m) { float a = -INFINITY;
#pragma unroll
                for (int bj = 0; bj < 2; ++bj)
#pragma unroll
                    for (int n = 0; n < 2; ++n)
#pragma unroll
                        for (int e = 0; e < 4; ++e) a = fmaxf(a, acc[ai][bj][m][n][e]);
                a = fmaxf(a, xor_get<16>(a)); a = xor32_max(a);
                if (fq == 0) RM[(ai * 128 + wr * 64 + m * 16 + fr) * 4 + wc] = a; }
        LDS_WAIT(); __builtin_amdgcn_s_barrier(); asm volatile("" ::: "memory");
#pragma unroll
        for (int ai = 0; ai < 2; ++ai)
#pragma unroll
            for (int m = 0; m < 4; ++m) { const int r = ai * 128 + wr * 64 + m * 16 + fr; const f32x4 q = *(const LAS f32x4*)(RM + r * 4);
                const float mm = fmaxf(fmaxf(q[0], q[1]), fmaxf(q[2], q[3])); float s = 0.f;
#pragma unroll
                for (int bj = 0; bj < 2; ++bj)
#pragma unroll
                    for (int n = 0; n < 2; ++n)
#pragma unroll
                        for (int e = 0; e < 4; ++e) { const float p = fast_exp2((acc[ai][bj][m][n][e] - mm) * CX); acc[ai][bj][m][n][e] = p; s += p; }
                s += xor_get<16>(s); s = xor32_sum(s);
                if (fq == 0) RS[r * 4 + wc] = s; }
        LDS_WAIT(); __builtin_amdgcn_s_barrier(); asm volatile("" ::: "memory");
        bf16_t* base = P + (size_t)(u.pm * 256 + wr * 64 + fr) * DM + u.pn * 256 + wc * 32 + 8 * fq;
#pragma unroll
        for (int ai = 0; ai < 2; ++ai)
#pragma unroll
            for (int m = 0; m < 4; ++m) { const int r = ai * 128 + wr * 64 + m * 16 + fr; const f32x4 q = *(const LAS f32x4*)(RS + r * 4);
                const float inv = 1.f / ((q[0] + q[1]) + (q[2] + q[3]));
#pragma unroll
                for (int bj = 0; bj < 2; ++bj) { u32x4 w;
                    const f32x4 p0 = acc[ai][bj][m][0] * inv, p1 = acc[ai][bj][m][1] * inv;
                    w.x = cvt_pk_bf16(p0[0], p0[1]); w.y = cvt_pk_bf16(p0[2], p0[3]); w.z = cvt_pk_bf16(p1[0], p1[1]); w.w = cvt_pk_bf16(p1[2], p1[3]);
                    *(u32x4*)(base + (size_t)(ai * 128 + m * 16) * DM + bj * 128) = w; } }
        LDS_WAIT(); __builtin_amdgcn_s_barrier(); asm volatile("" ::: "memory");
    }
};

namespace nsa {
constexpr int L_K = 0, L_V = 16384, L_PCS = 32768, L_OST = 98304, L_WSF = XTRA_OFF, L_SEL = XTRA_OFF + 2048;
__device__ __forceinline__ int crow(int r, int hi) { return (r & 3) + 8 * (r >> 2) + 4 * hi; }
__device__ __forceinline__ unsigned cvtpk(float lo, float hi) { return cvt_pk_bf16(lo, hi); }

__device__ __forceinline__ void qkt(f32x16& p0, f32x16& p1, const LAS unsigned char* Kslot, const bf16x8* qr, int r32, int hi, float zero_) {
    const LAS unsigned char* kb = Kslot + hi * 1024 + r32 * 16;
    f32x16 z;
#pragma unroll
    for (int r = 0; r < 16; ++r) z[r] = zero_;
    p0 = z; p1 = z;
#pragma unroll
    for (int d0 = 0; d0 < 4; ++d0) {
        const bf16x8 b0 = *(const LAS bf16x8*)(kb + d0 * 2048);
        const bf16x8 b1 = *(const LAS bf16x8*)(kb + d0 * 2048 + 512);
        p0 = __builtin_amdgcn_mfma_f32_32x32x16_bf16(b0, qr[d0], p0, 0, 0, 0);
        p1 = __builtin_amdgcn_mfma_f32_32x32x16_bf16(b1, qr[d0], p1, 0, 0, 0);
    }
}
__device__ __forceinline__ void pv(f32x16* o, int vb, bf16x8 pa0, bf16x8 pa1, bf16x8 pa2, bf16x8 pa3) {
#pragma unroll
    for (int d0 = 0; d0 < 2; ++d0) { s16x4 lo[4], hi[4];
#pragma unroll
        for (int ks = 0; ks < 4; ++ks) {
            asm volatile("ds_read_b64_tr_b16 %0,%1 offset:%c2" : "=&v"(lo[ks]) : "v"(vb), "i"(d0 * 4096 + ks * 1024) : "memory");
            asm volatile("ds_read_b64_tr_b16 %0,%1 offset:%c2" : "=&v"(hi[ks]) : "v"(vb), "i"(d0 * 4096 + ks * 1024 + 512) : "memory"); }
        asm volatile("s_waitcnt lgkmcnt(0)" ::: "memory"); __builtin_amdgcn_sched_barrier(0);
#define NSA_PK(k) (bf16x8){lo[k][0], lo[k][1], lo[k][2], lo[k][3], hi[k][0], hi[k][1], hi[k][2], hi[k][3]}
        o[d0] = __builtin_amdgcn_mfma_f32_32x32x16_bf16(pa0, NSA_PK(0), o[d0], 0, 0, 0);
        o[d0] = __builtin_amdgcn_mfma_f32_32x32x16_bf16(pa1, NSA_PK(1), o[d0], 0, 0, 0);
        o[d0] = __builtin_amdgcn_mfma_f32_32x32x16_bf16(pa2, NSA_PK(2), o[d0], 0, 0, 0);
        o[d0] = __builtin_amdgcn_mfma_f32_32x32x16_bf16(pa3, NSA_PK(3), o[d0], 0, 0, 0);
#undef NSA_PK
    }
}
__device__ __forceinline__ void mask_tile(f32x16& p0, f32x16& p1, int lo, int hi_, int hi) {
#pragma unroll
    for (int r = 0; r < 16; ++r) { const int kv = crow(r, hi); if (kv < lo || kv > hi_) p0[r] = -INFINITY; if (kv + 32 < lo || kv + 32 > hi_) p1[r] = -INFINITY; }
}
__device__ __forceinline__ float tile_max(const f32x16& p0, const f32x16& p1) {
    float a = fmaxf(p0[0], p1[0]);
#pragma unroll
    for (int r = 1; r < 16; ++r) a = fmaxf(a, fmaxf(p0[r], p1[r]));
    return xor32_max(a);
}
__device__ __forceinline__ void pack_p(const f32x16& p0, const f32x16& p1, bf16x8& a0, bf16x8& a1, bf16x8& a2, bf16x8& a3) {
    u32x4 w0, w1, w2, w3;
    w0 = (u32x4){cvtpk(p0[0], p0[1]), cvtpk(p0[2], p0[3]), cvtpk(p0[4], p0[5]), cvtpk(p0[6], p0[7])};
    w1 = (u32x4){cvtpk(p0[8], p0[9]), cvtpk(p0[10], p0[11]), cvtpk(p0[12], p0[13]), cvtpk(p0[14], p0[15])};
    w2 = (u32x4){cvtpk(p1[0], p1[1]), cvtpk(p1[2], p1[3]), cvtpk(p1[4], p1[5]), cvtpk(p1[6], p1[7])};
    w3 = (u32x4){cvtpk(p1[8], p1[9]), cvtpk(p1[10], p1[11]), cvtpk(p1[12], p1[13]), cvtpk(p1[14], p1[15])};
    a0 = __builtin_bit_cast(bf16x8, w0); a1 = __builtin_bit_cast(bf16x8, w1); a2 = __builtin_bit_cast(bf16x8, w2); a3 = __builtin_bit_cast(bf16x8, w3);
}
__device__ __forceinline__ void online_step(f32x16& p0, f32x16& p1, float& m, float& l, f32x16* o, LAS float* wsf, int r32, int hi) {
    const float rm = tile_max(p0, p1);
    const float mn = fmaxf(m, rm), mu = (mn == -INFINITY) ? 0.f : mn;
    const float sc = fast_exp2(m - mu);
    float s = 0.f;
#pragma unroll
    for (int r = 0; r < 16; ++r) { p0[r] = fast_exp2(p0[r] - mu); p1[r] = fast_exp2(p1[r] - mu); s += p0[r] + p1[r]; }
    l = l * sc + s; m = mn;
    if (__any(sc != 1.f)) {
        if (hi == 0) wsf[r32] = sc;
        LDS_WAIT();
#pragma unroll
        for (int r = 0; r < 16; ++r) { const float f = wsf[crow(r, hi)]; o[0][r] *= f; o[1][r] *= f; }
        LDS_WAIT();
    }
}

struct Ptrs { const bf16_t* qraw; const bf16_t* qrot; const bf16_t* kv; const bf16_t* kcmp; const bf16_t* vcmp; const float* gates; bf16_t* ab; };

template <bool WITH_V, class F>
__device__ __forceinline__ void tile_loop(int n, const bf16_t* Kb, const bf16_t* Vb, int row0, LAS unsigned char* lds, int wid, int lane, F&& body) {
    const bf16_t* ksrc = Kb + (size_t)(row0 + lane) * 64 + wid * 8;
    const bf16_t* vsrc = Vb + (size_t)(row0 + 16 * (wid & 3) + (lane >> 2)) * 64 + (wid >> 2) * 32 + (lane & 3) * 8;
#define NSA_ISSUE(i) do { const int sl_ = ((i) & 1) * 8192; \
        __builtin_amdgcn_global_load_lds((const unsigned*)(ksrc + (size_t)(i) * 4096), (LAS unsigned*)(lds + L_K + sl_ + wid * 1024), 16, 0, 0); \
        if (WITH_V) __builtin_amdgcn_global_load_lds((const unsigned*)(vsrc + (size_t)(i) * 4096), (LAS unsigned*)(lds + L_V + sl_ + wid * 1024), 16, 0, 0); } while (0)
    NSA_ISSUE(0);
    for (int i = 0; i < n; ++i) {
        VM_WAIT(); __syncthreads();
        if (i + 1 < n) NSA_ISSUE(i + 1);
        body(i, (i & 1) * 8192);
    }
    __syncthreads();
#undef NSA_ISSUE
}

__device__ __forceinline__ void unit(const Ptrs& P, int b, int g, int qt, LAS unsigned char* lds, int tid_in) {
    int tid_ = tid_in; asm volatile("" : "+v"(tid_));
    const int tid = tid_, lane = tid & 63, r32 = lane & 31, hi = lane >> 5; const int wid = __builtin_amdgcn_readfirstlane(tid >> 6);
    const int bg = b * 2 + g;
    const int tl = 8 * wid + (r32 >> 2), hr = r32 & 3;
    const int tpos = 64 * qt + tl;
    const size_t tok = (size_t)b * SEQ + tpos;
    LAS float* wsf = (LAS float*)(lds + L_WSF) + wid * 64;
    LAS float* pcs = (LAS float*)(lds + L_PCS);
    LAS unsigned long long* selm = (LAS unsigned long long*)(lds + L_SEL);
    const int vb0 = (int)(unsigned)(uintptr_t)(lds + L_V) + ((lane >> 4) & 1) * 32 + (lane & 3) * 8 + (4 * hi + ((lane & 15) >> 2)) * 64;
    const float* gp = P.gates + tok * 24 + (g * 4 + hr) * 3;
    const float g0 = gp[0], g1 = gp[1], g2 = gp[2];
    float zero_ = 0.f; asm volatile("" : "+v"(zero_));
    f32x16 ot[2];
#pragma unroll
    for (int r = 0; r < 16; ++r) { ot[0][r] = zero_; ot[1][r] = zero_; }
    bf16x8 qr[4];
    const size_t qoff = ((size_t)bg * SEQ + 64 * qt) * 256 + (size_t)(wid * 32 + r32) * 64 + hi * 8;
#pragma unroll
    for (int d0 = 0; d0 < 4; ++d0) qr[d0] = *(const bf16x8*)(P.qraw + qoff + d0 * 16);

    const int nv = tpos >= 15 ? ((tpos - 15) >> 4) : 0;
    const int nct = (4 * qt + 3 + 63) >> 6;
    const bf16_t* kc = P.kcmp + (size_t)bg * 256 * 64; const bf16_t* vc = P.vcmp + (size_t)bg * 256 * 64;
    float mc = -INFINITY, lc = 0.f;
    tile_loop<false>(nct, kc, vc, 0, lds, wid, lane, [&](int i, int sl) {
        f32x16 p0, p1; qkt(p0, p1, lds + L_K + sl, qr, r32, hi, zero_);
        mask_tile(p0, p1, 0, nv - 64 * i - 1, hi);
        const float rm = tile_max(p0, p1); const float mn = fmaxf(mc, rm), mu = (mn == -INFINITY) ? 0.f : mn;
        float s = 0.f;
#pragma unroll
        for (int r = 0; r < 16; ++r) s += fast_exp2(p0[r] - mu) + fast_exp2(p1[r] - mu);
        lc = lc * fast_exp2(mc - mu) + s; mc = mn;
    });
    lc = xor32_sum(lc);
    {
        const float mu = (mc == -INFINITY) ? 0.f : mc, inv = lc > 0.f ? 1.f / lc : 0.f;
        tile_loop<true>(nct, kc, vc, 0, lds, wid, lane, [&](int i, int sl) {
            f32x16 p0, p1; qkt(p0, p1, lds + L_K + sl, qr, r32, hi, zero_);
            mask_tile(p0, p1, 0, nv - 64 * i - 1, hi);
#pragma unroll
            for (int r = 0; r < 16; ++r) { p0[r] = fast_exp2(p0[r] - mu) * inv; p1[r] = fast_exp2(p1[r] - mu) * inv; }
#pragma unroll
            for (int r = 0; r < 16; ++r) {
                float a = p0[r], c = p1[r];
                a += xor_get<1>(a); a += xor_get<2>(a); c += xor_get<1>(c); c += xor_get<2>(c);
                if (hr == 0) { pcs[tl * 256 + 64 * i + crow(r, hi)] = a; pcs[tl * 256 + 64 * i + 32 + crow(r, hi)] = c; }
            }
#pragma unroll
            for (int r = 0; r < 16; ++r) { p0[r] *= g0; p1[r] *= g0; }
            bf16x8 a0, a1, a2, a3; pack_p(p0, p1, a0, a1, a2, a3);
            pv(ot, vb0 + sl, a0, a1, a2, a3);
        });
    }
    LDS_WAIT(); __syncthreads();
    if (qt < 16) { if (lane < 8) selm[8 * wid + lane] = (2ull << qt) - 1ull; }
    else {
        for (int k = 0; k < 8; ++k) {
            const int t8 = 8 * wid + k; const LAS float* pr = pcs + t8 * 256;
            float sc = -INFINITY;
            if (lane <= qt) { float imp = 0.f;
#pragma unroll
                for (int j = -1; j < 4; ++j) { const int c = 4 * lane + j; if (c >= 0 && c < 255) imp += pr[c]; }
                sc = (lane == 0 || lane == qt || lane == qt - 1) ? INFINITY : imp; }
            int rank = 0;
            for (int j = 0; j <= qt; ++j) { const float sj = __builtin_bit_cast(float, __builtin_amdgcn_readlane(__builtin_bit_cast(int, sc), j)); rank += (sj > sc || (sj == sc && j < lane)) ? 1 : 0; }
            const unsigned long long mk = __ballot(lane <= qt && rank < 16);
            if (lane == 0) selm[t8] = mk;
        }
    }
    LDS_WAIT(); __syncthreads();
    const unsigned long long sel = selm[tl];
#pragma unroll
    for (int d0 = 0; d0 < 4; ++d0) qr[d0] = *(const bf16x8*)(P.qrot + qoff + d0 * 16);
    {
        f32x16 o[2];
#pragma unroll
        for (int r = 0; r < 16; ++r) { o[0][r] = zero_; o[1][r] = zero_; }
        float m = -INFINITY, l = 0.f;
        const bf16_t* kb = P.kv + 2 * KVSZ + (size_t)bg * SEQ * 64; const bf16_t* vb = P.kv + 3 * KVSZ + (size_t)bg * SEQ * 64;
        tile_loop<true>(qt + 1, kb, vb, 0, lds, wid, lane, [&](int i, int sl) {
            f32x16 p0, p1; qkt(p0, p1, lds + L_K + sl, qr, r32, hi, zero_);
            const int hi_ = ((sel >> i) & 1ull) ? (i == qt ? tl : 63) : -1;
            if (!__all(hi_ >= 63)) mask_tile(p0, p1, 0, hi_, hi);
            online_step(p0, p1, m, l, o, wsf, r32, hi);
            bf16x8 a0, a1, a2, a3; pack_p(p0, p1, a0, a1, a2, a3);
            pv(o, vb0 + sl, a0, a1, a2, a3);
        });
        l = xor32_sum(l);
        if (hi == 0) wsf[r32] = l > 0.f ? g1 / l : 0.f;
        LDS_WAIT();
#pragma unroll
        for (int r = 0; r < 16; ++r) { const float f = wsf[crow(r, hi)]; ot[0][r] += o[0][r] * f; ot[1][r] += o[1][r] * f; }
        LDS_WAIT();
    }
    {
        f32x16 o[2];
#pragma unroll
        for (int r = 0; r < 16; ++r) { o[0][r] = zero_; o[1][r] = zero_; }
        float m = -INFINITY, l = 0.f;
        const int k0 = qt >= 8 ? qt - 8 : 0;
        const bf16_t* kb = P.kv + 4 * KVSZ + (size_t)bg * SEQ * 64; const bf16_t* vb = P.kv + 5 * KVSZ + (size_t)bg * SEQ * 64;
        tile_loop<true>(qt - k0 + 1, kb, vb, 64 * k0, lds, wid, lane, [&](int i, int sl) {
            f32x16 p0, p1; qkt(p0, p1, lds + L_K + sl, qr, r32, hi, zero_);
            const int kt = k0 + i;
            const int lo = (kt == qt - 8) ? tl + 1 : 0, hi_ = (kt == qt) ? tl : 63;
            if (!__all(lo <= 0 && hi_ >= 63)) mask_tile(p0, p1, lo, hi_, hi);
            online_step(p0, p1, m, l, o, wsf, r32, hi);
            bf16x8 a0, a1, a2, a3; pack_p(p0, p1, a0, a1, a2, a3);
            pv(o, vb0 + sl, a0, a1, a2, a3);
        });
        l = xor32_sum(l);
        if (hi == 0) wsf[r32] = l > 0.f ? g2 / l : 0.f;
        LDS_WAIT();
#pragma unroll
        for (int r = 0; r < 16; ++r) { const float f = wsf[crow(r, hi)]; ot[0][r] += o[0][r] * f; ot[1][r] += o[1][r] * f; }
        LDS_WAIT();
    }
    {
        LAS bf16_t* stg = (LAS bf16_t*)(lds + L_OST) + wid * 2048;
#pragma unroll
        for (int r = 0; r < 16; ++r) { const int orow = crow(r, hi);
#pragma unroll
            for (int d0 = 0; d0 < 2; ++d0) stg[orow * 64 + d0 * 32 + r32] = (bf16_t)f2bf(ot[d0][r]); }
        LDS_WAIT();
#pragma unroll
        for (int it = 0; it < 4; ++it) { const int row = it * 8 + (lane >> 3), ch = lane & 7; const u32x4 v = *(const LAS u32x4*)(stg + row * 64 + ch * 8);
            bf16_t* dst = P.ab + ((size_t)b * SEQ + 64 * qt + 8 * wid + (row >> 2)) * 1024 + g * 256 + (row & 3) * 64 + ch * 8;
            *(u32x4*)dst = v; }
        LDS_WAIT();
    }
    __syncthreads();
}
}

#define XB_TMO      128
#define XB_XCNT(j)  (256  + 64 * (j))
#define XB_XSUB(j)  (1280 + 64 * (j))
#define XB_XGEN(j)  (2304 + 64 * (j))
#define XB_TOP      3328
#define XB_TOPGEN   3392
#define XCD_BAR_WORDS 3456
#define XB_SPIN_CAP (1u << 18)
__device__ __forceinline__ unsigned xb_ld(unsigned* p)              { return __hip_atomic_load(p, __ATOMIC_RELAXED, __HIP_MEMORY_SCOPE_AGENT); }
__device__ __forceinline__ unsigned xb_add(unsigned* p, unsigned v) { return __hip_atomic_fetch_add(p, v, __ATOMIC_RELAXED, __HIP_MEMORY_SCOPE_AGENT); }
__device__ __forceinline__ unsigned xb_xcc_id() { return (unsigned)__builtin_amdgcn_s_getreg((3 << 11) | 20) & 0xFu; }
#define XB_SPIN(cond, bar) do { unsigned _sp = 0; while (cond) { __builtin_amdgcn_s_sleep(1); \
    if ((++_sp & 255u) == 0u) { if (xb_ld(&(bar)[XB_TMO])) break; if (_sp > XB_SPIN_CAP) { atomicAdd(&(bar)[XB_TMO], 1u); break; } } } } while (0)
struct XcdBarrier { unsigned* bar; unsigned x; volatile LAS unsigned* st; };
__device__ __forceinline__ XcdBarrier xcd_barrier_post(unsigned* bar, volatile LAS unsigned* st) {
    XcdBarrier b; b.bar = bar; b.x = xb_xcc_id(); b.st = st;
    if (threadIdx.x == 0) (void)xb_add(&bar[XB_XCNT(b.x)], 1u);
    return b;
}
__device__ __forceinline__ void xcd_barrier_complete(unsigned* bar, unsigned x, unsigned& nloc, unsigned& nx) {
    const unsigned G = gridDim.x * gridDim.y * gridDim.z;
    unsigned sum, cnt, mine, sp = 0u;
    for (;;) {
        sum = 0u; cnt = 0u; mine = 0u;
#pragma unroll
        for (unsigned j = 0; j < 16; ++j) { const unsigned c = xb_ld(&bar[XB_XCNT(j)]); sum += c; cnt += (c > 0u) ? 1u : 0u; mine = (j == x) ? c : mine; }
        if (sum == G) break;
        __builtin_amdgcn_s_sleep(1);
        if ((++sp & 255u) == 0u) { if (xb_ld(&bar[XB_TMO])) break; if (sp > XB_SPIN_CAP) { atomicAdd(&bar[XB_TMO], 1u); break; } }
    }
    nloc = mine > 0u ? mine : 1u; nx = cnt > 0u ? cnt : 1u;
}
__device__ __forceinline__ void xcd_barrier(const XcdBarrier& b, int tid) {
    asm volatile("s_waitcnt vmcnt(0)" ::: "memory");
    __syncthreads();
    if (tid == 0) {
        unsigned* bar = b.bar;
        __builtin_amdgcn_s_waitcnt(0);
        unsigned nloc = b.st[0], nx = b.st[1];
        if (nloc == 0u) { xcd_barrier_complete(bar, b.x, nloc, nx); b.st[0] = nloc; b.st[1] = nx; }
        const unsigned old = xb_add(&bar[XB_XSUB(b.x)], 1u);
        const unsigned gen = old / nloc;
        if (old + 1u == (gen + 1u) * nloc) {
            __builtin_amdgcn_fence(__ATOMIC_RELEASE, "agent");
            asm volatile("s_waitcnt vmcnt(0)" ::: "memory");
            const unsigned og = xb_add(&bar[XB_TOP], 1u);
            const unsigned tg = og / nx;
            if (og + 1u == (tg + 1u) * nx) xb_add(&bar[XB_TOPGEN], 1u);
            else XB_SPIN(xb_ld(&bar[XB_TOPGEN]) == tg, bar);
            __builtin_amdgcn_fence(__ATOMIC_ACQUIRE, "agent");
            xb_add(&bar[XB_XGEN(b.x)], 1u);
            asm volatile("s_waitcnt vmcnt(0)" ::: "memory");
        } else {
            XB_SPIN(xb_ld(&bar[XB_XGEN(b.x)]) == gen, bar);
            __builtin_amdgcn_fence(__ATOMIC_ACQUIRE, "agent");
            asm volatile("s_waitcnt vmcnt(0)" ::: "memory");
        }
    }
    __syncthreads();
}

__device__ __forceinline__ void xpose_item(const float* W, int ldw, int k0, int n0, int ncv, bf16_t* WT, int ldt, int dr0, LAS float* scr, int lane) {
    const int c = lane & 31;
#pragma unroll 8
    for (int i = 0; i < 32; ++i) { const int kk = 2 * i + (lane >> 5); scr[kk * 33 + c] = c < ncv ? W[(size_t)(k0 + kk) * ldw + n0 + c] : 0.f; }
    LDS_WAIT(); asm volatile("" ::: "memory");
    const int c8 = lane & 7;
#pragma unroll
    for (int j = 0; j < 4; ++j) { const int n = (lane >> 3) + 8 * j; const LAS float* s = scr + (8 * c8) * 33 + n;
        u32x4 o; o.x = pk2(s[0 * 33], s[1 * 33]); o.y = pk2(s[2 * 33], s[3 * 33]); o.z = pk2(s[4 * 33], s[5 * 33]); o.w = pk2(s[6 * 33], s[7 * 33]);
        *(u32x4*)(WT + (size_t)(dr0 + n) * ldt + k0 + 8 * c8) = o; }
    LDS_WAIT(); asm volatile("" ::: "memory");
}
__device__ __forceinline__ void xpose_mat(const float* W, int K, int N, bf16_t* WT, int rowmap, int item, LAS float* scr, int lane) {
    const int ng = N / 32, kb = item / ng, j = item % ng, n = 32 * j;
    const int dr = rowmap == 0 ? n : (256 * (n >> 7) + (n & 127) + (rowmap == 2 ? 128 : 0));
    xpose_item(W, N, 64 * kb, n, 32, WT, K, dr, scr, lane);
}
__device__ __forceinline__ float row_rs(const float* xrow, int lane, f32x4 (&v)[4]) {
    const f32x4* xr = (const f32x4*)xrow + lane; float s = 0.f;
#pragma unroll
    for (int j = 0; j < 4; ++j) { v[j] = xr[64 * j]; s += (v[j].x * v[j].x + v[j].y * v[j].y) + (v[j].z * v[j].z + v[j].w * v[j].w); }
    return 1.0f / sqrtf(wave_sum(s) * (1.f / DM) + EPS);
}
__device__ __forceinline__ void norm_row(const float* xrow, const float* gain, bf16_t* orow, int lane) {
    f32x4 v[4]; const float rs = row_rs(xrow, lane, v);
    const f32x4* gr = (const f32x4*)gain + lane; unsigned long long* o8 = (unsigned long long*)orow + lane;
#pragma unroll
    for (int j = 0; j < 4; ++j) { const f32x4 g = gr[64 * j];
        o8[64 * j] = (unsigned long long)pk2(v[j].x * rs * g.x, v[j].y * rs * g.y) | ((unsigned long long)pk2(v[j].z * rs * g.z, v[j].w * rs * g.w) << 32); }
}
__device__ __forceinline__ void sincos_d(double a, float& s, float& c) {
    const double n = rint(a * 0.6366197723675814);
    double r = fma(-n, 1.5707963267948966, a); r = fma(-n, 6.123233995736766e-17, r);
    const double r2 = r * r;
    double sp = -1.0 / 1307674368000.0; sp = sp * r2 + 1.0 / 6227020800.0; sp = sp * r2 - 1.0 / 39916800.0; sp = sp * r2 + 1.0 / 362880.0; sp = sp * r2 - 1.0 / 5040.0; sp = sp * r2 + 1.0 / 120.0; sp = sp * r2 - 1.0 / 6.0; sp = sp * r2 * r + r;
    double cp = 1.0 / 20922789888000.0; cp = cp * r2 - 1.0 / 87178291200.0; cp = cp * r2 + 1.0 / 479001600.0; cp = cp * r2 - 1.0 / 3628800.0; cp = cp * r2 + 1.0 / 40320.0; cp = cp * r2 - 1.0 / 720.0; cp = cp * r2 + 1.0 / 24.0; cp = cp * r2 - 0.5; cp = cp * r2 + 1.0;
    const int q = (int)n & 3;
    const double ss = (q & 1) ? cp : sp, cc = (q & 1) ? sp : cp;
    s = (float)((q & 2) ? -ss : ss); c = (float)(((q + 1) & 2) ? -cc : cc);
}

struct Args {
    const float* in[30]; float* out; unsigned char* ws; int ph_lo, ph_hi;
};
enum { I_X = 0, I_MEM, I_NORM_MIX, I_W_IN, I_PE_K, I_W1_K, I_B1_K, I_W2_K, I_PE_V, I_W1_V, I_B1_V, I_W2_V, I_W_POOL, I_POOL_SCALE, I_W_OUT, I_NORM_X, I_NORM_MEM,
       I_WQ, I_WK, I_WV, I_WO, I_NORM_FFN, I_FFN_WG, I_FFN_WU, I_FFN_WD, I_ROUTER, I_MOE_WG, I_MOE_WU, I_MOE_WD, I_NORM_FINAL };
constexpr int PH_PRO = 0, PH_KV = 1, PH_L0 = 2, PH_LSTRIDE = 20;
constexpr int PO_WIN = 0, PO_CMP = 1, PO_ATT = 2, PO_WOUT = 3, PO_N2 = 4, PO_WQ = 5, PO_S = 6, PO_PV = 7, PO_WO = 8, PO_F0 = 9;

typedef const Args __attribute__((address_space(4))) CArgs;
#define PHASE_IDS CArgs* ap_ = (CArgs*)__builtin_amdgcn_kernarg_segment_ptr(); asm volatile("" : "+s"(ap_)); unsigned char* ws = ap_->ws; (void)ws; int tid_; asm volatile("v_mbcnt_lo_u32_b32 %0, -1, 0\n\tv_mbcnt_hi_u32_b32 %0, -1, %0" : "=v"(tid_)); tid_ += wid0 * 64; const int tid = tid_, lane = tid & 63, wid = wid0, gw = bid * NWAVES + wid; (void)lane; (void)gw;
#ifndef PHMASK
#define PHMASK 0xffffffffu
#endif
#define PM(b) ((PHMASK >> (b)) & 1u)
#define IN(k) (lo <= (k) && (k) < hi)
#define SEAM(k) do { if (hi > (k) + 1) xcd_barrier(bar, tid); } while (0)
#define W16(off) ((bf16_t*)(ws + (off)))
template <int layer> __device__ __forceinline__ void layer_phases(LAS unsigned char* lds, const int lo, const int hi, const XcdBarrier& bar, const int G, const int bid, const int NGW, const int wid0) {
        const int pb = PH_L0 + layer * PH_LSTRIDE;
        if (PM(2) && IN(pb + PO_WIN)) {
            PHASE_IDS
            pg8::Gemm g{(const char*)(ws + WS_HB), (const char*)(ws + WS_WIN + (size_t)layer * ZW * DM * 2), DM, DM, DM};
            SchedPlain S; S.init(T / 256, ZW / 256, DM, DM, G, bid);
            EpiWin E{W16(WS_QRAW), W16(WS_QROT), W16(WS_KV), W16(WS_U), (float*)(ws + WS_GATES), (const float*)(ws + WS_ROPE)};
            pg8::gemm_phase<EpiWin, SchedPlain, true, true>(lds, g, S, E, tid);
            SEAM(pb + PO_WIN);
        }
        if (PM(3) && IN(pb + PO_CMP)) {
            PHASE_IDS
            if (bid < 16) {
                const int kv = bid >> 3, pm = bid & 7, mtx = layer * 2 + kv;
                {
                    pg8::Gemm g{(const char*)(ws + WS_KV + (size_t)kv * KVSZ * 2), (const char*)(ws + WS_CW1 + (size_t)mtx * 256 * 2048 * 2), 2048, 1024, 2048};
                    SchedOne S; S.u.pm = pm; S.u.pn = 0; S.u.aoff = (long)pm * 256 * 1024 * 2; S.u.boff = 0; S.u.coff = 0;
                    EpiHid E{W16(WS_HID) + (size_t)kv * 2048 * 256, (const float*)(ws + WS_BIAS) + mtx * 256};
                    pg8::gemm_phase<EpiHid, SchedOne, false, true>(lds, g, S, E, tid);
                }
                VM_WAIT(); __syncthreads();
                __builtin_amdgcn_fence(__ATOMIC_ACQUIRE, "agent"); VM_WAIT(); __syncthreads();
                {
                    pg8::Gemm g{(const char*)(ws + WS_HID + (size_t)kv * 2048 * 256 * 2), (const char*)(ws + WS_CW2 + (size_t)mtx * 256 * 256 * 2), 256, 256, 256};
                    SchedOne S; S.u.pm = pm; S.u.pn = 0; S.u.aoff = (long)pm * 256 * 256 * 2; S.u.boff = 0; S.u.coff = 0;
                    EpiCmp2 E{W16(WS_KCMP) + (size_t)kv * 8 * 256 * 64};
                    pg8::gemm_phase<EpiCmp2, SchedOne, false, true>(lds, g, S, E, tid);
                }
            } else {
                const bf16_t* ub = W16(WS_U); bf16_t* ab = W16(WS_AB);
                for (int idx = (bid - 16) * 512 + tid; idx < T * 64; idx += (G - 16) * 512) {
                    const int tok = idx >> 6, col = (idx & 63) * 8, w = 2 << (col >> 7), t = tok & (SEQ - 1), n = (t + 1) < w ? (t + 1) : w;
                    float s[8], own[8];
#pragma unroll
                    for (int j = 0; j < 8; ++j) s[j] = 0.f;
                    for (int q = 0; q < n; ++q) { const u32x4 v = *(const u32x4*)(ub + (size_t)(tok - q) * 512 + col);
#pragma unroll
                        for (int j = 0; j < 4; ++j) { const float a = __builtin_bit_cast(float, v[j] << 16), c = __builtin_bit_cast(float, v[j] & 0xffff0000u); s[2 * j] += a; s[2 * j + 1] += c;
                            if (q == 0) { own[2 * j] = a; own[2 * j + 1] = c; } } }
                    const float inv = 1.f / (float)n;
                    u32x4 o; o.x = pk2(s[0] * inv - own[0], s[1] * inv - own[1]); o.y = pk2(s[2] * inv - own[2], s[3] * inv - own[3]);
                    o.z = pk2(s[4] * inv - own[4], s[5] * inv - own[5]); o.w = pk2(s[6] * inv - own[6], s[7] * inv - own[7]);
                    *(u32x4*)(ab + (size_t)tok * 1024 + 512 + col) = o;
                }
            }
            SEAM(pb + PO_CMP);
        }
        if (PM(4) && IN(pb + PO_ATT)) {
            PHASE_IDS
            nsa::Ptrs P{W16(WS_QRAW), W16(WS_QROT), W16(WS_KV), W16(WS_KCMP), W16(WS_KCMP) + 8 * 256 * 64, (const float*)(ws + WS_GATES), W16(WS_AB)};
            const int vcu = (G % 8 == 0) ? (bid % 8) * (G / 8) + bid / 8 : bid;
            for (int uix = vcu; uix < 8 * 32; uix += G) { const int bgx = uix >> 5, s = uix & 31;
                nsa::unit(P, bgx >> 1, bgx & 1, 63 - s, lds, tid);
                nsa::unit(P, bgx >> 1, bgx & 1, s, lds, tid); }
            SEAM(pb + PO_ATT);
        }
        if (PM(5) && IN(pb + PO_WOUT)) {
            PHASE_IDS
            pg8::Gemm g{(const char*)(ws + WS_AB), (const char*)(ws + WS_WOUT + (size_t)layer * DM * DM * 2), DM, DM, DM};
            SchedPlain S; S.init(T / 256, DM / 256, DM, DM, G, bid);
            EpiRes E{layer == 0 ? ap_->in[I_X] : ap_->out, ap_->out, ((ABL & 1) || ((ABL & 16) && layer == 1) || ((ABL & 32) && layer == 0)) ? 0.f : 1.f};
            pg8::gemm_phase<EpiRes, SchedPlain, true, true>(lds, g, S, E, tid);
            SEAM(pb + PO_WOUT);
        }
        if (PM(6) && IN(pb + PO_N2)) {
            PHASE_IDS
            for (int r = gw; r < T; r += NGW) norm_row(ap_->out + (size_t)r * DM, ap_->in[I_NORM_X] + layer * DM, W16(WS_HB) + (size_t)r * DM, lane);
            SEAM(pb + PO_N2);
        }
        if (PM(7) && IN(pb + PO_WQ)) {
            PHASE_IDS
            pg8::Gemm g{(const char*)(ws + WS_HB), (const char*)(ws + WS_WQ + (size_t)layer * DM * DM * 2), DM, DM, DM};
            SchedPlain S; S.init(T / 256, DM / 256, DM, DM, G, bid);
            EpiPlain E{W16(WS_QX), DM};
            pg8::gemm_phase<EpiPlain, SchedPlain, true, true>(lds, g, S, E, tid);
            SEAM(pb + PO_WQ);
        }
        if (PM(8) && IN(pb + PO_S)) {
            PHASE_IDS
            pg8::Gemm g{(const char*)(ws + WS_QX), (const char*)(ws + WS_KX + (size_t)layer * 2 * MiB), 256, DM, DM};
            SchedX<0> S; S.init(G, bid);
            EpiSoftmax E{W16(WS_PB)};
            pg8::gemm_phase<EpiSoftmax, SchedX<0>, false, true>(lds, g, S, E, tid);
            SEAM(pb + PO_S);
        }
        if (PM(9) && IN(pb + PO_PV)) {
            PHASE_IDS
            pg8::Gemm g{(const char*)(ws + WS_PB), (const char*)(ws + WS_VXT + (size_t)layer * 2 * MiB), 256, DM, DM};
            SchedX<1> S; S.init(G, bid);
            EpiPlain E{W16(WS_OX), DM};
            pg8::gemm_phase<EpiPlain, SchedX<1>, true, true>(lds, g, S, E, tid);
            SEAM(pb + PO_PV);
        }
        if (PM(10) && IN(pb + PO_WO)) {
            PHASE_IDS
            pg8::Gemm g{(const char*)(ws + WS_OX), (const char*)(ws + WS_WO + (size_t)layer * DM * DM * 2), DM, DM, DM};
            SchedPlain S; S.init(T / 256, DM / 256, DM, DM, G, bid);
            EpiRes E{ap_->out, ap_->out, (ABL & 2) ? 0.f : 1.f};
            pg8::gemm_phase<EpiRes, SchedPlain, true, true>(lds, g, S, E, tid);
            SEAM(pb + PO_WO);
        }
        if constexpr (layer == 0) {
            if (PM(11) && IN(pb + PO_F0)) {
            PHASE_IDS
                for (int r = gw; r < T; r += NGW) norm_row(ap_->out + (size_t)r * DM, ap_->in[I_NORM_FFN], W16(WS_HB) + (size_t)r * DM, lane);
                SEAM(pb + PO_F0);
            }
            if (PM(12) && IN(pb + PO_F0 + 1)) {
            PHASE_IDS
                pg8::Gemm g{(const char*)(ws + WS_HB), (const char*)(ws + WS_FGU), DM, DM, DM};
                SchedPlain S; S.init(T / 256, 2 * DFF / 256, DM, DM, G, bid);
                EpiSwiglu E{W16(WS_ACT0), DFF};
                pg8::gemm_phase<EpiSwiglu, SchedPlain, true, true>(lds, g, S, E, tid);
                SEAM(pb + PO_F0 + 1);
            }
            if (PM(13) && IN(pb + PO_F0 + 2)) {
            PHASE_IDS
                pg8::Gemm g{(const char*)(ws + WS_ACT0), (const char*)(ws + WS_FD), DFF, DFF, DFF};
                SchedPlain S; S.init(T / 256, DM / 256, DFF, DFF, G, bid);
                EpiRes E{ap_->out, ap_->out, (ABL & 4) ? 0.f : 1.f};
                pg8::gemm_phase<EpiRes, SchedPlain, true, true>(lds, g, S, E, tid);
                SEAM(pb + PO_F0 + 2);
            }
            if (PM(14) && IN(pb + PO_F0 + 3)) {
            PHASE_IDS
                for (int r = gw; r < T; r += NGW) norm_row(ap_->out + (size_t)r * DM, ap_->in[I_NORM_MIX] + DM, W16(WS_HB) + (size_t)r * DM, lane);
                SEAM(pb + PO_F0 + 3);
            }
        } else {
#define route ((unsigned*)(ws + WS_ROUTE))
#define cntg ((unsigned*)(ws + WS_CNTG))
#define tinfo ((unsigned*)(ws + WS_TILE))
#define slot ((unsigned*)(ws + WS_SLOT))
            LAS int* LE = (LAS int*)lds;
            LAS float* LW = (LAS float*)(lds + 512);
            LAS int* LR = (LAS int*)(lds + 1024);
            LAS int* LC = (LAS int*)(lds + 1536);
            if (PM(15) && IN(pb + PO_F0)) {
            PHASE_IDS
                const float* gain = ap_->in[I_NORM_FFN] + DM; const float* wr = ap_->in[I_ROUTER];
                for (int tb = bid; tb < T / 64; tb += G) {
                    for (int k = 0; k < 8; ++k) { const int tl = 8 * wid + k, tok = 64 * tb + tl;
                        f32x4 v[4]; const float rs = row_rs(ap_->out + (size_t)tok * DM, lane, v);
                        float lg[8];
#pragma unroll
                        for (int e = 0; e < 8; ++e) lg[e] = 0.f;
#pragma unroll
                        for (int j = 0; j < 4; ++j) { const f32x4 gg = ((const f32x4*)gain)[lane + 64 * j];
#pragma unroll
                            for (int c = 0; c < 4; ++c) { const float h = v[j][c] * rs * gg[c]; const f32x4* wp = (const f32x4*)(wr + (size_t)(4 * (lane + 64 * j) + c) * 8); const f32x4 w0 = wp[0], w1 = wp[1];
                                lg[0] += h * w0[0]; lg[1] += h * w0[1]; lg[2] += h * w0[2]; lg[3] += h * w0[3]; lg[4] += h * w1[0]; lg[5] += h * w1[1]; lg[6] += h * w1[2]; lg[7] += h * w1[3]; } }
#pragma unroll
                        for (int e = 0; e < 8; ++e) lg[e] = wave_sum(lg[e]);
                        if (lane == 0) { int i1 = 0; float v1 = lg[0];
#pragma unroll
                            for (int e = 1; e < 8; ++e) if (lg[e] > v1) { v1 = lg[e]; i1 = e; }
                            int i2 = -1; float v2 = -INFINITY;
#pragma unroll
                            for (int e = 0; e < 8; ++e) if (e != i1 && lg[e] > v2) { v2 = lg[e]; i2 = e; }
                            const float w1 = 1.f / (1.f + expf(v2 - v1));
                            LE[2 * tl] = i1; LE[2 * tl + 1] = i2; LW[2 * tl] = w1; LW[2 * tl + 1] = 1.f - w1; }
                    }
                    LDS_WAIT(); __syncthreads();
                    if (tid < 8) { int c = 0; for (int i = 0; i < 128; ++i) if (LE[i] == tid) LR[i] = c++; LC[tid] = c; }
                    LDS_WAIT(); __syncthreads();
                    if (tid < 64) { const int tok = 64 * tb + tid; u32x4 a, b2; a.x = LE[2 * tid]; a.y = LE[2 * tid + 1]; a.z = LR[2 * tid]; a.w = LR[2 * tid + 1];
                        b2.x = __builtin_bit_cast(unsigned, LW[2 * tid]); b2.y = __builtin_bit_cast(unsigned, LW[2 * tid + 1]); b2.z = 0u; b2.w = 0u;
                        *(u32x4*)(route + (size_t)tok * 8) = a; *(u32x4*)(route + (size_t)tok * 8 + 4) = b2; }
                    if (tid < 8) cntg[tb * 8 + tid] = (unsigned)LC[tid];
                    LDS_WAIT(); __syncthreads();
                }
                SEAM(pb + PO_F0);
            }
            if (PM(16) && IN(pb + PO_F0 + 1)) {
            PHASE_IDS
                LAS unsigned* CN = (LAS unsigned*)(lds + 4096);
                LAS unsigned* SB = (LAS unsigned*)(lds + 2048);
                LAS unsigned* TOTS = (LAS unsigned*)(lds + 2048 + 64);
                LAS unsigned* MYB = (LAS unsigned*)(lds + 2048 + 128);
                const float* gain = ap_->in[I_NORM_FFN] + DM;
                for (int tb = bid; tb < T / 64; tb += G) {
                    for (int i = tid; i < 2048; i += 512) CN[i] = cntg[i];
                    LDS_WAIT(); __syncthreads();
                    if (tid < 8) { unsigned tot = 0, myb = 0; for (int w = 0; w < 256; ++w) { const unsigned c = CN[w * 8 + tid]; if (w < tb) myb += c; tot += c; } TOTS[tid] = tot; MYB[tid] = myb; }
                    LDS_WAIT(); __syncthreads();
                    if (tid == 0) { unsigned toff = 0; for (int e = 0; e < 8; ++e) { SB[e] = toff * 256 + MYB[e]; const unsigned nte = (TOTS[e] + 255) >> 8;
                            if (tb == 0) for (unsigned k = 0; k < nte; ++k) tinfo[8 + toff + k] = e;
                            toff += nte; }
                        if (tb == 0) tinfo[0] = toff; }
                    LDS_WAIT(); __syncthreads();
                    for (int k = 0; k < 8; ++k) { const int tok = 64 * tb + 8 * wid + k;
                        const u32x4 a = *(const u32x4*)(route + (size_t)tok * 8); const u32x4 b2 = *(const u32x4*)(route + (size_t)tok * 8 + 4);
                        const unsigned s1 = SB[a.x] + a.z, s2 = SB[a.y] + a.w;
                        if (lane == 0) { u32x4 o; o.x = s1; o.y = s2; o.z = b2.x; o.w = b2.y; *(u32x4*)(slot + (size_t)tok * 4) = o; }
                        f32x4 v[4]; const float rs = row_rs(ap_->out + (size_t)tok * DM, lane, v);
                        unsigned long long* o1 = (unsigned long long*)(W16(WS_HP) + (size_t)s1 * DM) + lane; unsigned long long* o2 = (unsigned long long*)(W16(WS_HP) + (size_t)s2 * DM) + lane;
#pragma unroll
                        for (int j = 0; j < 4; ++j) { const f32x4 gg = ((const f32x4*)gain)[lane + 64 * j];
                            const unsigned long long pk = (unsigned long long)pk2(v[j].x * rs * gg.x, v[j].y * rs * gg.y) | ((unsigned long long)pk2(v[j].z * rs * gg.z, v[j].w * rs * gg.w) << 32);
                            o1[64 * j] = pk; o2[64 * j] = pk; }
                    }
                    LDS_WAIT(); __syncthreads();
                }
                SEAM(pb + PO_F0 + 1);
            }
#pragma unroll 1
            for (int ch = 0; ch < 2; ++ch) {
                const int t0 = ch * HALFT;
#define MOE_NM int nm = (int)tinfo[0] - t0; nm = nm < 0 ? 0 : (nm > HALFT ? HALFT : nm);
                if (PM(17) && IN(pb + PO_F0 + 2 + 2 * ch)) {
            PHASE_IDS
                    MOE_NM
                    pg8::Gemm g{(const char*)(ws + WS_HP + (size_t)t0 * 256 * DM * 2), (const char*)(ws + WS_MGU), DM, DM, DM};
                    SchedMoe S; S.o.init(nm, 2 * DFFE / 256, G, bid); S.texp = tinfo + 8; S.t0 = t0; S.astep = 256L * DM * 2; S.bstep = 256L * DM * 2; S.estep = 7168L * DM * 2; S.cstep = 256L * DFFE;
                    EpiSwiglu E{W16(WS_ACTC), DFFE};
                    pg8::gemm_phase<EpiSwiglu, SchedMoe, true, true>(lds, g, S, E, tid);
                    SEAM(pb + PO_F0 + 2 + 2 * ch);
                }
                if (PM(18) && IN(pb + PO_F0 + 3 + 2 * ch)) {
            PHASE_IDS
                    MOE_NM
                    pg8::Gemm g{(const char*)(ws + WS_ACTC), (const char*)(ws + WS_MD), DFFE, DFFE, DFFE};
                    SchedMoe S; S.o.init(nm, DM / 256, G, bid); S.texp = tinfo + 8; S.t0 = t0; S.astep = 256L * DFFE * 2; S.bstep = 256L * DFFE * 2; S.estep = 1024L * DFFE * 2; S.cstep = 0;
                    EpiPlain E{W16(WS_HP), DM};
                    pg8::gemm_phase<EpiPlain, SchedMoe, true, true>(lds, g, S, E, tid);
                    SEAM(pb + PO_F0 + 3 + 2 * ch);
                }
            }
            if (PM(19) && IN(pb + PO_F0 + 6)) {
            PHASE_IDS
                const float* gain = ap_->in[I_NORM_FINAL];
                for (int r = gw; r < T; r += NGW) {
                    const u32x2 si = *(const u32x2*)(slot + (size_t)r * 4);
                    float w1 = ((const float*)slot)[(size_t)r * 4 + 2], w2 = ((const float*)slot)[(size_t)r * 4 + 3]; asm volatile("" : "+v"(w1), "+v"(w2));
                    if (ABL & 8) { w1 = 0.f; w2 = 0.f; }
                    const f32x4* xr = (const f32x4*)(ap_->out + (size_t)r * DM) + lane;
                    const u32x2* y1 = (const u32x2*)(W16(WS_HP) + (size_t)si.x * DM) + lane; const u32x2* y2 = (const u32x2*)(W16(WS_HP) + (size_t)si.y * DM) + lane;
                    f32x4 v[4]; float s = 0.f;
#pragma unroll
                    for (int j = 0; j < 4; ++j) { const f32x4 x = xr[64 * j]; const u32x2 a = y1[64 * j], c = y2[64 * j];
                        v[j].x = x.x + w1 * __builtin_bit_cast(float, a.x << 16) + w2 * __builtin_bit_cast(float, c.x << 16);
                        v[j].y = x.y + w1 * __builtin_bit_cast(float, a.x & 0xffff0000u) + w2 * __builtin_bit_cast(float, c.x & 0xffff0000u);
                        v[j].z = x.z + w1 * __builtin_bit_cast(float, a.y << 16) + w2 * __builtin_bit_cast(float, c.y << 16);
                        v[j].w = x.w + w1 * __builtin_bit_cast(float, a.y & 0xffff0000u) + w2 * __builtin_bit_cast(float, c.y & 0xffff0000u);
                        s += (v[j].x * v[j].x + v[j].y * v[j].y) + (v[j].z * v[j].z + v[j].w * v[j].w); }
#if DBG
                    { float sm = 0.f, sx = 0.f; const f32x4* xr2 = (const f32x4*)(ap_->out + (size_t)r * DM) + lane;
                      for (int j = 0; j < 4; ++j) { const f32x4 x = xr2[64 * j]; for (int c = 0; c < 4; ++c) { const float mm = v[j][c] - x[c]; sm += mm * mm; sx += x[c] * x[c]; } }
                      sm = wave_sum(sm); sx = wave_sum(sx); if (lane == 0) { if (sm > 1024.f) atomicAdd((float*)(ws + WS_CTL) + 16072, 1.f); if (!(sm < 1e30f)) atomicAdd((float*)(ws + WS_CTL) + 16073, 1.f); atomicAdd((float*)(ws + WS_CTL) + 16070, sm * (1.f / (T * 1024.f))); atomicAdd((float*)(ws + WS_CTL) + 16071, sx * (1.f / (T * 1024.f))); } }
#endif
                    const float rs = 1.0f / sqrtf(wave_sum(s) * (1.f / DM) + EPS);
                    f32x4* orow = (f32x4*)(ap_->out + (size_t)r * DM) + lane;
#pragma unroll
                    for (int j = 0; j < 4; ++j) { const f32x4 gg = ((const f32x4*)gain)[lane + 64 * j]; orow[64 * j] = (f32x4){v[j].x * rs * gg.x, v[j].y * rs * gg.y, v[j].z * rs * gg.z, v[j].w * rs * gg.w} * ((ABL & 256) ? 2.f : 1.f); }
                }
            }
        }
}

__global__ void __launch_bounds__(NWAVES * 64, 2) fwd(Args args) {
    extern __shared__ __attribute__((aligned(16))) unsigned char lds_raw[];
    LAS unsigned char* lds = (LAS unsigned char*)lds_raw;
    const int G = gridDim.x, bid = blockIdx.x, NGW = G * NWAVES;
    const int wid0 = __builtin_amdgcn_readfirstlane((int)threadIdx.x >> 6);
    unsigned* ctl = (unsigned*)(args.ws + WS_CTL);
    const int lo = args.ph_lo, hi = args.ph_hi;
    for (int u = threadIdx.x; u < (LDS_BYTES - LDSCTL_OFF) / 4; u += NWAVES * 64) ((LAS unsigned*)(lds + LDSCTL_OFF))[u] = 0u;
    __syncthreads();
    const bool multi = (hi - lo) > 1;
    XcdBarrier bar; bar.bar = ctl + CW_BAR; bar.x = 0; bar.st = nullptr;
    if (multi) bar = xcd_barrier_post(ctl + CW_BAR, (volatile LAS unsigned*)(lds + LDSCTL_OFF + 32));

    if (PM(0) && IN(PH_PRO)) {
            PHASE_IDS
        LAS float* scr = (LAS float*)(lds + wid * 16384);
        constexpr int IT_WIN = 16 * 64, IT_WOUT = 8 * 32, IT_SQ = 16 * 32, IT_C1 = 32 * 8, IT_C2 = 4 * 8, IT_FG = 16 * 88, IT_FD = 44 * 32, IT_MG = 16 * 112, IT_MD = 56 * 32;
        constexpr int N0 = 2 * IT_WIN, N1 = N0 + 2 * IT_WOUT, N2 = N1 + 8 * IT_SQ, N3 = N2 + 4 * IT_C1, N4 = N3 + 4 * IT_C2, N5 = N4 + 2 * IT_FG, N6 = N5 + IT_FD, N7 = N6 + 16 * IT_MG, N8 = N7 + 8 * IT_MD;
        for (int it = gw; it < N8; it += NGW) {
            if (it < N0) { const int l = it / IT_WIN, r = it % IT_WIN, kb = r / 64, j = r % 64;
                int n0, ncv, dr = 32 * j;
                if (j < 40) { n0 = 32 * j; ncv = 32; } else if (j < 56) { n0 = 1304 + 32 * (j - 40); ncv = 32; } else if (j == 56) { n0 = 1280; ncv = 24; } else { n0 = 0; ncv = 0; }
                xpose_item(ap_->in[I_W_IN] + (size_t)l * DM * 1816, 1816, 64 * kb, n0, ncv, W16(WS_WIN) + (size_t)l * ZW * DM, DM, dr, scr, lane);
            } else if (it < N1) { const int r0 = it - N0, l = r0 / IT_WOUT, r = r0 % IT_WOUT, kb = r / 32, j = r % 32;
                xpose_item(ap_->in[I_W_OUT] + (size_t)l * DM * DM, DM, 64 * kb, 32 * j, 32, W16(WS_WOUT) + (size_t)l * DM * DM, DM, 32 * j, scr, lane);
            } else if (it < N2) { const int r0 = it - N1, mtx = r0 / IT_SQ, r = r0 % IT_SQ, which = mtx >> 1, l = mtx & 1;
                const float* src = ap_->in[which == 0 ? I_WQ : which == 1 ? I_WO : which == 2 ? I_WK : I_WV] + (size_t)l * DM * DM;
                bf16_t* dst = W16(which == 0 ? WS_WQ : which == 1 ? WS_WO : which == 2 ? WS_WK : WS_WV) + (size_t)l * DM * DM;
                xpose_mat(src, DM, DM, dst, 0, r, scr, lane);
            } else if (it < N3) { const int r0 = it - N2, mtx = r0 / IT_C1, r = r0 % IT_C1, l = mtx >> 1, kv = mtx & 1;
                xpose_mat(ap_->in[kv ? I_W1_V : I_W1_K] + (size_t)l * 2048 * 256, 2048, 256, W16(WS_CW1) + (size_t)mtx * 256 * 2048, 0, r, scr, lane);
            } else if (it < N4) { const int r0 = it - N3, mtx = r0 / IT_C2, r = r0 % IT_C2, l = mtx >> 1, kv = mtx & 1, kb = r / 8, j = r % 8;
                xpose_item(ap_->in[kv ? I_W2_V : I_W2_K] + (size_t)l * 256 * 64, 64, 64 * kb, j < 2 ? 32 * j : 0, j < 2 ? 32 : 0, W16(WS_CW2) + (size_t)mtx * 256 * 256, 256, 32 * j, scr, lane);
            } else if (it < N5) { const int r0 = it - N4, up = r0 / IT_FG, r = r0 % IT_FG;
                xpose_mat(ap_->in[up ? I_FFN_WU : I_FFN_WG], DM, DFF, W16(WS_FGU), up ? 2 : 1, r, scr, lane);
            } else if (it < N6) { xpose_mat(ap_->in[I_FFN_WD], DFF, DM, W16(WS_FD), 0, it - N5, scr, lane);
            } else if (it < N7) { const int r0 = it - N6, mtx = r0 / IT_MG, r = r0 % IT_MG, e = mtx >> 1, up = mtx & 1;
                xpose_mat(ap_->in[up ? I_MOE_WU : I_MOE_WG] + (size_t)e * DM * DFFE, DM, DFFE, W16(WS_MGU) + (size_t)e * 7168 * DM, up ? 2 : 1, r, scr, lane);
            } else { const int r0 = it - N7, e = r0 / IT_MD, r = r0 % IT_MD;
                xpose_mat(ap_->in[I_MOE_WD] + (size_t)e * DFFE * DM, DFFE, DM, W16(WS_MD) + (size_t)e * DM * DFFE, 0, r, scr, lane);
            }
        }
        for (int i = bid * 512 + tid; i < SEQ * 8; i += G * 512) {
            const int pos = i >> 3, j = i & 7;
            const double inv = j == 0 ? 1.0 : j == 1 ? 0.19389587045179572 : j == 2 ? 0.037606030930863934 : j == 3 ? 0.007291654101443755 : j == 4 ? 0.0014142135623730951
                             : j == 5 ? 0.00027421616994972156 : j == 6 ? 5.3169310700017e-05 : 1.0309310618636385e-05;
            float s, c; sincos_d((double)pos * inv, s, c);
            ((float*)(ws + WS_ROPE))[2 * i] = c; ((float*)(ws + WS_ROPE))[2 * i + 1] = s;
        }
        for (int r = gw; r < 2 * 1024; r += NGW) { const int l = r >> 10, row = r & 1023;
            norm_row(ap_->in[I_MEM] + (size_t)row * DM, ap_->in[I_NORM_MEM] + l * DM, W16(WS_MN) + (size_t)r * DM, lane); }
        for (int itb = gw; itb < 4 * 4 * 16; itb += NGW) { const int mtx = itb >> 6, cg = (itb >> 4) & 3, fc = itb & 15, l = mtx >> 1, kv = mtx & 1, c = cg * 64 + lane;
            const float* pe = ap_->in[kv ? I_PE_V : I_PE_K] + l * 2048 + fc * 128; const float* w1 = ap_->in[kv ? I_W1_V : I_W1_K] + (size_t)l * 2048 * 256 + (size_t)fc * 128 * 256 + c;
            float a = fc == 0 ? ap_->in[kv ? I_B1_V : I_B1_K][l * 256 + c] : 0.f;
#pragma unroll 8
            for (int f = 0; f < 128; ++f) a += pe[f] * w1[(size_t)f * 256];
            atomicAdd((float*)(ctl + 8192) + mtx * 256 + c, a); }
        for (int itw = gw; itw < 2 * 4 * 16 * 16; itw += NGW) { const int l = itw >> 10, g = (itw >> 8) & 3, nb = (itw >> 4) & 15, cb = itw & 15, n = nb * 64 + lane;
            const float* wp = ap_->in[I_W_POOL] + ((size_t)(l * 4 + g) * 128 + cb * 8) * 128; const float* ps = ap_->in[I_POOL_SCALE] + l * 512 + g * 128;
            const float* wo = ap_->in[I_W_OUT] + (size_t)l * DM * DM + (size_t)(512 + g * 128) * DM + n;
            float a[8];
#pragma unroll
            for (int c = 0; c < 8; ++c) a[c] = 0.f;
            for (int e = 0; e < 128; ++e) { const float w = wo[(size_t)e * DM] * ps[e];
#pragma unroll
                for (int c = 0; c < 8; ++c) a[c] += wp[c * 128 + e] * w; }
            u32x4 o; o.x = pk2(a[0], a[1]); o.y = pk2(a[2], a[3]); o.z = pk2(a[4], a[5]); o.w = pk2(a[6], a[7]);
            *(u32x4*)(W16(WS_WOUT) + (size_t)l * DM * DM + (size_t)n * DM + 512 + g * 128 + cb * 8) = o; }
        __syncthreads();
        SEAM(PH_PRO);
    }
    if (PM(1) && IN(PH_KV)) {
            PHASE_IDS
        for (int i = bid * 512 + tid; i < 1024; i += G * 512) ((float*)(ws + WS_BIAS))[i] = __hip_atomic_load((float*)(ctl + 8192) + i, RLX_AGENT);
        for (int r = gw; r < T; r += NGW) norm_row(ap_->in[I_X] + (size_t)r * DM, ap_->in[I_NORM_MIX], W16(WS_HB) + (size_t)r * DM, lane);
        VM_WAIT(); __syncthreads();
        pg8::Gemm g{(const char*)ws, (const char*)ws, DM, DM, DM}; SchedKV S{G, bid}; EpiPlain E{(bf16_t*)ws, DM};
        pg8::gemm_phase<EpiPlain, SchedKV, true, true>(lds, g, S, E, tid);
        SEAM(PH_KV);
    }
    layer_phases<0>(lds, lo, hi, bar, G, bid, NGW, wid0);
    layer_phases<1>(lds, lo, hi, bar, G, bid, NGW, wid0);
#undef IN
#undef SEAM
}

#if DBG
struct DbgIn { const float* in[30]; };
__device__ float dbg_block_sum(float v, float* red) { const int t = threadIdx.x; red[t] = v; __syncthreads(); for (int o = 128; o > 0; o >>= 1) { if (t < o) red[t] += red[t + o]; __syncthreads(); } const float r = red[0]; __syncthreads(); return r; }
__global__ void dbg_check(DbgIn di, const float* xcur, unsigned char* ws, int stage) {
    __shared__ float red[256]; __shared__ float act[3584]; __shared__ float hrow[1024];
    const int t = threadIdx.x; float* W = (float*)(ws + WS_CTL) + 16000;
    const unsigned* sl = (const unsigned*)(ws + WS_SLOT); const unsigned* rt = (const unsigned*)(ws + WS_ROUTE); const bf16_t* hp = (const bf16_t*)(ws + WS_HP); const bf16_t* ac = (const bf16_t*)(ws + WS_ACTC);
    const int toks[4] = {0, 5000, 12000, 16383}; float worst = 0.f; int nchk = 0;
    for (int q = 0; q < 4; ++q) for (int kk = 0; kk < 2; ++kk) { const int tok = toks[q]; const unsigned e = rt[tok * 8 + kk], sidx = sl[tok * 4 + kk]; const int ch = sidx >= (unsigned)(HALFT * 256) ? 1 : 0;
        if (stage == 1) {
            float ss = 0.f; for (int c = t; c < 1024; c += 256) { const float x = xcur[(size_t)tok * 1024 + c]; ss += x * x; } ss = dbg_block_sum(ss, red);
            const float rs = 1.f / sqrtf(ss / 1024.f + EPS); float num = 0.f, den = 0.f;
            for (int c = t; c < 1024; c += 256) { const float h = xcur[(size_t)tok * 1024 + c] * rs * di.in[I_NORM_FFN][1024 + c], f = bf2f(hp[(size_t)sidx * 1024 + c]); num += (h - f) * (h - f); den += h * h; }
            num = dbg_block_sum(num, red); den = dbg_block_sum(den, red); worst = fmaxf(worst, sqrtf(num / fmaxf(den, 1e-20f))); ++nchk;
        } else if ((stage == 2 && ch == 0) || (stage == 4 && ch == 1)) {
            for (int c = t; c < 1024; c += 256) hrow[c] = bf2f(hp[(size_t)sidx * 1024 + c]); __syncthreads();
            const float* wg = di.in[I_MOE_WG] + (size_t)e * DM * DFFE; const float* wu = di.in[I_MOE_WU] + (size_t)e * DM * DFFE; float num = 0.f, den = 0.f;
            for (int j = t; j < 3584; j += 256) { float g = 0.f, u = 0.f; for (int k2 = 0; k2 < 1024; ++k2) { g += hrow[k2] * wg[(size_t)k2 * DFFE + j]; u += hrow[k2] * wu[(size_t)k2 * DFFE + j]; }
                const float a = g / (1.f + expf(-g)) * u, f = bf2f(ac[((size_t)sidx - (size_t)ch * HALFT * 256) * 3584 + j]); num += (a - f) * (a - f); den += a * a; }
            num = dbg_block_sum(num, red); den = dbg_block_sum(den, red); worst = fmaxf(worst, sqrtf(num / fmaxf(den, 1e-20f))); ++nchk; __syncthreads();
        } else if ((stage == 3 && ch == 0) || (stage == 5 && ch == 1)) {
            for (int j = t; j < 3584; j += 256) act[j] = bf2f(ac[((size_t)sidx - (size_t)ch * HALFT * 256) * 3584 + j]); __syncthreads();
            const float* wd = di.in[I_MOE_WD] + (size_t)e * DFFE * DM; float num = 0.f, den = 0.f;
            for (int n = t; n < 1024; n += 256) { float y = 0.f; for (int j = 0; j < 3584; ++j) y += act[j] * wd[(size_t)j * DM + n]; const float f = bf2f(hp[(size_t)sidx * 1024 + n]); num += (y - f) * (y - f); den += y * y; }
            num = dbg_block_sum(num, red); den = dbg_block_sum(den, red); worst = fmaxf(worst, sqrtf(num / fmaxf(den, 1e-20f))); ++nchk; __syncthreads();
        } }
    if (stage == 1) {
        float mism = 0.f, werr = 0.f;
        for (int q = 0; q < 64; ++q) { const int tok = q * 251 + 3;
            float ss = 0.f; for (int c = t; c < 1024; c += 256) { const float x = xcur[(size_t)tok * 1024 + c]; ss += x * x; } ss = dbg_block_sum(ss, red);
            const float rs = 1.f / sqrtf(ss / 1024.f + EPS); float lg[8];
            for (int e = 0; e < 8; ++e) { float a = 0.f; for (int c = t; c < 1024; c += 256) a += xcur[(size_t)tok * 1024 + c] * rs * di.in[I_NORM_FFN][1024 + c] * di.in[I_ROUTER][c * 8 + e]; lg[e] = dbg_block_sum(a, red); }
            int i1 = 0; for (int e = 1; e < 8; ++e) if (lg[e] > lg[i1]) i1 = e; int i2 = -1; for (int e = 0; e < 8; ++e) if (e != i1 && (i2 < 0 || lg[e] > lg[i2])) i2 = e;
            const float w1 = 1.f / (1.f + expf(lg[i2] - lg[i1]));
            if ((int)rt[tok * 8] != i1 || (int)rt[tok * 8 + 1] != i2) mism += 1.f;
            werr = fmaxf(werr, fabsf(w1 - __builtin_bit_cast(float, rt[tok * 8 + 4]))); }
        if (t == 0) { W[8] = mism; W[9] = werr; } }
    if (stage == 5) {
        float sx = 0.f, sm = 0.f;
        for (int q = 0; q < 4; ++q) { const int tok = toks[q]; const unsigned s1 = sl[tok * 4], s2 = sl[tok * 4 + 1]; const float w1 = __builtin_bit_cast(float, sl[tok * 4 + 2]), w2 = __builtin_bit_cast(float, sl[tok * 4 + 3]);
            for (int c = t; c < 1024; c += 256) { const float x = xcur[(size_t)tok * 1024 + c], m = w1 * bf2f(hp[(size_t)s1 * 1024 + c]) + w2 * bf2f(hp[(size_t)s2 * 1024 + c]); sx += x * x; sm += m * m; } }
        sx = dbg_block_sum(sx, red); sm = dbg_block_sum(sm, red);
        if (t == 0) { W[6] = sx / 4096.f; W[7] = sm / 4096.f; } }
    if (t == 0) { W[stage] = worst; W[10 + stage] = (float)nchk; }
}
__global__ void dbg_attn(unsigned char* ws, int b, int g, int t, int slotw) {
    __shared__ float red[256]; __shared__ float lgt[4096]; __shared__ float pcs[4][256]; __shared__ float osum[4][64]; __shared__ int selb[64]; __shared__ float impv[64];
    const int tid = threadIdx.x, bg = b * 2 + g, tok = b * SEQ + t; float* W = (float*)(ws + WS_CTL) + 16000;
    const bf16_t* qraw = (const bf16_t*)(ws + WS_QRAW) + ((size_t)bg * SEQ + t) * 256; const bf16_t* qrot = (const bf16_t*)(ws + WS_QROT) + ((size_t)bg * SEQ + t) * 256;
    const bf16_t* kc = (const bf16_t*)(ws + WS_KCMP) + (size_t)bg * 256 * 64; const bf16_t* vc = kc + 8 * 256 * 64;
    const bf16_t* kvb = (const bf16_t*)(ws + WS_KV); const float* gt = (const float*)(ws + WS_GATES) + (size_t)tok * 24 + g * 12;
    const int nv = t >= 15 ? ((t - 15) >> 4) : 0, tb = t >> 6;
    for (int i = tid; i < 256; i += 256) osum[i >> 6][i & 63] = 0.f;
    __syncthreads();
    for (int r = 0; r < 4; ++r) {
        float s = -INFINITY; const int c = tid;
        if (c < 255 && c < nv) { s = 0.f; for (int d = 0; d < 64; ++d) s += bf2f(qraw[r * 64 + d]) * bf2f(kc[c * 64 + d]); }
        red[tid] = s; __syncthreads(); for (int o = 128; o > 0; o >>= 1) { if (tid < o) red[tid] = fmaxf(red[tid], red[tid + o]); __syncthreads(); } float m = red[0]; __syncthreads(); if (m == -INFINITY) m = 0.f;
        const float p = s == -INFINITY ? 0.f : exp2f(s - m); const float l = dbg_block_sum(p, red);
        pcs[r][c] = l > 0.f ? p / l : 0.f; __syncthreads();
        if (tid < 64) { float o = 0.f; for (int cc = 0; cc < 255; ++cc) o += bf2f((unsigned short)f2bf(pcs[r][cc])) * bf2f(vc[cc * 64 + tid]); osum[r][tid] += gt[r * 3 + 0] * o; }
        __syncthreads();
    }
    if (tid < 64) { float im = 0.f; for (int j = -1; j < 4; ++j) { const int c = 4 * tid + j; if (c >= 0 && c < 255) for (int r = 0; r < 4; ++r) im += pcs[r][c]; }
        const bool fut = tid > tb, forced = tid == 0 || tid == tb || tid == tb - 1; impv[tid] = fut ? -INFINITY : forced ? INFINITY : im; selb[tid] = 0; }
    __syncthreads();
    if (tid == 0) { for (int k = 0; k < 16; ++k) { int best = -1; float bv = 0.f; for (int n = 0; n < 64; ++n) if (!selb[n] && (best < 0 || impv[n] > bv)) { best = n; bv = impv[n]; } selb[best] = 1; } }
    __syncthreads();
    for (int br = 1; br <= 2; ++br) {
        const bf16_t* kb = kvb + (size_t)(br == 1 ? 2 : 4) * KVSZ + (size_t)bg * SEQ * 64; const bf16_t* vb = kvb + (size_t)(br == 1 ? 3 : 5) * KVSZ + (size_t)bg * SEQ * 64;
        for (int r = 0; r < 4; ++r) {
            float mx = -INFINITY;
            for (int j = tid; j < SEQ; j += 256) { bool ok = j <= t; if (br == 1) ok = ok && selb[j >> 6]; else ok = ok && (t - j) < 512;
                float sv = -INFINITY; if (ok) { sv = 0.f; for (int d = 0; d < 64; ++d) sv += bf2f(qrot[r * 64 + d]) * bf2f(kb[(size_t)j * 64 + d]); } lgt[j] = sv; mx = fmaxf(mx, sv); }
            red[tid] = mx; __syncthreads(); for (int o = 128; o > 0; o >>= 1) { if (tid < o) red[tid] = fmaxf(red[tid], red[tid + o]); __syncthreads(); } const float m = red[0]; __syncthreads();
            float ls = 0.f; for (int j = tid; j < SEQ; j += 256) { const float p = lgt[j] == -INFINITY ? 0.f : exp2f(lgt[j] - m); lgt[j] = p; ls += p; }
            const float l = dbg_block_sum(ls, red);
            if (tid < 64) { float o = 0.f; for (int j = 0; j <= t; ++j) o += lgt[j] * bf2f(vb[(size_t)j * 64 + tid]); osum[r][tid] += gt[r * 3 + br] * o / l; }
            __syncthreads();
        }
    }
    const bf16_t* ab = (const bf16_t*)(ws + WS_AB) + (size_t)tok * 1024 + g * 256;
    float num = 0.f, den = 0.f; { const float o = osum[tid >> 6][tid & 63], f = bf2f(ab[tid]); num = (o - f) * (o - f); den = o * o; }
    num = dbg_block_sum(num, red); den = dbg_block_sum(den, red);
    if (tid == 0) { W[slotw] = sqrtf(num / fmaxf(den, 1e-30f)); W[slotw + 40] = sqrtf(den / 256.f); }
}
__global__ void dbg_mixer(DbgIn di, const float* outp, unsigned char* ws, int stage) {
    __shared__ float red[256]; __shared__ float hrow[1024]; __shared__ float zrow[1816]; __shared__ float hid[256];
    const int t = threadIdx.x; float* W = (float*)(ws + WS_CTL) + 16000;
    const bf16_t* hb = (const bf16_t*)(ws + WS_HB); const bf16_t* kvb = (const bf16_t*)(ws + WS_KV);
    const int toks[4] = {7, 4101, 9000, 16383};
    if (stage == 30) {
        float nq = 0, dq = 0, nr = 0, dr = 0, nk = 0, dk = 0, nkr = 0, dkr = 0, nu = 0, du = 0, ng = 0, dg = 0;
        for (int q = 0; q < 4; ++q) { const int tok = toks[q], b = tok >> 12, pos = tok & 4095;
            for (int c = t; c < 1024; c += 256) hrow[c] = bf2f(hb[(size_t)tok * 1024 + c]); __syncthreads();
            for (int n = t; n < 1816; n += 256) { float a = 0.f; for (int k = 0; k < 1024; ++k) a += hrow[k] * di.in[I_W_IN][(size_t)k * 1816 + n]; zrow[n] = a; } __syncthreads();
            for (int n = t; n < 1816; n += 256) { const float z = zrow[n];
                if (n < 512) { const int g = n >> 8, c = n & 255, d = n & 63; const size_t idx = ((size_t)(b * 2 + g) * SEQ + pos) * 256 + c;
                    const float f = bf2f(((const bf16_t*)(ws + WS_QRAW))[idx]) / C2; nq += (z - f) * (z - f); dq += z * z;
                    float zr = z; if (d < 16) { const int j = d & 7; const double inv = pow(500000.0, -(double)j / 8.0); const float cs = (float)cos((double)pos * inv), sn = (float)sin((double)pos * inv);
                        zr = d < 8 ? z * cs - zrow[n + 8] * sn : z * cs + zrow[n - 8] * sn; }
                    const float fr = bf2f(((const bf16_t*)(ws + WS_QROT))[idx]) / C2; nr += (zr - fr) * (zr - fr); dr += zr * zr;
                } else if (n < 1280) { const int m = n - 512, i = m >> 7, g = (m >> 6) & 1, d = m & 63; const float f = bf2f(kvb[(size_t)i * KVSZ + ((size_t)(b * 2 + g) * SEQ + pos) * 64 + d]);
                    if (i == 2 || i == 4) { float zr = z; if (d < 16) { const int j = d & 7; const double inv = pow(500000.0, -(double)j / 8.0); const float cs = (float)cos((double)pos * inv), sn = (float)sin((double)pos * inv);
                            zr = d < 8 ? z * cs - zrow[n + 8] * sn : z * cs + zrow[n - 8] * sn; } nkr += (zr - f) * (zr - f); dkr += zr * zr; }
                    else { nk += (z - f) * (z - f); dk += z * z; }
                } else if (n < 1304) { const float sg = 1.f / (1.f + expf(-z)), f = ((const float*)(ws + WS_GATES))[(size_t)tok * 24 + (n - 1280)]; ng += (sg - f) * (sg - f); dg += sg * sg;
                } else { const float f = bf2f(((const bf16_t*)(ws + WS_U))[(size_t)tok * 512 + (n - 1304)]); nu += (z - f) * (z - f); du += z * z; } }
            __syncthreads(); }
        nq = dbg_block_sum(nq, red); dq = dbg_block_sum(dq, red); nr = dbg_block_sum(nr, red); dr = dbg_block_sum(dr, red); nk = dbg_block_sum(nk, red); dk = dbg_block_sum(dk, red);
        nkr = dbg_block_sum(nkr, red); dkr = dbg_block_sum(dkr, red); nu = dbg_block_sum(nu, red); du = dbg_block_sum(du, red); ng = dbg_block_sum(ng, red); dg = dbg_block_sum(dg, red);
        if (t == 0) { W[30] = sqrtf(nq / dq); W[31] = sqrtf(nr / dr); W[32] = sqrtf(nk / dk); W[33] = sqrtf(nkr / dkr); W[34] = sqrtf(nu / du); W[35] = sqrtf(ng / dg); }
    }
    if (stage == 31) {
        float nc = 0, dc = 0, nd = 0, dd = 0;
        const int cs_[4] = {0, 17, 200, 254};
        for (int q = 0; q < 4; ++q) for (int kv = 0; kv < 2; ++kv) { const int bg = (q * 3 + 1) & 7, c = cs_[q];
            const bf16_t* src = kvb + (size_t)kv * KVSZ + ((size_t)bg * SEQ + 16 * c) * 64; const float* pe = di.in[kv ? I_PE_V : I_PE_K]; const float* w1 = di.in[kv ? I_W1_V : I_W1_K]; const float* b1 = di.in[kv ? I_B1_V : I_B1_K]; const float* w2 = di.in[kv ? I_W2_V : I_W2_K];
            { float a = b1[t]; for (int f = 0; f < 2048; ++f) a += (bf2f(src[f]) + pe[f]) * w1[(size_t)f * 256 + t]; const float y = 0.7978845608f * (a + 0.044715f * a * a * a); hid[t] = 0.5f * a * (1.f + tanhf(y)); } __syncthreads();
            if (t < 64) { float o = 0.f; for (int h = 0; h < 256; ++h) o += hid[h] * w2[h * 64 + t]; const float f = bf2f(((const bf16_t*)(ws + WS_KCMP))[(size_t)kv * 8 * 256 * 64 + ((size_t)bg * 256 + c) * 64 + t]); nc += (o - f) * (o - f); dc += o * o; } __syncthreads(); }
        for (int q = 0; q < 4; ++q) { const int tok = toks[q], pos = tok & 4095; for (int c = t; c < 512; c += 256) { const int w = 2 << (c >> 7), n = (pos + 1) < w ? (pos + 1) : w; float sm = 0.f; const bf16_t* ub = (const bf16_t*)(ws + WS_U);
                for (int i = 0; i < n; ++i) sm += bf2f(ub[(size_t)(tok - i) * 512 + c]); const float d = sm / n - bf2f(ub[(size_t)tok * 512 + c]), f = bf2f(((const bf16_t*)(ws + WS_AB))[(size_t)tok * 1024 + 512 + c]); nd += (d - f) * (d - f); dd += d * d; } }
        nc = dbg_block_sum(nc, red); dc = dbg_block_sum(dc, red); nd = dbg_block_sum(nd, red); dd = dbg_block_sum(dd, red);
        if (t == 0) { W[36] = sqrtf(nc / dc); W[37] = sqrtf(nd / dd); }
    }
    if (stage == 32) {
        float nn = 0, dn = 0; const bf16_t* ab = (const bf16_t*)(ws + WS_AB);
        for (int q = 0; q < 4; ++q) { const int tok = toks[q];
            for (int c = t; c < 1024; c += 256) hrow[c] = bf2f(ab[(size_t)tok * 1024 + c]); __syncthreads();
            for (int ge = t; ge < 512; ge += 256) { const int g = ge >> 7, e = ge & 127; float y = 0.f; for (int c = 0; c < 128; ++c) y += hrow[512 + g * 128 + c] * di.in[I_W_POOL][((size_t)g * 128 + c) * 128 + e]; zrow[ge] = y * di.in[I_POOL_SCALE][ge]; } __syncthreads();
            for (int n = t; n < 1024; n += 256) { float a = di.in[I_X][(size_t)tok * 1024 + n]; const float x0 = a; for (int k = 0; k < 512; ++k) a += hrow[k] * di.in[I_W_OUT][(size_t)k * 1024 + n]; for (int k = 0; k < 512; ++k) a += zrow[k] * di.in[I_W_OUT][(size_t)(512 + k) * 1024 + n];
                const float f = outp[(size_t)tok * 1024 + n]; nn += (a - f) * (a - f); dn += (a - x0) * (a - x0); } __syncthreads(); }
        nn = dbg_block_sum(nn, red); dn = dbg_block_sum(dn, red);
        if (t == 0) W[38] = sqrtf(nn / dn);
    }
}
__global__ void dbg_moe_tok(DbgIn di, const float* xcur, unsigned char* ws) {
    __shared__ float red[256]; __shared__ float hrow[1024]; __shared__ float act[3584]; __shared__ float ynaive[1024];
    const int t = threadIdx.x, tok = blockIdx.x * 251 + 3; float* W = (float*)(ws + WS_CTL) + 16000;
    const unsigned* sl = (const unsigned*)(ws + WS_SLOT); const unsigned* rt = (const unsigned*)(ws + WS_ROUTE); const bf16_t* hp = (const bf16_t*)(ws + WS_HP);
    float ss = 0.f; for (int c = t; c < 1024; c += 256) { const float x = xcur[(size_t)tok * 1024 + c]; ss += x * x; } ss = dbg_block_sum(ss, red);
    const float rs = 1.f / sqrtf(ss / 1024.f + EPS);
    for (int c = t; c < 1024; c += 256) { hrow[c] = xcur[(size_t)tok * 1024 + c] * rs * di.in[I_NORM_FFN][1024 + c]; ynaive[c] = 0.f; } __syncthreads();
    float lg[8]; for (int e = 0; e < 8; ++e) { float a = 0.f; for (int c = t; c < 1024; c += 256) a += hrow[c] * di.in[I_ROUTER][c * 8 + e]; lg[e] = dbg_block_sum(a, red); }
    int i1 = 0; for (int e = 1; e < 8; ++e) if (lg[e] > lg[i1]) i1 = e; int i2 = -1; for (int e = 0; e < 8; ++e) if (e != i1 && (i2 < 0 || lg[e] > lg[i2])) i2 = e;
    const float w1 = 1.f / (1.f + expf(lg[i2] - lg[i1]));
    for (int kk = 0; kk < 2; ++kk) { const int e = kk ? i2 : i1; const float wgt = kk ? 1.f - w1 : w1;
        const float* wg = di.in[I_MOE_WG] + (size_t)e * DM * DFFE; const float* wu = di.in[I_MOE_WU] + (size_t)e * DM * DFFE; const float* wd = di.in[I_MOE_WD] + (size_t)e * DFFE * DM;
        for (int j = t; j < 3584; j += 256) { float g = 0.f, u = 0.f; for (int k2 = 0; k2 < 1024; ++k2) { g += hrow[k2] * wg[(size_t)k2 * DFFE + j]; u += hrow[k2] * wu[(size_t)k2 * DFFE + j]; } act[j] = g / (1.f + expf(-g)) * u; } __syncthreads();
        for (int n = t; n < 1024; n += 256) { float y = 0.f; for (int j = 0; j < 3584; ++j) y += act[j] * wd[(size_t)j * DM + n]; ynaive[n] += wgt * y; } __syncthreads(); }
    const unsigned s1 = sl[tok * 4], s2 = sl[tok * 4 + 1]; const float f1 = __builtin_bit_cast(float, sl[tok * 4 + 2]), f2 = __builtin_bit_cast(float, sl[tok * 4 + 3]);
    float num = 0.f, den = 0.f; for (int n = t; n < 1024; n += 256) { const float m = f1 * bf2f(hp[(size_t)s1 * 1024 + n]) + f2 * bf2f(hp[(size_t)s2 * 1024 + n]); num += (m - ynaive[n]) * (m - ynaive[n]); den += ynaive[n] * ynaive[n]; }
    num = dbg_block_sum(num, red); den = dbg_block_sum(den, red);
    if (t == 0) { const float er = sqrtf(num / den); atomicMax((unsigned*)&W[50], __builtin_bit_cast(unsigned, er)); if (er > 0.1f) atomicAdd(&W[51], 1.f); atomicAdd(&W[52], er / 64.f); }
}
#ifndef DBGBR
#define DBGBR -1
#endif
__global__ void dbg_setgates(unsigned char* ws, int br) { float* g = (float*)(ws + WS_GATES); for (size_t i = (size_t)blockIdx.x * 256 + threadIdx.x; i < (size_t)T * 24; i += (size_t)gridDim.x * 256) g[i] = ((int)(i % 3) == br) ? 1.f : 0.f; }
#ifndef DBGV1
#define DBGV1 0
#endif
__global__ void dbg_setv(unsigned char* ws) { bf16_t* kv = (bf16_t*)(ws + WS_KV); for (size_t i = (size_t)blockIdx.x * 256 + threadIdx.x; i < KVSZ; i += (size_t)gridDim.x * 256) { kv[3 * KVSZ + i] = 0x3F80; kv[5 * KVSZ + i] = 0x3F80; } }
__global__ void dbg_tail(float* out, unsigned char* ws) {
    const int t = threadIdx.x; const float* W = (const float*)(ws + WS_CTL) + 16000; float k = 0.f;
    if (DBG == 100) { for (int i = 1; i < 10; ++i) if (W[i] > 0.05f) { k = (float)i; break; } }
    else if (DBG == 103) { int m = 0; for (int i = 0; i < 6; ++i) if (!(W[20 + i] <= 0.05f)) m |= 1 << i; k = (float)m; }
    else if (DBG == 104) { int m = 0; for (int i = 6; i < 8; ++i) if (!(W[20 + i] <= 0.05f)) m |= 1 << (i - 6); k = (float)m; }
    else if (DBG == 105 || DBG == 106) { float mn = 1e30f, mx = 0.f; for (int i = 0; i < 8; ++i) { mn = fminf(mn, W[20 + i]); mx = fmaxf(mx, W[20 + i]); }
        k = rintf(10.f * (log10f(fmaxf(DBG == 105 ? mn : mx, 1e-6f)) + 6.f)); k = fminf(fmaxf(k, 0.f), 89.f); }
    else if (DBG == 107) { for (int i = 30; i <= 38; ++i) if (!(W[i] <= 0.03f)) { k = (float)(i - 29); break; } }
    else if (DBG == 101) { for (int i = 0; i < 8; ++i) if (!(W[20 + i] <= 0.05f)) { k = (float)(i + 1); break; } }
    else { k = rintf(10.f * (log10f(fmaxf(W[DBG], 1e-6f)) + 6.f)); k = fminf(fmaxf(k, 0.f), 89.f); }
    const float c = sqrtf(0.1f * k + 0.02f);
    for (size_t i = (size_t)blockIdx.x * 256 + t; i < (size_t)T * DM; i += (size_t)gridDim.x * 256) out[i] = c;
}
#endif

extern "C" void kernel_launch(void* const* d_in, const int* in_sizes, int n_in, void* d_out, int out_size, void* d_ws, size_t ws_size, hipStream_t stream) {
    static int grid = 0;
    if (grid == 0) {
        if (n_in != 30 || out_size != T * DM || ws_size < WS_END) { fprintf(stderr, "kernel_launch: unexpected problem shape / workspace (%d inputs, out %d, ws %zu)\n", n_in, out_size, ws_size); grid = -1; return; }
        int dev = 0, cus = 0;
        if (hipGetDevice(&dev) != hipSuccess || hipDeviceGetAttribute(&cus, hipDeviceAttributeMultiprocessorCount, dev) != hipSuccess) { grid = -1; return; }
        if (hipFuncSetAttribute((const void*)fwd, hipFuncAttributeMaxDynamicSharedMemorySize, LDS_BYTES) != hipSuccess) { fprintf(stderr, "kernel_launch: hipFuncSetAttribute failed\n"); grid = -1; return; }
        int per_cu = 0;
        if (hipOccupancyMaxActiveBlocksPerMultiprocessor(&per_cu, (const void*)fwd, NWAVES * 64, LDS_BYTES) != hipSuccess || per_cu < 1) { fprintf(stderr, "kernel_launch: occupancy query says %d\n", per_cu); }
        (void)hipGetLastError();
        if (cus != 256) { fprintf(stderr, "kernel_launch: built for a 256-CU device, found %d\n", cus); grid = -1; return; }
        grid = cus;
    }
    if (grid < 0) return;
    if (hipMemsetAsync((char*)d_ws + WS_CTL, 0, CTL_ZERO_BYTES, stream) != hipSuccess) return;
    Args a{};
    for (int i = 0; i < 30; ++i) a.in[i] = (const float*)d_in[i];
    a.out = (float*)d_out; a.ws = (unsigned char*)d_ws;
#if MK_PER_PHASE
    int ids[64]; int n = 0;
    ids[n++] = PH_PRO; ids[n++] = PH_KV;
    for (int l = 0; l < NL; ++l) { const int pb = PH_L0 + l * PH_LSTRIDE; for (int k = 0; k < 9; ++k) ids[n++] = pb + k; const int nf = l == 0 ? 4 : 7; for (int k = 0; k < nf; ++k) ids[n++] = pb + PO_F0 + k; }
    for (int i = 0; i < n; ++i) { a.ph_lo = ids[i]; a.ph_hi = ids[i] + 1; hipLaunchKernelGGL(fwd, dim3(grid), dim3(NWAVES * 64), LDS_BYTES, stream, a);
#if DBG
        { DbgIn di; for (int q = 0; q < 30; ++q) di.in[q] = (const float*)d_in[q]; const int st = ids[i] - (PH_L0 + PH_LSTRIDE + PO_F0);
          if (st == 5) hipLaunchKernelGGL(dbg_moe_tok, dim3(64), dim3(256), 0, stream, di, (const float*)d_out, (unsigned char*)d_ws);
          if (st >= 1 && st <= 5) hipLaunchKernelGGL(dbg_check, dim3(1), dim3(256), 0, stream, di, (const float*)d_out, (unsigned char*)d_ws, st);
          if (ids[i] == PH_L0 + PO_WIN && DBGBR >= 0) hipLaunchKernelGGL(dbg_setgates, dim3(256), dim3(256), 0, stream, (unsigned char*)d_ws, DBGBR);
          if (ids[i] == PH_L0 + PO_WIN && DBGV1) hipLaunchKernelGGL(dbg_setv, dim3(256), dim3(256), 0, stream, (unsigned char*)d_ws);
          if (ids[i] == PH_L0 + PO_WIN) hipLaunchKernelGGL(dbg_mixer, dim3(1), dim3(256), 0, stream, di, (const float*)d_out, (unsigned char*)d_ws, 30);
          if (ids[i] == PH_L0 + PO_CMP) hipLaunchKernelGGL(dbg_mixer, dim3(1), dim3(256), 0, stream, di, (const float*)d_out, (unsigned char*)d_ws, 31);
          if (ids[i] == PH_L0 + PO_WOUT) hipLaunchKernelGGL(dbg_mixer, dim3(1), dim3(256), 0, stream, di, (const float*)d_out, (unsigned char*)d_ws, 32);
          if (ids[i] == PH_L0 + PO_ATT) { const int pt[8] = {5, 40, 100, 700, 1000, 1500, 3000, 4095};
            for (int q = 0; q < 8; ++q) hipLaunchKernelGGL(dbg_attn, dim3(1), dim3(256), 0, stream, (unsigned char*)d_ws, q & 3, q & 1, pt[q], 20 + q); } }
#endif
    }
#else
    a.ph_lo = 0; a.ph_hi = 1000;
    hipLaunchKernelGGL(fwd, dim3(grid), dim3(NWAVES * 64), LDS_BYTES, stream, a);
#endif
#if DBG
    hipLaunchKernelGGL(dbg_tail, dim3(64), dim3(256), 0, stream, (float*)d_out, (unsigned char*)d_ws);
#endif
}
```

```cpp
#include <hip/hip_runtime.h>
#include <cstdio>
#include <cstdint>
#include <cmath>

#ifndef DBG
#define DBG 0
#endif
#ifndef REP_MASK
#define REP_MASK 0u
#endif
#define REPN(b) (((REP_MASK >> (b)) & 1u) ? 2 : 1)
#ifndef REP_ATT
#define REP_ATT 1
#endif
#ifndef REP_PRO
#define REP_PRO 1
#endif
#ifndef REP_CMP
#define REP_CMP 1
#endif
#ifndef MK_PER_PHASE
#define MK_PER_PHASE 0
#endif

#define LAS __attribute__((address_space(3)))
#define GAS __attribute__((address_space(1)))
typedef unsigned short bf16_t;
typedef short bf16x8 __attribute__((ext_vector_type(8)));
typedef short s16x4 __attribute__((ext_vector_type(4)));
typedef float f32x2 __attribute__((ext_vector_type(2)));
typedef float f32x4 __attribute__((ext_vector_type(4)));
typedef float f32x16 __attribute__((ext_vector_type(16)));
typedef unsigned u32x4 __attribute__((ext_vector_type(4)));
typedef unsigned u32x2 __attribute__((ext_vector_type(2)));

constexpr int NB = 4, SEQ = 4096, DM = 1024, T = NB * SEQ, NL = 2;
constexpr int ZW = 2048;
constexpr int DFF = 2816, DFFE = 3584, NE = 8;
constexpr int MAXT = 136, HALFT = 64, CH1T = MAXT - HALFT;
constexpr float EPS = 1e-6f;
constexpr float C2 = 0.125f * 1.4426950408889634f;
constexpr float CX = 0.0625f * 1.4426950408889634f;

constexpr size_t MiB = 1u << 20;
constexpr size_t WS_CTL = 0, CTL_ZERO_BYTES = 1 * MiB;
constexpr size_t WS_ROPE = 1 * MiB;
constexpr size_t WS_BIAS = 1 * MiB + 512 * 1024;
constexpr size_t WS_ROUTE = 2 * MiB;
constexpr size_t WS_CNTG = 2 * MiB + 512 * 1024;
constexpr size_t WS_TILE = 2 * MiB + 640 * 1024;
constexpr size_t WS_SLOT = 1 * MiB + 512 * 1024;
constexpr size_t WS_YB = 3 * MiB;
constexpr size_t WS_GATES = 4 * MiB;
constexpr size_t WS_KCMP = 6 * MiB;
constexpr size_t WS_HID = 7 * MiB;
constexpr size_t WS_MN = 9 * MiB;
constexpr size_t WS_KX = 13 * MiB;
constexpr size_t WS_VXT = 17 * MiB;
constexpr size_t WS_WIN = 21 * MiB;
constexpr size_t WS_WOUT = 29 * MiB;
constexpr size_t WS_WQ = 33 * MiB, WS_WO = 37 * MiB, WS_WK = 41 * MiB, WS_WV = 45 * MiB;
constexpr size_t WS_CW1 = 49 * MiB;
constexpr size_t WS_CW2 = 53 * MiB;
constexpr size_t WS_FGU = 54 * MiB;
constexpr size_t WS_FD = 65 * MiB;
constexpr size_t WS_MGU = 71 * MiB;
constexpr size_t WS_MD = 183 * MiB;
constexpr size_t WS_HB = 239 * MiB;
constexpr size_t WS_R = 271 * MiB;
constexpr size_t WS_QRAW = WS_R, WS_QROT = WS_R + 16 * MiB, WS_KV = WS_R + 32 * MiB  , WS_U = WS_R + 57 * MiB, WS_AB = WS_R + 73 * MiB;
constexpr size_t WS_QX = WS_R, WS_PB = WS_R + 32 * MiB, WS_OX = WS_R + 73 * MiB;
constexpr size_t WS_ACT0 = WS_R;
constexpr size_t WS_HP = WS_HB;
constexpr size_t WS_ACTC = 307 * MiB;
constexpr size_t WS_END = 433 * MiB;
constexpr size_t KVSZ = (size_t)NB * 2 * SEQ * 64;
static_assert(WS_HP + (size_t)MAXT * 256 * 1024 * 2 <= WS_ACTC && WS_ACTC + (size_t)CH1T * 256 * DFFE * 2 <= WS_END && WS_YB + (size_t)MAXT * 256 * 1024 * 2 <= WS_MGU && WS_SLOT + (size_t)T * 16 <= 2 * MiB, "ws map");
static_assert(WS_MGU + (size_t)NE * 7168 * 1024 * 2 <= WS_MD && WS_MD + (size_t)NE * 1024 * DFFE * 2 <= WS_HB, "ws map");

constexpr int CW_TMO = 0, CW_BAR = 4096, CW_BIAS = 8192, CW_SS = 32768;
typedef unsigned long long ssq_t;
#define SSP(i) ((ssq_t*)((unsigned*)(ws + WS_CTL) + CW_SS) + (size_t)(i) * T)
__device__ __forceinline__ float ss_rs(const ssq_t* ss, int row) { return 1.0f / sqrtf((float)((double)ss[row] * (1.0 / 4294967296.0)) * (1.f / DM) + EPS); }
__device__ __forceinline__ ssq_t ss_fix(float v) { return (ssq_t)((double)v * 4294967296.0); }

constexpr int RING_BYTES = 131072;
constexpr int XTRA_OFF = RING_BYTES, XTRA_BYTES = 24576;
constexpr int LDSCTL_OFF = XTRA_OFF + XTRA_BYTES, LDS_BYTES = LDSCTL_OFF + 512;
constexpr int NWAVES = 8;

#define LDS_WAIT() asm volatile("s_waitcnt lgkmcnt(0)" ::: "memory")
#define VM_WAIT() asm volatile("s_waitcnt vmcnt(0)" ::: "memory")
#define RLX_AGENT __ATOMIC_RELAXED, __HIP_MEMORY_SCOPE_AGENT

__device__ __forceinline__ unsigned f2bf(float f) { unsigned u = __builtin_bit_cast(unsigned, f); return (u + 0x7fffu + ((u >> 16) & 1u)) >> 16; }
__device__ __forceinline__ unsigned pk2(float lo, float hi) { return f2bf(lo) | (f2bf(hi) << 16); }
__device__ __forceinline__ float bf2f(unsigned short h) { return __builtin_bit_cast(float, (unsigned)h << 16); }
__device__ __forceinline__ unsigned cvt_pk_bf16(float lo, float hi) { unsigned r; asm volatile("v_cvt_pk_bf16_f32 %0, %1, %2" : "=v"(r) : "v"(lo), "v"(hi)); return r; }
template <int M> __device__ __forceinline__ float xor_get(float v) {
    static_assert(M > 0 && M < 32, "xor_get: within 32 lanes");
    return __builtin_bit_cast(float, __builtin_amdgcn_ds_swizzle(__builtin_bit_cast(int, v), (M << 10) | 0x1f));
}
__device__ __forceinline__ void half_swap(float v, float& lo, float& hi) {
    unsigned a = __builtin_bit_cast(unsigned, v), b = a;
    asm volatile("s_nop 1\n\tv_permlane32_swap_b32 %0, %1\n\ts_nop 1" : "+v"(a), "+v"(b));
    lo = __builtin_bit_cast(float, a); hi = __builtin_bit_cast(float, b);
}
__device__ __forceinline__ float xor32_sum(float v) { float lo, hi; half_swap(v, lo, hi); return lo + hi; }
__device__ __forceinline__ float xor32_max(float v) { float lo, hi; half_swap(v, lo, hi); return fmaxf(lo, hi); }
__device__ __forceinline__ float wave_sum(float v) {
    v += xor_get<1>(v); v += xor_get<2>(v); v += xor_get<4>(v); v += xor_get<8>(v); v += xor_get<16>(v);
    return xor32_sum(v);
}
__device__ __forceinline__ float fast_exp2(float x) { return __builtin_amdgcn_exp2f(x); }

namespace pg8 {
constexpr int BM = 256, BK = 64, HALF = 128, HTB = HALF * BK * 2, NXCD = 8, WGM = 8;
__host__ __device__ __forceinline__ int lds_byte(int r, int c) { const int st = (r >> 4) * 2 + (c >> 5), rr = r & 15, cc = c & 31, ob = rr * 64 + cc * 2; return st * 1024 + (ob ^ (((ob >> 9) & 1) << 5)); }
__host__ __device__ __forceinline__ void stage_rc(int b, int& R, int& C) { const int st = b / 1024, sb = b % 1024, swz = sb ^ (((sb >> 9) & 1) << 5); R = (st >> 1) * 16 + swz / 64; C = (st & 1) * 32 + (swz % 64) / 2; }
__host__ __device__ __forceinline__ int perm32(int rho) { const int n = rho >> 4, i = rho & 15; return 8 * (i >> 2) + 4 * n + (i & 3); }

struct Unit { int pm, pn; long aoff, boff, coff; };
struct Gemm { const char* A; const char* Bt; int K, lda, ldb; };

struct TileOrder {
    int nM, nN, nwg, G, c;
    __device__ void init(int nM_, int nN_, int G_, int c_) { nM = nM_; nN = nN_; nwg = nM * nN; G = G_; c = c_; }
    __device__ bool tile(int i, int& pm, int& pn) const {
        const long L = (long)i * G + c; if (L >= nwg) return false;
        int wgid = (int)L; { const int q = nwg / NXCD, r = nwg % NXCD, xcd = wgid % NXCD, off = wgid / NXCD; wgid = (xcd < r ? xcd * (q + 1) : r * (q + 1) + (xcd - r) * q) + off; }
        const int nig = WGM * nN, gid = wgid / nig, fm = gid * WGM, gsz = (nM - fm) < WGM ? (nM - fm) : WGM;
        pm = fm + ((wgid % nig) % gsz); pn = (wgid % nig) / gsz; return true;
    }
};

template <class Epi, class Sched, bool ALIGN_EPI, bool SP2>
__device__ __forceinline__ void gemm_phase(LAS unsigned char* lds, const Gemm g, const Sched S, const Epi E, int tid_in) {
    int tid_ = tid_in; asm volatile("" : "+v"(tid_));
    const int tid = tid_, wid = __builtin_amdgcn_readfirstlane(tid >> 6), lane = tid & 63, wr = wid >> 2, wc = wid & 3, fr = lane & 15, fq = lane >> 4;
    const int K = g.K, nt = K / BK;
    unsigned voffA[2], voffB[2];
#pragma unroll
    for (int i = 0; i < 2; ++i) { int R, C; stage_rc(tid * 16 + i * 8192, R, C); const int Rb = Epi::PERM ? ((R & ~31) + perm32(R & 31)) : R;
        voffA[i] = (unsigned)(R * g.lda + C) * 2u; voffB[i] = (unsigned)(Rb * g.ldb + C) * 2u; }
    const size_t kstep = (size_t)(BK * 2);
    const size_t hstepA = (size_t)HALF * g.lda * 2, hstepB = (size_t)HALF * g.ldb * 2;
    const unsigned ldsw = (unsigned)wid * 1024u;
    const int aoff = lds_byte(wr * 64 + fr, fq * 8), boff = lds_byte(wc * 32 + fr, fq * 8);
#define PG8_SA(b, h) (((b) * 2 + (h)) * HTB)
#define PG8_SB(b, h) ((4 + (b) * 2 + (h)) * HTB)
#define PG8_STAGE(bufoff, gbase, voff) do { _Pragma("unroll") for (int _i = 0; _i < 2; ++_i) \
        __builtin_amdgcn_global_load_lds((const unsigned*)((const char*)(gbase) + (voff)[_i]), (LAS unsigned*)(lds + (bufoff) + ldsw + _i * 8192), 16, 0, 0); } while (0)
#define PG8_LDA(dst, b, h) do { _Pragma("unroll") for (int m = 0; m < 4; ++m) _Pragma("unroll") for (int k = 0; k < 2; ++k) dst[m][k] = *(const LAS bf16x8*)(lds + PG8_SA(b, h) + aoff + m * 2048 + k * 1024); } while (0)
#define PG8_LDB(dst, b, h) do { _Pragma("unroll") for (int n = 0; n < 2; ++n) _Pragma("unroll") for (int k = 0; k < 2; ++k) dst[n][k] = *(const LAS bf16x8*)(lds + PG8_SB(b, h) + boff + n * 2048 + k * 1024); } while (0)
#define PG8_MMA(ai, bj, At, Bt) do { __builtin_amdgcn_s_setprio(1); _Pragma("unroll") for (int m = 0; m < 4; ++m) _Pragma("unroll") for (int n = 0; n < 2; ++n) _Pragma("unroll") for (int k = 0; k < 2; ++k) \
        acc[ai][bj][m][n] = __builtin_amdgcn_mfma_f32_16x16x32_bf16(Bt[n][k], At[m][k], acc[ai][bj][m][n], 0, 0, 0); __builtin_amdgcn_s_setprio(0); } while (0)
#define PG8_WAIT_V(n) asm volatile("s_waitcnt vmcnt(" #n ")" ::: "memory")
#define PG8_WAIT_L(n) asm volatile("s_waitcnt lgkmcnt(" #n ")" ::: "memory")
#define PG8_BAR __builtin_amdgcn_s_barrier()
#define PG8_SCHED __builtin_amdgcn_sched_barrier(0)
    Unit cur, nxt; int ui = 0;
    if (!S.next(0, cur)) return;
    f32x4 acc[2][2][4][2];
    float zero_ = 0.f; asm volatile("" : "+v"(zero_));
#pragma unroll
    for (int a = 0; a < 2; ++a)
#pragma unroll
        for (int b = 0; b < 2; ++b)
#pragma unroll
            for (int m = 0; m < 4; ++m)
#pragma unroll
                for (int n = 0; n < 2; ++n) acc[a][b][m][n] = (f32x4){zero_, zero_, zero_, zero_};
    bf16x8 At[4][2], B0[2][2], B1[2][2];
    const char* cA = g.A + cur.aoff; const char* cB = g.Bt + cur.boff;
    if constexpr (SP2) {
        PG8_STAGE(PG8_SB(0, 0), cB, voffB); PG8_STAGE(PG8_SB(0, 1), cB + hstepB, voffB); PG8_STAGE(PG8_SA(0, 0), cA, voffA); PG8_STAGE(PG8_SA(0, 1), cA + hstepA, voffA);
        if (wr == 1) PG8_BAR;
        PG8_WAIT_V(2); PG8_BAR;
        PG8_STAGE(PG8_SB(1, 0), cB + kstep, voffB); PG8_STAGE(PG8_SA(1, 0), cA + kstep, voffA); PG8_STAGE(PG8_SB(1, 1), cB + hstepB + kstep, voffB);
        PG8_WAIT_V(6); PG8_BAR;
    } else {
        PG8_STAGE(PG8_SB(0, 0), cB, voffB); PG8_STAGE(PG8_SA(0, 0), cA, voffA); PG8_STAGE(PG8_SB(0, 1), cB + hstepB, voffB); PG8_STAGE(PG8_SA(0, 1), cA + hstepA, voffA);
        if (wr == 1) PG8_BAR;
        PG8_WAIT_V(4); PG8_BAR;
        PG8_STAGE(PG8_SB(1, 0), cB + kstep, voffB); PG8_STAGE(PG8_SA(1, 0), cA + kstep, voffA); PG8_STAGE(PG8_SB(1, 1), cB + hstepB + kstep, voffB);
        PG8_WAIT_V(6); PG8_BAR;
    }
    for (;;) {
        const bool has_next = S.next(ui + 1, nxt);
        const char* nA = has_next ? g.A + nxt.aoff : cA; const char* nB = has_next ? g.Bt + nxt.boff : cB;
#pragma unroll 1
        for (int t = 0; t < nt; t += 2) {
            const bool last = (t == nt - 2);
            const char* a1 = cA + (size_t)(t + 1) * kstep;
            const char* a2 = last ? nA : cA + (size_t)(t + 2) * kstep; const char* b2 = last ? nB : cB + (size_t)(t + 2) * kstep;
            const char* a3 = a2 + kstep; const char* b3 = b2 + kstep;
            if constexpr (SP2) {
            PG8_LDB(B0, 0, 0); PG8_LDB(B1, 0, 1); PG8_SCHED; PG8_LDA(At, 0, 0); PG8_STAGE(PG8_SA(1, 1), a1 + hstepA, voffA);
            PG8_WAIT_V(8); PG8_WAIT_L(0); PG8_BAR; PG8_MMA(0, 0, At, B0); PG8_MMA(0, 1, At, B1); PG8_BAR; PG8_SCHED;
            PG8_LDA(At, 0, 1); PG8_STAGE(PG8_SB(0, 0), b2, voffB); PG8_STAGE(PG8_SB(0, 1), b2 + hstepB, voffB); PG8_STAGE(PG8_SA(0, 0), a2, voffA);
            PG8_WAIT_V(8); PG8_WAIT_L(0); PG8_BAR; PG8_MMA(1, 0, At, B0); PG8_MMA(1, 1, At, B1); PG8_BAR; PG8_SCHED;
            PG8_LDB(B0, 1, 0); PG8_LDB(B1, 1, 1); PG8_SCHED; PG8_LDA(At, 1, 0); PG8_STAGE(PG8_SA(0, 1), a2 + hstepA, voffA);
            PG8_WAIT_V(8); PG8_WAIT_L(0); PG8_BAR; PG8_MMA(0, 0, At, B0); PG8_MMA(0, 1, At, B1); PG8_BAR; PG8_SCHED;
            PG8_LDA(At, 1, 1); PG8_STAGE(PG8_SB(1, 0), b3, voffB); PG8_STAGE(PG8_SB(1, 1), b3 + hstepB, voffB); PG8_STAGE(PG8_SA(1, 0), a3, voffA);
            PG8_WAIT_V(8); PG8_WAIT_L(0); PG8_BAR; PG8_MMA(1, 0, At, B0); PG8_MMA(1, 1, At, B1); PG8_BAR; PG8_SCHED;
            } else {
            PG8_LDB(B0, 0, 0); PG8_SCHED; PG8_LDA(At, 0, 0); PG8_STAGE(PG8_SA(1, 1), a1 + hstepA, voffA);
            PG8_WAIT_L(8); PG8_BAR; PG8_WAIT_L(0); PG8_MMA(0, 0, At, B0); PG8_BAR; PG8_SCHED;
            PG8_LDB(B1, 0, 1); PG8_STAGE(PG8_SB(0, 0), b2, voffB);
            PG8_BAR; PG8_WAIT_L(0); PG8_MMA(0, 1, At, B1); PG8_BAR;
            PG8_LDA(At, 0, 1); PG8_STAGE(PG8_SA(0, 0), a2, voffA);
            PG8_BAR; PG8_WAIT_L(0); PG8_MMA(1, 0, At, B0); PG8_BAR; PG8_SCHED;
            PG8_STAGE(PG8_SB(0, 1), b2 + hstepB, voffB);
            PG8_WAIT_V(6); PG8_BAR; PG8_MMA(1, 1, At, B1); PG8_BAR;
            PG8_LDB(B0, 1, 0); PG8_SCHED; PG8_LDA(At, 1, 0); PG8_STAGE(PG8_SA(0, 1), a2 + hstepA, voffA);
            PG8_WAIT_L(8); PG8_BAR; PG8_WAIT_L(0); PG8_MMA(0, 0, At, B0); PG8_BAR; PG8_SCHED;
            PG8_LDB(B1, 1, 1); PG8_STAGE(PG8_SB(1, 0), b3, voffB);
            PG8_BAR; PG8_WAIT_L(0); PG8_MMA(0, 1, At, B1); PG8_BAR;
            PG8_LDA(At, 1, 1); PG8_STAGE(PG8_SA(1, 0), a3, voffA);
            PG8_BAR; PG8_WAIT_L(0); PG8_MMA(1, 0, At, B0); PG8_BAR; PG8_SCHED;
            PG8_STAGE(PG8_SB(1, 1), b3 + hstepB, voffB);
            PG8_WAIT_V(6); PG8_BAR; PG8_MMA(1, 1, At, B1); PG8_BAR;
            }
        }
        if constexpr (ALIGN_EPI) { if (wr == 0) PG8_BAR; }
        if constexpr (!Epi::AFTER_DRAIN) { E(acc, cur, wr, wc, fr, fq); }
        if (!has_next) break;
#pragma unroll
        for (int a = 0; a < 2; ++a)
#pragma unroll
            for (int b = 0; b < 2; ++b)
#pragma unroll
                for (int m = 0; m < 4; ++m)
#pragma unroll
                    for (int n = 0; n < 2; ++n) acc[a][b][m][n] = (f32x4){zero_, zero_, zero_, zero_};
        cur = nxt; cA = nA; cB = nB; ++ui;
        if constexpr (ALIGN_EPI) { if (wr == 1) PG8_BAR; }
    }
    PG8_WAIT_V(0);
    if constexpr (!ALIGN_EPI) { if (wr == 0) PG8_BAR; }
    PG8_BAR;
    if constexpr (Epi::AFTER_DRAIN) { E.fused(acc, cur, wr, wc, fr, fq, lds, wid, lane); }
#undef PG8_SA
#undef PG8_SB
#undef PG8_STAGE
#undef PG8_LDA
#undef PG8_LDB
#undef PG8_MMA
#undef PG8_WAIT_V
#undef PG8_WAIT_L
#undef PG8_BAR
#undef PG8_SCHED
}
}
using pg8::Unit;
typedef const f32x4 (&AccRef)[2][2][4][2];

struct SchedPlain {
    pg8::TileOrder o; long astep, bstep;
    __device__ void init(int nM, int nN, int lda, int ldb, int G, int c) { o.init(nM, nN, G, c); astep = (long)256 * lda * 2; bstep = (long)256 * ldb * 2; }
    __device__ bool next(int i, Unit& u) const { if (!o.tile(i, u.pm, u.pn)) return false; u.aoff = u.pm * astep; u.boff = u.pn * bstep; u.coff = 0; return true; }
};
struct SchedOne { Unit u; __device__ bool next(int i, Unit& out) const { if (i > 0) return false; out = u; return true; } };
struct SchedKV {
    int G, c;
    __device__ bool next(int i, Unit& u) const {
        const int L = i * G + c; if (L >= 64 || (G == 1 && i > 0)) return false;
        const int job = L >> 4, l = job >> 1, isv = job & 1; u.pm = (L >> 2) & 3; u.pn = L & 3;
        const long mn = (long)WS_MN + (long)l * 2 * MiB, wk = (long)WS_WK + (long)l * 2 * MiB, wv = (long)WS_WV + (long)l * 2 * MiB;
        const long ts = 256L * 1024 * 2;
        if (!isv) { u.aoff = mn + u.pm * ts; u.boff = wk + u.pn * ts; u.coff = ((long)WS_KX + (long)l * 2 * MiB) / 2; }
        else { u.aoff = wv + u.pm * ts; u.boff = mn + u.pn * ts; u.coff = ((long)WS_VXT + (long)l * 2 * MiB) / 2; }
        return true;
    }
};
template <int MODE> struct SchedX {
    pg8::TileOrder o;
    __device__ void init(int G, int c) { o.init(64, 4, G, c); }
    __device__ bool next(int i, Unit& u) const {
        if (!o.tile(i, u.pm, u.pn)) return false;
        const int b = u.pm >> 4, h = u.pn;
        u.aoff = ((long)u.pm * 256 * 1024 + h * 256) * 2;
        u.boff = MODE == 0 ? ((long)b * 256 * 1024 + h * 256) * 2 : ((long)h * 256 * 1024 + b * 256) * 2;
        u.coff = 0; return true;
    }
};
struct SchedMoe {
    pg8::TileOrder o; const unsigned* texp; int t0, nn; long astep, bstep, estep, cstep, khb, khc;
    __device__ bool next(int i, Unit& u) const {
        int pm, pn; if (!o.tile(i, pm, pn)) return false;
        const int rt = t0 + pm; const int e = (int)texp[rt]; const int kh = pn >= nn ? 1 : 0; pn -= kh * nn;
        u.pm = rt; u.pn = pn; u.aoff = pm * astep + kh * khb; u.boff = e * estep + pn * bstep + kh * khb; u.coff = -(long)t0 * cstep + kh * khc; return true;
    }
};

struct EpiPlain {
    static constexpr bool PERM = true, AFTER_DRAIN = false;
    bf16_t* O; int ldc; const ssq_t* ss;
    __device__ __forceinline__ void operator()(AccRef acc, const Unit& u, int wr, int wc, int fr, int fq) const {
        const int row0 = u.pm * 256 + wr * 64 + fr;
        bf16_t* base = O + u.coff + (size_t)row0 * ldc + u.pn * 256 + wc * 32 + 8 * fq;
#pragma unroll
        for (int ai = 0; ai < 2; ++ai)
#pragma unroll
            for (int m = 0; m < 4; ++m) { const float rs = ss ? ss_rs(ss, row0 + ai * 128 + m * 16) : 1.f;
#pragma unroll
                for (int bj = 0; bj < 2; ++bj) { const f32x4 v0 = acc[ai][bj][m][0] * rs, v1 = acc[ai][bj][m][1] * rs;
                    u32x4 w; w.x = cvt_pk_bf16(v0[0], v0[1]); w.y = cvt_pk_bf16(v0[2], v0[3]); w.z = cvt_pk_bf16(v1[0], v1[1]); w.w = cvt_pk_bf16(v1[2], v1[3]);
                    *(u32x4*)(base + (size_t)(ai * 128 + m * 16) * ldc + bj * 128) = w; } }
    }
};
#ifndef ABL
#define ABL 0
#endif
struct EpiRes {
    static constexpr bool PERM = false, AFTER_DRAIN = false;
    const float* src; float* out; bf16_t* xb; ssq_t* ss;
    __device__ __forceinline__ void operator()(AccRef acc, const Unit& u, int wr, int wc, int fr, int fq) const {
        const int row0 = u.pm * 256 + wr * 64 + fr;
        const size_t off0 = (size_t)row0 * DM + u.pn * 256 + wc * 32 + 4 * fq;
#pragma unroll
        for (int ai = 0; ai < 2; ++ai)
#pragma unroll
            for (int m = 0; m < 4; ++m) { float part = 0.f;
#pragma unroll
                for (int bj = 0; bj < 2; ++bj)
#pragma unroll
                    for (int n = 0; n < 2; ++n) { const size_t off = off0 + (size_t)(ai * 128 + m * 16) * DM + bj * 128 + n * 16;
                        const f32x4 s = *(const f32x4*)(src + off) + acc[ai][bj][m][n]; *(f32x4*)(out + off) = s;
                        if (xb) { u32x2 w; w.x = cvt_pk_bf16(s[0], s[1]); w.y = cvt_pk_bf16(s[2], s[3]); *(u32x2*)(xb + off) = w; part += (s[0] * s[0] + s[1] * s[1]) + (s[2] * s[2] + s[3] * s[3]); } }
                if (xb) { part += xor_get<16>(part); part = xor32_sum(part); if (fq == 0) atomicAdd(ss + row0 + ai * 128 + m * 16, ss_fix(part)); } }
    }
};
__device__ __forceinline__ float gelu_tanh(float x) {
    const float y = 0.7978845608028654f * (x + 0.044715f * x * x * x);
    const float e = fast_exp2(y * 2.8853900817779268f);
    const float th = 1.f - 2.f * __builtin_amdgcn_rcpf(e + 1.f);
    return 0.5f * x * (1.f + th);
}
struct EpiHid {
    static constexpr bool PERM = true, AFTER_DRAIN = false;
    bf16_t* O; const long long* bias;
    __device__ __forceinline__ void operator()(AccRef acc, const Unit& u, int wr, int wc, int fr, int fq) const {
        bf16_t* base = O + (size_t)(u.pm * 256 + wr * 64 + fr) * 256 + wc * 32 + 8 * fq;
#pragma unroll
        for (int bj = 0; bj < 2; ++bj) { const long long* bp = bias + bj * 128 + wc * 32 + 8 * fq; f32x4 b0, b1;
#pragma unroll
            for (int j = 0; j < 4; ++j) { b0[j] = (float)((double)bp[j] * (1.0 / 1099511627776.0)); b1[j] = (float)((double)bp[4 + j] * (1.0 / 1099511627776.0)); }
#pragma unroll
            for (int ai = 0; ai < 2; ++ai)
#pragma unroll
                for (int m = 0; m < 4; ++m) { const f32x4 v0 = acc[ai][bj][m][0] + b0, v1 = acc[ai][bj][m][1] + b1;
                    u32x4 w; w.x = cvt_pk_bf16(gelu_tanh(v0[0]), gelu_tanh(v0[1])); w.y = cvt_pk_bf16(gelu_tanh(v0[2]), gelu_tanh(v0[3]));
                    w.z = cvt_pk_bf16(gelu_tanh(v1[0]), gelu_tanh(v1[1])); w.w = cvt_pk_bf16(gelu_tanh(v1[2]), gelu_tanh(v1[3]));
                    *(u32x4*)(base + (size_t)(ai * 128 + m * 16) * 256 + bj * 128) = w; } }
    }
};
struct EpiCmp2 {
    static constexpr bool PERM = true, AFTER_DRAIN = false;
    bf16_t* O;
    __device__ __forceinline__ void operator()(AccRef acc, const Unit& u, int wr, int wc, int fr, int fq) const {
        if (wc >= 2) return;
#pragma unroll
        for (int ai = 0; ai < 2; ++ai)
#pragma unroll
            for (int m = 0; m < 4; ++m) { const int row = u.pm * 256 + ai * 128 + wr * 64 + m * 16 + fr; const f32x4 v0 = acc[ai][0][m][0], v1 = acc[ai][0][m][1];
                u32x4 w; w.x = cvt_pk_bf16(v0[0], v0[1]); w.y = cvt_pk_bf16(v0[2], v0[3]); w.z = cvt_pk_bf16(v1[0], v1[1]); w.w = cvt_pk_bf16(v1[2], v1[3]);
                if ((row & 255) == 255) w = (u32x4){0u, 0u, 0u, 0u};
                *(u32x4*)(O + (size_t)row * 64 + wc * 32 + 8 * fq) = w; }
    }
};
__device__ __forceinline__ float silu_mul(float g, float u) { return g * __builtin_amdgcn_rcpf(1.f + fast_exp2(-1.4426950408889634f * g)) * u; }
struct EpiSwiglu {
    static constexpr bool PERM = true, AFTER_DRAIN = false;
    bf16_t* O; int ldc; const ssq_t* ss;
    __device__ __forceinline__ void operator()(AccRef acc, const Unit& u, int wr, int wc, int fr, int fq) const {
        const int row0 = u.pm * 256 + wr * 64 + fr;
        bf16_t* base = O + u.coff + (size_t)row0 * ldc + u.pn * 128 + wc * 32 + 8 * fq;
#pragma unroll
        for (int ai = 0; ai < 2; ++ai)
#pragma unroll
            for (int m = 0; m < 4; ++m) { const float rs = ss ? ss_rs(ss, row0 + ai * 128 + m * 16) : 1.f;
                const f32x4 g0 = acc[ai][0][m][0] * rs, g1 = acc[ai][0][m][1] * rs, u0 = acc[ai][1][m][0] * rs, u1 = acc[ai][1][m][1] * rs;
                u32x4 w; w.x = cvt_pk_bf16(silu_mul(g0[0], u0[0]), silu_mul(g0[1], u0[1])); w.y = cvt_pk_bf16(silu_mul(g0[2], u0[2]), silu_mul(g0[3], u0[3]));
                w.z = cvt_pk_bf16(silu_mul(g1[0], u1[0]), silu_mul(g1[1], u1[1])); w.w = cvt_pk_bf16(silu_mul(g1[2], u1[2]), silu_mul(g1[3], u1[3]));
                *(u32x4*)(base + (size_t)(ai * 128 + m * 16) * ldc) = w; }
    }
};
struct EpiWin {
    static constexpr bool PERM = true, AFTER_DRAIN = false;
    bf16_t *qraw, *qrot, *kv, *ub; float* gates; const float* rope; const ssq_t* ss;
    __device__ __forceinline__ void operator()(AccRef acc, const Unit& u, int wr, int wc, int fr, int fq) const {
        const int pn = u.pn;
#pragma unroll
        for (int ai = 0; ai < 2; ++ai)
#pragma unroll
            for (int m = 0; m < 4; ++m) {
                const int row = u.pm * 256 + ai * 128 + wr * 64 + m * 16 + fr, b = row >> 12, t = row & 4095;
                const float rs = ss_rs(ss, row);
#pragma unroll
                for (int bj = 0; bj < 2; ++bj) {
                    float v[8];
#pragma unroll
                    for (int j = 0; j < 4; ++j) { v[j] = acc[ai][bj][m][0][j] * rs; v[4 + j] = acc[ai][bj][m][1][j] * rs; }
                    if (pn < 2) {
                        const size_t idx = ((size_t)(b * 2 + pn) * SEQ + t) * 256 + bj * 128 + wc * 32 + 8 * fq;
                        u32x4 w; w.x = cvt_pk_bf16(v[0] * C2, v[1] * C2); w.y = cvt_pk_bf16(v[2] * C2, v[3] * C2); w.z = cvt_pk_bf16(v[4] * C2, v[5] * C2); w.w = cvt_pk_bf16(v[6] * C2, v[7] * C2);
                        *(u32x4*)(qraw + idx) = w;
                        if ((wc & 1) == 0) {
                            float p[8];
#pragma unroll
                            for (int j = 0; j < 8; ++j) p[j] = xor_get<16>(v[j]);
                            if (fq < 2) { const float* rp = rope + (size_t)t * 16;
#pragma unroll
                                for (int j = 0; j < 8; ++j) { const float cs = rp[2 * j], sn = rp[2 * j + 1]; v[j] = fq == 0 ? v[j] * cs - p[j] * sn : v[j] * cs + p[j] * sn; } }
                            w.x = cvt_pk_bf16(v[0] * C2, v[1] * C2); w.y = cvt_pk_bf16(v[2] * C2, v[3] * C2); w.z = cvt_pk_bf16(v[4] * C2, v[5] * C2); w.w = cvt_pk_bf16(v[6] * C2, v[7] * C2);
                        }
                        *(u32x4*)(qrot + idx) = w;
                    } else if (pn < 5) {
                        const int i = 2 * (pn - 2) + bj, g = wc >> 1;
                        if (bj == 0 && pn >= 3 && (wc & 1) == 0) {
                            float p[8];
#pragma unroll
                            for (int j = 0; j < 8; ++j) p[j] = xor_get<16>(v[j]);
                            if (fq < 2) { const float* rp = rope + (size_t)t * 16;
#pragma unroll
                                for (int j = 0; j < 8; ++j) { const float cs = rp[2 * j], sn = rp[2 * j + 1]; v[j] = fq == 0 ? v[j] * cs - p[j] * sn : v[j] * cs + p[j] * sn; } }
                        }
                        u32x4 w; w.x = cvt_pk_bf16(v[0], v[1]); w.y = cvt_pk_bf16(v[2], v[3]); w.z = cvt_pk_bf16(v[4], v[5]); w.w = cvt_pk_bf16(v[6], v[7]);
                        *(u32x4*)(kv + (size_t)i * KVSZ + ((size_t)(b * 2 + g) * SEQ + t) * 64 + (wc & 1) * 32 + 8 * fq) = w;
                    } else if (pn < 7) {
                        u32x4 w; w.x = cvt_pk_bf16(v[0], v[1]); w.y = cvt_pk_bf16(v[2], v[3]); w.z = cvt_pk_bf16(v[4], v[5]); w.w = cvt_pk_bf16(v[6], v[7]);
                        *(u32x4*)(ub + (size_t)row * 512 + (pn - 5) * 256 + bj * 128 + wc * 32 + 8 * fq) = w;
                    } else {
                        if (bj == 0 && wc == 0 && fq < 3) { float* gp = gates + (size_t)row * 24 + 8 * fq;
#pragma unroll
                            for (int j = 0; j < 8; ++j) gp[j] = __builtin_amdgcn_rcpf(1.f + fast_exp2(-1.4426950408889634f * v[j])); }
                    }
                }
            }
    }
};
struct EpiSoftmax {
    static constexpr bool PERM = true, AFTER_DRAIN = true;
    bf16_t* P;
    __device__ __forceinline__ void operator()(AccRef, const Unit&, int, int, int, int) const {}
    __device__ __forceinline__ void fused(f32x4 (&acc)[2][2][4][2], const Unit& u, int wr, int wc, int fr, int fq, LAS unsigned char* lds, int wid, int lane) const {
        LAS float* RM = (LAS float*)lds;
        LAS float* RS = (LAS float*)(lds + 4096);
        float mx[2][4];
#pragma unroll
        for (int ai = 0; ai < 2; ++ai)
#pragma unroll
            for (int m = 0; m < 4; ++m) { float a = -INFINITY;
#pragma unroll
                for (int bj = 0; bj < 2; ++bj)
#pragma unroll
                    for (int n = 0; n < 2; ++n)
#pragma unroll
                        for (int e = 0; e < 4; ++e) a = fmaxf(a, acc[ai][bj][m][n][e]);
                a = fmaxf(a, xor_get<16>(a)); a = xor32_max(a);
                if (fq == 0) RM[(ai * 128 + wr * 64 + m * 16 + fr) * 4 + wc] = a; }
        LDS_WAIT(); __builtin_amdgcn_s_barrier(); asm volatile("" ::: "memory");
#pragma unroll
        for (int ai = 0; ai < 2; ++ai)
#pragma unroll
            for (int m = 0; m < 4; ++m) { const int r = ai * 128 + wr * 64 + m * 16 + fr; const f32x4 q = *(const LAS f32x4*)(RM + r * 4);
                const float mm = fmaxf(fmaxf(q[0], q[1]), fmaxf(q[2], q[3])); float s = 0.f;
#pragma unroll
                for (int bj = 0; bj < 2; ++bj)
#pragma unroll
                    for (int n = 0; n < 2; ++n)
#pragma unroll
                        for (int e = 0; e < 4; ++e) { const float p = fast_exp2((acc[ai][bj][m][n][e] - mm) * CX); acc[ai][bj][m][n][e] = p; s += p; }
                s += xor_get<16>(s); s = xor32_sum(s);
                if (fq == 0) RS[r * 4 + wc] = s; }
        LDS_WAIT(); __builtin_amdgcn_s_barrier(); asm volatile("" ::: "memory");
        bf16_t* base = P + (size_t)(u.pm * 256 + wr * 64 + fr) * DM + u.pn * 256 + wc * 32 + 8 * fq;
#pragma unroll
        for (int ai = 0; ai < 2; ++ai)
#pragma unroll
            for (int m = 0; m < 4; ++m) { const int r = ai * 128 + wr * 64 + m * 16 + fr; const f32x4 q = *(const LAS f32x4*)(RS + r * 4);
                const float inv = 1.f / ((q[0] + q[1]) + (q[2] + q[3]));
#pragma unroll
                for (int bj = 0; bj < 2; ++bj) { u32x4 w;
                    const f32x4 p0 = acc[ai][bj][m][0] * inv, p1 = acc[ai][bj][m][1] * inv;
                    w.x = cvt_pk_bf16(p0[0], p0[1]); w.y = cvt_pk_bf16(p0[2], p0[3]); w.z = cvt_pk_bf16(p1[0], p1[1]); w.w = cvt_pk_bf16(p1[2], p1[3]);
                    *(u32x4*)(base + (size_t)(ai * 128 + m * 16) * DM + bj * 128) = w; } }
        LDS_WAIT(); __builtin_amdgcn_s_barrier(); asm volatile("" ::: "memory");
    }
};

namespace nsa {
constexpr int L_K = 0, L_V = 16384, L_PCS = 32768, L_OST = 98304, L_WSF = XTRA_OFF, L_SEL = XTRA_OFF + 2048;
__device__ __forceinline__ int crow(int r, int hi) { return (r & 3) + 8 * (r >> 2) + 4 * hi; }
__device__ __forceinline__ unsigned cvtpk(float lo, float hi) { return cvt_pk_bf16(lo, hi); }

__device__ __forceinline__ void qkt(f32x16& p0, f32x16& p1, const LAS unsigned char* Kslot, const bf16x8* qr, int r32, int hi, float zero_) {
    const LAS unsigned char* kb = Kslot + hi * 1024 + r32 * 16;
    f32x16 z;
#pragma unroll
    for (int r = 0; r < 16; ++r) z[r] = zero_;
    p0 = z; p1 = z;
#pragma unroll
    for (int d0 = 0; d0 < 4; ++d0) {
        const bf16x8 b0 = *(const LAS bf16x8*)(kb + d0 * 2048);
        const bf16x8 b1 = *(const LAS bf16x8*)(kb + d0 * 2048 + 512);
        p0 = __builtin_amdgcn_mfma_f32_32x32x16_bf16(b0, qr[d0], p0, 0, 0, 0);
        p1 = __builtin_amdgcn_mfma_f32_32x32x16_bf16(b1, qr[d0], p1, 0, 0, 0);
    }
}
__device__ __forceinline__ void pv(f32x16* o, int vb, bf16x8 pa0, bf16x8 pa1, bf16x8 pa2, bf16x8 pa3) {
#pragma unroll
    for (int d0 = 0; d0 < 2; ++d0) { s16x4 lo[4], hi[4];
#pragma unroll
        for (int ks = 0; ks < 4; ++ks) {
            asm volatile("ds_read_b64_tr_b16 %0,%1 offset:%c2" : "=&v"(lo[ks]) : "v"(vb), "i"(d0 * 4096 + ks * 1024) : "memory");
            asm volatile("ds_read_b64_tr_b16 %0,%1 offset:%c2" : "=&v"(hi[ks]) : "v"(vb), "i"(d0 * 4096 + ks * 1024 + 512) : "memory"); }
        asm volatile("s_waitcnt lgkmcnt(0)" ::: "memory"); __builtin_amdgcn_sched_barrier(0);
#define NSA_PK(k) (bf16x8){lo[k][0], lo[k][1], lo[k][2], lo[k][3], hi[k][0], hi[k][1], hi[k][2], hi[k][3]}
        o[d0] = __builtin_amdgcn_mfma_f32_32x32x16_bf16(pa0, NSA_PK(0), o[d0], 0, 0, 0);
        o[d0] = __builtin_amdgcn_mfma_f32_32x32x16_bf16(pa1, NSA_PK(1), o[d0], 0, 0, 0);
        o[d0] = __builtin_amdgcn_mfma_f32_32x32x16_bf16(pa2, NSA_PK(2), o[d0], 0, 0, 0);
        o[d0] = __builtin_amdgcn_mfma_f32_32x32x16_bf16(pa3, NSA_PK(3), o[d0], 0, 0, 0);
#undef NSA_PK
    }
}
__device__ __forceinline__ void mask_tile(f32x16& p0, f32x16& p1, int lo, int hi_, int hi) {
#pragma unroll
    for (int r = 0; r < 16; ++r) { const int kv = crow(r, hi); if (kv < lo || kv > hi_) p0[r] = -INFINITY; if (kv + 32 < lo || kv + 32 > hi_) p1[r] = -INFINITY; }
}
__device__ __forceinline__ float tile_max(const f32x16& p0, const f32x16& p1) {
    float a = fmaxf(p0[0], p1[0]);
#pragma unroll
    for (int r = 1; r < 16; ++r) a = fmaxf(a, fmaxf(p0[r], p1[r]));
    return xor32_max(a);
}
__device__ __forceinline__ void pack_p(const f32x16& p0, const f32x16& p1, bf16x8& a0, bf16x8& a1, bf16x8& a2, bf16x8& a3) {
    u32x4 w0, w1, w2, w3;
    w0 = (u32x4){cvtpk(p0[0], p0[1]), cvtpk(p0[2], p0[3]), cvtpk(p0[4], p0[5]), cvtpk(p0[6], p0[7])};
    w1 = (u32x4){cvtpk(p0[8], p0[9]), cvtpk(p0[10], p0[11]), cvtpk(p0[12], p0[13]), cvtpk(p0[14], p0[15])};
    w2 = (u32x4){cvtpk(p1[0], p1[1]), cvtpk(p1[2], p1[3]), cvtpk(p1[4], p1[5]), cvtpk(p1[6], p1[7])};
    w3 = (u32x4){cvtpk(p1[8], p1[9]), cvtpk(p1[10], p1[11]), cvtpk(p1[12], p1[13]), cvtpk(p1[14], p1[15])};
    a0 = __builtin_bit_cast(bf16x8, w0); a1 = __builtin_bit_cast(bf16x8, w1); a2 = __builtin_bit_cast(bf16x8, w2); a3 = __builtin_bit_cast(bf16x8, w3);
}
__device__ __forceinline__ void online_step(f32x16& p0, f32x16& p1, float& m, float& l, f32x16* o, LAS float* wsf, int r32, int hi) {
    const float rm = tile_max(p0, p1);
    const float mn = fmaxf(m, rm), mu = (mn == -INFINITY) ? 0.f : mn;
    const float sc = fast_exp2(m - mu);
    float s = 0.f;
#pragma unroll
    for (int r = 0; r < 16; ++r) { p0[r] = fast_exp2(p0[r] - mu); p1[r] = fast_exp2(p1[r] - mu); s += p0[r] + p1[r]; }
    l = l * sc + s; m = mn;
    if (__any(sc != 1.f)) {
        if (hi == 0) wsf[r32] = sc;
        LDS_WAIT();
#pragma unroll
        for (int r = 0; r < 16; ++r) { const float f = wsf[crow(r, hi)]; o[0][r] *= f; o[1][r] *= f; }
        LDS_WAIT();
    }
}

struct Ptrs { const bf16_t* qraw; const bf16_t* qrot; const bf16_t* kv; const bf16_t* kcmp; const bf16_t* vcmp; const float* gates; bf16_t* ab; };

template <bool WITH_V, class F>
__device__ __forceinline__ void tile_loop(int n, const bf16_t* Kb, const bf16_t* Vb, int row0, LAS unsigned char* lds, int wid, int lane, F&& body) {
    const bf16_t* ksrc = Kb + (size_t)(row0 + lane) * 64 + wid * 8;
    const bf16_t* vsrc = Vb + (size_t)(row0 + 16 * (wid & 3) + (lane >> 2)) * 64 + (wid >> 2) * 32 + (lane & 3) * 8;
#define NSA_ISSUE(i) do { const int sl_ = ((i) & 1) * 8192; \
        __builtin_amdgcn_global_load_lds((const unsigned*)(ksrc + (size_t)(i) * 4096), (LAS unsigned*)(lds + L_K + sl_ + wid * 1024), 16, 0, 0); \
        if (WITH_V) __builtin_amdgcn_global_load_lds((const unsigned*)(vsrc + (size_t)(i) * 4096), (LAS unsigned*)(lds + L_V + sl_ + wid * 1024), 16, 0, 0); } while (0)
    NSA_ISSUE(0);
    for (int i = 0; i < n; ++i) {
        VM_WAIT(); __syncthreads();
        if (i + 1 < n) NSA_ISSUE(i + 1);
        body(i, (i & 1) * 8192);
    }
    __syncthreads();
#undef NSA_ISSUE
}

template <int MODE>
__device__ __forceinline__ void branch_pipe(int n, const bf16_t* Kb, const bf16_t* Vb, int row0, LAS unsigned char* lds, int wid, int lane, int r32, int hi, const bf16x8* qr,
                                            unsigned long long sel, int tl, int qt, int kt0, float gate, LAS float* otl, LAS float* wsf, int vb0, float zero_) {
    const int half = wid >> 2;
    const bf16_t* ksrc = Kb + (size_t)(row0 + lane) * 64 + wid * 8;
    const bf16_t* vsrc = Vb + (size_t)(row0 + 16 * (wid & 3) + (lane >> 2)) * 64 + (wid >> 2) * 32 + (lane & 3) * 8;
#define BP_ISSUE_K(i) __builtin_amdgcn_global_load_lds((const unsigned*)(ksrc + (size_t)(i) * 4096), (LAS unsigned*)(lds + L_K + ((i) & 1) * 8192 + wid * 1024), 16, 0, 0)
#define BP_ISSUE_V(i) __builtin_amdgcn_global_load_lds((const unsigned*)(vsrc + (size_t)(i) * 4096), (LAS unsigned*)(lds + L_V + ((i) & 1) * 8192 + wid * 1024), 16, 0, 0)
#define BP_BAR() asm volatile("s_waitcnt lgkmcnt(0)\n\ts_barrier" ::: "memory")
    f32x16 o[2], p0, p1;
#pragma unroll
    for (int r = 0; r < 16; ++r) { o[0][r] = zero_; o[1][r] = zero_; p0[r] = zero_; p1[r] = zero_; }
    bf16x8 a0 = {0, 0, 0, 0, 0, 0, 0, 0}, a1 = a0, a2 = a0, a3 = a0;
    float m = -INFINITY, l = 0.f; bool resc = false;
    BP_ISSUE_K(0); VM_WAIT(); BP_BAR();
    auto X = [&](int i) {
        if (i > 0) {
            if (resc) {
#pragma unroll
                for (int r = 0; r < 16; ++r) { const float f = wsf[crow(r, hi)]; o[0][r] *= f; o[1][r] *= f; }
                LDS_WAIT(); }
            pv(o, vb0 + ((i - 1) & 1) * 8192, a0, a1, a2, a3);
        }
        if (i < n) qkt(p0, p1, lds + L_K + (i & 1) * 8192, qr, r32, hi, zero_);
    };
    auto Y = [&](int i) {
        int lo = 0, hi_ = 63; bool rowsel = true;
        if (MODE == 2) { rowsel = ((sel >> i) & 1ull) != 0; if (i == qt) hi_ = tl; }
        else { const int kt = kt0 + i; if (kt == qt - 8) lo = tl + 1; if (kt == qt) hi_ = tl; }
        if (!__all(lo <= 0 && hi_ >= 63)) mask_tile(p0, p1, lo, hi_, hi);
        float rm = tile_max(p0, p1); if (!rowsel) rm = -INFINITY;
        const float mn = fmaxf(m, rm), mu = (mn == -INFINITY) ? 0.f : mn;
        const float sc = fast_exp2(m - mu), mue = rowsel ? mu : INFINITY;
        float sum = 0.f;
#pragma unroll
        for (int r = 0; r < 16; ++r) { p0[r] = fast_exp2(p0[r] - mue); p1[r] = fast_exp2(p1[r] - mue); sum += p0[r] + p1[r]; }
        l = l * sc + sum; m = mn;
        resc = __any(sc != 1.f) != 0;
        if (resc) { if (hi == 0) wsf[r32] = sc; }
        pack_p(p0, p1, a0, a1, a2, a3);
    };
    if (half == 0) {
        for (int j = 0; j <= n; ++j) {
            if (j + 1 < n) BP_ISSUE_K(j + 1); if (j < n) BP_ISSUE_V(j);
            X(j); BP_BAR();
            if (j < n) Y(j);
            VM_WAIT(); BP_BAR();
        }
    } else {
        for (int j = 0; j <= n; ++j) {
            if (j + 1 < n) BP_ISSUE_K(j + 1); if (j < n) BP_ISSUE_V(j);
            if (j > 0) Y(j - 1);
            BP_BAR();
            X(j);
            VM_WAIT(); BP_BAR();
        }
    }
    l = xor32_sum(l);
    if (hi == 0) wsf[r32] = l > 0.f ? gate / l : 0.f;
    LDS_WAIT();
#pragma unroll
    for (int r = 0; r < 16; ++r) { const float f = wsf[crow(r, hi)]; otl[r * 64] += o[0][r] * f; otl[(16 + r) * 64] += o[1][r] * f; }
    LDS_WAIT();
#undef BP_ISSUE_K
#undef BP_ISSUE_V
#undef BP_BAR
}

__device__ __forceinline__ void unit(const Ptrs& P, int b, int g, int qt, LAS unsigned char* lds, int tid_in) {
    int tid_ = tid_in; asm volatile("" : "+v"(tid_));
    const int tid = tid_, lane = tid & 63, r32 = lane & 31, hi = lane >> 5; const int wid = __builtin_amdgcn_readfirstlane(tid >> 6);
    const int bg = b * 2 + g;
    const int tl = 8 * wid + (r32 >> 2), hr = r32 & 3;
    const int tpos = 64 * qt + tl;
    const size_t tok = (size_t)b * SEQ + tpos;
    LAS float* wsf = (LAS float*)(lds + L_WSF) + wid * 64;
    LAS float* pcs = (LAS float*)(lds + L_PCS);
    LAS unsigned long long* selm = (LAS unsigned long long*)(lds + L_SEL);
    const int vb0 = (int)(unsigned)(uintptr_t)(lds + L_V) + ((lane >> 4) & 1) * 32 + (lane & 3) * 8 + (4 * hi + ((lane & 15) >> 2)) * 64;
    const float* gp = P.gates + tok * 24 + (g * 4 + hr) * 3;
    const float g0 = gp[0], g1 = gp[1], g2 = gp[2];
    float zero_ = 0.f; asm volatile("" : "+v"(zero_));
    f32x16 ot[2];
#pragma unroll
    for (int r = 0; r < 16; ++r) { ot[0][r] = zero_; ot[1][r] = zero_; }
    bf16x8 qr[4];
    const size_t qoff = ((size_t)bg * SEQ + 64 * qt) * 256 + (size_t)(wid * 32 + r32) * 64 + hi * 8;
#pragma unroll
    for (int d0 = 0; d0 < 4; ++d0) qr[d0] = *(const bf16x8*)(P.qraw + qoff + d0 * 16);

    const int nv = tpos >= 15 ? ((tpos - 15) >> 4) : 0;
    const int nct = (4 * qt + 3 + 63) >> 6;
    const bf16_t* kc = P.kcmp + (size_t)bg * 256 * 64; const bf16_t* vc = P.vcmp + (size_t)bg * 256 * 64;
    float mc = -INFINITY, lc = 0.f;
    tile_loop<false>(nct, kc, vc, 0, lds, wid, lane, [&](int i, int sl) {
        f32x16 p0, p1; qkt(p0, p1, lds + L_K + sl, qr, r32, hi, zero_);
        mask_tile(p0, p1, 0, nv - 64 * i - 1, hi);
        const float rm = tile_max(p0, p1); const float mn = fmaxf(mc, rm), mu = (mn == -INFINITY) ? 0.f : mn;
        float s = 0.f;
#pragma unroll
        for (int r = 0; r < 16; ++r) s += fast_exp2(p0[r] - mu) + fast_exp2(p1[r] - mu);
        lc = lc * fast_exp2(mc - mu) + s; mc = mn;
    });
    lc = xor32_sum(lc);
    {
        const float mu = (mc == -INFINITY) ? 0.f : mc, inv = lc > 0.f ? 1.f / lc : 0.f;
        tile_loop<true>(nct, kc, vc, 0, lds, wid, lane, [&](int i, int sl) {
            f32x16 p0, p1; qkt(p0, p1, lds + L_K + sl, qr, r32, hi, zero_);
            mask_tile(p0, p1, 0, nv - 64 * i - 1, hi);
#pragma unroll
            for (int r = 0; r < 16; ++r) { p0[r] = fast_exp2(p0[r] - mu) * inv; p1[r] = fast_exp2(p1[r] - mu) * inv; }
#pragma unroll
            for (int r = 0; r < 16; ++r) {
                float a = p0[r], c = p1[r];
                a += xor_get<1>(a); a += xor_get<2>(a); c += xor_get<1>(c); c += xor_get<2>(c);
                if (hr == 0) { pcs[tl * 256 + 64 * i + crow(r, hi)] = a; pcs[tl * 256 + 64 * i + 32 + crow(r, hi)] = c; }
            }
#pragma unroll
            for (int r = 0; r < 16; ++r) { p0[r] *= g0; p1[r] *= g0; }
            bf16x8 a0, a1, a2, a3; pack_p(p0, p1, a0, a1, a2, a3);
            pv(ot, vb0 + sl, a0, a1, a2, a3);
        });
    }
    LDS_WAIT(); __syncthreads();
    if (qt < 16) { if (lane < 8) selm[8 * wid + lane] = (2ull << qt) - 1ull; }
    else {
        for (int k = 0; k < 8; ++k) {
            const int t8 = 8 * wid + k; const LAS float* pr = pcs + t8 * 256;
            float sc = -INFINITY;
            if (lane <= qt) { float imp = 0.f;
#pragma unroll
                for (int j = -1; j < 4; ++j) { const int c = 4 * lane + j; if (c >= 0 && c < 255) imp += pr[c]; }
                sc = (lane == 0 || lane == qt || lane == qt - 1) ? INFINITY : imp; }
            int rank = 0;
            for (int j = 0; j <= qt; ++j) { const float sj = __builtin_bit_cast(float, __builtin_amdgcn_readlane(__builtin_bit_cast(int, sc), j)); rank += (sj > sc || (sj == sc && j < lane)) ? 1 : 0; }
            const unsigned long long mk = __ballot(lane <= qt && rank < 16);
            if (lane == 0) selm[t8] = mk;
        }
    }
    LDS_WAIT(); __syncthreads();
    const unsigned long long sel = selm[tl];
    LAS float* otl = (LAS float*)(lds + L_PCS) + wid * 2048 + lane;
#pragma unroll
    for (int r = 0; r < 16; ++r) { otl[r * 64] = ot[0][r]; otl[(16 + r) * 64] = ot[1][r]; }
    LDS_WAIT();
#pragma unroll
    for (int d0 = 0; d0 < 4; ++d0) qr[d0] = *(const bf16x8*)(P.qrot + qoff + d0 * 16);
    branch_pipe<2>(qt + 1, P.kv + 2 * KVSZ + (size_t)bg * SEQ * 64, P.kv + 3 * KVSZ + (size_t)bg * SEQ * 64, 0, lds, wid, lane, r32, hi, qr, sel, tl, qt, 0, g1, otl, wsf, vb0, zero_);
    { const int k0 = qt >= 8 ? qt - 8 : 0;
      branch_pipe<3>(qt - k0 + 1, P.kv + 4 * KVSZ + (size_t)bg * SEQ * 64, P.kv + 5 * KVSZ + (size_t)bg * SEQ * 64, 64 * k0, lds, wid, lane, r32, hi, qr, sel, tl, qt, k0, g2, otl, wsf, vb0, zero_); }
    {
        LAS bf16_t* stg = (LAS bf16_t*)(lds + L_OST) + wid * 2048;
#pragma unroll
        for (int r = 0; r < 16; ++r) { const int orow = crow(r, hi);
#pragma unroll
            for (int d0 = 0; d0 < 2; ++d0) stg[orow * 64 + d0 * 32 + r32] = (bf16_t)f2bf(otl[(d0 * 16 + r) * 64]); }
        LDS_WAIT();
#pragma unroll
        for (int it = 0; it < 4; ++it) { const int row = it * 8 + (lane >> 3), ch = lane & 7; const u32x4 v = *(const LAS u32x4*)(stg + row * 64 + ch * 8);
            bf16_t* dst = P.ab + ((size_t)b * SEQ + 64 * qt + 8 * wid + (row >> 2)) * 1024 + g * 256 + (row & 3) * 64 + ch * 8;
            *(u32x4*)dst = v; }
        LDS_WAIT();
    }
    __syncthreads();
}
}

#define XB_TMO      128
#define XB_XCNT(j)  (256  + 64 * (j))
#define XB_XSUB(j)  (1280 + 64 * (j))
#define XB_XGEN(j)  (2304 + 64 * (j))
#define XB_TOP      3328
#define XB_TOPGEN   3392
#define XCD_BAR_WORDS 3456
#define XB_SPIN_CAP (1u << 18)
__device__ __forceinline__ unsigned xb_ld(unsigned* p)              { return __hip_atomic_load(p, __ATOMIC_RELAXED, __HIP_MEMORY_SCOPE_AGENT); }
__device__ __forceinline__ unsigned xb_add(unsigned* p, unsigned v) { return __hip_atomic_fetch_add(p, v, __ATOMIC_RELAXED, __HIP_MEMORY_SCOPE_AGENT); }
__device__ __forceinline__ unsigned xb_xcc_id() { return (unsigned)__builtin_amdgcn_s_getreg((3 << 11) | 20) & 0xFu; }
#define XB_SPIN(cond, bar) do { unsigned _sp = 0; while (cond) { __builtin_amdgcn_s_sleep(1); \
    if ((++_sp & 255u) == 0u) { if (xb_ld(&(bar)[XB_TMO])) break; if (_sp > XB_SPIN_CAP) { atomicAdd(&(bar)[XB_TMO], 1u); break; } } } } while (0)
struct XcdBarrier { unsigned* bar; unsigned x; volatile LAS unsigned* st; };
__device__ __forceinline__ XcdBarrier xcd_barrier_post(unsigned* bar, volatile LAS unsigned* st) {
    XcdBarrier b; b.bar = bar; b.x = xb_xcc_id(); b.st = st;
    if (threadIdx.x == 0) (void)xb_add(&bar[XB_XCNT(b.x)], 1u);
    return b;
}
__device__ __forceinline__ void xcd_barrier_complete(unsigned* bar, unsigned x, unsigned& nloc, unsigned& nx) {
    const unsigned G = gridDim.x * gridDim.y * gridDim.z;
    unsigned sum, cnt, mine, sp = 0u;
    for (;;) {
        sum = 0u; cnt = 0u; mine = 0u;
#pragma unroll
        for (unsigned j = 0; j < 16; ++j) { const unsigned c = xb_ld(&bar[XB_XCNT(j)]); sum += c; cnt += (c > 0u) ? 1u : 0u; mine = (j == x) ? c : mine; }
        if (sum == G) break;
        __builtin_amdgcn_s_sleep(1);
        if ((++sp & 255u) == 0u) { if (xb_ld(&bar[XB_TMO])) break; if (sp > XB_SPIN_CAP) { atomicAdd(&bar[XB_TMO], 1u); break; } }
    }
    nloc = mine > 0u ? mine : 1u; nx = cnt > 0u ? cnt : 1u;
}
__device__ __forceinline__ void xcd_barrier(const XcdBarrier& b, int tid) {
    asm volatile("s_waitcnt vmcnt(0)" ::: "memory");
    __syncthreads();
    if (tid == 0) {
        unsigned* bar = b.bar;
        __builtin_amdgcn_s_waitcnt(0);
        unsigned nloc = b.st[0], nx = b.st[1];
        if (nloc == 0u) { xcd_barrier_complete(bar, b.x, nloc, nx); b.st[0] = nloc; b.st[1] = nx; }
        const unsigned old = xb_add(&bar[XB_XSUB(b.x)], 1u);
        const unsigned gen = old / nloc;
        if (old + 1u == (gen + 1u) * nloc) {
            __builtin_amdgcn_fence(__ATOMIC_RELEASE, "agent");
            asm volatile("s_waitcnt vmcnt(0)" ::: "memory");
            const unsigned og = xb_add(&bar[XB_TOP], 1u);
            const unsigned tg = og / nx;
            if (og + 1u == (tg + 1u) * nx) xb_add(&bar[XB_TOPGEN], 1u);
            else XB_SPIN(xb_ld(&bar[XB_TOPGEN]) == tg, bar);
            __builtin_amdgcn_fence(__ATOMIC_ACQUIRE, "agent");
            xb_add(&bar[XB_XGEN(b.x)], 1u);
            asm volatile("s_waitcnt vmcnt(0)" ::: "memory");
        } else {
            XB_SPIN(xb_ld(&bar[XB_XGEN(b.x)]) == gen, bar);
            __builtin_amdgcn_fence(__ATOMIC_ACQUIRE, "agent");
            asm volatile("s_waitcnt vmcnt(0)" ::: "memory");
        }
    }
    __syncthreads();
}

__device__ __forceinline__ void xpose_item(const float* W, int ldw, int k0, int n0, int ncv, bf16_t* WT, int ldt, int dr0, LAS float* scr, int lane, const float* gain = nullptr) {
    const int c = lane & 31;
#pragma unroll 8
    for (int i = 0; i < 32; ++i) { const int kk = 2 * i + (lane >> 5); scr[kk * 33 + c] = c < ncv ? W[(size_t)(k0 + kk) * ldw + n0 + c] * (gain ? gain[k0 + kk] : 1.f) : 0.f; }
    LDS_WAIT(); asm volatile("" ::: "memory");
    const int c8 = lane & 7;
#pragma unroll
    for (int j = 0; j < 4; ++j) { const int n = (lane >> 3) + 8 * j; const LAS float* s = scr + (8 * c8) * 33 + n;
        u32x4 o; o.x = pk2(s[0 * 33], s[1 * 33]); o.y = pk2(s[2 * 33], s[3 * 33]); o.z = pk2(s[4 * 33], s[5 * 33]); o.w = pk2(s[6 * 33], s[7 * 33]);
        *(u32x4*)(WT + (size_t)(dr0 + n) * ldt + k0 + 8 * c8) = o; }
    LDS_WAIT(); asm volatile("" ::: "memory");
}
__device__ __forceinline__ void xpose_item64(const float* W, int ldw, int k0, int n0, bf16_t* WT, int ldt, int dr0, LAS float* scr, int lane, const float* gain) {
    const int c4 = lane & 15, r4 = lane >> 4;
    f32x4 v[16];
#pragma unroll
    for (int i = 0; i < 16; ++i) v[i] = *(const f32x4*)(W + (size_t)(k0 + 4 * i + r4) * ldw + n0 + 4 * c4);
    if (gain) {
#pragma unroll
        for (int i = 0; i < 16; ++i) v[i] = v[i] * gain[k0 + 4 * i + r4]; }
#pragma unroll
    for (int i = 0; i < 16; ++i) { LAS float* d = scr + (4 * i + r4) * 65 + 4 * c4; d[0] = v[i].x; d[1] = v[i].y; d[2] = v[i].z; d[3] = v[i].w; }
    LDS_WAIT(); asm volatile("" ::: "memory");
    const int c8 = lane & 7;
#pragma unroll
    for (int j = 0; j < 8; ++j) { const int n = (lane >> 3) + 8 * j; const LAS float* s = scr + (8 * c8) * 65 + n;
        u32x4 o; o.x = pk2(s[0 * 65], s[1 * 65]); o.y = pk2(s[2 * 65], s[3 * 65]); o.z = pk2(s[4 * 65], s[5 * 65]); o.w = pk2(s[6 * 65], s[7 * 65]);
        *(u32x4*)(WT + (size_t)(dr0 + n) * ldt + k0 + 8 * c8) = o; }
    LDS_WAIT(); asm volatile("" ::: "memory");
}
__device__ __forceinline__ void xpose_mat(const float* W, int K, int N, bf16_t* WT, int rowmap, int item, LAS float* scr, int lane, const float* gain = nullptr) {
    const int ng = N / 64, kb = item / ng, j = item % ng, n = 64 * j;
    const int dr = rowmap == 0 ? n : (256 * (n >> 7) + (n & 127) + (rowmap == 2 ? 128 : 0));
    xpose_item64(W, N, 64 * kb, n, WT, K, dr, scr, lane, gain);
}
__device__ __forceinline__ float row_rs(const float* xrow, int lane, f32x4 (&v)[4]) {
    const f32x4* xr = (const f32x4*)xrow + lane; float s = 0.f;
#pragma unroll
    for (int j = 0; j < 4; ++j) { v[j] = xr[64 * j]; s += (v[j].x * v[j].x + v[j].y * v[j].y) + (v[j].z * v[j].z + v[j].w * v[j].w); }
    return 1.0f / sqrtf(wave_sum(s) * (1.f / DM) + EPS);
}
__device__ __forceinline__ void norm_row(const float* xrow, const float* gain, bf16_t* orow, int lane) {
    f32x4 v[4]; const float rs = row_rs(xrow, lane, v);
    const f32x4* gr = (const f32x4*)gain + lane; unsigned long long* o8 = (unsigned long long*)orow + lane;
#pragma unroll
    for (int j = 0; j < 4; ++j) { const f32x4 g = gr[64 * j];
        o8[64 * j] = (unsigned long long)pk2(v[j].x * rs * g.x, v[j].y * rs * g.y) | ((unsigned long long)pk2(v[j].z * rs * g.z, v[j].w * rs * g.w) << 32); }
}
__device__ __forceinline__ void sincos_d(double a, float& s, float& c) {
    const double n = rint(a * 0.6366197723675814);
    double r = fma(-n, 1.5707963267948966, a); r = fma(-n, 6.123233995736766e-17, r);
    const double r2 = r * r;
    double sp = -1.0 / 1307674368000.0; sp = sp * r2 + 1.0 / 6227020800.0; sp = sp * r2 - 1.0 / 39916800.0; sp = sp * r2 + 1.0 / 362880.0; sp = sp * r2 - 1.0 / 5040.0; sp = sp * r2 + 1.0 / 120.0; sp = sp * r2 - 1.0 / 6.0; sp = sp * r2 * r + r;
    double cp = 1.0 / 20922789888000.0; cp = cp * r2 - 1.0 / 87178291200.0; cp = cp * r2 + 1.0 / 479001600.0; cp = cp * r2 - 1.0 / 3628800.0; cp = cp * r2 + 1.0 / 40320.0; cp = cp * r2 - 1.0 / 720.0; cp = cp * r2 + 1.0 / 24.0; cp = cp * r2 - 0.5; cp = cp * r2 + 1.0;
    const int q = (int)n & 3;
    const double ss = (q & 1) ? cp : sp, cc = (q & 1) ? sp : cp;
    s = (float)((q & 2) ? -ss : ss); c = (float)(((q + 1) & 2) ? -cc : cc);
}

struct Args {
    const float* in[30]; float* out; unsigned char* ws; int ph_lo, ph_hi;
};
enum { I_X = 0, I_MEM, I_NORM_MIX, I_W_IN, I_PE_K, I_W1_K, I_B1_K, I_W2_K, I_PE_V, I_W1_V, I_B1_V, I_W2_V, I_W_POOL, I_POOL_SCALE, I_W_OUT, I_NORM_X, I_NORM_MEM,
       I_WQ, I_WK, I_WV, I_WO, I_NORM_FFN, I_FFN_WG, I_FFN_WU, I_FFN_WD, I_ROUTER, I_MOE_WG, I_MOE_WU, I_MOE_WD, I_NORM_FINAL };
constexpr int PH_PRO = 0, PH_KV = 1, PH_L0 = 2, PH_LSTRIDE = 20;
constexpr int PO_WIN = 0, PO_CMP = 1, PO_ATT = 2, PO_WOUT = 3, PO_N2 = 4, PO_WQ = 5, PO_S = 6, PO_PV = 7, PO_WO = 8, PO_F0 = 9;

typedef const Args __attribute__((address_space(4))) CArgs;
#define PHASE_IDS CArgs* ap_ = (CArgs*)__builtin_amdgcn_kernarg_segment_ptr(); asm volatile("" : "+s"(ap_)); unsigned char* ws = ap_->ws; (void)ws; int tid_; asm volatile("v_mbcnt_lo_u32_b32 %0, -1, 0\n\tv_mbcnt_hi_u32_b32 %0, -1, %0" : "=v"(tid_)); tid_ += wid0 * 64; const int tid = tid_, lane = tid & 63, wid = wid0, gw = bid * NWAVES + wid; (void)lane; (void)gw;
#ifndef PHMASK
#define PHMASK 0xffffffffu
#endif
#define PM(b) ((PHMASK >> (b)) & 1u)
#define IN(k) (lo <= (k) && (k) < hi)
#define SEAM(k) do { if (hi > (k) + 1) xcd_barrier(bar, tid); } while (0)
#define W16(off) ((bf16_t*)(ws + (off)))
template <int layer> __device__ __forceinline__ void layer_phases(LAS unsigned char* lds, const int lo, const int hi, const XcdBarrier& bar, const int G, const int bid, const int NGW, const int wid0) {
        const int pb = PH_L0 + layer * PH_LSTRIDE;
        if (PM(2) && IN(pb + PO_WIN)) {
            PHASE_IDS
            pg8::Gemm g{(const char*)(ws + WS_HB), (const char*)(ws + WS_WIN + (size_t)layer * ZW * DM * 2), DM, DM, DM};
            SchedPlain S; S.init(T / 256, ZW / 256, DM, DM, G, bid);
            EpiWin E{W16(WS_QRAW), W16(WS_QROT), W16(WS_KV), W16(WS_U), (float*)(ws + WS_GATES), (const float*)(ws + WS_ROPE), SSP(layer == 0 ? 0 : 3)};
            for (int rep_ = 0; rep_ < REPN(2); ++rep_) pg8::gemm_phase<EpiWin, SchedPlain, true, true>(lds, g, S, E, tid);
            SEAM(pb + PO_WIN);
        }
        if (PM(3) && IN(pb + PO_CMP)) {
            PHASE_IDS
            for (int rep_ = 0; rep_ < REPN(3); ++rep_)
            if (bid < 16) {
                const int kv = bid >> 3, pm = bid & 7, mtx = layer * 2 + kv;
                {
                    pg8::Gemm g{(const char*)(ws + WS_KV + (size_t)kv * KVSZ * 2), (const char*)(ws + WS_CW1 + (size_t)mtx * 256 * 2048 * 2), 2048, 1024, 2048};
                    SchedOne S; S.u.pm = pm; S.u.pn = 0; S.u.aoff = (long)pm * 256 * 1024 * 2; S.u.boff = 0; S.u.coff = 0;
                    EpiHid E{W16(WS_HID) + (size_t)kv * 2048 * 256, (const long long*)((const unsigned*)(ws + WS_CTL) + CW_BIAS) + mtx * 256};
                    pg8::gemm_phase<EpiHid, SchedOne, false, true>(lds, g, S, E, tid);
                }
                VM_WAIT(); __syncthreads();
                __builtin_amdgcn_fence(__ATOMIC_ACQUIRE, "agent"); VM_WAIT(); __syncthreads();
                {
                    pg8::Gemm g{(const char*)(ws + WS_HID + (size_t)kv * 2048 * 256 * 2), (const char*)(ws + WS_CW2 + (size_t)mtx * 256 * 256 * 2), 256, 256, 256};
                    SchedOne S; S.u.pm = pm; S.u.pn = 0; S.u.aoff = (long)pm * 256 * 256 * 2; S.u.boff = 0; S.u.coff = 0;
                    EpiCmp2 E{W16(WS_KCMP) + (size_t)kv * 8 * 256 * 64};
                    pg8::gemm_phase<EpiCmp2, SchedOne, false, true>(lds, g, S, E, tid);
                }
            } else if (layer == 0 && bid < 80) {
                pg8::Gemm g{(const char*)ws, (const char*)ws, DM, DM, DM}; SchedKV S{1, bid - 16}; EpiPlain E{(bf16_t*)ws, DM, nullptr};
                pg8::gemm_phase<EpiPlain, SchedKV, false, true>(lds, g, S, E, tid);
            } else {
                const int nw = layer == 0 ? G - 80 : G - 16, w0 = layer == 0 ? 80 : 16;
                const bf16_t* ub = W16(WS_U); bf16_t* ab = W16(WS_AB);
                for (int idx = (bid - w0) * 512 + tid; idx < T * 64; idx += nw * 512) {
                    const int tok = idx >> 6, col = (idx & 63) * 8, w = 2 << (col >> 7), t = tok & (SEQ - 1), n = (t + 1) < w ? (t + 1) : w;
                    float s[8], own[8];
#pragma unroll
                    for (int j = 0; j < 8; ++j) s[j] = 0.f;
                    for (int q = 0; q < n; ++q) { const u32x4 v = *(const u32x4*)(ub + (size_t)(tok - q) * 512 + col);
#pragma unroll
                        for (int j = 0; j < 4; ++j) { const float a = __builtin_bit_cast(float, v[j] << 16), c = __builtin_bit_cast(float, v[j] & 0xffff0000u); s[2 * j] += a; s[2 * j + 1] += c;
                            if (q == 0) { own[2 * j] = a; own[2 * j + 1] = c; } } }
                    const float inv = 1.f / (float)n;
                    u32x4 o; o.x = pk2(s[0] * inv - own[0], s[1] * inv - own[1]); o.y = pk2(s[2] * inv - own[2], s[3] * inv - own[3]);
                    o.z = pk2(s[4] * inv - own[4], s[5] * inv - own[5]); o.w = pk2(s[6] * inv - own[6], s[7] * inv - own[7]);
                    *(u32x4*)(ab + (size_t)tok * 1024 + 512 + col) = o;
                }
            }
            SEAM(pb + PO_CMP);
        }
        if (PM(4) && IN(pb + PO_ATT)) {
            PHASE_IDS
            nsa::Ptrs P{W16(WS_QRAW), W16(WS_QROT), W16(WS_KV), W16(WS_KCMP), W16(WS_KCMP) + 8 * 256 * 64, (const float*)(ws + WS_GATES), W16(WS_AB)};
            const int vcu = (G % 8 == 0) ? (bid % 8) * (G / 8) + bid / 8 : bid;
            for (int rep_ = 0; rep_ < REP_ATT; ++rep_)
            for (int uix = vcu; uix < 8 * 32; uix += G) { const int bgx = uix >> 5, s = uix & 31;
                nsa::unit(P, bgx >> 1, bgx & 1, 63 - s, lds, tid);
                nsa::unit(P, bgx >> 1, bgx & 1, s, lds, tid); }
            SEAM(pb + PO_ATT);
        }
        if (PM(5) && IN(pb + PO_WOUT)) {
            PHASE_IDS
            pg8::Gemm g{(const char*)(ws + WS_AB), (const char*)(ws + WS_WOUT + (size_t)layer * DM * DM * 2), DM, DM, DM};
            SchedPlain S; S.init(T / 256, DM / 256, DM, DM, G, bid);
            EpiRes E{layer == 0 ? ap_->in[I_X] : ap_->out, ap_->out, W16(WS_HB), SSP(layer == 0 ? 1 : 4)};
            pg8::gemm_phase<EpiRes, SchedPlain, true, true>(lds, g, S, E, tid);
            SEAM(pb + PO_WOUT);
        }
        if (PM(7) && IN(pb + PO_WQ)) {
            PHASE_IDS
            {   pg8::Gemm g{(const char*)(ws + WS_HB), (const char*)(ws + WS_WQ + (size_t)layer * DM * DM * 2), DM, DM, DM};
                SchedPlain S; S.init(T / 256, DM / 256, DM, DM, G, bid);
                EpiPlain E{W16(WS_QX), DM, SSP(layer == 0 ? 1 : 4)};
                pg8::gemm_phase<EpiPlain, SchedPlain, false, true>(lds, g, S, E, tid); }
            VM_WAIT(); __syncthreads(); __builtin_amdgcn_fence(__ATOMIC_ACQUIRE, "agent"); VM_WAIT(); __syncthreads();
            {   pg8::Gemm g{(const char*)(ws + WS_QX), (const char*)(ws + WS_KX + (size_t)layer * 2 * MiB), 256, DM, DM};
                SchedX<0> S; S.init(G, bid);
                EpiSoftmax E{W16(WS_PB)};
                pg8::gemm_phase<EpiSoftmax, SchedX<0>, false, true>(lds, g, S, E, tid); }
            VM_WAIT(); __syncthreads(); __builtin_amdgcn_fence(__ATOMIC_ACQUIRE, "agent"); VM_WAIT(); __syncthreads();
            {   pg8::Gemm g{(const char*)(ws + WS_PB), (const char*)(ws + WS_VXT + (size_t)layer * 2 * MiB), 256, DM, DM};
                SchedX<1> S; S.init(G, bid);
                EpiPlain E{W16(WS_OX), DM, nullptr};
                pg8::gemm_phase<EpiPlain, SchedX<1>, false, true>(lds, g, S, E, tid); }
            SEAM(pb + PO_PV);
        }
        if (PM(10) && IN(pb + PO_WO)) {
            PHASE_IDS
            pg8::Gemm g{(const char*)(ws + WS_OX), (const char*)(ws + WS_WO + (size_t)layer * DM * DM * 2), DM, DM, DM};
            SchedPlain S; S.init(T / 256, DM / 256, DM, DM, G, bid);
            EpiRes E{ap_->out, ap_->out, layer == 0 ? W16(WS_HB) : nullptr, SSP(2)};
            pg8::gemm_phase<EpiRes, SchedPlain, true, true>(lds, g, S, E, tid);
            SEAM(pb + PO_WO);
        }
        if constexpr (layer == 0) {
            if (PM(12) && IN(pb + PO_F0 + 1)) {
            PHASE_IDS
                pg8::Gemm g{(const char*)(ws + WS_HB), (const char*)(ws + WS_FGU), DM, DM, DM};
                SchedPlain S; S.init(T / 256, 2 * DFF / 256, DM, DM, G, bid);
                EpiSwiglu E{W16(WS_ACT0), DFF, SSP(2)};
                for (int rep_ = 0; rep_ < REPN(12); ++rep_) pg8::gemm_phase<EpiSwiglu, SchedPlain, true, true>(lds, g, S, E, tid);
                SEAM(pb + PO_F0 + 1);
            }
            if (PM(13) && IN(pb + PO_F0 + 2)) {
            PHASE_IDS
                pg8::Gemm g{(const char*)(ws + WS_ACT0), (const char*)(ws + WS_FD), DFF, DFF, DFF};
                SchedPlain S; S.init(T / 256, DM / 256, DFF, DFF, G, bid);
                EpiRes E{ap_->out, ap_->out, W16(WS_HB), SSP(3)};
                pg8::gemm_phase<EpiRes, SchedPlain, true, true>(lds, g, S, E, tid);
                SEAM(pb + PO_F0 + 2);
            }
        } else {
#define route ((unsigned*)(ws + WS_ROUTE))
#define cntg ((unsigned*)(ws + WS_CNTG))
#define tinfo ((unsigned*)(ws + WS_TILE))
#define slot ((unsigned*)(ws + WS_SLOT))
            LAS int* LE = (LAS int*)lds;
            LAS float* LW = (LAS float*)(lds + 512);
            LAS int* LR = (LAS int*)(lds + 1024);
            LAS int* LC = (LAS int*)(lds + 1536);
            if (PM(15) && IN(pb + PO_F0)) {
            PHASE_IDS
                const float* gain = ap_->in[I_NORM_FFN] + DM; const float* wr = ap_->in[I_ROUTER];
                for (int rep_ = 0; rep_ < REPN(15); ++rep_)
                for (int tb = bid; tb < T / 64; tb += G) {
                    for (int k = 0; k < 8; ++k) { const int tl = 8 * wid + k, tok = 64 * tb + tl;
                        f32x4 v[4]; const float rs = row_rs(ap_->out + (size_t)tok * DM, lane, v);
                        float lg[8];
#pragma unroll
                        for (int e = 0; e < 8; ++e) lg[e] = 0.f;
#pragma unroll
                        for (int j = 0; j < 4; ++j) { const f32x4 gg = ((const f32x4*)gain)[lane + 64 * j];
#pragma unroll
                            for (int c = 0; c < 4; ++c) { const float h = v[j][c] * rs * gg[c]; const f32x4* wp = (const f32x4*)(wr + (size_t)(4 * (lane + 64 * j) + c) * 8); const f32x4 w0 = wp[0], w1 = wp[1];
                                lg[0] += h * w0[0]; lg[1] += h * w0[1]; lg[2] += h * w0[2]; lg[3] += h * w0[3]; lg[4] += h * w1[0]; lg[5] += h * w1[1]; lg[6] += h * w1[2]; lg[7] += h * w1[3]; } }
#pragma unroll
                        for (int e = 0; e < 8; ++e) lg[e] = wave_sum(lg[e]);
                        if (lane == 0) { int i1 = 0; float v1 = lg[0];
#pragma unroll
                            for (int e = 1; e < 8; ++e) if (lg[e] > v1) { v1 = lg[e]; i1 = e; }
                            int i2 = -1; float v2 = -INFINITY;
#pragma unroll
                            for (int e = 0; e < 8; ++e) if (e != i1 && lg[e] > v2) { v2 = lg[e]; i2 = e; }
                            const float w1 = 1.f / (1.f + expf(v2 - v1));
                            LE[2 * tl] = i1; LE[2 * tl + 1] = i2; LW[2 * tl] = w1; LW[2 * tl + 1] = 1.f - w1; }
                    }
                    LDS_WAIT(); __syncthreads();
                    if (tid < 8) { int c = 0; for (int i = 0; i < 128; ++i) if (LE[i] == tid) LR[i] = c++; LC[tid] = c; }
                    LDS_WAIT(); __syncthreads();
                    if (tid < 64) { const int tok = 64 * tb + tid; u32x4 a, b2; a.x = LE[2 * tid]; a.y = LE[2 * tid + 1]; a.z = LR[2 * tid]; a.w = LR[2 * tid + 1];
                        b2.x = __builtin_bit_cast(unsigned, LW[2 * tid]); b2.y = __builtin_bit_cast(unsigned, LW[2 * tid + 1]); b2.z = 0u; b2.w = 0u;
                        *(u32x4*)(route + (size_t)tok * 8) = a; *(u32x4*)(route + (size_t)tok * 8 + 4) = b2; }
                    if (tid < 8) cntg[tb * 8 + tid] = (unsigned)LC[tid];
                    LDS_WAIT(); __syncthreads();
                }
                SEAM(pb + PO_F0);
            }
            if (PM(16) && IN(pb + PO_F0 + 1)) {
            PHASE_IDS
                LAS unsigned* CN = (LAS unsigned*)(lds + 4096);
                LAS unsigned* SB = (LAS unsigned*)(lds + 2048);
                LAS unsigned* TOTS = (LAS unsigned*)(lds + 2048 + 64);
                LAS unsigned* MYB = (LAS unsigned*)(lds + 2048 + 128);
                const float* gain = ap_->in[I_NORM_FFN] + DM;
                for (int rep_ = 0; rep_ < REPN(16); ++rep_)
                for (int tb = bid; tb < T / 64; tb += G) {
                    for (int i = tid; i < 2048; i += 512) CN[i] = cntg[i];
                    LDS_WAIT(); __syncthreads();
                    if (tid < 8) { unsigned tot = 0, myb = 0; for (int w = 0; w < 256; ++w) { const unsigned c = CN[w * 8 + tid]; if (w < tb) myb += c; tot += c; } TOTS[tid] = tot; MYB[tid] = myb; }
                    LDS_WAIT(); __syncthreads();
                    if (tid == 0) { unsigned toff = 0; for (int e = 0; e < 8; ++e) { SB[e] = toff * 256 + MYB[e]; const unsigned nte = (TOTS[e] + 255) >> 8;
                            if (tb == 0) for (unsigned k = 0; k < nte; ++k) tinfo[8 + toff + k] = e;
                            toff += nte; }
                        if (tb == 0) tinfo[0] = toff; }
                    LDS_WAIT(); __syncthreads();
                    for (int k = 0; k < 8; ++k) { const int tok = 64 * tb + 8 * wid + k;
                        const u32x4 a = *(const u32x4*)(route + (size_t)tok * 8); const u32x4 b2 = *(const u32x4*)(route + (size_t)tok * 8 + 4);
                        const unsigned s1 = SB[a.x] + a.z, s2 = SB[a.y] + a.w;
                        if (lane == 0) { u32x4 o; o.x = s1; o.y = s2; o.z = b2.x; o.w = b2.y; *(u32x4*)(slot + (size_t)tok * 4) = o; }
                        f32x4 v[4]; const float rs = row_rs(ap_->out + (size_t)tok * DM, lane, v);
                        unsigned long long* o1 = (unsigned long long*)(W16(WS_HP) + (size_t)s1 * DM) + lane; unsigned long long* o2 = (unsigned long long*)(W16(WS_HP) + (size_t)s2 * DM) + lane;
#pragma unroll
                        for (int j = 0; j < 4; ++j) { const f32x4 gg = ((const f32x4*)gain)[lane + 64 * j];
                            const unsigned long long pk = (unsigned long long)pk2(v[j].x * rs * gg.x, v[j].y * rs * gg.y) | ((unsigned long long)pk2(v[j].z * rs * gg.z, v[j].w * rs * gg.w) << 32);
                            o1[64 * j] = pk; o2[64 * j] = pk; }
                    }
                    LDS_WAIT(); __syncthreads();
                }
                SEAM(pb + PO_F0 + 1);
            }
#pragma unroll 1
            for (int ch = 0; ch < 2; ++ch) {
                const int t0 = ch * HALFT;
#define MOE_NM int nm = (int)tinfo[0] - t0; if (ch == 0) nm = nm > HALFT ? HALFT : nm; nm = nm < 0 ? 0 : (nm > CH1T ? CH1T : nm);
                if (PM(17) && IN(pb + PO_F0 + 2 + 2 * ch)) {
            PHASE_IDS
                    MOE_NM
                    pg8::Gemm g{(const char*)(ws + WS_HP + (size_t)t0 * 256 * DM * 2), (const char*)(ws + WS_MGU), DM, DM, DM};
                    SchedMoe S; S.o.init(nm, 2 * DFFE / 256, G, bid); S.texp = tinfo + 8; S.t0 = t0; S.nn = 2 * DFFE / 256; S.astep = 256L * DM * 2; S.bstep = 256L * DM * 2; S.estep = 7168L * DM * 2; S.cstep = 256L * DFFE; S.khb = 0; S.khc = 0;
                    EpiSwiglu E{W16(WS_ACTC), DFFE, nullptr};
                    for (int rep_ = 0; rep_ < REPN(17); ++rep_) pg8::gemm_phase<EpiSwiglu, SchedMoe, true, true>(lds, g, S, E, tid);
                    SEAM(pb + PO_F0 + 2 + 2 * ch);
                }
                if (PM(18) && IN(pb + PO_F0 + 3 + 2 * ch)) {
            PHASE_IDS
                    MOE_NM
                    pg8::Gemm g{(const char*)(ws + WS_ACTC), (const char*)(ws + WS_MD), DFFE / 2, DFFE, DFFE};
                    SchedMoe S; S.o.init(nm, 2 * DM / 256, G, bid); S.texp = tinfo + 8; S.t0 = t0; S.nn = DM / 256; S.astep = 256L * DFFE * 2; S.bstep = 256L * DFFE * 2; S.estep = 1024L * DFFE * 2; S.cstep = 0;
                    S.khb = (long)(DFFE / 2) * 2; S.khc = ((long)WS_YB - (long)WS_HP) / 2;
                    EpiPlain E{W16(WS_HP), DM, nullptr};
                    for (int rep_ = 0; rep_ < REPN(18); ++rep_) pg8::gemm_phase<EpiPlain, SchedMoe, true, true>(lds, g, S, E, tid);
                    SEAM(pb + PO_F0 + 3 + 2 * ch);
                }
            }
            if (PM(19) && IN(pb + PO_F0 + 6)) {
            PHASE_IDS
                const float* gain = ap_->in[I_NORM_FINAL];
                for (int r = gw; r < T; r += NGW) {
                    const u32x2 si = *(const u32x2*)(slot + (size_t)r * 4);
                    float w1 = ((const float*)slot)[(size_t)r * 4 + 2], w2 = ((const float*)slot)[(size_t)r * 4 + 3]; asm volatile("" : "+v"(w1), "+v"(w2));
                    if (ABL & 8) { w1 = 0.f; w2 = 0.f; }
                    const f32x4* xr = (const f32x4*)(ap_->out + (size_t)r * DM) + lane;
                    const u32x2* y1 = (const u32x2*)(W16(WS_HP) + (size_t)si.x * DM) + lane; const u32x2* y2 = (const u32x2*)(W16(WS_HP) + (size_t)si.y * DM) + lane;
                    const u32x2* z1 = (const u32x2*)(W16(WS_YB) + (size_t)si.x * DM) + lane; const u32x2* z2 = (const u32x2*)(W16(WS_YB) + (size_t)si.y * DM) + lane;
                    f32x4 v[4]; float s = 0.f;
#define BLO(u) __builtin_bit_cast(float, (u) << 16)
#define BHI(u) __builtin_bit_cast(float, (u) & 0xffff0000u)
#pragma unroll
                    for (int j = 0; j < 4; ++j) { const f32x4 x = xr[64 * j]; const u32x2 a = y1[64 * j], c = y2[64 * j], a2 = z1[64 * j], c2 = z2[64 * j];
                        v[j].x = x.x + w1 * (BLO(a.x) + BLO(a2.x)) + w2 * (BLO(c.x) + BLO(c2.x));
                        v[j].y = x.y + w1 * (BHI(a.x) + BHI(a2.x)) + w2 * (BHI(c.x) + BHI(c2.x));
                        v[j].z = x.z + w1 * (BLO(a.y) + BLO(a2.y)) + w2 * (BLO(c.y) + BLO(c2.y));
                        v[j].w = x.w + w1 * (BHI(a.y) + BHI(a2.y)) + w2 * (BHI(c.y) + BHI(c2.y));
                        s += (v[j].x * v[j].x + v[j].y * v[j].y) + (v[j].z * v[j].z + v[j].w * v[j].w); }
#if DBG
                    { float sm = 0.f, sx = 0.f; const f32x4* xr2 = (const f32x4*)(ap_->out + (size_t)r * DM) + lane;
                      for (int j = 0; j < 4; ++j) { const f32x4 x = xr2[64 * j]; for (int c = 0; c < 4; ++c) { const float mm = v[j][c] - x[c]; sm += mm * mm; sx += x[c] * x[c]; } }
                      sm = wave_sum(sm); sx = wave_sum(sx); if (lane == 0) { if (sm > 1024.f) atomicAdd((float*)(ws + WS_CTL) + 16072, 1.f); if (!(sm < 1e30f)) atomicAdd((float*)(ws + WS_CTL) + 16073, 1.f); atomicAdd((float*)(ws + WS_CTL) + 16070, sm * (1.f / (T * 1024.f))); atomicAdd((float*)(ws + WS_CTL) + 16071, sx * (1.f / (T * 1024.f))); } }
#endif
                    const float rs = 1.0f / sqrtf(wave_sum(s) * (1.f / DM) + EPS);
                    f32x4* orow = (f32x4*)(ap_->out + (size_t)r * DM) + lane;
#pragma unroll
                    for (int j = 0; j < 4; ++j) { const f32x4 gg = ((const f32x4*)gain)[lane + 64 * j]; orow[64 * j] = (f32x4){v[j].x * rs * gg.x, v[j].y * rs * gg.y, v[j].z * rs * gg.z, v[j].w * rs * gg.w} * ((ABL & 256) ? 2.f : 1.f); }
                }
            }
        }
}

__global__ void __launch_bounds__(NWAVES * 64, 2) fwd(Args args) {
    extern __shared__ __attribute__((aligned(16))) unsigned char lds_raw[];
    LAS unsigned char* lds = (LAS unsigned char*)lds_raw;
    const int G = gridDim.x, bid = blockIdx.x, NGW = G * NWAVES;
    const int wid0 = __builtin_amdgcn_readfirstlane((int)threadIdx.x >> 6);
    unsigned* ctl = (unsigned*)(args.ws + WS_CTL);
    const int lo = args.ph_lo, hi = args.ph_hi;
    for (int u = threadIdx.x; u < (LDS_BYTES - LDSCTL_OFF) / 4; u += NWAVES * 64) ((LAS unsigned*)(lds + LDSCTL_OFF))[u] = 0u;
    __syncthreads();
    const bool multi = (hi - lo) > 1;
    XcdBarrier bar; bar.bar = ctl + CW_BAR; bar.x = 0; bar.st = nullptr;
    if (multi) bar = xcd_barrier_post(ctl + CW_BAR, (volatile LAS unsigned*)(lds + LDSCTL_OFF + 32));

    if (PM(0) && IN(PH_PRO)) {
            PHASE_IDS
        LAS float* scr = (LAS float*)(lds + wid * 16896);
        constexpr int IT_WIN = 16 * 64, IT_WOUT = 8 * 32, IT_SQ = 16 * 16, IT_C1 = 32 * 4, IT_C2 = 4 * 8, IT_FG = 16 * 44, IT_FD = 44 * 16, IT_MG = 16 * 56, IT_MD = 56 * 16;
        constexpr int N0 = 2 * IT_WIN, N1 = N0 + 2 * IT_WOUT, N2 = N1 + 8 * IT_SQ, N3 = N2 + 4 * IT_C1, N4 = N3 + 4 * IT_C2, N5 = N4 + 2 * IT_FG, N6 = N5 + IT_FD, N7 = N6 + 16 * IT_MG, N8 = N7 + 8 * IT_MD;
        for (int rep_ = 0; rep_ < REP_PRO; ++rep_)
        for (int it = gw; it < N8; it += NGW) {
            if (it < N0) { const int l = it / IT_WIN, r = it % IT_WIN, kb = r / 64, j = r % 64;
                int n0, ncv, dr = 32 * j;
                if (j < 40) { n0 = 32 * j; ncv = 32; } else if (j < 56) { n0 = 1304 + 32 * (j - 40); ncv = 32; } else if (j == 56) { n0 = 1280; ncv = 24; } else { n0 = 0; ncv = 0; }
                xpose_item(ap_->in[I_W_IN] + (size_t)l * DM * 1816, 1816, 64 * kb, n0, ncv, W16(WS_WIN) + (size_t)l * ZW * DM, DM, dr, scr, lane, ap_->in[I_NORM_MIX] + l * DM);
            } else if (it < N1) { const int r0 = it - N0, l = r0 / IT_WOUT, r = r0 % IT_WOUT, kb = r / 32, j = r % 32;
                xpose_item(ap_->in[I_W_OUT] + (size_t)l * DM * DM, DM, 64 * kb, 32 * j, 32, W16(WS_WOUT) + (size_t)l * DM * DM, DM, 32 * j, scr, lane);
            } else if (it < N2) { const int r0 = it - N1, mtx = r0 / IT_SQ, r = r0 % IT_SQ, which = mtx >> 1, l = mtx & 1;
                const float* src = ap_->in[which == 0 ? I_WQ : which == 1 ? I_WO : which == 2 ? I_WK : I_WV] + (size_t)l * DM * DM;
                bf16_t* dst = W16(which == 0 ? WS_WQ : which == 1 ? WS_WO : which == 2 ? WS_WK : WS_WV) + (size_t)l * DM * DM;
                xpose_mat(src, DM, DM, dst, 0, r, scr, lane, which == 0 ? ap_->in[I_NORM_X] + l * DM : nullptr);
            } else if (it < N3) { const int r0 = it - N2, mtx = r0 / IT_C1, r = r0 % IT_C1, l = mtx >> 1, kv = mtx & 1;
                xpose_mat(ap_->in[kv ? I_W1_V : I_W1_K] + (size_t)l * 2048 * 256, 2048, 256, W16(WS_CW1) + (size_t)mtx * 256 * 2048, 0, r, scr, lane);
            } else if (it < N4) { const int r0 = it - N3, mtx = r0 / IT_C2, r = r0 % IT_C2, l = mtx >> 1, kv = mtx & 1, kb = r / 8, j = r % 8;
                xpose_item(ap_->in[kv ? I_W2_V : I_W2_K] + (size_t)l * 256 * 64, 64, 64 * kb, j < 2 ? 32 * j : 0, j < 2 ? 32 : 0, W16(WS_CW2) + (size_t)mtx * 256 * 256, 256, 32 * j, scr, lane);
            } else if (it < N5) { const int r0 = it - N4, up = r0 / IT_FG, r = r0 % IT_FG;
                xpose_mat(ap_->in[up ? I_FFN_WU : I_FFN_WG], DM, DFF, W16(WS_FGU), up ? 2 : 1, r, scr, lane, ap_->in[I_NORM_FFN]);
            } else if (it < N6) { xpose_mat(ap_->in[I_FFN_WD], DFF, DM, W16(WS_FD), 0, it - N5, scr, lane);
            } else if (it < N7) { const int r0 = it - N6, mtx = r0 / IT_MG, r = r0 % IT_MG, e = mtx >> 1, up = mtx & 1;
                xpose_mat(ap_->in[up ? I_MOE_WU : I_MOE_WG] + (size_t)e * DM * DFFE, DM, DFFE, W16(WS_MGU) + (size_t)e * 7168 * DM, up ? 2 : 1, r, scr, lane);
            } else { const int r0 = it - N7, e = r0 / IT_MD, r = r0 % IT_MD;
                xpose_mat(ap_->in[I_MOE_WD] + (size_t)e * DFFE * DM, DFFE, DM, W16(WS_MD) + (size_t)e * DM * DFFE, 0, r, scr, lane);
            }
        }
        for (int i = bid * 512 + tid; i < SEQ * 8; i += G * 512) {
            const int pos = i >> 3, j = i & 7;
            const double inv = j == 0 ? 1.0 : j == 1 ? 0.19389587045179572 : j == 2 ? 0.037606030930863934 : j == 3 ? 0.007291654101443755 : j == 4 ? 0.0014142135623730951
                             : j == 5 ? 0.00027421616994972156 : j == 6 ? 5.3169310700017e-05 : 1.0309310618636385e-05;
            float s, c; sincos_d((double)pos * inv, s, c);
            ((float*)(ws + WS_ROPE))[2 * i] = c; ((float*)(ws + WS_ROPE))[2 * i + 1] = s;
        }
        for (int r = gw; r < T; r += NGW) { const f32x4* xr = (const f32x4*)(ap_->in[I_X] + (size_t)r * DM) + lane; unsigned long long* o8 = (unsigned long long*)(W16(WS_HB) + (size_t)r * DM) + lane; float sq = 0.f;
#pragma unroll
            for (int j = 0; j < 4; ++j) { const f32x4 v = xr[64 * j]; sq += (v.x * v.x + v.y * v.y) + (v.z * v.z + v.w * v.w); o8[64 * j] = (unsigned long long)pk2(v.x, v.y) | ((unsigned long long)pk2(v.z, v.w) << 32); }
            sq = wave_sum(sq); if (lane == 0) SSP(0)[r] = ss_fix(sq); }
        for (int r = gw; r < 2 * 1024; r += NGW) { const int l = r >> 10, row = r & 1023;
            norm_row(ap_->in[I_MEM] + (size_t)row * DM, ap_->in[I_NORM_MEM] + l * DM, W16(WS_MN) + (size_t)r * DM, lane); }
        for (int itb = gw; itb < 4 * 4 * 16; itb += NGW) { const int mtx = itb >> 6, cg = (itb >> 4) & 3, fc = itb & 15, l = mtx >> 1, kv = mtx & 1, c = cg * 64 + lane;
            const float* pe = ap_->in[kv ? I_PE_V : I_PE_K] + l * 2048 + fc * 128; const float* w1 = ap_->in[kv ? I_W1_V : I_W1_K] + (size_t)l * 2048 * 256 + (size_t)fc * 128 * 256 + c;
            float a = fc == 0 ? ap_->in[kv ? I_B1_V : I_B1_K][l * 256 + c] : 0.f;
#pragma unroll 8
            for (int f = 0; f < 128; ++f) a += pe[f] * w1[(size_t)f * 256];
            atomicAdd((unsigned long long*)(ctl + CW_BIAS) + mtx * 256 + c, (unsigned long long)(long long)((double)a * 1099511627776.0)); }
        for (int itw = gw; itw < 2 * 4 * 16 * 16; itw += NGW) { const int l = itw >> 10, g = (itw >> 8) & 3, nb = (itw >> 4) & 15, cb = itw & 15, n = nb * 64 + lane;
            const float* wp = ap_->in[I_W_POOL] + ((size_t)(l * 4 + g) * 128 + cb * 8) * 128; const float* ps = ap_->in[I_POOL_SCALE] + l * 512 + g * 128;
            const float* wo = ap_->in[I_W_OUT] + (size_t)l * DM * DM + (size_t)(512 + g * 128) * DM + n;
            float a[8];
#pragma unroll
            for (int c = 0; c < 8; ++c) a[c] = 0.f;
            for (int e = 0; e < 128; ++e) { const float w = wo[(size_t)e * DM] * ps[e];
#pragma unroll
                for (int c = 0; c < 8; ++c) a[c] += wp[c * 128 + e] * w; }
            u32x4 o; o.x = pk2(a[0], a[1]); o.y = pk2(a[2], a[3]); o.z = pk2(a[4], a[5]); o.w = pk2(a[6], a[7]);
            *(u32x4*)(W16(WS_WOUT) + (size_t)l * DM * DM + (size_t)n * DM + 512 + g * 128 + cb * 8) = o; }
        __syncthreads();
        SEAM(PH_PRO);
    }
    layer_phases<0>(lds, lo, hi, bar, G, bid, NGW, wid0);
    layer_phases<1>(lds, lo, hi, bar, G, bid, NGW, wid0);
#undef IN
#undef SEAM
}

#if DBG
struct DbgIn { const float* in[30]; };
__device__ float dbg_block_sum(float v, float* red) { const int t = threadIdx.x; red[t] = v; __syncthreads(); for (int o = 128; o > 0; o >>= 1) { if (t < o) red[t] += red[t + o]; __syncthreads(); } const float r = red[0]; __syncthreads(); return r; }
__global__ void dbg_check(DbgIn di, const float* xcur, unsigned char* ws, int stage) {
    __shared__ float red[256]; __shared__ float act[3584]; __shared__ float hrow[1024];
    const int t = threadIdx.x; float* W = (float*)(ws + WS_CTL) + 16000;
    const unsigned* sl = (const unsigned*)(ws + WS_SLOT); const unsigned* rt = (const unsigned*)(ws + WS_ROUTE); const bf16_t* hp = (const bf16_t*)(ws + WS_HP); const bf16_t* ac = (const bf16_t*)(ws + WS_ACTC);
    const int toks[4] = {0, 5000, 12000, 16383}; float worst = 0.f; int nchk = 0;
    for (int q = 0; q < 4; ++q) for (int kk = 0; kk < 2; ++kk) { const int tok = toks[q]; const unsigned e = rt[tok * 8 + kk], sidx = sl[tok * 4 + kk]; const int ch = sidx >= (unsigned)(HALFT * 256) ? 1 : 0;
        if (stage == 1) {
            float ss = 0.f; for (int c = t; c < 1024; c += 256) { const float x = xcur[(size_t)tok * 1024 + c]; ss += x * x; } ss = dbg_block_sum(ss, red);
            const float rs = 1.f / sqrtf(ss / 1024.f + EPS); float num = 0.f, den = 0.f;
            for (int c = t; c < 1024; c += 256) { const float h = xcur[(size_t)tok * 1024 + c] * rs * di.in[I_NORM_FFN][1024 + c], f = bf2f(hp[(size_t)sidx * 1024 + c]); num += (h - f) * (h - f); den += h * h; }
            num = dbg_block_sum(num, red); den = dbg_block_sum(den, red); worst = fmaxf(worst, sqrtf(num / fmaxf(den, 1e-20f))); ++nchk;
        } else if ((stage == 2 && ch == 0) || (stage == 4 && ch == 1)) {
            for (int c = t; c < 1024; c += 256) hrow[c] = bf2f(hp[(size_t)sidx * 1024 + c]); __syncthreads();
            const float* wg = di.in[I_MOE_WG] + (size_t)e * DM * DFFE; const float* wu = di.in[I_MOE_WU] + (size_t)e * DM * DFFE; float num = 0.f, den = 0.f;
            for (int j = t; j < 3584; j += 256) { float g = 0.f, u = 0.f; for (int k2 = 0; k2 < 1024; ++k2) { g += hrow[k2] * wg[(size_t)k2 * DFFE + j]; u += hrow[k2] * wu[(size_t)k2 * DFFE + j]; }
                const float a = g / (1.f + expf(-g)) * u, f = bf2f(ac[((size_t)sidx - (size_t)ch * HALFT * 256) * 3584 + j]); num += (a - f) * (a - f); den += a * a; }
            num = dbg_block_sum(num, red); den = dbg_block_sum(den, red); worst = fmaxf(worst, sqrtf(num / fmaxf(den, 1e-20f))); ++nchk; __syncthreads();
        } else if ((stage == 3 && ch == 0) || (stage == 5 && ch == 1)) {
            for (int j = t; j < 3584; j += 256) act[j] = bf2f(ac[((size_t)sidx - (size_t)ch * HALFT * 256) * 3584 + j]); __syncthreads();
            const float* wd = di.in[I_MOE_WD] + (size_t)e * DFFE * DM; float num = 0.f, den = 0.f;
            for (int n = t; n < 1024; n += 256) { float y = 0.f; for (int j = 0; j < 3584; ++j) y += act[j] * wd[(size_t)j * DM + n]; const float f = bf2f(hp[(size_t)sidx * 1024 + n]); num += (y - f) * (y - f); den += y * y; }
            num = dbg_block_sum(num, red); den = dbg_block_sum(den, red); worst = fmaxf(worst, sqrtf(num / fmaxf(den, 1e-20f))); ++nchk; __syncthreads();
        } }
    if (stage == 1) {
        float mism = 0.f, werr = 0.f;
        for (int q = 0; q < 64; ++q) { const int tok = q * 251 + 3;
            float ss = 0.f; for (int c = t; c < 1024; c += 256) { const float x = xcur[(size_t)tok * 1024 + c]; ss += x * x; } ss = dbg_block_sum(ss, red);
            const float rs = 1.f / sqrtf(ss / 1024.f + EPS); float lg[8];
            for (int e = 0; e < 8; ++e) { float a = 0.f; for (int c = t; c < 1024; c += 256) a += xcur[(size_t)tok * 1024 + c] * rs * di.in[I_NORM_FFN][1024 + c] * di.in[I_ROUTER][c * 8 + e]; lg[e] = dbg_block_sum(a, red); }
            int i1 = 0; for (int e = 1; e < 8; ++e) if (lg[e] > lg[i1]) i1 = e; int i2 = -1; for (int e = 0; e < 8; ++e) if (e != i1 && (i2 < 0 || lg[e] > lg[i2])) i2 = e;
            const float w1 = 1.f / (1.f + expf(lg[i2] - lg[i1]));
            if ((int)rt[tok * 8] != i1 || (int)rt[tok * 8 + 1] != i2) mism += 1.f;
            werr = fmaxf(werr, fabsf(w1 - __builtin_bit_cast(float, rt[tok * 8 + 4]))); }
        if (t == 0) { W[8] = mism; W[9] = werr; } }
    if (stage == 5) {
        float sx = 0.f, sm = 0.f;
        for (int q = 0; q < 4; ++q) { const int tok = toks[q]; const unsigned s1 = sl[tok * 4], s2 = sl[tok * 4 + 1]; const float w1 = __builtin_bit_cast(float, sl[tok * 4 + 2]), w2 = __builtin_bit_cast(float, sl[tok * 4 + 3]);
            for (int c = t; c < 1024; c += 256) { const float x = xcur[(size_t)tok * 1024 + c], m = w1 * bf2f(hp[(size_t)s1 * 1024 + c]) + w2 * bf2f(hp[(size_t)s2 * 1024 + c]); sx += x * x; sm += m * m; } }
        sx = dbg_block_sum(sx, red); sm = dbg_block_sum(sm, red);
        if (t == 0) { W[6] = sx / 4096.f; W[7] = sm / 4096.f; } }
    if (t == 0) { W[stage] = worst; W[10 + stage] = (float)nchk; }
}
__global__ void dbg_attn(unsigned char* ws, int b, int g, int t, int slotw) {
    __shared__ float red[256]; __shared__ float lgt[4096]; __shared__ float pcs[4][256]; __shared__ float osum[4][64]; __shared__ int selb[64]; __shared__ float impv[64];
    const int tid = threadIdx.x, bg = b * 2 + g, tok = b * SEQ + t; float* W = (float*)(ws + WS_CTL) + 16000;
    const bf16_t* qraw = (const bf16_t*)(ws + WS_QRAW) + ((size_t)bg * SEQ + t) * 256; const bf16_t* qrot = (const bf16_t*)(ws + WS_QROT) + ((size_t)bg * SEQ + t) * 256;
    const bf16_t* kc = (const bf16_t*)(ws + WS_KCMP) + (size_t)bg * 256 * 64; const bf16_t* vc = kc + 8 * 256 * 64;
    const bf16_t* kvb = (const bf16_t*)(ws + WS_KV); const float* gt = (const float*)(ws + WS_GATES) + (size_t)tok * 24 + g * 12;
    const int nv = t >= 15 ? ((t - 15) >> 4) : 0, tb = t >> 6;
    for (int i = tid; i < 256; i += 256) osum[i >> 6][i & 63] = 0.f;
    __syncthreads();
    for (int r = 0; r < 4; ++r) {
        float s = -INFINITY; const int c = tid;
        if (c < 255 && c < nv) { s = 0.f; for (int d = 0; d < 64; ++d) s += bf2f(qraw[r * 64 + d]) * bf2f(kc[c * 64 + d]); }
        red[tid] = s; __syncthreads(); for (int o = 128; o > 0; o >>= 1) { if (tid < o) red[tid] = fmaxf(red[tid], red[tid + o]); __syncthreads(); } float m = red[0]; __syncthreads(); if (m == -INFINITY) m = 0.f;
        const float p = s == -INFINITY ? 0.f : exp2f(s - m); const float l = dbg_block_sum(p, red);
        pcs[r][c] = l > 0.f ? p / l : 0.f; __syncthreads();
        if (tid < 64) { float o = 0.f; for (int cc = 0; cc < 255; ++cc) o += bf2f((unsigned short)f2bf(pcs[r][cc])) * bf2f(vc[cc * 64 + tid]); osum[r][tid] += gt[r * 3 + 0] * o; }
        __syncthreads();
    }
    if (tid < 64) { float im = 0.f; for (int j = -1; j < 4; ++j) { const int c = 4 * tid + j; if (c >= 0 && c < 255) for (int r = 0; r < 4; ++r) im += pcs[r][c]; }
        const bool fut = tid > tb, forced = tid == 0 || tid == tb || tid == tb - 1; impv[tid] = fut ? -INFINITY : forced ? INFINITY : im; selb[tid] = 0; }
    __syncthreads();
    if (tid == 0) { for (int k = 0; k < 16; ++k) { int best = -1; float bv = 0.f; for (int n = 0; n < 64; ++n) if (!selb[n] && (best < 0 || impv[n] > bv)) { best = n; bv = impv[n]; } selb[best] = 1; } }
    __syncthreads();
    for (int br = 1; br <= 2; ++br) {
        const bf16_t* kb = kvb + (size_t)(br == 1 ? 2 : 4) * KVSZ + (size_t)bg * SEQ * 64; const bf16_t* vb = kvb + (size_t)(br == 1 ? 3 : 5) * KVSZ + (size_t)bg * SEQ * 64;
        for (int r = 0; r < 4; ++r) {
            float mx = -INFINITY;
            for (int j = tid; j < SEQ; j += 256) { bool ok = j <= t; if (br == 1) ok = ok && selb[j >> 6]; else ok = ok && (t - j) < 512;
                float sv = -INFINITY; if (ok) { sv = 0.f; for (int d = 0; d < 64; ++d) sv += bf2f(qrot[r * 64 + d]) * bf2f(kb[(size_t)j * 64 + d]); } lgt[j] = sv; mx = fmaxf(mx, sv); }
            red[tid] = mx; __syncthreads(); for (int o = 128; o > 0; o >>= 1) { if (tid < o) red[tid] = fmaxf(red[tid], red[tid + o]); __syncthreads(); } const float m = red[0]; __syncthreads();
            float ls = 0.f; for (int j = tid; j < SEQ; j += 256) { const float p = lgt[j] == -INFINITY ? 0.f : exp2f(lgt[j] - m); lgt[j] = p; ls += p; }
            const float l = dbg_block_sum(ls, red);
            if (tid < 64) { float o = 0.f; for (int j = 0; j <= t; ++j) o += lgt[j] * bf2f(vb[(size_t)j * 64 + tid]); osum[r][tid] += gt[r * 3 + br] * o / l; }
            __syncthreads();
        }
    }
    const bf16_t* ab = (const bf16_t*)(ws + WS_AB) + (size_t)tok * 1024 + g * 256;
    float num = 0.f, den = 0.f; { const float o = osum[tid >> 6][tid & 63], f = bf2f(ab[tid]); num = (o - f) * (o - f); den = o * o; }
    num = dbg_block_sum(num, red); den = dbg_block_sum(den, red);
    if (tid == 0) { W[slotw] = sqrtf(num / fmaxf(den, 1e-30f)); W[slotw + 40] = sqrtf(den / 256.f); }
}
__global__ void dbg_mixer(DbgIn di, const float* outp, unsigned char* ws, int stage) {
    __shared__ float red[256]; __shared__ float hrow[1024]; __shared__ float zrow[1816]; __shared__ float hid[256];
    const int t = threadIdx.x; float* W = (float*)(ws + WS_CTL) + 16000;
    const bf16_t* hb = (const bf16_t*)(ws + WS_HB); const bf16_t* kvb = (const bf16_t*)(ws + WS_KV);
    const int toks[4] = {7, 4101, 9000, 16383};
    if (stage == 30) {
        float nq = 0, dq = 0, nr = 0, dr = 0, nk = 0, dk = 0, nkr = 0, dkr = 0, nu = 0, du = 0, ng = 0, dg = 0;
        for (int q = 0; q < 4; ++q) { const int tok = toks[q], b = tok >> 12, pos = tok & 4095;
            for (int c = t; c < 1024; c += 256) hrow[c] = bf2f(hb[(size_t)tok * 1024 + c]); __syncthreads();
            for (int n = t; n < 1816; n += 256) { float a = 0.f; for (int k = 0; k < 1024; ++k) a += hrow[k] * di.in[I_W_IN][(size_t)k * 1816 + n]; zrow[n] = a; } __syncthreads();
            for (int n = t; n < 1816; n += 256) { const float z = zrow[n];
                if (n < 512) { const int g = n >> 8, c = n & 255, d = n & 63; const size_t idx = ((size_t)(b * 2 + g) * SEQ + pos) * 256 + c;
                    const float f = bf2f(((const bf16_t*)(ws + WS_QRAW))[idx]) / C2; nq += (z - f) * (z - f); dq += z * z;
                    float zr = z; if (d < 16) { const int j = d & 7; const double inv = pow(500000.0, -(double)j / 8.0); const float cs = (float)cos((double)pos * inv), sn = (float)sin((double)pos * inv);
                        zr = d < 8 ? z * cs - zrow[n + 8] * sn : z * cs + zrow[n - 8] * sn; }
                    const float fr = bf2f(((const bf16_t*)(ws + WS_QROT))[idx]) / C2; nr += (zr - fr) * (zr - fr); dr += zr * zr;
                } else if (n < 1280) { const int m = n - 512, i = m >> 7, g = (m >> 6) & 1, d = m & 63; const float f = bf2f(kvb[(size_t)i * KVSZ + ((size_t)(b * 2 + g) * SEQ + pos) * 64 + d]);
                    if (i == 2 || i == 4) { float zr = z; if (d < 16) { const int j = d & 7; const double inv = pow(500000.0, -(double)j / 8.0); const float cs = (float)cos((double)pos * inv), sn = (float)sin((double)pos * inv);
                            zr = d < 8 ? z * cs - zrow[n + 8] * sn : z * cs + zrow[n - 8] * sn; } nkr += (zr - f) * (zr - f); dkr += zr * zr; }
                    else { nk += (z - f) * (z - f); dk += z * z; }
                } else if (n < 1304) { const float sg = 1.f / (1.f + expf(-z)), f = ((const float*)(ws + WS_GATES))[(size_t)tok * 24 + (n - 1280)]; ng += (sg - f) * (sg - f); dg += sg * sg;
                } else { const float f = bf2f(((const bf16_t*)(ws + WS_U))[(size_t)tok * 512 + (n - 1304)]); nu += (z - f) * (z - f); du += z * z; } }
            __syncthreads(); }
        nq = dbg_block_sum(nq, red); dq = dbg_block_sum(dq, red); nr = dbg_block_sum(nr, red); dr = dbg_block_sum(dr, red); nk = dbg_block_sum(nk, red); dk = dbg_block_sum(dk, red);
        nkr = dbg_block_sum(nkr, red); dkr = dbg_block_sum(dkr, red); nu = dbg_block_sum(nu, red); du = dbg_block_sum(du, red); ng = dbg_block_sum(ng, red); dg = dbg_block_sum(dg, red);
        if (t == 0) { W[30] = sqrtf(nq / dq); W[31] = sqrtf(nr / dr); W[32] = sqrtf(nk / dk); W[33] = sqrtf(nkr / dkr); W[34] = sqrtf(nu / du); W[35] = sqrtf(ng / dg); }
    }
    if (stage == 31) {
        float nc = 0, dc = 0, nd = 0, dd = 0;
        const int cs_[4] = {0, 17, 200, 254};
        for (int q = 0; q < 4; ++q) for (int kv = 0; kv < 2; ++kv) { const int bg = (q * 3 + 1) & 7, c = cs_[q];
            const bf16_t* src = kvb + (size_t)kv * KVSZ + ((size_t)bg * SEQ + 16 * c) * 64; const float* pe = di.in[kv ? I_PE_V : I_PE_K]; const float* w1 = di.in[kv ? I_W1_V : I_W1_K]; const float* b1 = di.in[kv ? I_B1_V : I_B1_K]; const float* w2 = di.in[kv ? I_W2_V : I_W2_K];
            { float a = b1[t]; for (int f = 0; f < 2048; ++f) a += (bf2f(src[f]) + pe[f]) * w1[(size_t)f * 256 + t]; const float y = 0.7978845608f * (a + 0.044715f * a * a * a); hid[t] = 0.5f * a * (1.f + tanhf(y)); } __syncthreads();
            if (t < 64) { float o = 0.f; for (int h = 0; h < 256; ++h) o += hid[h] * w2[h * 64 + t]; const float f = bf2f(((const bf16_t*)(ws + WS_KCMP))[(size_t)kv * 8 * 256 * 64 + ((size_t)bg * 256 + c) * 64 + t]); nc += (o - f) * (o - f); dc += o * o; } __syncthreads(); }
        for (int q = 0; q < 4; ++q) { const int tok = toks[q], pos = tok & 4095; for (int c = t; c < 512; c += 256) { const int w = 2 << (c >> 7), n = (pos + 1) < w ? (pos + 1) : w; float sm = 0.f; const bf16_t* ub = (const bf16_t*)(ws + WS_U);
                for (int i = 0; i < n; ++i) sm += bf2f(ub[(size_t)(tok - i) * 512 + c]); const float d = sm / n - bf2f(ub[(size_t)tok * 512 + c]), f = bf2f(((const bf16_t*)(ws + WS_AB))[(size_t)tok * 1024 + 512 + c]); nd += (d - f) * (d - f); dd += d * d; } }
        nc = dbg_block_sum(nc, red); dc = dbg_block_sum(dc, red); nd = dbg_block_sum(nd, red); dd = dbg_block_sum(dd, red);
        if (t == 0) { W[36] = sqrtf(nc / dc); W[37] = sqrtf(nd / dd); }
    }
    if (stage == 32) {
        float nn = 0, dn = 0; const bf16_t* ab = (const bf16_t*)(ws + WS_AB);
        for (int q = 0; q < 4; ++q) { const int tok = toks[q];
            for (int c = t; c < 1024; c += 256) hrow[c] = bf2f(ab[(size_t)tok * 1024 + c]); __syncthreads();
            for (int ge = t; ge < 512; ge += 256) { const int g = ge >> 7, e = ge & 127; float y = 0.f; for (int c = 0; c < 128; ++c) y += hrow[512 + g * 128 + c] * di.in[I_W_POOL][((size_t)g * 128 + c) * 128 + e]; zrow[ge] = y * di.in[I_POOL_SCALE][ge]; } __syncthreads();
            for (int n = t; n < 1024; n += 256) { float a = di.in[I_X][(size_t)tok * 1024 + n]; const float x0 = a; for (int k = 0; k < 512; ++k) a += hrow[k] * di.in[I_W_OUT][(size_t)k * 1024 + n]; for (int k = 0; k < 512; ++k) a += zrow[k] * di.in[I_W_OUT][(size_t)(512 + k) * 1024 + n];
                const float f = outp[(size_t)tok * 1024 + n]; nn += (a - f) * (a - f); dn += (a - x0) * (a - x0); } __syncthreads(); }
        nn = dbg_block_sum(nn, red); dn = dbg_block_sum(dn, red);
        if (t == 0) W[38] = sqrtf(nn / dn);
    }
}
__global__ void dbg_moe_tok(DbgIn di, const float* xcur, unsigned char* ws) {
    __shared__ float red[256]; __shared__ float hrow[1024]; __shared__ float act[3584]; __shared__ float ynaive[1024];
    const int t = threadIdx.x, tok = blockIdx.x * 251 + 3; float* W = (float*)(ws + WS_CTL) + 16000;
    const unsigned* sl = (const unsigned*)(ws + WS_SLOT); const unsigned* rt = (const unsigned*)(ws + WS_ROUTE); const bf16_t* hp = (const bf16_t*)(ws + WS_HP);
    float ss = 0.f; for (int c = t; c < 1024; c += 256) { const float x = xcur[(size_t)tok * 1024 + c]; ss += x * x; } ss = dbg_block_sum(ss, red);
    const float rs = 1.f / sqrtf(ss / 1024.f + EPS);
    for (int c = t; c < 1024; c += 256) { hrow[c] = xcur[(size_t)tok * 1024 + c] * rs * di.in[I_NORM_FFN][1024 + c]; ynaive[c] = 0.f; } __syncthreads();
    float lg[8]; for (int e = 0; e < 8; ++e) { float a = 0.f; for (int c = t; c < 1024; c += 256) a += hrow[c] * di.in[I_ROUTER][c * 8 + e]; lg[e] = dbg_block_sum(a, red); }
    int i1 = 0; for (int e = 1; e < 8; ++e) if (lg[e] > lg[i1]) i1 = e; int i2 = -1; for (int e = 0; e < 8; ++e) if (e != i1 && (i2 < 0 || lg[e] > lg[i2])) i2 = e;
    const float w1 = 1.f / (1.f + expf(lg[i2] - lg[i1]));
    for (int kk = 0; kk < 2; ++kk) { const int e = kk ? i2 : i1; const float wgt = kk ? 1.f - w1 : w1;
        const float* wg = di.in[I_MOE_WG] + (size_t)e * DM * DFFE; const float* wu = di.in[I_MOE_WU] + (size_t)e * DM * DFFE; const float* wd = di.in[I_MOE_WD] + (size_t)e * DFFE * DM;
        for (int j = t; j < 3584; j += 256) { float g = 0.f, u = 0.f; for (int k2 = 0; k2 < 1024; ++k2) { g += hrow[k2] * wg[(size_t)k2 * DFFE + j]; u += hrow[k2] * wu[(size_t)k2 * DFFE + j]; } act[j] = g / (1.f + expf(-g)) * u; } __syncthreads();
        for (int n = t; n < 1024; n += 256) { float y = 0.f; for (int j = 0; j < 3584; ++j) y += act[j] * wd[(size_t)j * DM + n]; ynaive[n] += wgt * y; } __syncthreads(); }
    const unsigned s1 = sl[tok * 4], s2 = sl[tok * 4 + 1]; const float f1 = __builtin_bit_cast(float, sl[tok * 4 + 2]), f2 = __builtin_bit_cast(float, sl[tok * 4 + 3]);
    float num = 0.f, den = 0.f; for (int n = t; n < 1024; n += 256) { const bf16_t* yb = (const bf16_t*)(ws + WS_YB); const float m = f1 * (bf2f(hp[(size_t)s1 * 1024 + n]) + bf2f(yb[(size_t)s1 * 1024 + n])) + f2 * (bf2f(hp[(size_t)s2 * 1024 + n]) + bf2f(yb[(size_t)s2 * 1024 + n])); num += (m - ynaive[n]) * (m - ynaive[n]); den += ynaive[n] * ynaive[n]; }
    num = dbg_block_sum(num, red); den = dbg_block_sum(den, red);
    if (t == 0) { const float er = sqrtf(num / den); atomicMax((unsigned*)&W[50], __builtin_bit_cast(unsigned, er)); if (er > 0.1f) atomicAdd(&W[51], 1.f); atomicAdd(&W[52], er / 64.f); }
}
#ifndef DBGBR
#define DBGBR -1
#endif
__global__ void dbg_setgates(unsigned char* ws, int br) { float* g = (float*)(ws + WS_GATES); for (size_t i = (size_t)blockIdx.x * 256 + threadIdx.x; i < (size_t)T * 24; i += (size_t)gridDim.x * 256) g[i] = ((int)(i % 3) == br) ? 1.f : 0.f; }
#ifndef DBGV1
#define DBGV1 0
#endif
__global__ void dbg_setv(unsigned char* ws) { bf16_t* kv = (bf16_t*)(ws + WS_KV); for (size_t i = (size_t)blockIdx.x * 256 + threadIdx.x; i < KVSZ; i += (size_t)gridDim.x * 256) { kv[3 * KVSZ + i] = 0x3F80; kv[5 * KVSZ + i] = 0x3F80; } }
__global__ void dbg_tail(float* out, unsigned char* ws) {
    const int t = threadIdx.x; const float* W = (const float*)(ws + WS_CTL) + 16000; float k = 0.f;
    if (DBG == 100) { for (int i = 1; i < 10; ++i) if (W[i] > 0.05f) { k = (float)i; break; } }
    else if (DBG == 103) { int m = 0; for (int i = 0; i < 6; ++i) if (!(W[20 + i] <= 0.05f)) m |= 1 << i; k = (float)m; }
    else if (DBG == 104) { int m = 0; for (int i = 6; i < 8; ++i) if (!(W[20 + i] <= 0.05f)) m |= 1 << (i - 6); k = (float)m; }
    else if (DBG == 105 || DBG == 106) { float mn = 1e30f, mx = 0.f; for (int i = 0; i < 8; ++i) { mn = fminf(mn, W[20 + i]); mx = fmaxf(mx, W[20 + i]); }
        k = rintf(10.f * (log10f(fmaxf(DBG == 105 ? mn : mx, 1e-6f)) + 6.f)); k = fminf(fmaxf(k, 0.f), 89.f); }
    else if (DBG == 107) { for (int i = 30; i <= 38; ++i) if (!(W[i] <= 0.03f)) { k = (float)(i - 29); break; } }
    else if (DBG == 101) { for (int i = 0; i < 8; ++i) if (!(W[20 + i] <= 0.05f)) { k = (float)(i + 1); break; } }
    else { k = rintf(10.f * (log10f(fmaxf(W[DBG], 1e-6f)) + 6.f)); k = fminf(fmaxf(k, 0.f), 89.f); }
    const float c = sqrtf(0.1f * k + 0.02f);
    for (size_t i = (size_t)blockIdx.x * 256 + t; i < (size_t)T * DM; i += (size_t)gridDim.x * 256) out[i] = c;
}
#endif

extern "C" void kernel_launch(void* const* d_in, const int* in_sizes, int n_in, void* d_out, int out_size, void* d_ws, size_t ws_size, hipStream_t stream) {
    static int grid = 0;
    if (grid == 0) {
        if (n_in != 30 || out_size != T * DM || ws_size < WS_END) { fprintf(stderr, "kernel_launch: unexpected problem shape / workspace (%d inputs, out %d, ws %zu)\n", n_in, out_size, ws_size); grid = -1; return; }
        int dev = 0, cus = 0;
        if (hipGetDevice(&dev) != hipSuccess || hipDeviceGetAttribute(&cus, hipDeviceAttributeMultiprocessorCount, dev) != hipSuccess) { grid = -1; return; }
        if (hipFuncSetAttribute((const void*)fwd, hipFuncAttributeMaxDynamicSharedMemorySize, LDS_BYTES) != hipSuccess) { fprintf(stderr, "kernel_launch: hipFuncSetAttribute failed\n"); grid = -1; return; }
        int per_cu = 0;
        if (hipOccupancyMaxActiveBlocksPerMultiprocessor(&per_cu, (const void*)fwd, NWAVES * 64, LDS_BYTES) != hipSuccess || per_cu < 1) { fprintf(stderr, "kernel_launch: occupancy query says %d\n", per_cu); }
        (void)hipGetLastError();
        if (cus != 256) { fprintf(stderr, "kernel_launch: built for a 256-CU device, found %d\n", cus); grid = -1; return; }
        grid = cus;
    }
    if (grid < 0) return;
    if (hipMemsetAsync((char*)d_ws + WS_CTL, 0, CTL_ZERO_BYTES, stream) != hipSuccess) return;
    Args a{};
    for (int i = 0; i < 30; ++i) a.in[i] = (const float*)d_in[i];
    a.out = (float*)d_out; a.ws = (unsigned char*)d_ws;
#if MK_PER_PHASE
    int ids[64]; int n = 0;
    ids[n++] = PH_PRO;
    for (int l = 0; l < NL; ++l) { const int pb = PH_L0 + l * PH_LSTRIDE; for (int k = 0; k < 9; ++k) if (k != PO_N2 && k != PO_S && k != PO_PV) ids[n++] = pb + k;
        if (l == 0) { ids[n++] = pb + PO_F0 + 1; ids[n++] = pb + PO_F0 + 2; } else for (int k = 0; k < 7; ++k) ids[n++] = pb + PO_F0 + k; }
    for (int i = 0; i < n; ++i) { a.ph_lo = ids[i]; a.ph_hi = ids[i] + 1; hipLaunchKernelGGL(fwd, dim3(grid), dim3(NWAVES * 64), LDS_BYTES, stream, a);
#if DBG
        { DbgIn di; for (int q = 0; q < 30; ++q) di.in[q] = (const float*)d_in[q]; const int st = ids[i] - (PH_L0 + PH_LSTRIDE + PO_F0);
          if (st == 5) hipLaunchKernelGGL(dbg_moe_tok, dim3(64), dim3(256), 0, stream, di, (const float*)d_out, (unsigned char*)d_ws);
          if (st >= 1 && st <= 5) hipLaunchKernelGGL(dbg_check, dim3(1), dim3(256), 0, stream, di, (const float*)d_out, (unsigned char*)d_ws, st);
          if (ids[i] == PH_L0 + PO_WIN && DBGBR >= 0) hipLaunchKernelGGL(dbg_setgates, dim3(256), dim3(256), 0, stream, (unsigned char*)d_ws, DBGBR);
          if (ids[i] == PH_L0 + PO_WIN && DBGV1) hipLaunchKernelGGL(dbg_setv, dim3(256), dim3(256), 0, stream, (unsigned char*)d_ws);
          if (ids[i] == PH_L0 + PO_WIN) hipLaunchKernelGGL(dbg_mixer, dim3(1), dim3(256), 0, stream, di, (const float*)d_out, (unsigned char*)d_ws, 30);
          if (ids[i] == PH_L0 + PO_CMP) hipLaunchKernelGGL(dbg_mixer, dim3(1), dim3(256), 0, stream, di, (const float*)d_out, (unsigned char*)d_ws, 31);
          if (ids[i] == PH_L0 + PO_WOUT) hipLaunchKernelGGL(dbg_mixer, dim3(1), dim3(256), 0, stream, di, (const float*)d_out, (unsigned char*)d_ws, 32);
          if (ids[i] == PH_L0 + PO_ATT) { const int pt[8] = {5, 40, 100, 700, 1000, 1500, 3000, 4095};
            for (int q = 0; q < 8; ++q) hipLaunchKernelGGL(dbg_attn, dim3(1), dim3(256), 0, stream, (unsigned char*)d_ws, q & 3, q & 1, pt[q], 20 + q); } }
#endif
    }
#else
    a.ph_lo = 0; a.ph_hi = 1000;
    hipLaunchKernelGGL(fwd, dim3(grid), dim3(NWAVES * 64), LDS_BYTES, stream, a);
#endif
#if DBG
    hipLaunchKernelGGL(dbg_tail, dim3(64), dim3(256), 0, stream, (float*)d_out, (unsigned char*)d_ws);
#endif
}
```

```cpp
#include <hip/hip_runtime.h>
#include <cstdio>
#include <cstdint>
#include <cmath>

#ifndef DBG
#define DBG 0
#endif
#ifndef XMODE
#define XMODE 0
#endif
#ifndef XDIAG
#define XDIAG 0
#endif
#ifndef RES_BF16
#define RES_BF16 1
#endif
#ifndef REP_MASK
#define REP_MASK 0u
#endif
#define REPN(b) (((REP_MASK >> (b)) & 1u) ? 2 : 1)
#ifndef REP_ATT
#define REP_ATT 1
#endif
#ifndef REP_PRO
#define REP_PRO 1
#endif
#ifndef REP_CMP
#define REP_CMP 1
#endif
#ifndef MK_PER_PHASE
#define MK_PER_PHASE 0
#endif

#define LAS __attribute__((address_space(3)))
#define GAS __attribute__((address_space(1)))
typedef unsigned short bf16_t;
typedef short bf16x8 __attribute__((ext_vector_type(8)));
typedef short s16x4 __attribute__((ext_vector_type(4)));
typedef float f32x2 __attribute__((ext_vector_type(2)));
typedef float f32x4 __attribute__((ext_vector_type(4)));
typedef float f32x16 __attribute__((ext_vector_type(16)));
typedef unsigned u32x4 __attribute__((ext_vector_type(4)));
typedef unsigned u32x2 __attribute__((ext_vector_type(2)));

constexpr int NB = 4, SEQ = 4096, DM = 1024, T = NB * SEQ, NL = 2;
constexpr int ZW = 2048;
constexpr int DFF = 2816, DFFE = 3584, NE = 8;
constexpr int MAXT = 136, HALFT = 64, CH1T = MAXT - HALFT;
constexpr float EPS = 1e-6f;
constexpr float C2 = 0.125f * 1.4426950408889634f;
constexpr float CX = 0.0625f * 1.4426950408889634f;

constexpr size_t MiB = 1u << 20;
constexpr size_t WS_CTL = 0, CTL_ZERO_BYTES = 1 * MiB;
constexpr size_t WS_ROPE = 1 * MiB;
constexpr size_t WS_BIAS = 1 * MiB + 512 * 1024;
constexpr size_t WS_ROUTE = 2 * MiB;
constexpr size_t WS_CNTG = 2 * MiB + 512 * 1024;
constexpr size_t WS_TILE = 2 * MiB + 640 * 1024;
constexpr size_t WS_SLOT = 1 * MiB + 512 * 1024;
constexpr size_t WS_STOK = 1 * MiB + 768 * 1024;
constexpr size_t WS_SRS = 2 * MiB + 768 * 1024;
constexpr size_t WS_YB = 3 * MiB;
constexpr size_t WS_GATES = 4 * MiB;
constexpr size_t WS_KCMP = 6 * MiB;
constexpr size_t WS_HID = 7 * MiB;
constexpr size_t WS_MN = 9 * MiB;
constexpr size_t WS_KX = 13 * MiB;
constexpr size_t WS_VXT = 17 * MiB;
constexpr size_t WS_WIN = 21 * MiB;
constexpr size_t WS_WOUT = 29 * MiB;
constexpr size_t WS_WQ = 33 * MiB, WS_WO = 37 * MiB, WS_WK = 41 * MiB, WS_WV = 45 * MiB;
constexpr size_t WS_CW1 = 49 * MiB;
constexpr size_t WS_CW2 = 53 * MiB;
constexpr size_t WS_FGU = 54 * MiB;
constexpr size_t WS_FD = 65 * MiB;
constexpr size_t WS_MGU = 71 * MiB;
constexpr size_t WS_MD = 183 * MiB;
constexpr size_t WS_HB = 239 * MiB;
constexpr size_t WS_R = 271 * MiB;
constexpr size_t WS_QRAW = WS_R, WS_QROT = WS_R + 16 * MiB, WS_KV = WS_R + 32 * MiB  , WS_U = WS_R + 57 * MiB, WS_AB = WS_R + 73 * MiB;
constexpr size_t WS_QX = WS_R, WS_PB = WS_R + 32 * MiB, WS_OX = WS_R + 73 * MiB;
constexpr size_t WS_ACT0 = WS_R;
constexpr size_t WS_HP = WS_HB;
constexpr size_t WS_ACTC = 307 * MiB;
constexpr size_t WS_END = 433 * MiB;
constexpr size_t WS_XB2 = 433 * MiB;
constexpr size_t WS_END2 = 465 * MiB;
constexpr size_t KVSZ = (size_t)NB * 2 * SEQ * 64;
static_assert(WS_HP + (size_t)MAXT * 256 * 1024 * 2 <= WS_ACTC && WS_ACTC + (size_t)CH1T * 256 * DFFE * 2 <= WS_END && WS_YB + (size_t)MAXT * 256 * 1024 * 2 <= WS_MGU && WS_SLOT + (size_t)T * 16 <= 2 * MiB, "ws map");
static_assert(WS_MGU + (size_t)NE * 7168 * 1024 * 2 <= WS_MD && WS_MD + (size_t)NE * 1024 * DFFE * 2 <= WS_HB, "ws map");

constexpr int CW_TMO = 0, CW_BAR = 4096, CW_BIAS = 8192, CW_SS = 32768;
typedef unsigned long long ssq_t;
#define SSP(i) ((ssq_t*)((unsigned*)(ws + WS_CTL) + CW_SS) + (size_t)(i) * T)
__device__ __forceinline__ float ss_rs(const ssq_t* ss, int row) { return 1.0f / sqrtf((float)((double)ss[row] * (1.0 / 4294967296.0)) * (1.f / DM) + EPS); }
__device__ __forceinline__ ssq_t ss_fix(float v) { return (ssq_t)((double)v * 4294967296.0); }

constexpr int RING_BYTES = 131072;
constexpr int XTRA_OFF = RING_BYTES, XTRA_BYTES = 24576;
constexpr int LDSCTL_OFF = XTRA_OFF + XTRA_BYTES, LDS_BYTES = LDSCTL_OFF + 512;
constexpr int NWAVES = 8;

#define LDS_WAIT() asm volatile("s_waitcnt lgkmcnt(0)" ::: "memory")
#define VM_WAIT() asm volatile("s_waitcnt vmcnt(0)" ::: "memory")
#define RLX_AGENT __ATOMIC_RELAXED, __HIP_MEMORY_SCOPE_AGENT

__device__ __forceinline__ unsigned f2bf(float f) { unsigned u = __builtin_bit_cast(unsigned, f); return (u + 0x7fffu + ((u >> 16) & 1u)) >> 16; }
__device__ __forceinline__ unsigned pk2(float lo, float hi) { return f2bf(lo) | (f2bf(hi) << 16); }
__device__ __forceinline__ float bf2f(unsigned short h) { return __builtin_bit_cast(float, (unsigned)h << 16); }
__device__ __forceinline__ unsigned cvt_pk_bf16(float lo, float hi) { unsigned r; asm volatile("v_cvt_pk_bf16_f32 %0, %1, %2" : "=v"(r) : "v"(lo), "v"(hi)); return r; }
template <int M> __device__ __forceinline__ float xor_get(float v) {
    static_assert(M > 0 && M < 32, "xor_get: within 32 lanes");
    return __builtin_bit_cast(float, __builtin_amdgcn_ds_swizzle(__builtin_bit_cast(int, v), (M << 10) | 0x1f));
}
__device__ __forceinline__ void half_swap(float v, float& lo, float& hi) {
    unsigned a = __builtin_bit_cast(unsigned, v), b = a;
    asm volatile("s_nop 1\n\tv_permlane32_swap_b32 %0, %1\n\ts_nop 1" : "+v"(a), "+v"(b));
    lo = __builtin_bit_cast(float, a); hi = __builtin_bit_cast(float, b);
}
__device__ __forceinline__ float xor32_sum(float v) { float lo, hi; half_swap(v, lo, hi); return lo + hi; }
__device__ __forceinline__ float xor32_max(float v) { float lo, hi; half_swap(v, lo, hi); return fmaxf(lo, hi); }
__device__ __forceinline__ float wave_sum(float v) {
    v += xor_get<1>(v); v += xor_get<2>(v); v += xor_get<4>(v); v += xor_get<8>(v); v += xor_get<16>(v);
    return xor32_sum(v);
}
__device__ __forceinline__ float fast_exp2(float x) { return __builtin_amdgcn_exp2f(x); }

namespace pg8 {
constexpr int BM = 256, BK = 64, HALF = 128, HTB = HALF * BK * 2, NXCD = 8, WGM = 8;
__host__ __device__ __forceinline__ int lds_byte(int r, int c) { const int st = (r >> 4) * 2 + (c >> 5), rr = r & 15, cc = c & 31, ob = rr * 64 + cc * 2; return st * 1024 + (ob ^ (((ob >> 9) & 1) << 5)); }
__host__ __device__ __forceinline__ void stage_rc(int b, int& R, int& C) { const int st = b / 1024, sb = b % 1024, swz = sb ^ (((sb >> 9) & 1) << 5); R = (st >> 1) * 16 + swz / 64; C = (st & 1) * 32 + (swz % 64) / 2; }
__host__ __device__ __forceinline__ int perm32(int rho) { const int n = rho >> 4, i = rho & 15; return 8 * (i >> 2) + 4 * n + (i & 3); }

struct Unit { int pm, pn; long aoff, boff, coff; };
struct Gemm { const char* A; const char* Bt; int K, lda, ldb; };

struct TileOrder {
    int nM, nN, nwg, G, c;
    __device__ __forceinline__ void init(int nM_, int nN_, int G_, int c_) { nM = nM_; nN = nN_; nwg = nM * nN; G = G_; c = c_; }
    __device__ __forceinline__ bool tile(int i, int& pm, int& pn) const {
        const long L = (long)i * G + c; if (L >= nwg) return false;
        int wgid = (int)L; { const int q = nwg / NXCD, r = nwg % NXCD, xcd = wgid % NXCD, off = wgid / NXCD; wgid = (xcd < r ? xcd * (q + 1) : r * (q + 1) + (xcd - r) * q) + off; }
        const int nig = WGM * nN, gid = wgid / nig, fm = gid * WGM, gsz = (nM - fm) < WGM ? (nM - fm) : WGM;
        pm = fm + ((wgid % nig) % gsz); pn = (wgid % nig) / gsz; return true;
    }
};

template <class Epi, class Sched, bool ALIGN_EPI, bool SP2>
__device__ __forceinline__ void gemm_phase(LAS unsigned char* lds, const Gemm g, const Sched S, const Epi E, int tid_in) {
    int tid_ = tid_in; asm volatile("" : "+v"(tid_));
    const int tid = tid_, wid = __builtin_amdgcn_readfirstlane(tid >> 6), lane = tid & 63, wr = wid >> 2, wc = wid & 3, fr = lane & 15, fq = lane >> 4;
    const int K = g.K, nt = K / BK;
    constexpr bool GA = Sched::GATHER;
    static_assert(!GA || SP2, "gather is wired into the SP2 schedule only");
    unsigned vA0[2], vA1[2], voffB[2];
#pragma unroll
    for (int i = 0; i < 2; ++i) { int R, C; stage_rc(tid * 16 + i * 8192, R, C); const int Rb = Epi::PERM ? ((R & ~31) + perm32(R & 31)) : R;
        vA0[i] = (unsigned)(R * g.lda + C) * 2u; vA1[i] = vA0[i]; voffB[i] = (unsigned)(Rb * g.ldb + C) * 2u; }
    const size_t kstep = (size_t)(BK * 2);
    const size_t hstepA = GA ? (size_t)0 : (size_t)HALF * g.lda * 2, hstepB = (size_t)HALF * g.ldb * 2;
    const unsigned rowb = (unsigned)g.lda * 2u;
    const unsigned ldsw = (unsigned)wid * 1024u;
    const int aoff = lds_byte(wr * 64 + fr, fq * 8), boff = lds_byte(wc * 32 + fr, fq * 8);
#define PG8_SA(b, h) (((b) * 2 + (h)) * HTB)
#define PG8_SB(b, h) ((4 + (b) * 2 + (h)) * HTB)
#define PG8_STAGE(bufoff, gbase, voff) do { _Pragma("unroll") for (int _i = 0; _i < 2; ++_i) \
        __builtin_amdgcn_global_load_lds((const unsigned*)((const char*)(gbase) + (voff)[_i]), (LAS unsigned*)(lds + (bufoff) + ldsw + _i * 8192), 16, 0, 0); } while (0)
#define PG8_LDA(dst, b, h) do { _Pragma("unroll") for (int m = 0; m < 4; ++m) _Pragma("unroll") for (int k = 0; k < 2; ++k) dst[m][k] = *(const LAS bf16x8*)(lds + PG8_SA(b, h) + aoff + m * 2048 + k * 1024); } while (0)
#define PG8_LDB(dst, b, h) do { _Pragma("unroll") for (int n = 0; n < 2; ++n) _Pragma("unroll") for (int k = 0; k < 2; ++k) dst[n][k] = *(const LAS bf16x8*)(lds + PG8_SB(b, h) + boff + n * 2048 + k * 1024); } while (0)
#define PG8_MMA(ai, bj, At, Bt) do { __builtin_amdgcn_s_setprio(1); _Pragma("unroll") for (int m = 0; m < 4; ++m) _Pragma("unroll") for (int n = 0; n < 2; ++n) _Pragma("unroll") for (int k = 0; k < 2; ++k) \
        acc[ai][bj][m][n] = __builtin_amdgcn_mfma_f32_16x16x32_bf16(Bt[n][k], At[m][k], acc[ai][bj][m][n], 0, 0, 0); __builtin_amdgcn_s_setprio(0); } while (0)
#define PG8_WAIT_V(n) asm volatile("s_waitcnt vmcnt(" #n ")" ::: "memory")
#define PG8_WAIT_L(n) asm volatile("s_waitcnt lgkmcnt(" #n ")" ::: "memory")
#define PG8_BAR __builtin_amdgcn_s_barrier()
#define PG8_SCHED __builtin_amdgcn_sched_barrier(0)
    Unit cur, nxt; int ui = 0;
    if (!S.next(0, cur)) return;
#define PG8_GATHER(ix) do { _Pragma("unroll") for (int i = 0; i < 2; ++i) { int R, C; stage_rc(tid * 16 + i * 8192, R, C); \
            vA0[i] = S.arow(lds, (ix), R) * rowb + (unsigned)C * 2u; vA1[i] = S.arow(lds, (ix), 128 + R) * rowb + (unsigned)C * 2u; } \
        asm volatile("s_waitcnt lgkmcnt(0)" : "+v"(vA0[0]), "+v"(vA0[1]), "+v"(vA1[0]), "+v"(vA1[1]) :: "memory"); } while (0)
    if constexpr (GA) PG8_GATHER(0);
    f32x4 acc[2][2][4][2];
    float zero_ = 0.f; asm volatile("" : "+v"(zero_));
#pragma unroll
    for (int a = 0; a < 2; ++a)
#pragma unroll
        for (int b = 0; b < 2; ++b)
#pragma unroll
            for (int m = 0; m < 4; ++m)
#pragma unroll
                for (int n = 0; n < 2; ++n) acc[a][b][m][n] = (f32x4){zero_, zero_, zero_, zero_};
    bf16x8 At[4][2], B0[2][2], B1[2][2];
    const char* cA = g.A + cur.aoff; const char* cB = g.Bt + cur.boff;
    if constexpr (SP2) {
        PG8_STAGE(PG8_SB(0, 0), cB, voffB); PG8_STAGE(PG8_SB(0, 1), cB + hstepB, voffB); PG8_STAGE(PG8_SA(0, 0), cA, vA0); PG8_STAGE(PG8_SA(0, 1), cA + hstepA, vA1);
        if (wr == 1) PG8_BAR;
        PG8_WAIT_V(2); PG8_BAR;
        PG8_STAGE(PG8_SB(1, 0), cB + kstep, voffB); PG8_STAGE(PG8_SA(1, 0), cA + kstep, vA0); PG8_STAGE(PG8_SB(1, 1), cB + hstepB + kstep, voffB);
        PG8_WAIT_V(6); PG8_BAR;
    } else {
        PG8_STAGE(PG8_SB(0, 0), cB, voffB); PG8_STAGE(PG8_SA(0, 0), cA, vA0); PG8_STAGE(PG8_SB(0, 1), cB + hstepB, voffB); PG8_STAGE(PG8_SA(0, 1), cA + hstepA, vA1);
        if (wr == 1) PG8_BAR;
        PG8_WAIT_V(4); PG8_BAR;
        PG8_STAGE(PG8_SB(1, 0), cB + kstep, voffB); PG8_STAGE(PG8_SA(1, 0), cA + kstep, vA0); PG8_STAGE(PG8_SB(1, 1), cB + hstepB + kstep, voffB);
        PG8_WAIT_V(6); PG8_BAR;
    }
    for (;;) {
        const bool has_next = S.next(ui + 1, nxt);
        const char* nA = has_next ? g.A + nxt.aoff : cA; const char* nB = has_next ? g.Bt + nxt.boff : cB;
#pragma unroll 1
        for (int t = 0; t < nt; t += 2) {
            const bool last = (t == nt - 2);
            const char* a1 = cA + (size_t)(t + 1) * kstep;
            const char* a2 = last ? nA : cA + (size_t)(t + 2) * kstep; const char* b2 = last ? nB : cB + (size_t)(t + 2) * kstep;
            const char* a3 = a2 + kstep; const char* b3 = b2 + kstep;
            if constexpr (SP2) {
            PG8_LDB(B0, 0, 0); PG8_LDB(B1, 0, 1); PG8_SCHED; PG8_LDA(At, 0, 0); PG8_STAGE(PG8_SA(1, 1), a1 + hstepA, vA1);
            if constexpr (GA) { if (last && has_next) PG8_GATHER(ui + 1); }
            PG8_WAIT_V(8); PG8_WAIT_L(0); PG8_BAR; PG8_MMA(0, 0, At, B0); PG8_MMA(0, 1, At, B1); PG8_BAR; PG8_SCHED;
            PG8_LDA(At, 0, 1); PG8_STAGE(PG8_SB(0, 0), b2, voffB); PG8_STAGE(PG8_SB(0, 1), b2 + hstepB, voffB); PG8_STAGE(PG8_SA(0, 0), a2, vA0);
            PG8_WAIT_V(8); PG8_WAIT_L(0); PG8_BAR; PG8_MMA(1, 0, At, B0); PG8_MMA(1, 1, At, B1); PG8_BAR; PG8_SCHED;
            PG8_LDB(B0, 1, 0); PG8_LDB(B1, 1, 1); PG8_SCHED; PG8_LDA(At, 1, 0); PG8_STAGE(PG8_SA(0, 1), a2 + hstepA, vA1);
            PG8_WAIT_V(8); PG8_WAIT_L(0); PG8_BAR; PG8_MMA(0, 0, At, B0); PG8_MMA(0, 1, At, B1); PG8_BAR; PG8_SCHED;
            PG8_LDA(At, 1, 1); PG8_STAGE(PG8_SB(1, 0), b3, voffB); PG8_STAGE(PG8_SB(1, 1), b3 + hstepB, voffB); PG8_STAGE(PG8_SA(1, 0), a3, vA0);
            PG8_WAIT_V(8); PG8_WAIT_L(0); PG8_BAR; PG8_MMA(1, 0, At, B0); PG8_MMA(1, 1, At, B1); PG8_BAR; PG8_SCHED;
            } else {
            PG8_LDB(B0, 0, 0); PG8_SCHED; PG8_LDA(At, 0, 0); PG8_STAGE(PG8_SA(1, 1), a1 + hstepA, vA1);
            PG8_WAIT_L(8); PG8_BAR; PG8_WAIT_L(0); PG8_MMA(0, 0, At, B0); PG8_BAR; PG8_SCHED;
            PG8_LDB(B1, 0, 1); PG8_STAGE(PG8_SB(0, 0), b2, voffB);
            PG8_BAR; PG8_WAIT_L(0); PG8_MMA(0, 1, At, B1); PG8_BAR;
            PG8_LDA(At, 0, 1); PG8_STAGE(PG8_SA(0, 0), a2, vA0);
            PG8_BAR; PG8_WAIT_L(0); PG8_MMA(1, 0, At, B0); PG8_BAR; PG8_SCHED;
            PG8_STAGE(PG8_SB(0, 1), b2 + hstepB, voffB);
            PG8_WAIT_V(6); PG8_BAR; PG8_MMA(1, 1, At, B1); PG8_BAR;
            PG8_LDB(B0, 1, 0); PG8_SCHED; PG8_LDA(At, 1, 0); PG8_STAGE(PG8_SA(0, 1), a2 + hstepA, vA1);
            PG8_WAIT_L(8); PG8_BAR; PG8_WAIT_L(0); PG8_MMA(0, 0, At, B0); PG8_BAR; PG8_SCHED;
            PG8_LDB(B1, 1, 1); PG8_STAGE(PG8_SB(1, 0), b3, voffB);
            PG8_BAR; PG8_WAIT_L(0); PG8_MMA(0, 1, At, B1); PG8_BAR;
            PG8_LDA(At, 1, 1); PG8_STAGE(PG8_SA(1, 0), a3, vA0);
            PG8_BAR; PG8_WAIT_L(0); PG8_MMA(1, 0, At, B0); PG8_BAR; PG8_SCHED;
            PG8_STAGE(PG8_SB(1, 1), b3 + hstepB, voffB);
            PG8_WAIT_V(6); PG8_BAR; PG8_MMA(1, 1, At, B1); PG8_BAR;
            }
        }
        if constexpr (ALIGN_EPI) { if (wr == 0) PG8_BAR; }
        if constexpr (!Epi::AFTER_DRAIN) { E(acc, cur, wr, wc, fr, fq); }
        if (!has_next) break;
#pragma unroll
        for (int a = 0; a < 2; ++a)
#pragma unroll
            for (int b = 0; b < 2; ++b)
#pragma unroll
                for (int m = 0; m < 4; ++m)
#pragma unroll
                    for (int n = 0; n < 2; ++n) acc[a][b][m][n] = (f32x4){zero_, zero_, zero_, zero_};
        cur = nxt; cA = nA; cB = nB; ++ui;
        if constexpr (ALIGN_EPI) { if (wr == 1) PG8_BAR; }
    }
    PG8_WAIT_V(0);
    if constexpr (!ALIGN_EPI) { if (wr == 0) PG8_BAR; }
    PG8_BAR;
    if constexpr (Epi::AFTER_DRAIN) { E.fused(acc, cur, wr, wc, fr, fq, lds, wid, lane); }
#undef PG8_GATHER
#undef PG8_SA
#undef PG8_SB
#undef PG8_STAGE
#undef PG8_LDA
#undef PG8_LDB
#undef PG8_MMA
#undef PG8_WAIT_V
#undef PG8_WAIT_L
#undef PG8_BAR
#undef PG8_SCHED
}
}
using pg8::Unit;
typedef const f32x4 (&AccRef)[2][2][4][2];

struct SchedPlain {
    static constexpr bool GATHER = false;
    pg8::TileOrder o; long astep, bstep;
    __device__ void init(int nM, int nN, int lda, int ldb, int G, int c) { o.init(nM, nN, G, c); astep = (long)256 * lda * 2; bstep = (long)256 * ldb * 2; }
    __device__ bool next(int i, Unit& u) const { if (!o.tile(i, u.pm, u.pn)) return false; u.aoff = u.pm * astep; u.boff = u.pn * bstep; u.coff = 0; return true; }
};
struct SchedOne { static constexpr bool GATHER = false; Unit u; __device__ bool next(int i, Unit& out) const { if (i > 0) return false; out = u; return true; } };
struct SchedKV {
    static constexpr bool GATHER = false;
    int G, c;
    __device__ bool next(int i, Unit& u) const {
        const int L = i * G + c; if (L >= 64 || (G == 1 && i > 0)) return false;
        const int job = L >> 4, l = job >> 1, isv = job & 1; u.pm = (L >> 2) & 3; u.pn = L & 3;
        const long mn = (long)WS_MN + (long)l * 2 * MiB, wk = (long)WS_WK + (long)l * 2 * MiB, wv = (long)WS_WV + (long)l * 2 * MiB;
        const long ts = 256L * 1024 * 2;
        if (!isv) { u.aoff = mn + u.pm * ts; u.boff = wk + u.pn * ts; u.coff = ((long)WS_KX + (long)l * 2 * MiB) / 2; }
        else { u.aoff = mn + u.pm * ts; u.boff = wv + u.pn * ts; u.coff = ((long)WS_VXT + (long)l * 2 * MiB) / 2; }
        return true;
    }
};
template <int MODE> struct SchedX {
    static constexpr bool GATHER = false;
    pg8::TileOrder o;
    __device__ void init(int G, int c) { o.init(64, 4, G, c); }
    __device__ bool next(int i, Unit& u) const {
        if (!o.tile(i, u.pm, u.pn)) return false;
        const int b = u.pm >> 4, h = u.pn;
        u.aoff = ((long)u.pm * 256 * 1024 + h * 256) * 2;
        u.boff = MODE == 0 ? ((long)b * 256 * 1024 + h * 256) * 2 : ((long)h * 256 * 1024 + b * 256) * 2;
        u.coff = 0; return true;
    }
};
struct SchedMoe {
    static constexpr bool GATHER = false;
    pg8::TileOrder o; const unsigned* texp; int t0, nn; long astep, bstep, estep, cstep, khb, khc;
    __device__ bool next(int i, Unit& u) const {
        int pm, pn; if (!o.tile(i, pm, pn)) return false;
        const int rt = t0 + pm; const int e = (int)texp[rt]; const int kh = pn >= nn ? 1 : 0; pn -= kh * nn;
        u.pm = rt; u.pn = pn; u.aoff = pm * astep + kh * khb; u.boff = e * estep + pn * bstep + kh * khb; u.coff = -(long)t0 * cstep + kh * khc; return true;
    }
};

struct SchedMoeG : SchedMoe {
    static constexpr bool GATHER = true;
    int tab;
    __device__ __forceinline__ unsigned arow(LAS unsigned char* lds, int i, int r) const { return ((const LAS unsigned*)(lds + tab))[256 * i + r]; }
};

struct EpiPlain {
    static constexpr bool PERM = true, AFTER_DRAIN = false;
    bf16_t* O; int ldc; const ssq_t* ss;
    __device__ __forceinline__ void operator()(AccRef acc, const Unit& u, int wr, int wc, int fr, int fq) const {
        const int row0 = u.pm * 256 + wr * 64 + fr;
        bf16_t* base = O + u.coff + (size_t)row0 * ldc + u.pn * 256 + wc * 32 + 8 * fq;
#pragma unroll
        for (int ai = 0; ai < 2; ++ai)
#pragma unroll
            for (int m = 0; m < 4; ++m) { const float rs = ss ? ss_rs(ss, row0 + ai * 128 + m * 16) : 1.f;
#pragma unroll
                for (int bj = 0; bj < 2; ++bj) { const f32x4 v0 = acc[ai][bj][m][0] * rs, v1 = acc[ai][bj][m][1] * rs;
                    u32x4 w; w.x = cvt_pk_bf16(v0[0], v0[1]); w.y = cvt_pk_bf16(v0[2], v0[3]); w.z = cvt_pk_bf16(v1[0], v1[1]); w.w = cvt_pk_bf16(v1[2], v1[3]);
                    *(u32x4*)(base + (size_t)(ai * 128 + m * 16) * ldc + bj * 128) = w; } }
    }
};
#ifndef ABL
#define ABL 0
#endif
template <bool SRC_F32> struct EpiResB {
    static constexpr bool PERM = true, AFTER_DRAIN = false;
    const void* src; bf16_t* xo; ssq_t* ss;
    __device__ __forceinline__ void operator()(AccRef acc, const Unit& u, int wr, int wc, int fr, int fq) const {
        const int row0 = u.pm * 256 + wr * 64 + fr;
        const size_t off0 = (size_t)row0 * DM + u.pn * 256 + wc * 32 + 8 * fq;
#pragma unroll
        for (int ai = 0; ai < 2; ++ai)
#pragma unroll
            for (int m = 0; m < 4; ++m) { float part = 0.f;
#pragma unroll
                for (int bj = 0; bj < 2; ++bj) { const size_t off = off0 + (size_t)(ai * 128 + m * 16) * DM + bj * 128;
                    f32x4 s0, s1;
                    if (SRC_F32) { s0 = *(const f32x4*)((const float*)src + off); s1 = *(const f32x4*)((const float*)src + off + 4); }
                    else { const u32x4 w = *(const u32x4*)((const bf16_t*)src + off);
                        s0 = (f32x4){__builtin_bit_cast(float, w.x << 16), __builtin_bit_cast(float, w.x & 0xffff0000u), __builtin_bit_cast(float, w.y << 16), __builtin_bit_cast(float, w.y & 0xffff0000u)};
                        s1 = (f32x4){__builtin_bit_cast(float, w.z << 16), __builtin_bit_cast(float, w.z & 0xffff0000u), __builtin_bit_cast(float, w.w << 16), __builtin_bit_cast(float, w.w & 0xffff0000u)}; }
                    s0 = s0 + acc[ai][bj][m][0]; s1 = s1 + acc[ai][bj][m][1];
                    u32x4 w; w.x = cvt_pk_bf16(s0[0], s0[1]); w.y = cvt_pk_bf16(s0[2], s0[3]); w.z = cvt_pk_bf16(s1[0], s1[1]); w.w = cvt_pk_bf16(s1[2], s1[3]); *(u32x4*)(xo + off) = w;
                    part += ((s0[0] * s0[0] + s0[1] * s0[1]) + (s0[2] * s0[2] + s0[3] * s0[3])) + ((s1[0] * s1[0] + s1[1] * s1[1]) + (s1[2] * s1[2] + s1[3] * s1[3])); }
                if (ss) { part += xor_get<16>(part); part = xor32_sum(part); if (fq == 0) atomicAdd(ss + row0 + ai * 128 + m * 16, ss_fix(part)); } }
    }
};
struct EpiRes {
    static constexpr bool PERM = true, AFTER_DRAIN = false;
    const float* src; float* out; bf16_t* xb; ssq_t* ss;
    __device__ __forceinline__ void operator()(AccRef acc, const Unit& u, int wr, int wc, int fr, int fq) const {
        const int row0 = u.pm * 256 + wr * 64 + fr;
        const size_t off0 = (size_t)row0 * DM + u.pn * 256 + wc * 32 + 8 * fq;
#pragma unroll
        for (int ai = 0; ai < 2; ++ai)
#pragma unroll
            for (int m = 0; m < 4; ++m) { float part = 0.f;
#pragma unroll
                for (int bj = 0; bj < 2; ++bj) { const size_t off = off0 + (size_t)(ai * 128 + m * 16) * DM + bj * 128;
                    const f32x4 s0 = *(const f32x4*)(src + off) + acc[ai][bj][m][0], s1 = *(const f32x4*)(src + off + 4) + acc[ai][bj][m][1];
                    *(f32x4*)(out + off) = s0; *(f32x4*)(out + off + 4) = s1;
                    if (xb) { u32x4 w; w.x = cvt_pk_bf16(s0[0], s0[1]); w.y = cvt_pk_bf16(s0[2], s0[3]); w.z = cvt_pk_bf16(s1[0], s1[1]); w.w = cvt_pk_bf16(s1[2], s1[3]); *(u32x4*)(xb + off) = w;
                        part += ((s0[0] * s0[0] + s0[1] * s0[1]) + (s0[2] * s0[2] + s0[3] * s0[3])) + ((s1[0] * s1[0] + s1[1] * s1[1]) + (s1[2] * s1[2] + s1[3] * s1[3])); } }
                if (xb) { part += xor_get<16>(part); part = xor32_sum(part); if (fq == 0) atomicAdd(ss + row0 + ai * 128 + m * 16, ss_fix(part)); } }
    }
};
__device__ __forceinline__ float gelu_tanh(float x) {
    const float y = 0.7978845608028654f * (x + 0.044715f * x * x * x);
    const float e = fast_exp2(y * 2.8853900817779268f);
    const float th = 1.f - 2.f * __builtin_amdgcn_rcpf(e + 1.f);
    return 0.5f * x * (1.f + th);
}
struct EpiHid {
    static constexpr bool PERM = true, AFTER_DRAIN = false;
    bf16_t* O; const long long* bias;
    __device__ __forceinline__ void operator()(AccRef acc, const Unit& u, int wr, int wc, int fr, int fq) const {
        bf16_t* base = O + (size_t)(u.pm * 256 + wr * 64 + fr) * 256 + wc * 32 + 8 * fq;
#pragma unroll
        for (int bj = 0; bj < 2; ++bj) { const long long* bp = bias + bj * 128 + wc * 32 + 8 * fq; f32x4 b0, b1;
#pragma unroll
            for (int j = 0; j < 4; ++j) { b0[j] = (float)((double)bp[j] * (1.0 / 1099511627776.0)); b1[j] = (float)((double)bp[4 + j] * (1.0 / 1099511627776.0)); }
#pragma unroll
            for (int ai = 0; ai < 2; ++ai)
#pragma unroll
                for (int m = 0; m < 4; ++m) { const f32x4 v0 = acc[ai][bj][m][0] + b0, v1 = acc[ai][bj][m][1] + b1;
                    u32x4 w; w.x = cvt_pk_bf16(gelu_tanh(v0[0]), gelu_tanh(v0[1])); w.y = cvt_pk_bf16(gelu_tanh(v0[2]), gelu_tanh(v0[3]));
                    w.z = cvt_pk_bf16(gelu_tanh(v1[0]), gelu_tanh(v1[1])); w.w = cvt_pk_bf16(gelu_tanh(v1[2]), gelu_tanh(v1[3]));
                    *(u32x4*)(base + (size_t)(ai * 128 + m * 16) * 256 + bj * 128) = w; } }
    }
};
struct EpiCmp2 {
    static constexpr bool PERM = true, AFTER_DRAIN = false;
    bf16_t* O;
    __device__ __forceinline__ void operator()(AccRef acc, const Unit& u, int wr, int wc, int fr, int fq) const {
        if (wc >= 2) return;
#pragma unroll
        for (int ai = 0; ai < 2; ++ai)
#pragma unroll
            for (int m = 0; m < 4; ++m) { const int row = u.pm * 256 + ai * 128 + wr * 64 + m * 16 + fr; const f32x4 v0 = acc[ai][0][m][0], v1 = acc[ai][0][m][1];
                u32x4 w; w.x = cvt_pk_bf16(v0[0], v0[1]); w.y = cvt_pk_bf16(v0[2], v0[3]); w.z = cvt_pk_bf16(v1[0], v1[1]); w.w = cvt_pk_bf16(v1[2], v1[3]);
                if ((row & 255) == 255) w = (u32x4){0u, 0u, 0u, 0u};
                *(u32x4*)(O + (size_t)row * 64 + wc * 32 + 8 * fq) = w; }
    }
};
__device__ __forceinline__ float silu_mul(float g, float u) { return g * __builtin_amdgcn_rcpf(1.f + fast_exp2(-1.4426950408889634f * g)) * u; }
struct EpiSwiglu {
    static constexpr bool PERM = true, AFTER_DRAIN = false;
    bf16_t* O; int ldc; const ssq_t* ss; const float* rsf;
    __device__ __forceinline__ void operator()(AccRef acc, const Unit& u, int wr, int wc, int fr, int fq) const {
        const int row0 = u.pm * 256 + wr * 64 + fr;
        bf16_t* base = O + u.coff + (size_t)row0 * ldc + u.pn * 128 + wc * 32 + 8 * fq;
#pragma unroll
        for (int ai = 0; ai < 2; ++ai)
#pragma unroll
            for (int m = 0; m < 4; ++m) { const float rs = ss ? ss_rs(ss, row0 + ai * 128 + m * 16) : rsf ? rsf[row0 + ai * 128 + m * 16] : 1.f;
                const f32x4 g0 = acc[ai][0][m][0] * rs, g1 = acc[ai][0][m][1] * rs, u0 = acc[ai][1][m][0] * rs, u1 = acc[ai][1][m][1] * rs;
                u32x4 w; w.x = cvt_pk_bf16(silu_mul(g0[0], u0[0]), silu_mul(g0[1], u0[1])); w.y = cvt_pk_bf16(silu_mul(g0[2], u0[2]), silu_mul(g0[3], u0[3]));
                w.z = cvt_pk_bf16(silu_mul(g1[0], u1[0]), silu_mul(g1[1], u1[1])); w.w = cvt_pk_bf16(silu_mul(g1[2], u1[2]), silu_mul(g1[3], u1[3]));
                *(u32x4*)(base + (size_t)(ai * 128 + m * 16) * ldc) = w; }
    }
};
struct EpiWin {
    static constexpr bool PERM = true, AFTER_DRAIN = false;
    bf16_t *qraw, *qrot, *kv, *ub; float* gates; const float* rope; const ssq_t* ss;
    __device__ __forceinline__ void operator()(AccRef acc, const Unit& u, int wr, int wc, int fr, int fq) const {
        const int pn = u.pn;
#pragma unroll
        for (int ai = 0; ai < 2; ++ai)
#pragma unroll
            for (int m = 0; m < 4; ++m) {
                const int row = u.pm * 256 + ai * 128 + wr * 64 + m * 16 + fr, b = row >> 12, t = row & 4095;
                const float rs = ss_rs(ss, row);
#pragma unroll
                for (int bj = 0; bj < 2; ++bj) {
                    float v[8];
#pragma unroll
                    for (int j = 0; j < 4; ++j) { v[j] = acc[ai][bj][m][0][j] * rs; v[4 + j] = acc[ai][bj][m][1][j] * rs; }
                    if (pn < 2) {
                        const size_t idx = ((size_t)(b * 2 + pn) * SEQ + t) * 256 + bj * 128 + wc * 32 + 8 * fq;
                        u32x4 w; w.x = cvt_pk_bf16(v[0] * C2, v[1] * C2); w.y = cvt_pk_bf16(v[2] * C2, v[3] * C2); w.z = cvt_pk_bf16(v[4] * C2, v[5] * C2); w.w = cvt_pk_bf16(v[6] * C2, v[7] * C2);
                        *(u32x4*)(qraw + idx) = w;
                        if ((wc & 1) == 0) {
                            float p[8];
#pragma unroll
                            for (int j = 0; j < 8; ++j) p[j] = xor_get<16>(v[j]);
                            if (fq < 2) { const float* rp = rope + (size_t)t * 16;
#pragma unroll
                                for (int j = 0; j < 8; ++j) { const float cs = rp[2 * j], sn = rp[2 * j + 1]; v[j] = fq == 0 ? v[j] * cs - p[j] * sn : v[j] * cs + p[j] * sn; } }
                            w.x = cvt_pk_bf16(v[0] * C2, v[1] * C2); w.y = cvt_pk_bf16(v[2] * C2, v[3] * C2); w.z = cvt_pk_bf16(v[4] * C2, v[5] * C2); w.w = cvt_pk_bf16(v[6] * C2, v[7] * C2);
                        }
                        *(u32x4*)(qrot + idx) = w;
                    } else if (pn < 5) {
                        const int i = 2 * (pn - 2) + bj, g = wc >> 1;
                        if (bj == 0 && pn >= 3 && (wc & 1) == 0) {
                            float p[8];
#pragma unroll
                            for (int j = 0; j < 8; ++j) p[j] = xor_get<16>(v[j]);
                            if (fq < 2) { const float* rp = rope + (size_t)t * 16;
#pragma unroll
                                for (int j = 0; j < 8; ++j) { const float cs = rp[2 * j], sn = rp[2 * j + 1]; v[j] = fq == 0 ? v[j] * cs - p[j] * sn : v[j] * cs + p[j] * sn; } }
                        }
                        u32x4 w; w.x = cvt_pk_bf16(v[0], v[1]); w.y = cvt_pk_bf16(v[2], v[3]); w.z = cvt_pk_bf16(v[4], v[5]); w.w = cvt_pk_bf16(v[6], v[7]);
                        *(u32x4*)(kv + (size_t)i * KVSZ + ((size_t)(b * 2 + g) * SEQ + t) * 64 + (wc & 1) * 32 + 8 * fq) = w;
                    } else if (pn < 7) {
                        u32x4 w; w.x = cvt_pk_bf16(v[0], v[1]); w.y = cvt_pk_bf16(v[2], v[3]); w.z = cvt_pk_bf16(v[4], v[5]); w.w = cvt_pk_bf16(v[6], v[7]);
                        *(u32x4*)(ub + (size_t)row * 512 + (pn - 5) * 256 + bj * 128 + wc * 32 + 8 * fq) = w;
                    } else {
                        if (bj == 0 && wc == 0 && fq < 3) { float* gp = gates + (size_t)row * 24 + 8 * fq;
#pragma unroll
                            for (int j = 0; j < 8; ++j) gp[j] = __builtin_amdgcn_rcpf(1.f + fast_exp2(-1.4426950408889634f * v[j])); }
                    }
                }
            }
    }
};
struct EpiSoftmax {
    static constexpr bool PERM = true, AFTER_DRAIN = true;
    bf16_t* P;
    __device__ __forceinline__ void operator()(AccRef, const Unit&, int, int, int, int) const {}
    __device__ __forceinline__ void fused(f32x4 (&acc)[2][2][4][2], const Unit& u, int wr, int wc, int fr, int fq, LAS unsigned char* lds, int wid, int lane) const {
        LAS float* RM = (LAS float*)lds;
        LAS float* RS = (LAS float*)(lds + 4096);
        float mx[2][4];
#pragma unroll
        for (int ai = 0; ai < 2; ++ai)
#pragma unroll
            for (int m = 0; m < 4; ++m) { float a = -INFINITY;
#pragma unroll
                for (int bj = 0; bj < 2; ++bj)
#pragma unroll
                    for (int n = 0; n < 2; ++n)
#pragma unroll
                        for (int e = 0; e < 4; ++e) a = fmaxf(a, acc[ai][bj][m][n][e]);
                a = fmaxf(a, xor_get<16>(a)); a = xor32_max(a);
                if (fq == 0) RM[(ai * 128 + wr * 64 + m * 16 + fr) * 4 + wc] = a; }
        LDS_WAIT(); __builtin_amdgcn_s_barrier(); asm volatile("" ::: "memory");
#pragma unroll
        for (int ai = 0; ai < 2; ++ai)
#pragma unroll
            for (int m = 0; m < 4; ++m) { const int r = ai * 128 + wr * 64 + m * 16 + fr; const f32x4 q = *(const LAS f32x4*)(RM + r * 4);
                const float mm = fmaxf(fmaxf(q[0], q[1]), fmaxf(q[2], q[3])); float s = 0.f;
#pragma unroll
                for (int bj = 0; bj < 2; ++bj)
#pragma unroll
                    for (int n = 0; n < 2; ++n)
#pragma unroll
                        for (int e = 0; e < 4; ++e) { const float p = fast_exp2((acc[ai][bj][m][n][e] - mm) * CX); acc[ai][bj][m][n][e] = p; s += p; }
                s += xor_get<16>(s); s = xor32_sum(s);
                if (fq == 0) RS[r * 4 + wc] = s; }
        LDS_WAIT(); __builtin_amdgcn_s_barrier(); asm volatile("" ::: "memory");
        bf16_t* base = P + (size_t)(u.pm * 256 + wr * 64 + fr) * DM + u.pn * 256 + wc * 32 + 8 * fq;
#pragma unroll
        for (int ai = 0; ai < 2; ++ai)
#pragma unroll
            for (int m = 0; m < 4; ++m) { const int r = ai * 128 + wr * 64 + m * 16 + fr; const f32x4 q = *(const LAS f32x4*)(RS + r * 4);
                const float inv = 1.f / ((q[0] + q[1]) + (q[2] + q[3]));
#pragma unroll
                for (int bj = 0; bj < 2; ++bj) { u32x4 w;
                    const f32x4 p0 = acc[ai][bj][m][0] * inv, p1 = acc[ai][bj][m][1] * inv;
                    w.x = cvt_pk_bf16(p0[0], p0[1]); w.y = cvt_pk_bf16(p0[2], p0[3]); w.z = cvt_pk_bf16(p1[0], p1[1]); w.w = cvt_pk_bf16(p1[2], p1[3]);
                    *(u32x4*)(base + (size_t)(ai * 128 + m * 16) * DM + bj * 128) = w; } }
        LDS_WAIT(); __builtin_amdgcn_s_barrier(); asm volatile("" ::: "memory");
    }
};

namespace nsa {
constexpr int L_K = 0, L_V = 24576, L_PCS = 49152, L_OST = 114688, L_WSF = 147456, L_SEL = 149504;
static_assert(L_SEL + 512 <= LDSCTL_OFF, "attention LDS map");
__device__ __forceinline__ int crow(int r, int hi) { return (r & 3) + 8 * (r >> 2) + 4 * hi; }
__device__ __forceinline__ unsigned cvtpk(float lo, float hi) { return cvt_pk_bf16(lo, hi); }

__device__ __forceinline__ void qkt(f32x16& p0, f32x16& p1, const LAS unsigned char* Kslot, const bf16x8* qr, int r32, int hi, float zero_) {
    const LAS unsigned char* kb = Kslot + hi * 1024 + r32 * 16;
    f32x16 z;
#pragma unroll
    for (int r = 0; r < 16; ++r) z[r] = zero_;
    p0 = z; p1 = z;
#pragma unroll
    for (int d0 = 0; d0 < 4; ++d0) {
        const bf16x8 b0 = *(const LAS bf16x8*)(kb + d0 * 2048);
        const bf16x8 b1 = *(const LAS bf16x8*)(kb + d0 * 2048 + 512);
        p0 = __builtin_amdgcn_mfma_f32_32x32x16_bf16(b0, qr[d0], p0, 0, 0, 0);
        p1 = __builtin_amdgcn_mfma_f32_32x32x16_bf16(b1, qr[d0], p1, 0, 0, 0);
    }
}
__device__ __forceinline__ void qkt_c(f32x16& p0, f32x16& p1, const LAS unsigned char* Kslot, const bf16x8* qr, int r32, int hi, const f32x16& c) {
    const LAS unsigned char* kb = Kslot + hi * 1024 + r32 * 16;
#pragma unroll
    for (int d0 = 0; d0 < 4; ++d0) {
        const bf16x8 b0 = *(const LAS bf16x8*)(kb + d0 * 2048);
        const bf16x8 b1 = *(const LAS bf16x8*)(kb + d0 * 2048 + 512);
        if (d0 == 0) { p0 = __builtin_amdgcn_mfma_f32_32x32x16_bf16(b0, qr[0], c, 0, 0, 0); p1 = __builtin_amdgcn_mfma_f32_32x32x16_bf16(b1, qr[0], c, 0, 0, 0); }
        else { p0 = __builtin_amdgcn_mfma_f32_32x32x16_bf16(b0, qr[d0], p0, 0, 0, 0); p1 = __builtin_amdgcn_mfma_f32_32x32x16_bf16(b1, qr[d0], p1, 0, 0, 0); }
    }
}
__device__ __forceinline__ void pv(f32x16* o, int vb, bf16x8 pa0, bf16x8 pa1, bf16x8 pa2, bf16x8 pa3) {
#pragma unroll
    for (int d0 = 0; d0 < 2; ++d0) { s16x4 lo[4], hi[4];
#pragma unroll
        for (int ks = 0; ks < 4; ++ks) {
            asm volatile("ds_read_b64_tr_b16 %0,%1 offset:%c2" : "=&v"(lo[ks]) : "v"(vb), "i"(d0 * 4096 + ks * 1024) : "memory");
            asm volatile("ds_read_b64_tr_b16 %0,%1 offset:%c2" : "=&v"(hi[ks]) : "v"(vb), "i"(d0 * 4096 + ks * 1024 + 512) : "memory"); }
        asm volatile("s_waitcnt lgkmcnt(0)" ::: "memory"); __builtin_amdgcn_sched_barrier(0);
#define NSA_PK(k) (bf16x8){lo[k][0], lo[k][1], lo[k][2], lo[k][3], hi[k][0], hi[k][1], hi[k][2], hi[k][3]}
        o[d0] = __builtin_amdgcn_mfma_f32_32x32x16_bf16(pa0, NSA_PK(0), o[d0], 0, 0, 0);
        o[d0] = __builtin_amdgcn_mfma_f32_32x32x16_bf16(pa1, NSA_PK(1), o[d0], 0, 0, 0);
        o[d0] = __builtin_amdgcn_mfma_f32_32x32x16_bf16(pa2, NSA_PK(2), o[d0], 0, 0, 0);
        o[d0] = __builtin_amdgcn_mfma_f32_32x32x16_bf16(pa3, NSA_PK(3), o[d0], 0, 0, 0);
#undef NSA_PK
    }
}
__device__ __forceinline__ void mask_tile(f32x16& p0, f32x16& p1, int lo, int hi_, int hi) {
#pragma unroll
    for (int r = 0; r < 16; ++r) { const int kv = crow(r, hi); if (kv < lo || kv > hi_) p0[r] = -INFINITY; if (kv + 32 < lo || kv + 32 > hi_) p1[r] = -INFINITY; }
}
__device__ __forceinline__ float max3f(float a, float b, float c) { float r; asm("v_max3_f32 %0, %1, %2, %3" : "=v"(r) : "v"(a), "v"(b), "v"(c)); return r; }
__device__ __forceinline__ float tile_max(const f32x16& p0, const f32x16& p1) {
    float a = max3f(p0[0], p0[1], p1[0]), b = max3f(p0[2], p0[3], p1[1]); a = max3f(a, p1[2], p1[3]);
#pragma unroll
    for (int r = 4; r < 16; r += 4) { a = max3f(a, p0[r], p0[r + 1]); b = max3f(b, p0[r + 2], p0[r + 3]); a = max3f(a, p1[r], p1[r + 1]); b = max3f(b, p1[r + 2], p1[r + 3]); }
    float lo, hi; half_swap(max3f(a, b, b), lo, hi); return max3f(lo, hi, hi);
}
__device__ __forceinline__ void pack_p(const f32x16& p0, const f32x16& p1, bf16x8& a0, bf16x8& a1, bf16x8& a2, bf16x8& a3) {
    u32x4 w0, w1, w2, w3;
    w0 = (u32x4){cvtpk(p0[0], p0[1]), cvtpk(p0[2], p0[3]), cvtpk(p0[4], p0[5]), cvtpk(p0[6], p0[7])};
    w1 = (u32x4){cvtpk(p0[8], p0[9]), cvtpk(p0[10], p0[11]), cvtpk(p0[12], p0[13]), cvtpk(p0[14], p0[15])};
    w2 = (u32x4){cvtpk(p1[0], p1[1]), cvtpk(p1[2], p1[3]), cvtpk(p1[4], p1[5]), cvtpk(p1[6], p1[7])};
    w3 = (u32x4){cvtpk(p1[8], p1[9]), cvtpk(p1[10], p1[11]), cvtpk(p1[12], p1[13]), cvtpk(p1[14], p1[15])};
    a0 = __builtin_bit_cast(bf16x8, w0); a1 = __builtin_bit_cast(bf16x8, w1); a2 = __builtin_bit_cast(bf16x8, w2); a3 = __builtin_bit_cast(bf16x8, w3);
}
__device__ __forceinline__ void online_step(f32x16& p0, f32x16& p1, float& m, float& l, f32x16* o, LAS float* wsf, int r32, int hi) {
    const float rm = tile_max(p0, p1);
    const float mn = fmaxf(m, rm), mu = (mn == -INFINITY) ? 0.f : mn;
    const float sc = fast_exp2(m - mu);
    float s = 0.f;
#pragma unroll
    for (int r = 0; r < 16; ++r) { p0[r] = fast_exp2(p0[r] - mu); p1[r] = fast_exp2(p1[r] - mu); s += p0[r] + p1[r]; }
    l = l * sc + s; m = mn;
    if (__any(sc != 1.f)) {
        if (hi == 0) wsf[r32] = sc;
        LDS_WAIT();
#pragma unroll
        for (int r = 0; r < 16; ++r) { const float f = wsf[crow(r, hi)]; o[0][r] *= f; o[1][r] *= f; }
        LDS_WAIT();
    }
}

struct Ptrs { const bf16_t* qraw; const bf16_t* qrot; const bf16_t* kv; const bf16_t* kcmp; const bf16_t* vcmp; const float* gates; bf16_t* ab; };

template <bool WITH_V, class F>
__device__ __forceinline__ void tile_loop(int n, const bf16_t* Kb, const bf16_t* Vb, int row0, LAS unsigned char* lds, int wid, int lane, F&& body) {
    const bf16_t* ksrc = Kb + (size_t)(row0 + lane) * 64 + wid * 8;
    const bf16_t* vsrc = Vb + (size_t)(row0 + 16 * (wid & 3) + (lane >> 2)) * 64 + (wid >> 2) * 32 + (lane & 3) * 8;
#define NSA_ISSUE(i) do { const int sl_ = ((i) & 1) * 8192; \
        __builtin_amdgcn_global_load_lds((const unsigned*)(ksrc + (size_t)(i) * 4096), (LAS unsigned*)(lds + L_K + sl_ + wid * 1024), 16, 0, 0); \
        if (WITH_V) __builtin_amdgcn_global_load_lds((const unsigned*)(vsrc + (size_t)(i) * 4096), (LAS unsigned*)(lds + L_V + sl_ + wid * 1024), 16, 0, 0); } while (0)
    NSA_ISSUE(0);
    for (int i = 0; i < n; ++i) {
        VM_WAIT(); __syncthreads();
        if (i + 1 < n) NSA_ISSUE(i + 1);
        body(i, (i & 1) * 8192);
    }
    __syncthreads();
#undef NSA_ISSUE
}

template <int MODE>
__device__ __forceinline__ void branch_pipe(int n, const bf16_t* Kb, const bf16_t* Vb, int row0, LAS unsigned char* lds, int wid, int lane, int r32, int hi, const bf16x8* qr,
                                            unsigned long long sel, int tl, int qt, int kt0, float gate, LAS float* otl, LAS float* wsf, int vb0, float zero_) {
    const int half = wid >> 2;
    const bf16_t* ksrc = Kb + (size_t)(row0 + lane) * 64 + wid * 8;
    const bf16_t* vsrc = Vb + (size_t)(row0 + 16 * (wid & 3) + (lane >> 2)) * 64 + (wid >> 2) * 32 + (lane & 3) * 8;
#define BP_ISSUE_K(i, slot) __builtin_amdgcn_global_load_lds((const unsigned*)(ksrc + (size_t)(i) * 4096), (LAS unsigned*)(lds + L_K + (slot) + wid * 1024), 16, 0, 0)
#define BP_ISSUE_V(i, slot) __builtin_amdgcn_global_load_lds((const unsigned*)(vsrc + (size_t)(i) * 4096), (LAS unsigned*)(lds + L_V + (slot) + wid * 1024), 16, 0, 0)
#define BP_NEXT(s) ((s) == 16384 ? 0 : (s) + 8192)
#define BP_WAIT(c) do { if ((c) == 2) asm volatile("s_waitcnt vmcnt(2)" ::: "memory"); else if ((c) == 1) asm volatile("s_waitcnt vmcnt(1)" ::: "memory"); else asm volatile("s_waitcnt vmcnt(0)" ::: "memory"); } while (0)
#define BP_BAR() asm volatile("s_waitcnt lgkmcnt(0)\n\ts_barrier" ::: "memory")
    f32x16 o[2], p0, p1;
#pragma unroll
    for (int r = 0; r < 16; ++r) { o[0][r] = zero_; o[1][r] = zero_; p0[r] = zero_; p1[r] = zero_; }
    bf16x8 a0 = {0, 0, 0, 0, 0, 0, 0, 0}, a1 = a0, a2 = a0, a3 = a0;
    constexpr float THR = 8.f;
    f32x16 negm;
#pragma unroll
    for (int r = 0; r < 16; ++r) negm[r] = zero_;
    float mref = 0.f, l = 0.f; bool resc = false;
    BP_ISSUE_K(0, 0); if (n > 1) BP_ISSUE_K(1, 8192); BP_ISSUE_V(0, 0); VM_WAIT(); BP_BAR();
    int s0 = 0, sm1 = 16384;
    auto X = [&](int i) {
        if (i > 0) {
            if (resc) {
#pragma unroll
                for (int r = 0; r < 16; ++r) { const float f = wsf[crow(r, hi)]; o[0][r] *= f; o[1][r] *= f; }
                LDS_WAIT(); }
            pv(o, vb0 + sm1, a0, a1, a2, a3);
        }
        if (i < n) qkt_c(p0, p1, lds + L_K + s0, qr, r32, hi, negm);
    };
    auto Y = [&](int i) {
        int lo = 0, hi_ = 63; bool rowsel = true;
        if (MODE == 2) { rowsel = ((sel >> i) & 1ull) != 0; if (i == qt) hi_ = tl; }
        else { const int kt = kt0 + i; if (kt == qt - 8) lo = tl + 1; if (kt == qt) hi_ = tl; }
        if (!__all(lo <= 0 && hi_ >= 63)) mask_tile(p0, p1, lo, hi_, hi);
        else asm volatile("s_nop 15\n\ts_nop 7" : "+v"(p0), "+v"(p1));
        float rm = tile_max(p0, p1); if (!rowsel) rm = -INFINITY;
        resc = __any(rm > THR) != 0;
        if (resc) {
            const float dl = fmaxf(rm, 0.f); mref += dl;
#pragma unroll
            for (int r = 0; r < 16; ++r) { p0[r] -= dl; p1[r] -= dl; negm[r] = -mref; }
            const float f = fast_exp2(-dl); l *= f; if (hi == 0) wsf[r32] = f;
        }
        float sum = 0.f;
#pragma unroll
        for (int r = 0; r < 16; ++r) { p0[r] = fast_exp2(p0[r]); p1[r] = fast_exp2(p1[r]); sum += p0[r] + p1[r]; }
        l += rowsel ? sum : 0.f;
        pack_p(p0, p1, a0, a1, a2, a3);
        if (MODE == 2 && !rowsel) { const bf16x8 zz = {0, 0, 0, 0, 0, 0, 0, 0}; a0 = zz; a1 = zz; a2 = zz; a3 = zz; }
    };
    if (half == 0) {
        for (int j = 0; j <= n; ++j) {
            const int s1 = BP_NEXT(s0); int c = 0; if (j + 2 < n) { BP_ISSUE_K(j + 2, sm1); ++c; } if (j + 1 < n) { BP_ISSUE_V(j + 1, s1); ++c; }
            X(j); BP_BAR();
            if (j < n) Y(j);
            BP_WAIT(c); BP_BAR();
            sm1 = s0; s0 = s1;
        }
    } else {
        for (int j = 0; j <= n; ++j) {
            const int s1 = BP_NEXT(s0); int c = 0; if (j + 2 < n) { BP_ISSUE_K(j + 2, sm1); ++c; } if (j + 1 < n) { BP_ISSUE_V(j + 1, s1); ++c; }
            if (j > 0) Y(j - 1);
            BP_BAR();
            X(j);
            BP_WAIT(c); BP_BAR();
            sm1 = s0; s0 = s1;
        }
    }
#undef BP_WAIT
#undef BP_NEXT
    l = xor32_sum(l);
    if (hi == 0) wsf[r32] = l > 0.f ? gate / l : 0.f;
    LDS_WAIT();
#pragma unroll
    for (int r = 0; r < 16; ++r) { const float f = wsf[crow(r, hi)]; otl[r * 64] += o[0][r] * f; otl[(16 + r) * 64] += o[1][r] * f; }
    LDS_WAIT();
#undef BP_ISSUE_K
#undef BP_ISSUE_V
#undef BP_BAR
}

__device__ __forceinline__ void unit(const Ptrs& P, int b, int g, int qt, LAS unsigned char* lds, int tid_in) {
    int tid_ = tid_in; asm volatile("" : "+v"(tid_));
    const int tid = tid_, lane = tid & 63, r32 = lane & 31, hi = lane >> 5; const int wid = __builtin_amdgcn_readfirstlane(tid >> 6);
    const int bg = b * 2 + g;
    const int tl = 8 * wid + (r32 >> 2), hr = r32 & 3;
    const int tpos = 64 * qt + tl;
    const size_t tok = (size_t)b * SEQ + tpos;
    LAS float* wsf = (LAS float*)(lds + L_WSF) + wid * 64;
    LAS float* pcs = (LAS float*)(lds + L_PCS);
    LAS unsigned long long* selm = (LAS unsigned long long*)(lds + L_SEL);
    const int vb0 = (int)(unsigned)(uintptr_t)(lds + L_V) + ((lane >> 4) & 1) * 32 + (lane & 3) * 8 + (4 * hi + ((lane & 15) >> 2)) * 64;
    const float* gp = P.gates + tok * 24 + (g * 4 + hr) * 3;
    const float g0 = gp[0], g1 = gp[1], g2 = gp[2];
    float zero_ = 0.f; asm volatile("" : "+v"(zero_));
    f32x16 ot[2];
#pragma unroll
    for (int r = 0; r < 16; ++r) { ot[0][r] = zero_; ot[1][r] = zero_; }
    bf16x8 qr[4];
    const size_t qoff = ((size_t)bg * SEQ + 64 * qt) * 256 + (size_t)(wid * 32 + r32) * 64 + hi * 8;
#pragma unroll
    for (int d0 = 0; d0 < 4; ++d0) qr[d0] = *(const bf16x8*)(P.qraw + qoff + d0 * 16);

    const int nv = tpos >= 15 ? ((tpos - 15) >> 4) : 0;
    const int nct = (4 * qt + 3 + 63) >> 6;
    const bf16_t* kc = P.kcmp + (size_t)bg * 256 * 64; const bf16_t* vc = P.vcmp + (size_t)bg * 256 * 64;
    float mc = -INFINITY, lc = 0.f;
    tile_loop<false>(nct, kc, vc, 0, lds, wid, lane, [&](int i, int sl) {
        f32x16 p0, p1; qkt(p0, p1, lds + L_K + sl, qr, r32, hi, zero_);
        mask_tile(p0, p1, 0, nv - 64 * i - 1, hi);
        const float rm = tile_max(p0, p1); const float mn = fmaxf(mc, rm), mu = (mn == -INFINITY) ? 0.f : mn;
        float s = 0.f;
#pragma unroll
        for (int r = 0; r < 16; ++r) s += fast_exp2(p0[r] - mu) + fast_exp2(p1[r] - mu);
        lc = lc * fast_exp2(mc - mu) + s; mc = mn;
    });
    lc = xor32_sum(lc);
    {
        const float mu = (mc == -INFINITY) ? 0.f : mc, inv = lc > 0.f ? 1.f / lc : 0.f;
        tile_loop<true>(nct, kc, vc, 0, lds, wid, lane, [&](int i, int sl) {
            f32x16 p0, p1; qkt(p0, p1, lds + L_K + sl, qr, r32, hi, zero_);
            mask_tile(p0, p1, 0, nv - 64 * i - 1, hi);
#pragma unroll
            for (int r = 0; r < 16; ++r) { p0[r] = fast_exp2(p0[r] - mu) * inv; p1[r] = fast_exp2(p1[r] - mu) * inv; }
#pragma unroll
            for (int r = 0; r < 16; ++r) {
                float a = p0[r], c = p1[r];
                a += xor_get<1>(a); a += xor_get<2>(a); c += xor_get<1>(c); c += xor_get<2>(c);
                if (hr == 0) { pcs[tl * 256 + 64 * i + crow(r, hi)] = a; pcs[tl * 256 + 64 * i + 32 + crow(r, hi)] = c; }
            }
#pragma unroll
            for (int r = 0; r < 16; ++r) { p0[r] *= g0; p1[r] *= g0; }
            bf16x8 a0, a1, a2, a3; pack_p(p0, p1, a0, a1, a2, a3);
            pv(ot, vb0 + sl, a0, a1, a2, a3);
        });
    }
    LDS_WAIT(); __syncthreads();
    if (qt < 16) { if (lane < 8) selm[8 * wid + lane] = (2ull << qt) - 1ull; }
    else {
        for (int k = 0; k < 8; ++k) {
            const int t8 = 8 * wid + k; const LAS float* pr = pcs + t8 * 256;
            float sc = -INFINITY;
            if (lane <= qt) { float imp = 0.f;
#pragma unroll
                for (int j = -1; j < 4; ++j) { const int c = 4 * lane + j; if (c >= 0 && c < 255) imp += pr[c]; }
                sc = (lane == 0 || lane == qt || lane == qt - 1) ? INFINITY : imp; }
            int rank = 0;
            for (int j = 0; j <= qt; ++j) { const float sj = __builtin_bit_cast(float, __builtin_amdgcn_readlane(__builtin_bit_cast(int, sc), j)); rank += (sj > sc || (sj == sc && j < lane)) ? 1 : 0; }
            const unsigned long long mk = __ballot(lane <= qt && rank < 16);
            if (lane == 0) selm[t8] = mk;
        }
    }
    LDS_WAIT(); __syncthreads();
    const unsigned long long sel = selm[tl];
    LAS float* otl = (LAS float*)(lds + L_PCS) + wid * 2048 + lane;
#pragma unroll
    for (int r = 0; r < 16; ++r) { otl[r * 64] = ot[0][r]; otl[(16 + r) * 64] = ot[1][r]; }
    LDS_WAIT();
#pragma unroll
    for (int d0 = 0; d0 < 4; ++d0) qr[d0] = *(const bf16x8*)(P.qrot + qoff + d0 * 16);
    branch_pipe<2>(qt + 1, P.kv + 2 * KVSZ + (size_t)bg * SEQ * 64, P.kv + 3 * KVSZ + (size_t)bg * SEQ * 64, 0, lds, wid, lane, r32, hi, qr, sel, tl, qt, 0, g1, otl, wsf, vb0, zero_);
    { const int k0 = qt >= 8 ? qt - 8 : 0;
      branch_pipe<3>(qt - k0 + 1, P.kv + 4 * KVSZ + (size_t)bg * SEQ * 64, P.kv + 5 * KVSZ + (size_t)bg * SEQ * 64, 64 * k0, lds, wid, lane, r32, hi, qr, sel, tl, qt, k0, g2, otl, wsf, vb0, zero_); }
    {
        LAS bf16_t* stg = (LAS bf16_t*)(lds + L_OST) + wid * 2048;
#pragma unroll
        for (int r = 0; r < 16; ++r) { const int orow = crow(r, hi);
#pragma unroll
            for (int d0 = 0; d0 < 2; ++d0) stg[orow * 64 + d0 * 32 + r32] = (bf16_t)f2bf(otl[(d0 * 16 + r) * 64]); }
        LDS_WAIT();
#pragma unroll
        for (int it = 0; it < 4; ++it) { const int row = it * 8 + (lane >> 3), ch = lane & 7; const u32x4 v = *(const LAS u32x4*)(stg + row * 64 + ch * 8);
            bf16_t* dst = P.ab + ((size_t)b * SEQ + 64 * qt + 8 * wid + (row >> 2)) * 1024 + g * 256 + (row & 3) * 64 + ch * 8;
            *(u32x4*)dst = v; }
        LDS_WAIT();
    }
    __syncthreads();
}

__device__ __forceinline__ void xattn_unit(const bf16_t* Q, const bf16_t* Kx, const bf16_t* Vx, bf16_t* O, int pm, int h, LAS unsigned char* lds, int tid_in) {
    int tid_ = tid_in; asm volatile("" : "+v"(tid_));
    const int tid = tid_, lane = tid & 63, r32 = lane & 31, hi = lane >> 5; const int wid = __builtin_amdgcn_readfirstlane(tid >> 6);
    constexpr int XK = 0, XV = 65536, SL = 32768;
    const int b = pm >> 4;
    const bf16_t* kbase = Kx + ((size_t)b * 256 + lane) * 1024 + h * 256 + wid * 32;
    const bf16_t* vbase = Vx + ((size_t)b * 256 + (lane >> 2)) * 1024 + h * 256 + wid * 32 + (lane & 3) * 8;
#define XA_ISSUE_K(t) do { _Pragma("unroll") for (int i_ = 0; i_ < 4; ++i_) __builtin_amdgcn_global_load_lds((const unsigned*)(kbase + (size_t)(t) * 64 * 1024 + 8 * i_), \
        (LAS unsigned*)(lds + XK + ((t) & 1) * SL + (wid * 4 + i_) * 1024), 16, 0, 0); } while (0)
#define XA_ISSUE_V(t) do { _Pragma("unroll") for (int i_ = 0; i_ < 4; ++i_) __builtin_amdgcn_global_load_lds((const unsigned*)(vbase + ((size_t)(t) * 64 + 16 * i_) * 1024), \
        (LAS unsigned*)(lds + XV + ((t) & 1) * SL + (wid * 4 + i_) * 1024), 16, 0, 0); } while (0)
#define XA_BAR() asm volatile("s_waitcnt lgkmcnt(0)\n\ts_barrier" ::: "memory")
    XA_ISSUE_K(0); XA_ISSUE_K(1); XA_ISSUE_V(0); XA_ISSUE_V(1);
    bf16x8 qr[16];
    { const bf16_t* qp = Q + (size_t)(pm * 256 + wid * 32 + r32) * 1024 + h * 256 + hi * 8;
#pragma unroll
      for (int d0 = 0; d0 < 16; ++d0) qr[d0] = *(const bf16x8*)(qp + d0 * 16); }
    float zero_ = 0.f; asm volatile("" : "+v"(zero_));
    f32x16 p[4][2];
#pragma unroll
    for (int t = 0; t < 4; ++t) {
        if (t != 1) asm volatile("s_waitcnt vmcnt(0)" ::: "memory");
        XA_BAR();
        if (t == 1) XA_ISSUE_K(2);
        if (t == 2) XA_ISSUE_K(3);
#if XDIAG
        asm volatile("s_waitcnt vmcnt(0)" ::: "memory"); XA_BAR();
#endif
        const LAS unsigned char* kb = lds + XK + (t & 1) * SL + hi * 1024 + r32 * 16;
#pragma unroll
        for (int r = 0; r < 16; ++r) { p[t][0][r] = zero_; p[t][1][r] = zero_; }
#pragma unroll
        for (int d0 = 0; d0 < 16; ++d0) {
            const bf16x8 k0 = *(const LAS bf16x8*)(kb + d0 * 2048), k1 = *(const LAS bf16x8*)(kb + d0 * 2048 + 512);
            p[t][0] = __builtin_amdgcn_mfma_f32_32x32x16_bf16(k0, qr[d0], p[t][0], 0, 0, 0);
            p[t][1] = __builtin_amdgcn_mfma_f32_32x32x16_bf16(k1, qr[d0], p[t][1], 0, 0, 0);
        }
    }
    asm volatile("s_nop 15\n\ts_nop 7" : "+v"(p[0][0]), "+v"(p[0][1]), "+v"(p[1][0]), "+v"(p[1][1]), "+v"(p[2][0]), "+v"(p[2][1]), "+v"(p[3][0]), "+v"(p[3][1]));
    float mx = -INFINITY;
#pragma unroll
    for (int t = 0; t < 4; ++t) mx = fmaxf(mx, tile_max(p[t][0], p[t][1]));
    float sum = 0.f;
#pragma unroll
    for (int t = 0; t < 4; ++t)
#pragma unroll
        for (int r = 0; r < 16; ++r) { p[t][0][r] = fast_exp2((p[t][0][r] - mx) * CX); p[t][1][r] = fast_exp2((p[t][1][r] - mx) * CX); sum += p[t][0][r] + p[t][1][r]; }
    sum = xor32_sum(sum);
    const float inv = 1.f / sum;
    bf16x8 pa[4][4];
#pragma unroll
    for (int t = 0; t < 4; ++t) {
#pragma unroll
        for (int r = 0; r < 16; ++r) { p[t][0][r] *= inv; p[t][1][r] *= inv; }
        pack_p(p[t][0], p[t][1], pa[t][0], pa[t][1], pa[t][2], pa[t][3]); }
#if XMODE == 1
    { XA_BAR(); asm volatile("s_waitcnt vmcnt(0)" ::: "memory"); XA_BAR();
      bf16_t* dst = O + (size_t)(pm * 256 + wid * 32 + (lane & 31)) * 1024 + h * 256 + (lane >> 5) * 128;
#pragma unroll
      for (int t = 0; t < 4; ++t)
#pragma unroll
          for (int k = 0; k < 4; ++k) *(bf16x8*)(dst + (t * 4 + k) * 8) = pa[t][k];
      XA_BAR(); return; }
#endif
    f32x16 o[8];
#pragma unroll
    for (int d = 0; d < 8; ++d)
#pragma unroll
        for (int r = 0; r < 16; ++r) o[d][r] = zero_;
    const int vb0 = (int)(unsigned)(uintptr_t)(lds + XV) + ((lane >> 4) & 1) * 32 + (lane & 3) * 8 + (4 * hi + ((lane & 15) >> 2)) * 64;
#pragma unroll
    for (int t = 0; t < 4; ++t) {
        if (t >= 2) asm volatile("s_waitcnt vmcnt(0)" ::: "memory");
        XA_BAR();
        if (t == 1) XA_ISSUE_V(2);
        if (t == 2) XA_ISSUE_V(3);
#if XDIAG
        asm volatile("s_waitcnt vmcnt(0)" ::: "memory"); XA_BAR();
#endif
        const int vb = vb0 + (t & 1) * SL;
#pragma unroll
        for (int d = 0; d < 8; ++d) { s16x4 lo[4], hh[4];
#pragma unroll
            for (int ks = 0; ks < 4; ++ks) {
                asm volatile("ds_read_b64_tr_b16 %0,%1 offset:%c2" : "=&v"(lo[ks]) : "v"(vb), "i"(d * 4096 + ks * 1024) : "memory");
                asm volatile("ds_read_b64_tr_b16 %0,%1 offset:%c2" : "=&v"(hh[ks]) : "v"(vb), "i"(d * 4096 + ks * 1024 + 512) : "memory"); }
            asm volatile("s_waitcnt lgkmcnt(0)" ::: "memory"); __builtin_amdgcn_sched_barrier(0);
#define XA_PK(k) (bf16x8){lo[k][0], lo[k][1], lo[k][2], lo[k][3], hh[k][0], hh[k][1], hh[k][2], hh[k][3]}
            o[d] = __builtin_amdgcn_mfma_f32_32x32x16_bf16(pa[t][0], XA_PK(0), o[d], 0, 0, 0);
            o[d] = __builtin_amdgcn_mfma_f32_32x32x16_bf16(pa[t][1], XA_PK(1), o[d], 0, 0, 0);
            o[d] = __builtin_amdgcn_mfma_f32_32x32x16_bf16(pa[t][2], XA_PK(2), o[d], 0, 0, 0);
            o[d] = __builtin_amdgcn_mfma_f32_32x32x16_bf16(pa[t][3], XA_PK(3), o[d], 0, 0, 0);
#undef XA_PK
        }
    }
    XA_BAR();
    {   LAS bf16_t* stg = (LAS bf16_t*)(lds + wid * 16384);
#pragma unroll
        for (int d = 0; d < 8; ++d)
#pragma unroll
            for (int r = 0; r < 16; ++r) stg[crow(r, hi) * 256 + d * 32 + r32] = (bf16_t)f2bf(o[d][r]);
        LDS_WAIT();
#pragma unroll
        for (int it = 0; it < 16; ++it) { const int row = it * 2 + (lane >> 5), ch = lane & 31; const u32x4 v = *(const LAS u32x4*)(stg + row * 256 + ch * 8);
            *(u32x4*)(O + (size_t)(pm * 256 + wid * 32 + row) * 1024 + h * 256 + ch * 8) = v; }
        LDS_WAIT();
    }
    XA_BAR();
#undef XA_ISSUE_K
#undef XA_ISSUE_V
#undef XA_BAR
}
}

#define XB_TMO      128
#define XB_XCNT(j)  (256  + 64 * (j))
#define XB_XSUB(j)  (1280 + 64 * (j))
#define XB_XGEN(j)  (2304 + 64 * (j))
#define XB_TOP      3328
#define XB_TOPGEN   3392
#define XCD_BAR_WORDS 3456
#define XB_SPIN_CAP (1u << 18)
__device__ __forceinline__ unsigned xb_ld(unsigned* p)              { return __hip_atomic_load(p, __ATOMIC_RELAXED, __HIP_MEMORY_SCOPE_AGENT); }
__device__ __forceinline__ unsigned xb_add(unsigned* p, unsigned v) { return __hip_atomic_fetch_add(p, v, __ATOMIC_RELAXED, __HIP_MEMORY_SCOPE_AGENT); }
__device__ __forceinline__ unsigned xb_xcc_id() { return (unsigned)__builtin_amdgcn_s_getreg((3 << 11) | 20) & 0xFu; }
#define XB_SPIN(cond, bar) do { unsigned _sp = 0; while (cond) { __builtin_amdgcn_s_sleep(1); \
    if ((++_sp & 255u) == 0u) { if (xb_ld(&(bar)[XB_TMO])) break; if (_sp > XB_SPIN_CAP) { atomicAdd(&(bar)[XB_TMO], 1u); break; } } } } while (0)
struct XcdBarrier { unsigned* bar; unsigned x; volatile LAS unsigned* st; };
__device__ __forceinline__ XcdBarrier xcd_barrier_post(unsigned* bar, volatile LAS unsigned* st) {
    XcdBarrier b; b.bar = bar; b.x = xb_xcc_id(); b.st = st;
    if (threadIdx.x == 0) (void)xb_add(&bar[XB_XCNT(b.x)], 1u);
    return b;
}
__device__ __forceinline__ void xcd_barrier_complete(unsigned* bar, unsigned x, unsigned& nloc, unsigned& nx) {
    const unsigned G = gridDim.x * gridDim.y * gridDim.z;
    unsigned sum, cnt, mine, sp = 0u;
    for (;;) {
        sum = 0u; cnt = 0u; mine = 0u;
#pragma unroll
        for (unsigned j = 0; j < 16; ++j) { const unsigned c = xb_ld(&bar[XB_XCNT(j)]); sum += c; cnt += (c > 0u) ? 1u : 0u; mine = (j == x) ? c : mine; }
        if (sum == G) break;
        __builtin_amdgcn_s_sleep(1);
        if ((++sp & 255u) == 0u) { if (xb_ld(&bar[XB_TMO])) break; if (sp > XB_SPIN_CAP) { atomicAdd(&bar[XB_TMO], 1u); break; } }
    }
    nloc = mine > 0u ? mine : 1u; nx = cnt > 0u ? cnt : 1u;
}
__device__ __forceinline__ void xcd_barrier(const XcdBarrier& b, int tid) {
    asm volatile("s_waitcnt vmcnt(0)" ::: "memory");
    __syncthreads();
    if (tid == 0) {
        unsigned* bar = b.bar;
        __builtin_amdgcn_s_waitcnt(0);
        unsigned nloc = b.st[0], nx = b.st[1];
        if (nloc == 0u) { xcd_barrier_complete(bar, b.x, nloc, nx); b.st[0] = nloc; b.st[1] = nx; }
        const unsigned old = xb_add(&bar[XB_XSUB(b.x)], 1u);
        const unsigned gen = old / nloc;
        if (old + 1u == (gen + 1u) * nloc) {
            __builtin_amdgcn_fence(__ATOMIC_RELEASE, "agent");
            asm volatile("s_waitcnt vmcnt(0)" ::: "memory");
            const unsigned og = xb_add(&bar[XB_TOP], 1u);
            const unsigned tg = og / nx;
            if (og + 1u == (tg + 1u) * nx) xb_add(&bar[XB_TOPGEN], 1u);
            else XB_SPIN(xb_ld(&bar[XB_TOPGEN]) == tg, bar);
            __builtin_amdgcn_fence(__ATOMIC_ACQUIRE, "agent");
            xb_add(&bar[XB_XGEN(b.x)], 1u);
            asm volatile("s_waitcnt vmcnt(0)" ::: "memory");
        } else {
            XB_SPIN(xb_ld(&bar[XB_XGEN(b.x)]) == gen, bar);
            __builtin_amdgcn_fence(__ATOMIC_ACQUIRE, "agent");
            asm volatile("s_waitcnt vmcnt(0)" ::: "memory");
        }
    }
    __syncthreads();
}

__device__ __forceinline__ void xpose_item(const float* W, int ldw, int k0, int n0, int ncv, bf16_t* WT, int ldt, int dr0, LAS float* scr, int lane, const float* gain = nullptr) {
    const int c = lane & 31;
#pragma unroll 8
    for (int i = 0; i < 32; ++i) { const int kk = 2 * i + (lane >> 5); scr[kk * 33 + c] = c < ncv ? W[(size_t)(k0 + kk) * ldw + n0 + c] * (gain ? gain[k0 + kk] : 1.f) : 0.f; }
    LDS_WAIT(); asm volatile("" ::: "memory");
    const int c8 = lane & 7;
#pragma unroll
    for (int j = 0; j < 4; ++j) { const int n = (lane >> 3) + 8 * j; const LAS float* s = scr + (8 * c8) * 33 + n;
        u32x4 o; o.x = pk2(s[0 * 33], s[1 * 33]); o.y = pk2(s[2 * 33], s[3 * 33]); o.z = pk2(s[4 * 33], s[5 * 33]); o.w = pk2(s[6 * 33], s[7 * 33]);
        *(u32x4*)(WT + (size_t)(dr0 + n) * ldt + k0 + 8 * c8) = o; }
    LDS_WAIT(); asm volatile("" ::: "memory");
}
__device__ __forceinline__ void xpose_item64(const float* W, int ldw, int k0, int n0, bf16_t* WT, int ldt, int dr0, LAS float* scr, int lane, const float* gain) {
    const int c4 = lane & 15, r4 = lane >> 4;
    f32x4 v[16];
#pragma unroll
    for (int i = 0; i < 16; ++i) v[i] = *(const f32x4*)(W + (size_t)(k0 + 4 * i + r4) * ldw + n0 + 4 * c4);
    if (gain) {
#pragma unroll
        for (int i = 0; i < 16; ++i) v[i] = v[i] * gain[k0 + 4 * i + r4]; }
#pragma unroll
    for (int i = 0; i < 16; ++i) { LAS float* d = scr + (4 * i + r4) * 65 + 4 * c4; d[0] = v[i].x; d[1] = v[i].y; d[2] = v[i].z; d[3] = v[i].w; }
    LDS_WAIT(); asm volatile("" ::: "memory");
    const int c8 = lane & 7;
#pragma unroll
    for (int j = 0; j < 8; ++j) { const int n = (lane >> 3) + 8 * j; const LAS float* s = scr + (8 * c8) * 65 + n;
        u32x4 o; o.x = pk2(s[0 * 65], s[1 * 65]); o.y = pk2(s[2 * 65], s[3 * 65]); o.z = pk2(s[4 * 65], s[5 * 65]); o.w = pk2(s[6 * 65], s[7 * 65]);
        *(u32x4*)(WT + (size_t)(dr0 + n) * ldt + k0 + 8 * c8) = o; }
    LDS_WAIT(); asm volatile("" ::: "memory");
}
__device__ __forceinline__ void xpose_load64(const float* W, int ldw, int k0, int n0, int lane, f32x4 (&v)[16]) {
    const int c4 = lane & 15, r4 = lane >> 4;
#pragma unroll
    for (int i = 0; i < 16; ++i) v[i] = *(const f32x4*)(W + (size_t)(k0 + 4 * i + r4) * ldw + n0 + 4 * c4);
}
__device__ __forceinline__ void xpose_store64(const f32x4 (&v)[16], int k0, bf16_t* WT, int ldt, int dr0, LAS float* scr, int lane, const float* gain = nullptr) {
    const int c4 = lane & 15, r4 = lane >> 4;
#pragma unroll
    for (int i = 0; i < 16; ++i) { LAS float* d = scr + (4 * i + r4) * 65 + 4 * c4; d[0] = v[i].x; d[1] = v[i].y; d[2] = v[i].z; d[3] = v[i].w; }
    LDS_WAIT(); asm volatile("" ::: "memory");
    const int c8 = lane & 7;
    f32x4 ga = {1.f, 1.f, 1.f, 1.f}, gb = ga;
    if (gain) { ga = *(const f32x4*)(gain + k0 + 8 * c8); gb = *(const f32x4*)(gain + k0 + 8 * c8 + 4); }
#pragma unroll
    for (int j = 0; j < 8; ++j) { const int n = (lane >> 3) + 8 * j; const LAS float* s = scr + (8 * c8) * 65 + n;
        u32x4 o; o.x = pk2(s[0 * 65] * ga.x, s[1 * 65] * ga.y); o.y = pk2(s[2 * 65] * ga.z, s[3 * 65] * ga.w); o.z = pk2(s[4 * 65] * gb.x, s[5 * 65] * gb.y); o.w = pk2(s[6 * 65] * gb.z, s[7 * 65] * gb.w);
        *(u32x4*)(WT + (size_t)(dr0 + n) * ldt + k0 + 8 * c8) = o; }
    LDS_WAIT(); asm volatile("" ::: "memory");
}
__device__ __forceinline__ void xpose_mat(const float* W, int K, int N, bf16_t* WT, int rowmap, int item, LAS float* scr, int lane, const float* gain = nullptr) {
    const int ng = N / 64, kb = item / ng, j = item % ng, n = 64 * j;
    const int dr = rowmap == 0 ? n : (256 * (n >> 7) + (n & 127) + (rowmap == 2 ? 128 : 0));
    xpose_item64(W, N, 64 * kb, n, WT, K, dr, scr, lane, gain);
}
template <int W> __device__ __forceinline__ void pool_run(const bf16_t* ub, bf16_t* ab, int rq, int lane) {
    constexpr int CLS = W == 2 ? 0 : W == 4 ? 1 : W == 8 ? 2 : 3, NR = 15 + W;
    const int t0 = (4 * rq + (lane >> 4)) * 16, t0s = t0 & (SEQ - 1), col = 128 * CLS + 8 * (lane & 15);
    u32x4 R[NR];
#pragma unroll
    for (int j = 0; j < NR; ++j) { R[j] = (u32x4){0u, 0u, 0u, 0u}; if (t0s - (W - 1) + j >= 0) R[j] = *(const u32x4*)(ub + (size_t)(t0 - (W - 1) + j) * 512 + col); }
    float s[8];
#pragma unroll
    for (int e = 0; e < 8; ++e) s[e] = 0.f;
#pragma unroll
    for (int j = 0; j < W - 1; ++j)
#pragma unroll
        for (int e = 0; e < 4; ++e) { s[2 * e] += __builtin_bit_cast(float, R[j][e] << 16); s[2 * e + 1] += __builtin_bit_cast(float, R[j][e] & 0xffff0000u); }
#pragma unroll
    for (int i = 0; i < 16; ++i) {
        float own[8];
#pragma unroll
        for (int e = 0; e < 4; ++e) { own[2 * e] = __builtin_bit_cast(float, R[W - 1 + i][e] << 16); own[2 * e + 1] = __builtin_bit_cast(float, R[W - 1 + i][e] & 0xffff0000u); }
#pragma unroll
        for (int e = 0; e < 8; ++e) s[e] += own[e];
        if (i > 0) {
#pragma unroll
            for (int e = 0; e < 4; ++e) { s[2 * e] -= __builtin_bit_cast(float, R[i - 1][e] << 16); s[2 * e + 1] -= __builtin_bit_cast(float, R[i - 1][e] & 0xffff0000u); } }
        const int n = (t0s + i + 1) < W ? (t0s + i + 1) : W; const float inv = 1.f / (float)n;
        u32x4 o; o.x = pk2(s[0] * inv - own[0], s[1] * inv - own[1]); o.y = pk2(s[2] * inv - own[2], s[3] * inv - own[3]);
        o.z = pk2(s[4] * inv - own[4], s[5] * inv - own[5]); o.w = pk2(s[6] * inv - own[6], s[7] * inv - own[7]);
        *(u32x4*)(ab + (size_t)(t0 + i) * 1024 + 512 + col) = o;
    }
}
__device__ __forceinline__ float row_rs(const float* xrow, int lane, f32x4 (&v)[4]) {
    const f32x4* xr = (const f32x4*)xrow + lane; float s = 0.f;
#pragma unroll
    for (int j = 0; j < 4; ++j) { v[j] = xr[64 * j]; s += (v[j].x * v[j].x + v[j].y * v[j].y) + (v[j].z * v[j].z + v[j].w * v[j].w); }
    return 1.0f / sqrtf(wave_sum(s) * (1.f / DM) + EPS);
}
__device__ __forceinline__ void norm_row(const float* xrow, const float* gain, bf16_t* orow, int lane) {
    f32x4 v[4]; const float rs = row_rs(xrow, lane, v);
    const f32x4* gr = (const f32x4*)gain + lane; unsigned long long* o8 = (unsigned long long*)orow + lane;
#pragma unroll
    for (int j = 0; j < 4; ++j) { const f32x4 g = gr[64 * j];
        o8[64 * j] = (unsigned long long)pk2(v[j].x * rs * g.x, v[j].y * rs * g.y) | ((unsigned long long)pk2(v[j].z * rs * g.z, v[j].w * rs * g.w) << 32); }
}
__device__ __forceinline__ void sincos_d(double a, float& s, float& c) {
    const double n = rint(a * 0.6366197723675814);
    double r = fma(-n, 1.5707963267948966, a); r = fma(-n, 6.123233995736766e-17, r);
    const double r2 = r * r;
    double sp = -1.0 / 1307674368000.0; sp = sp * r2 + 1.0 / 6227020800.0; sp = sp * r2 - 1.0 / 39916800.0; sp = sp * r2 + 1.0 / 362880.0; sp = sp * r2 - 1.0 / 5040.0; sp = sp * r2 + 1.0 / 120.0; sp = sp * r2 - 1.0 / 6.0; sp = sp * r2 * r + r;
    double cp = 1.0 / 20922789888000.0; cp = cp * r2 - 1.0 / 87178291200.0; cp = cp * r2 + 1.0 / 479001600.0; cp = cp * r2 - 1.0 / 3628800.0; cp = cp * r2 + 1.0 / 40320.0; cp = cp * r2 - 1.0 / 720.0; cp = cp * r2 + 1.0 / 24.0; cp = cp * r2 - 0.5; cp = cp * r2 + 1.0;
    const int q = (int)n & 3;
    const double ss = (q & 1) ? cp : sp, cc = (q & 1) ? sp : cp;
    s = (float)((q & 2) ? -ss : ss); c = (float)(((q + 1) & 2) ? -cc : cc);
}

struct Args {
    const float* in[30]; float* out; unsigned char* ws; int ph_lo, ph_hi;
};
enum { I_X = 0, I_MEM, I_NORM_MIX, I_W_IN, I_PE_K, I_W1_K, I_B1_K, I_W2_K, I_PE_V, I_W1_V, I_B1_V, I_W2_V, I_W_POOL, I_POOL_SCALE, I_W_OUT, I_NORM_X, I_NORM_MEM,
       I_WQ, I_WK, I_WV, I_WO, I_NORM_FFN, I_FFN_WG, I_FFN_WU, I_FFN_WD, I_ROUTER, I_MOE_WG, I_MOE_WU, I_MOE_WD, I_NORM_FINAL };
constexpr int PH_PRO = 0, PH_KV = 1, PH_L0 = 2, PH_LSTRIDE = 20;
constexpr int PO_WIN = 0, PO_CMP = 1, PO_ATT = 2, PO_WOUT = 3, PO_N2 = 4, PO_WQ = 5, PO_S = 6, PO_PV = 7, PO_WO = 8, PO_F0 = 9;

typedef const Args __attribute__((address_space(4))) CArgs;
#if RES_BF16
__device__ __forceinline__ f32x4 xrow4(const bf16_t* xb2, const float*, size_t tok, int idx) { const u32x2 w = ((const u32x2*)(xb2 + tok * DM))[idx];
    return (f32x4){__builtin_bit_cast(float, w.x << 16), __builtin_bit_cast(float, w.x & 0xffff0000u), __builtin_bit_cast(float, w.y << 16), __builtin_bit_cast(float, w.y & 0xffff0000u)}; }
__device__ __forceinline__ float xrow1(const bf16_t* xb2, const float*, size_t tok, int idx) { return bf2f(xb2[tok * DM + idx]); }
#else
__device__ __forceinline__ f32x4 xrow4(const bf16_t*, const float* x, size_t tok, int idx) { return ((const f32x4*)(x + tok * DM))[idx]; }
__device__ __forceinline__ float xrow1(const bf16_t*, const float* x, size_t tok, int idx) { return x[tok * DM + idx]; }
#endif
#define PHASE_IDS CArgs* ap_ = (CArgs*)__builtin_amdgcn_kernarg_segment_ptr(); asm volatile("" : "+s"(ap_)); unsigned char* ws = ap_->ws; (void)ws; int tid_; asm volatile("v_mbcnt_lo_u32_b32 %0, -1, 0\n\tv_mbcnt_hi_u32_b32 %0, -1, %0" : "=v"(tid_)); tid_ += wid0 * 64; const int tid = tid_, lane = tid & 63, wid = wid0, gw = bid * NWAVES + wid; (void)lane; (void)gw;
#ifndef PHMASK
#define PHMASK 0xffffffffu
#endif
#define PM(b) ((PHMASK >> (b)) & 1u)
#define IN(k) (lo <= (k) && (k) < hi)
#if DBG >= 200
#define SEAM(k) do { if (hi > (k) + 1) xcd_barrier(bar, tid); if (bid == 0 && tid == 0) ((unsigned long long*)((unsigned*)(ws + WS_CTL) + 20000))[(k)] = __builtin_amdgcn_s_memrealtime(); } while (0)
#else
#ifndef BAR_REP
#define BAR_REP 1
#endif
#define SEAM(k) do { if (hi > (k) + 1) for (int br_ = 0; br_ < BAR_REP; ++br_) xcd_barrier(bar, tid); } while (0)
#endif
#define W16(off) ((bf16_t*)(ws + (off)))
constexpr int MOE_IT_MG = 16 * 56, MOE_IT_MD = 56 * 16, MOE_NM = 16 * MOE_IT_MG + 8 * MOE_IT_MD, MOE_S0 = 5 * 176 * 8, MOE_S1 = MOE_S0 + 3 * 128 * 8;
__device__ __forceinline__ void moe_convert(const float* wgp, const float* wup, const float* wdp, const float* gain, unsigned char* ws, LAS unsigned char* lds, int it_lo, int it_hi, int rank, int nranks, int wid, int lane) {
    LAS float* scr = (LAS float*)(lds + wid * 16896);
    auto ld = [&](int it, f32x4 (&v)[16]) {
        if (it < 16 * MOE_IT_MG) { const int mtx = it / MOE_IT_MG, r = it % MOE_IT_MG, e = mtx >> 1, up = mtx & 1, kb = r / 56, j = r % 56;
            xpose_load64((up ? wup : wgp) + (size_t)e * DM * DFFE, DFFE, 64 * kb, 64 * j, lane, v);
        } else { const int r0 = it - 16 * MOE_IT_MG, e = r0 / MOE_IT_MD, r = r0 % MOE_IT_MD, kb = r / 16, j = r % 16;
            xpose_load64(wdp + (size_t)e * DFFE * DM, DM, 64 * kb, 64 * j, lane, v); } };
    auto st = [&](int it, const f32x4 (&v)[16]) {
        if (it < 16 * MOE_IT_MG) { const int mtx = it / MOE_IT_MG, r = it % MOE_IT_MG, e = mtx >> 1, up = mtx & 1, kb = r / 56, j = r % 56, n = 64 * j;
            xpose_store64(v, 64 * kb, W16(WS_MGU) + (size_t)e * 7168 * DM, DM, 256 * (n >> 7) + (n & 127) + (up ? 128 : 0), scr, lane, gain);
        } else { const int r0 = it - 16 * MOE_IT_MG, e = r0 / MOE_IT_MD, r = r0 % MOE_IT_MD, kb = r / 16, j = r % 16;
            xpose_store64(v, 64 * kb, W16(WS_MD) + (size_t)e * DM * DFFE, DFFE, 64 * j, scr, lane); } };
    int it = it_lo + rank;
    f32x4 va[16], vb[16];
    if (it < it_hi) ld(it, va);
    while (it < it_hi) {
        if (it + nranks < it_hi) ld(it + nranks, vb);
        st(it, va); it += nranks; if (it >= it_hi) break;
        if (it + nranks < it_hi) ld(it + nranks, va);
        st(it, vb); it += nranks;
    }
}
template <int layer> __device__ __forceinline__ void layer_phases(LAS unsigned char* lds, const int lo, const int hi, const XcdBarrier& bar, const int G, const int bid, const int NGW, const int wid0) {
        const int pb = PH_L0 + layer * PH_LSTRIDE;
        if (PM(2) && IN(pb + PO_WIN)) {
            PHASE_IDS
            pg8::Gemm g{(const char*)(ws + WS_HB), (const char*)(ws + WS_WIN + (size_t)layer * ZW * DM * 2), DM, DM, DM};
            SchedPlain S; S.init(T / 256, ZW / 256, DM, DM, G, bid);
            EpiWin E{W16(WS_QRAW), W16(WS_QROT), W16(WS_KV), W16(WS_U), (float*)(ws + WS_GATES), (const float*)(ws + WS_ROPE), SSP(layer == 0 ? 0 : 3)};
            for (int rep_ = 0; rep_ < REPN(2); ++rep_) pg8::gemm_phase<EpiWin, SchedPlain, true, true>(lds, g, S, E, tid);
            SEAM(pb + PO_WIN);
        }
        if (PM(3) && IN(pb + PO_CMP)) {
            PHASE_IDS
            for (int rep_ = 0; rep_ < REPN(3); ++rep_)
            if (bid < 16) {
                const int kv = bid >> 3, pm = bid & 7, mtx = layer * 2 + kv;
                {
                    pg8::Gemm g{(const char*)(ws + WS_KV + (size_t)kv * KVSZ * 2), (const char*)(ws + WS_CW1 + (size_t)mtx * 256 * 2048 * 2), 2048, 1024, 2048};
                    SchedOne S; S.u.pm = pm; S.u.pn = 0; S.u.aoff = (long)pm * 256 * 1024 * 2; S.u.boff = 0; S.u.coff = 0;
                    EpiHid E{W16(WS_HID) + (size_t)kv * 2048 * 256, (const long long*)((const unsigned*)(ws + WS_CTL) + CW_BIAS) + mtx * 256};
                    pg8::gemm_phase<EpiHid, SchedOne, false, true>(lds, g, S, E, tid);
                }
                VM_WAIT(); __syncthreads();
                __builtin_amdgcn_fence(__ATOMIC_ACQUIRE, "agent"); VM_WAIT(); __syncthreads();
                {
                    pg8::Gemm g{(const char*)(ws + WS_HID + (size_t)kv * 2048 * 256 * 2), (const char*)(ws + WS_CW2 + (size_t)mtx * 256 * 256 * 2), 256, 256, 256};
                    SchedOne S; S.u.pm = pm; S.u.pn = 0; S.u.aoff = (long)pm * 256 * 256 * 2; S.u.boff = 0; S.u.coff = 0;
                    EpiCmp2 E{W16(WS_KCMP) + (size_t)kv * 8 * 256 * 64};
                    pg8::gemm_phase<EpiCmp2, SchedOne, false, true>(lds, g, S, E, tid);
                }
            } else if (layer == 0 && bid < 80) {
                pg8::Gemm g{(const char*)ws, (const char*)ws, DM, DM, DM}; SchedKV S{1, bid - 16}; EpiPlain E{(bf16_t*)ws, DM, nullptr};
                pg8::gemm_phase<EpiPlain, SchedKV, false, true>(lds, g, S, E, tid);
            } else {
                const int nw = layer == 0 ? G - 80 : G - 16, w0 = layer == 0 ? 80 : 16;
                moe_convert(ap_->in[I_MOE_WG], ap_->in[I_MOE_WU], ap_->in[I_MOE_WD], ap_->in[I_NORM_FFN] + DM, ws, lds, layer == 0 ? 0 : MOE_S1, layer == 0 ? MOE_S0 : MOE_NM, (bid - w0) * NWAVES + wid, nw * NWAVES, wid, lane);
                const bf16_t* ub = W16(WS_U); bf16_t* ab = W16(WS_AB);
                for (int p = (bid - w0) * NWAVES + wid; p < 1024; p += nw * NWAVES) { const int rq = p & 255;
                    switch (p >> 8) { case 0: pool_run<16>(ub, ab, rq, lane); break; case 1: pool_run<8>(ub, ab, rq, lane); break; case 2: pool_run<4>(ub, ab, rq, lane); break; default: pool_run<2>(ub, ab, rq, lane); break; } }
            }
            SEAM(pb + PO_CMP);
        }
        if (PM(4) && IN(pb + PO_ATT)) {
            PHASE_IDS
            nsa::Ptrs P{W16(WS_QRAW), W16(WS_QROT), W16(WS_KV), W16(WS_KCMP), W16(WS_KCMP) + 8 * 256 * 64, (const float*)(ws + WS_GATES), W16(WS_AB)};
            const int vcu = (G % 8 == 0) ? (bid % 8) * (G / 8) + bid / 8 : bid;
            for (int rep_ = 0; rep_ < REP_ATT; ++rep_)
            for (int uix = vcu; uix < 8 * 32; uix += G) { const int bgx = uix >> 5, s = uix & 31;
                nsa::unit(P, bgx >> 1, bgx & 1, 63 - s, lds, tid);
                nsa::unit(P, bgx >> 1, bgx & 1, s, lds, tid); }
            SEAM(pb + PO_ATT);
        }
        if (PM(5) && IN(pb + PO_WOUT)) {
            PHASE_IDS
            pg8::Gemm g{(const char*)(ws + WS_AB), (const char*)(ws + WS_WOUT + (size_t)layer * DM * DM * 2), DM, DM, DM};
            SchedPlain S; S.init(T / 256, DM / 256, DM, DM, G, bid);
#if RES_BF16
            if constexpr (layer == 0) { EpiResB<true> E{ap_->in[I_X], W16(WS_HB), SSP(1)}; pg8::gemm_phase<EpiResB<true>, SchedPlain, true, true>(lds, g, S, E, tid); }
            else { EpiResB<false> E{W16(WS_HB), W16(WS_HB), SSP(4)}; pg8::gemm_phase<EpiResB<false>, SchedPlain, true, true>(lds, g, S, E, tid); }
#else
            EpiRes E{layer == 0 ? ap_->in[I_X] : ap_->out, ap_->out, W16(WS_HB), SSP(layer == 0 ? 1 : 4)};
            pg8::gemm_phase<EpiRes, SchedPlain, true, true>(lds, g, S, E, tid);
#endif
            SEAM(pb + PO_WOUT);
        }
        if (PM(7) && IN(pb + PO_WQ)) {
            PHASE_IDS
            for (int rep_ = 0; rep_ < REPN(7); ++rep_) {
            {   pg8::Gemm g{(const char*)(ws + WS_HB), (const char*)(ws + WS_WQ + (size_t)layer * DM * DM * 2), DM, DM, DM};
                SchedPlain S; S.init(T / 256, DM / 256, DM, DM, G, bid);
                EpiPlain E{W16(WS_QX), DM, SSP(layer == 0 ? 1 : 4)};
                pg8::gemm_phase<EpiPlain, SchedPlain, false, true>(lds, g, S, E, tid); }
            VM_WAIT(); __syncthreads(); __builtin_amdgcn_fence(__ATOMIC_ACQUIRE, "agent"); VM_WAIT(); __syncthreads();
            {
                pg8::TileOrder o; o.init(T / 256, DM / 256, G, bid); int pm, pn;
                if (o.tile(0, pm, pn)) { nsa::xattn_unit(W16(WS_QX), W16(WS_KX) + (size_t)layer * DM * DM, W16(WS_VXT) + (size_t)layer * DM * DM, W16(WS_OX), pm, pn, lds, tid);
#if DBG == 400
                    if (layer == 1) { nsa::xattn_unit(W16(WS_QX), W16(WS_KX) + (size_t)layer * DM * DM, W16(WS_VXT) + (size_t)layer * DM * DM, W16(WS_ACTC), pm, pn, lds, tid);
                        VM_WAIT(); __syncthreads(); __builtin_amdgcn_fence(__ATOMIC_ACQUIRE, "agent"); VM_WAIT(); __syncthreads();
                        unsigned c = 0; for (int i = tid; i < 256 * 256; i += 512) { const size_t off = (size_t)(pm * 256 + (i >> 8)) * 1024 + pn * 256 + (i & 255); c += W16(WS_OX)[off] != W16(WS_ACTC)[off]; }
                        if (c) atomicAdd((unsigned*)(ws + WS_CTL) + 21100, c); }
#endif
                } }
            if (rep_ + 1 < REPN(7)) { VM_WAIT(); __syncthreads(); }
            }
            SEAM(pb + PO_PV);
        }
        if (PM(10) && IN(pb + PO_WO)) {
            PHASE_IDS
            pg8::Gemm g{(const char*)(ws + WS_OX), (const char*)(ws + WS_WO + (size_t)layer * DM * DM * 2), DM, DM, DM};
            SchedPlain S; S.init(T / 256, DM / 256, DM, DM, G, bid);
#if RES_BF16
            EpiResB<false> E{W16(WS_HB), layer == 0 ? W16(WS_HB) : W16(WS_XB2), layer == 0 ? SSP(2) : nullptr};
            pg8::gemm_phase<EpiResB<false>, SchedPlain, true, true>(lds, g, S, E, tid);
#else
            EpiRes E{ap_->out, ap_->out, layer == 0 ? W16(WS_HB) : nullptr, SSP(2)};
            pg8::gemm_phase<EpiRes, SchedPlain, true, true>(lds, g, S, E, tid);
#endif
            SEAM(pb + PO_WO);
        }
        if constexpr (layer == 0) {
            if (PM(12) && IN(pb + PO_F0 + 1)) {
            PHASE_IDS
                pg8::Gemm g{(const char*)(ws + WS_HB), (const char*)(ws + WS_FGU), DM, DM, DM};
                SchedPlain S; S.init(T / 256, 2 * DFF / 256, DM, DM, G, bid);
                EpiSwiglu E{W16(WS_ACT0), DFF, SSP(2)};
                for (int rep_ = 0; rep_ < REPN(12); ++rep_) pg8::gemm_phase<EpiSwiglu, SchedPlain, true, true>(lds, g, S, E, tid);
                if (bid >= 128) { __syncthreads();
                    moe_convert(ap_->in[I_MOE_WG], ap_->in[I_MOE_WU], ap_->in[I_MOE_WD], ap_->in[I_NORM_FFN] + DM, ws, lds, MOE_S0, MOE_S1, (bid - 128) * NWAVES + wid, 128 * NWAVES, wid, lane); __syncthreads(); }
                SEAM(pb + PO_F0 + 1);
            }
            if (PM(13) && IN(pb + PO_F0 + 2)) {
            PHASE_IDS
                pg8::Gemm g{(const char*)(ws + WS_ACT0), (const char*)(ws + WS_FD), DFF, DFF, DFF};
                SchedPlain S; S.init(T / 256, DM / 256, DFF, DFF, G, bid);
#if RES_BF16
                EpiResB<false> E{W16(WS_HB), W16(WS_HB), SSP(3)};
                pg8::gemm_phase<EpiResB<false>, SchedPlain, true, true>(lds, g, S, E, tid);
#else
                EpiRes E{ap_->out, ap_->out, W16(WS_HB), SSP(3)};
                pg8::gemm_phase<EpiRes, SchedPlain, true, true>(lds, g, S, E, tid);
#endif
                SEAM(pb + PO_F0 + 2);
            }
        } else {
#define route ((unsigned*)(ws + WS_ROUTE))
#define cntg ((unsigned*)(ws + WS_CNTG))
#define tinfo ((unsigned*)(ws + WS_TILE))
#define slot ((unsigned*)(ws + WS_SLOT))
            LAS int* LE = (LAS int*)lds;
            LAS float* LW = (LAS float*)(lds + 512);
            LAS int* LR = (LAS int*)(lds + 1024);
            LAS int* LC = (LAS int*)(lds + 1536);
            LAS float* LS = (LAS float*)(lds + 1600);
            if (PM(15) && IN(pb + PO_F0)) {
            PHASE_IDS
                const float* gain = ap_->in[I_NORM_FFN] + DM; const float* wr = ap_->in[I_ROUTER];
                float wgr[16][8];
#pragma unroll
                for (int jj = 0; jj < 16; ++jj) { const int k = lane + 64 * jj; const float gk = gain[k]; const f32x4 w0 = *(const f32x4*)(wr + (size_t)k * 8), w1 = *(const f32x4*)(wr + (size_t)k * 8 + 4);
#pragma unroll
                    for (int c = 0; c < 4; ++c) { wgr[jj][c] = gk * w0[c]; wgr[jj][4 + c] = gk * w1[c]; } }
                for (int i = bid * 512 + tid; i < MAXT * 256; i += G * 512) { ((unsigned*)(ws + WS_STOK))[i] = 0u; ((float*)(ws + WS_SRS))[i] = 0.f; }
                for (int rep_ = 0; rep_ < REPN(15); ++rep_)
                for (int tb = bid; tb < T / 64; tb += G) {
                    for (int k = 0; k < 8; ++k) { const int tl = 8 * wid + k, tok = 64 * tb + tl;
                        float xs[16], sq = 0.f;
#pragma unroll
                        for (int jj = 0; jj < 16; ++jj) { xs[jj] = xrow1(W16(WS_XB2), ap_->out, (size_t)tok, lane + 64 * jj); sq += xs[jj] * xs[jj]; }
                        const float rs = 1.0f / sqrtf(wave_sum(sq) * (1.f / DM) + EPS);
                        float lg[8];
#pragma unroll
                        for (int e = 0; e < 8; ++e) lg[e] = 0.f;
#pragma unroll
                        for (int jj = 0; jj < 16; ++jj) { const float h = xs[jj] * rs;
#pragma unroll
                            for (int e = 0; e < 8; ++e) lg[e] += h * wgr[jj][e]; }
                        { const bool b0 = lane & 1, b1 = lane & 2, b2 = lane & 4; float a4[4], a2[2], a1;
#pragma unroll
                          for (int i = 0; i < 4; ++i) a4[i] = (b0 ? lg[4 + i] : lg[i]) + xor_get<1>(b0 ? lg[i] : lg[4 + i]);
#pragma unroll
                          for (int i = 0; i < 2; ++i) a2[i] = (b1 ? a4[2 + i] : a4[i]) + xor_get<2>(b1 ? a4[i] : a4[2 + i]);
                          a1 = (b2 ? a2[1] : a2[0]) + xor_get<4>(b2 ? a2[0] : a2[1]);
                          a1 += xor_get<8>(a1); a1 += xor_get<16>(a1); a1 = xor32_sum(a1);
#pragma unroll
                          for (int e = 0; e < 8; ++e) lg[e] = __builtin_bit_cast(float, __builtin_amdgcn_readlane(__builtin_bit_cast(int, a1), ((e >> 2) & 1) | (((e >> 1) & 1) << 1) | ((e & 1) << 2))); }
                        if (lane == 0) { int i1 = 0; float v1 = lg[0];
#pragma unroll
                            for (int e = 1; e < 8; ++e) if (lg[e] > v1) { v1 = lg[e]; i1 = e; }
                            int i2 = -1; float v2 = -INFINITY;
#pragma unroll
                            for (int e = 0; e < 8; ++e) if (e != i1 && lg[e] > v2) { v2 = lg[e]; i2 = e; }
                            const float w1 = 1.f / (1.f + expf(v2 - v1));
                            LE[2 * tl] = i1; LE[2 * tl + 1] = i2; LW[2 * tl] = w1; LW[2 * tl + 1] = 1.f - w1; LS[tl] = rs; }
                    }
                    LDS_WAIT(); __syncthreads();
                    {
                        const int e0 = LE[2 * lane], e1 = LE[2 * lane + 1]; const bool mm = (e0 == wid) || (e1 == wid);
                        const unsigned long long bal = __ballot(mm);
                        if (mm) LR[2 * lane + (e1 == wid ? 1 : 0)] = __popcll(bal & ((1ull << lane) - 1ull));
                        if (lane == 0) LC[wid] = __popcll(bal); }
                    LDS_WAIT(); __syncthreads();
                    if (tid < 64) { const int tok = 64 * tb + tid; u32x4 a, b2; a.x = LE[2 * tid]; a.y = LE[2 * tid + 1]; a.z = LR[2 * tid]; a.w = LR[2 * tid + 1];
                        b2.x = __builtin_bit_cast(unsigned, LW[2 * tid]); b2.y = __builtin_bit_cast(unsigned, LW[2 * tid + 1]); b2.z = __builtin_bit_cast(unsigned, LS[tid]); b2.w = 0u;
                        *(u32x4*)(route + (size_t)tok * 8) = a; *(u32x4*)(route + (size_t)tok * 8 + 4) = b2; }
                    if (tid < 8) cntg[tb * 8 + tid] = (unsigned)LC[tid];
                    LDS_WAIT(); __syncthreads();
                }
                SEAM(pb + PO_F0);
            }
            if (PM(16) && IN(pb + PO_F0 + 1)) {
            PHASE_IDS
                LAS unsigned* SB = (LAS unsigned*)(lds + 2048);
                LAS unsigned* TOTS = (LAS unsigned*)(lds + 2048 + 64);
                LAS unsigned* MYB = (LAS unsigned*)(lds + 2048 + 128);
                for (int rep_ = 0; rep_ < REPN(16); ++rep_)
                for (int tb = bid; tb < T / 64; tb += G) {
                    {
                        float tot = 0.f, myb = 0.f;
#pragma unroll
                        for (int j = 0; j < 4; ++j) { const float c = (float)cntg[(4 * lane + j) * 8 + wid]; tot += c; myb += (4 * lane + j < tb) ? c : 0.f; }
                        tot = wave_sum(tot); myb = wave_sum(myb);
                        if (lane == 0) { TOTS[wid] = (unsigned)tot; MYB[wid] = (unsigned)myb; } }
                    LDS_WAIT(); __syncthreads();
                    if (tid == 0) { unsigned toff = 0; for (int e = 0; e < 8; ++e) { SB[e] = toff * 256 + MYB[e]; const unsigned nte = (TOTS[e] + 255) >> 8;
                            if (tb == 0) for (unsigned k = 0; k < nte; ++k) tinfo[8 + toff + k] = e;
                            toff += nte; }
                        if (tb == 0) tinfo[0] = toff; }
                    LDS_WAIT(); __syncthreads();
                    if (tid < 64) {
                        const int tok = 64 * tb + tid; const u32x4 ra = *(const u32x4*)(route + (size_t)tok * 8), rb = *(const u32x4*)(route + (size_t)tok * 8 + 4);
                        const unsigned s1 = SB[ra.x] + ra.z, s2 = SB[ra.y] + ra.w;
                        u32x4 o; o.x = s1; o.y = s2; o.z = rb.x; o.w = rb.y; *(u32x4*)(slot + (size_t)tok * 4) = o;
                        ((unsigned*)(ws + WS_STOK))[s1] = (unsigned)tok; ((unsigned*)(ws + WS_STOK))[s2] = (unsigned)tok;
                        ((unsigned*)(ws + WS_SRS))[s1] = rb.z; ((unsigned*)(ws + WS_SRS))[s2] = rb.z; }
                    LDS_WAIT(); __syncthreads();
                }
                SEAM(pb + PO_F0 + 1);
            }
#pragma unroll 1
            for (int ch = 0; ch < 2; ++ch) {
                const int t0 = ch * HALFT;
#define MOE_NM int nm = (int)tinfo[0] - t0; if (ch == 0) nm = nm > HALFT ? HALFT : nm; nm = nm < 0 ? 0 : (nm > CH1T ? CH1T : nm);
                if (PM(17) && IN(pb + PO_F0 + 2 + 2 * ch)) {
            PHASE_IDS
                    MOE_NM
                    pg8::Gemm g{(const char*)(ws + WS_XB2), (const char*)(ws + WS_MGU), DM, DM, DM};
                    SchedMoeG S; S.o.init(nm, 2 * DFFE / 256, G, bid); S.texp = tinfo + 8; S.t0 = t0; S.nn = 2 * DFFE / 256; S.astep = 0; S.bstep = 256L * DM * 2; S.estep = 7168L * DM * 2; S.cstep = 256L * DFFE; S.khb = 0; S.khc = 0; S.tab = XTRA_OFF;
                    {
                        LAS unsigned* tab = (LAS unsigned*)(lds + XTRA_OFF); const unsigned* stok = (const unsigned*)(ws + WS_STOK);
                        for (int i = tid >> 8; i < 8; i += 2) { int pm, pn; if (S.o.tile(i, pm, pn)) tab[256 * i + (tid & 255)] = stok[(t0 + pm) * 256 + (tid & 255)]; }
                        LDS_WAIT(); __syncthreads(); }
                    EpiSwiglu E{W16(WS_ACTC), DFFE, nullptr, (const float*)(ws + WS_SRS)};
                    for (int rep_ = 0; rep_ < REPN(17); ++rep_) pg8::gemm_phase<EpiSwiglu, SchedMoeG, true, true>(lds, g, S, E, tid);
                    SEAM(pb + PO_F0 + 2 + 2 * ch);
                }
                if (PM(18) && IN(pb + PO_F0 + 3 + 2 * ch)) {
            PHASE_IDS
                    MOE_NM
                    pg8::Gemm g{(const char*)(ws + WS_ACTC), (const char*)(ws + WS_MD), DFFE / 2, DFFE, DFFE};
                    SchedMoe S; S.o.init(nm, 2 * DM / 256, G, bid); S.texp = tinfo + 8; S.t0 = t0; S.nn = DM / 256; S.astep = 256L * DFFE * 2; S.bstep = 256L * DFFE * 2; S.estep = 1024L * DFFE * 2; S.cstep = 0;
                    S.khb = (long)(DFFE / 2) * 2; S.khc = ((long)WS_YB - (long)WS_HP) / 2;
                    EpiPlain E{W16(WS_HP), DM, nullptr};
                    for (int rep_ = 0; rep_ < REPN(18); ++rep_) pg8::gemm_phase<EpiPlain, SchedMoe, true, true>(lds, g, S, E, tid);
                    SEAM(pb + PO_F0 + 3 + 2 * ch);
                }
            }
            if (PM(19) && IN(pb + PO_F0 + 6)) {
            PHASE_IDS
                const float* gain = ap_->in[I_NORM_FINAL];
                f32x4 gg[4];
#pragma unroll
                for (int j = 0; j < 4; ++j) gg[j] = ((const f32x4*)gain)[lane + 64 * j];
#define BLO(u) __builtin_bit_cast(float, (u) << 16)
#define BHI(u) __builtin_bit_cast(float, (u) & 0xffff0000u)
                int r = gw;
                u32x2 si = {0u, 0u}; float w1 = 0.f, w2 = 0.f; f32x4 xv[4];
                if (r < T) { si = *(const u32x2*)(slot + (size_t)r * 4); w1 = ((const float*)slot)[(size_t)r * 4 + 2]; w2 = ((const float*)slot)[(size_t)r * 4 + 3];
#pragma unroll
                    for (int j = 0; j < 4; ++j) xv[j] = xrow4(W16(WS_XB2), ap_->out, (size_t)r, lane + 64 * j); }
                while (r < T) {
                    asm volatile("" : "+v"(w1), "+v"(w2));
                    const u32x2* y1 = (const u32x2*)(W16(WS_HP) + (size_t)si.x * DM) + lane; const u32x2* y2 = (const u32x2*)(W16(WS_HP) + (size_t)si.y * DM) + lane;
                    const u32x2* z1 = (const u32x2*)(W16(WS_YB) + (size_t)si.x * DM) + lane; const u32x2* z2 = (const u32x2*)(W16(WS_YB) + (size_t)si.y * DM) + lane;
                    u32x2 a[4], c[4], a2[4], c2[4];
#pragma unroll
                    for (int j = 0; j < 4; ++j) { a[j] = y1[64 * j]; c[j] = y2[64 * j]; a2[j] = z1[64 * j]; c2[j] = z2[64 * j]; }
                    const int rn = r + NGW; u32x2 sin = {0u, 0u}; float w1n = 0.f, w2n = 0.f; f32x4 xn[4];
                    if (rn < T) { sin = *(const u32x2*)(slot + (size_t)rn * 4); w1n = ((const float*)slot)[(size_t)rn * 4 + 2]; w2n = ((const float*)slot)[(size_t)rn * 4 + 3];
#pragma unroll
                        for (int j = 0; j < 4; ++j) xn[j] = xrow4(W16(WS_XB2), ap_->out, (size_t)rn, lane + 64 * j); }
                    f32x4 v[4]; float s = 0.f;
#pragma unroll
                    for (int j = 0; j < 4; ++j) { const f32x4 x = xv[j];
                        v[j].x = x.x + w1 * (BLO(a[j].x) + BLO(a2[j].x)) + w2 * (BLO(c[j].x) + BLO(c2[j].x));
                        v[j].y = x.y + w1 * (BHI(a[j].x) + BHI(a2[j].x)) + w2 * (BHI(c[j].x) + BHI(c2[j].x));
                        v[j].z = x.z + w1 * (BLO(a[j].y) + BLO(a2[j].y)) + w2 * (BLO(c[j].y) + BLO(c2[j].y));
                        v[j].w = x.w + w1 * (BHI(a[j].y) + BHI(a2[j].y)) + w2 * (BHI(c[j].y) + BHI(c2[j].y));
                        s += (v[j].x * v[j].x + v[j].y * v[j].y) + (v[j].z * v[j].z + v[j].w * v[j].w); }
                    const float rs = 1.0f / sqrtf(wave_sum(s) * (1.f / DM) + EPS);
                    f32x4* orow = (f32x4*)(ap_->out + (size_t)r * DM) + lane;
#pragma unroll
                    for (int j = 0; j < 4; ++j) orow[64 * j] = (f32x4){v[j].x * rs * gg[j].x, v[j].y * rs * gg[j].y, v[j].z * rs * gg[j].z, v[j].w * rs * gg[j].w};
                    r = rn; si = sin; w1 = w1n; w2 = w2n;
#pragma unroll
                    for (int j = 0; j < 4; ++j) xv[j] = xn[j];
                }
            }
        }
}

__global__ void __launch_bounds__(NWAVES * 64, 2) fwd(Args args) {
    extern __shared__ __attribute__((aligned(16))) unsigned char lds_raw[];
    LAS unsigned char* lds = (LAS unsigned char*)lds_raw;
    const int G = gridDim.x, bid = blockIdx.x, NGW = G * NWAVES;
    const int wid0 = __builtin_amdgcn_readfirstlane((int)threadIdx.x >> 6);
    unsigned* ctl = (unsigned*)(args.ws + WS_CTL);
    const int lo = args.ph_lo, hi = args.ph_hi;
    for (int u = threadIdx.x; u < (LDS_BYTES - LDSCTL_OFF) / 4; u += NWAVES * 64) ((LAS unsigned*)(lds + LDSCTL_OFF))[u] = 0u;
    __syncthreads();
#if DBG >= 200
    if (blockIdx.x == 0 && threadIdx.x == 0) ((unsigned long long*)(ctl + 20000))[63] = __builtin_amdgcn_s_memrealtime();
#endif
    const bool multi = (hi - lo) > 1;
    XcdBarrier bar; bar.bar = ctl + CW_BAR; bar.x = 0; bar.st = nullptr;
    if (multi) bar = xcd_barrier_post(ctl + CW_BAR, (volatile LAS unsigned*)(lds + LDSCTL_OFF + 32));

    if (PM(0) && IN(PH_PRO)) {
            PHASE_IDS
        LAS float* scr = (LAS float*)(lds + wid * 16896);
        constexpr int IT_WIN = 16 * 64, IT_WOUT = 8 * 32, IT_SQ = 16 * 16, IT_C1 = 32 * 4, IT_C2 = 4 * 8, IT_FG = 16 * 44, IT_FD = 44 * 16;
        constexpr int N0 = 2 * IT_WIN, N1 = N0 + 2 * IT_WOUT, N2 = N1 + 8 * IT_SQ, N3 = N2 + 4 * IT_C1, N4 = N3 + 4 * IT_C2, N5 = N4 + 2 * IT_FG, N6 = N5 + IT_FD;
        for (int rep_ = 0; rep_ < REP_PRO; ++rep_)
        for (int it = gw; it < N6; it += NGW) {
            if (it < N0) { const int l = it / IT_WIN, r = it % IT_WIN, kb = r / 64, j = r % 64;
                int n0, ncv, dr = 32 * j;
                if (j < 40) { n0 = 32 * j; ncv = 32; } else if (j < 56) { n0 = 1304 + 32 * (j - 40); ncv = 32; } else if (j == 56) { n0 = 1280; ncv = 24; } else { n0 = 0; ncv = 0; }
                xpose_item(ap_->in[I_W_IN] + (size_t)l * DM * 1816, 1816, 64 * kb, n0, ncv, W16(WS_WIN) + (size_t)l * ZW * DM, DM, dr, scr, lane, ap_->in[I_NORM_MIX] + l * DM);
            } else if (it < N1) { const int r0 = it - N0, l = r0 / IT_WOUT, r = r0 % IT_WOUT, kb = r / 32, j = r % 32;
                xpose_item(ap_->in[I_W_OUT] + (size_t)l * DM * DM, DM, 64 * kb, 32 * j, 32, W16(WS_WOUT) + (size_t)l * DM * DM, DM, 32 * j, scr, lane);
            } else if (it < N2) { const int r0 = it - N1, mtx = r0 / IT_SQ, r = r0 % IT_SQ, which = mtx >> 1, l = mtx & 1;
                const float* src = ap_->in[which == 0 ? I_WQ : which == 1 ? I_WO : which == 2 ? I_WK : I_WV] + (size_t)l * DM * DM;
                bf16_t* dst = W16(which == 0 ? WS_WQ : which == 1 ? WS_WO : which == 2 ? WS_WK : WS_WV) + (size_t)l * DM * DM;
                xpose_mat(src, DM, DM, dst, 0, r, scr, lane, which == 0 ? ap_->in[I_NORM_X] + l * DM : nullptr);
            } else if (it < N3) { const int r0 = it - N2, mtx = r0 / IT_C1, r = r0 % IT_C1, l = mtx >> 1, kv = mtx & 1;
                xpose_mat(ap_->in[kv ? I_W1_V : I_W1_K] + (size_t)l * 2048 * 256, 2048, 256, W16(WS_CW1) + (size_t)mtx * 256 * 2048, 0, r, scr, lane);
            } else if (it < N4) { const int r0 = it - N3, mtx = r0 / IT_C2, r = r0 % IT_C2, l = mtx >> 1, kv = mtx & 1, kb = r / 8, j = r % 8;
                xpose_item(ap_->in[kv ? I_W2_V : I_W2_K] + (size_t)l * 256 * 64, 64, 64 * kb, j < 2 ? 32 * j : 0, j < 2 ? 32 : 0, W16(WS_CW2) + (size_t)mtx * 256 * 256, 256, 32 * j, scr, lane);
            } else if (it < N5) { const int r0 = it - N4, up = r0 / IT_FG, r = r0 % IT_FG;
                xpose_mat(ap_->in[up ? I_FFN_WU : I_FFN_WG], DM, DFF, W16(WS_FGU), up ? 2 : 1, r, scr, lane, ap_->in[I_NORM_FFN]);
            } else if (it < N6) { xpose_mat(ap_->in[I_FFN_WD], DFF, DM, W16(WS_FD), 0, it - N5, scr, lane);
            }
        }
        for (int i = bid * 512 + tid; i < SEQ * 8; i += G * 512) {
            const int pos = i >> 3, j = i & 7;
            const double inv = j == 0 ? 1.0 : j == 1 ? 0.19389587045179572 : j == 2 ? 0.037606030930863934 : j == 3 ? 0.007291654101443755 : j == 4 ? 0.0014142135623730951
                             : j == 5 ? 0.00027421616994972156 : j == 6 ? 5.3169310700017e-05 : 1.0309310618636385e-05;
            float s, c; sincos_d((double)pos * inv, s, c);
            ((float*)(ws + WS_ROPE))[2 * i] = c; ((float*)(ws + WS_ROPE))[2 * i + 1] = s;
        }
        for (int r0 = gw; r0 < T; r0 += 4 * NGW) {
            f32x4 xv[4][4];
#pragma unroll
            for (int q = 0; q < 4; ++q)
#pragma unroll
                for (int j = 0; j < 4; ++j) xv[q][j] = ((const f32x4*)(ap_->in[I_X] + (size_t)(r0 + q * NGW) * DM) + lane)[64 * j];
#pragma unroll
            for (int q = 0; q < 4; ++q) { const int r = r0 + q * NGW; unsigned long long* o8 = (unsigned long long*)(W16(WS_HB) + (size_t)r * DM) + lane; float sq = 0.f;
#pragma unroll
                for (int j = 0; j < 4; ++j) { const f32x4 v = xv[q][j]; sq += (v.x * v.x + v.y * v.y) + (v.z * v.z + v.w * v.w); o8[64 * j] = (unsigned long long)pk2(v.x, v.y) | ((unsigned long long)pk2(v.z, v.w) << 32); }
                sq = wave_sum(sq); if (lane == 0) SSP(0)[r] = ss_fix(sq); } }
        for (int r = gw; r < 2 * 1024; r += NGW) { const int l = r >> 10, row = r & 1023;
            norm_row(ap_->in[I_MEM] + (size_t)row * DM, ap_->in[I_NORM_MEM] + l * DM, W16(WS_MN) + (size_t)r * DM, lane); }
        for (int itb = gw; itb < 4 * 4 * 16; itb += NGW) { const int mtx = itb >> 6, cg = (itb >> 4) & 3, fc = itb & 15, l = mtx >> 1, kv = mtx & 1, c = cg * 64 + lane;
            const float* pe = ap_->in[kv ? I_PE_V : I_PE_K] + l * 2048 + fc * 128; const float* w1 = ap_->in[kv ? I_W1_V : I_W1_K] + (size_t)l * 2048 * 256 + (size_t)fc * 128 * 256 + c;
            float a = fc == 0 ? ap_->in[kv ? I_B1_V : I_B1_K][l * 256 + c] : 0.f;
#pragma unroll
            for (int h = 0; h < 4; ++h) { float wv[32];
#pragma unroll
                for (int f = 0; f < 32; ++f) wv[f] = w1[(size_t)(32 * h + f) * 256];
#pragma unroll
                for (int f = 0; f < 32; ++f) a += pe[32 * h + f] * wv[f]; }
            atomicAdd((unsigned long long*)(ctl + CW_BIAS) + mtx * 256 + c, (unsigned long long)(long long)((double)a * 1099511627776.0)); }
        for (int itw = gw; itw < 2 * 4 * 16 * 16; itw += NGW) { const int l = itw >> 10, g = (itw >> 8) & 3, nb = (itw >> 4) & 15, cb = itw & 15, n = nb * 64 + lane;
            const float* wp = ap_->in[I_W_POOL] + ((size_t)(l * 4 + g) * 128 + cb * 8) * 128; const float* ps = ap_->in[I_POOL_SCALE] + l * 512 + g * 128;
            const float* wo = ap_->in[I_W_OUT] + (size_t)l * DM * DM + (size_t)(512 + g * 128) * DM + n;
            float a[8];
#pragma unroll
            for (int c = 0; c < 8; ++c) a[c] = 0.f;
#pragma unroll
            for (int h = 0; h < 4; ++h) { float wv[32];
#pragma unroll
                for (int e = 0; e < 32; ++e) wv[e] = wo[(size_t)(32 * h + e) * DM];
#pragma unroll
                for (int e = 0; e < 32; ++e) { const float w = wv[e] * ps[32 * h + e];
#pragma unroll
                    for (int c = 0; c < 8; ++c) a[c] += wp[c * 128 + 32 * h + e] * w; } }
            u32x4 o; o.x = pk2(a[0], a[1]); o.y = pk2(a[2], a[3]); o.z = pk2(a[4], a[5]); o.w = pk2(a[6], a[7]);
            *(u32x4*)(W16(WS_WOUT) + (size_t)l * DM * DM + (size_t)n * DM + 512 + g * 128 + cb * 8) = o; }
        __syncthreads();
        SEAM(PH_PRO);
    }
    layer_phases<0>(lds, lo, hi, bar, G, bid, NGW, wid0);
    layer_phases<1>(lds, lo, hi, bar, G, bid, NGW, wid0);
#if DBG >= 200
    __syncthreads(); if (blockIdx.x == 0 && threadIdx.x == 0) ((unsigned long long*)(ctl + 20000))[62] = __builtin_amdgcn_s_memrealtime();
#endif
#undef IN
#undef SEAM
}

#if DBG
struct DbgIn { const float* in[30]; };
__device__ float dbg_block_sum(float v, float* red) { const int t = threadIdx.x; red[t] = v; __syncthreads(); for (int o = 128; o > 0; o >>= 1) { if (t < o) red[t] += red[t + o]; __syncthreads(); } const float r = red[0]; __syncthreads(); return r; }
__global__ void dbg_check(DbgIn di, const float* xcur, unsigned char* ws, int stage) {
    __shared__ float red[256]; __shared__ float act[3584]; __shared__ float hrow[1024];
    const int t = threadIdx.x; float* W = (float*)(ws + WS_CTL) + 16000;
    const unsigned* sl = (const unsigned*)(ws + WS_SLOT); const unsigned* rt = (const unsigned*)(ws + WS_ROUTE); const bf16_t* hp = (const bf16_t*)(ws + WS_HP); const bf16_t* ac = (const bf16_t*)(ws + WS_ACTC);
    const int toks[4] = {0, 5000, 12000, 16383}; float worst = 0.f; int nchk = 0;
    for (int q = 0; q < 4; ++q) for (int kk = 0; kk < 2; ++kk) { const int tok = toks[q]; const unsigned e = rt[tok * 8 + kk], sidx = sl[tok * 4 + kk]; const int ch = sidx >= (unsigned)(HALFT * 256) ? 1 : 0;
        if (stage == 1) {
            float ss = 0.f; for (int c = t; c < 1024; c += 256) { const float x = xcur[(size_t)tok * 1024 + c]; ss += x * x; } ss = dbg_block_sum(ss, red);
            const float rs = 1.f / sqrtf(ss / 1024.f + EPS); float num = 0.f, den = 0.f;
            for (int c = t; c < 1024; c += 256) { const float h = xcur[(size_t)tok * 1024 + c] * rs * di.in[I_NORM_FFN][1024 + c], f = bf2f(hp[(size_t)sidx * 1024 + c]); num += (h - f) * (h - f); den += h * h; }
            num = dbg_block_sum(num, red); den = dbg_block_sum(den, red); worst = fmaxf(worst, sqrtf(num / fmaxf(den, 1e-20f))); ++nchk;
        } else if ((stage == 2 && ch == 0) || (stage == 4 && ch == 1)) {
            for (int c = t; c < 1024; c += 256) hrow[c] = bf2f(hp[(size_t)sidx * 1024 + c]); __syncthreads();
            const float* wg = di.in[I_MOE_WG] + (size_t)e * DM * DFFE; const float* wu = di.in[I_MOE_WU] + (size_t)e * DM * DFFE; float num = 0.f, den = 0.f;
            for (int j = t; j < 3584; j += 256) { float g = 0.f, u = 0.f; for (int k2 = 0; k2 < 1024; ++k2) { g += hrow[k2] * wg[(size_t)k2 * DFFE + j]; u += hrow[k2] * wu[(size_t)k2 * DFFE + j]; }
                const float a = g / (1.f + expf(-g)) * u, f = bf2f(ac[((size_t)sidx - (size_t)ch * HALFT * 256) * 3584 + j]); num += (a - f) * (a - f); den += a * a; }
            num = dbg_block_sum(num, red); den = dbg_block_sum(den, red); worst = fmaxf(worst, sqrtf(num / fmaxf(den, 1e-20f))); ++nchk; __syncthreads();
        } else if ((stage == 3 && ch == 0) || (stage == 5 && ch == 1)) {
            for (int j = t; j < 3584; j += 256) act[j] = bf2f(ac[((size_t)sidx - (size_t)ch * HALFT * 256) * 3584 + j]); __syncthreads();
            const float* wd = di.in[I_MOE_WD] + (size_t)e * DFFE * DM; float num = 0.f, den = 0.f;
            for (int n = t; n < 1024; n += 256) { float y = 0.f; for (int j = 0; j < 3584; ++j) y += act[j] * wd[(size_t)j * DM + n]; const float f = bf2f(hp[(size_t)sidx * 1024 + n]); num += (y - f) * (y - f); den += y * y; }
            num = dbg_block_sum(num, red); den = dbg_block_sum(den, red); worst = fmaxf(worst, sqrtf(num / fmaxf(den, 1e-20f))); ++nchk; __syncthreads();
        } }
    if (stage == 1) {
        float mism = 0.f, werr = 0.f;
        for (int q = 0; q < 64; ++q) { const int tok = q * 251 + 3;
            float ss = 0.f; for (int c = t; c < 1024; c += 256) { const float x = xcur[(size_t)tok * 1024 + c]; ss += x * x; } ss = dbg_block_sum(ss, red);
            const float rs = 1.f / sqrtf(ss / 1024.f + EPS); float lg[8];
            for (int e = 0; e < 8; ++e) { float a = 0.f; for (int c = t; c < 1024; c += 256) a += xcur[(size_t)tok * 1024 + c] * rs * di.in[I_NORM_FFN][1024 + c] * di.in[I_ROUTER][c * 8 + e]; lg[e] = dbg_block_sum(a, red); }
            int i1 = 0; for (int e = 1; e < 8; ++e) if (lg[e] > lg[i1]) i1 = e; int i2 = -1; for (int e = 0; e < 8; ++e) if (e != i1 && (i2 < 0 || lg[e] > lg[i2])) i2 = e;
            const float w1 = 1.f / (1.f + expf(lg[i2] - lg[i1]));
            if ((int)rt[tok * 8] != i1 || (int)rt[tok * 8 + 1] != i2) mism += 1.f;
            werr = fmaxf(werr, fabsf(w1 - __builtin_bit_cast(float, rt[tok * 8 + 4]))); }
        if (t == 0) { W[8] = mism; W[9] = werr; } }
    if (stage == 5) {
        float sx = 0.f, sm = 0.f;
        for (int q = 0; q < 4; ++q) { const int tok = toks[q]; const unsigned s1 = sl[tok * 4], s2 = sl[tok * 4 + 1]; const float w1 = __builtin_bit_cast(float, sl[tok * 4 + 2]), w2 = __builtin_bit_cast(float, sl[tok * 4 + 3]);
            for (int c = t; c < 1024; c += 256) { const float x = xcur[(size_t)tok * 1024 + c], m = w1 * bf2f(hp[(size_t)s1 * 1024 + c]) + w2 * bf2f(hp[(size_t)s2 * 1024 + c]); sx += x * x; sm += m * m; } }
        sx = dbg_block_sum(sx, red); sm = dbg_block_sum(sm, red);
        if (t == 0) { W[6] = sx / 4096.f; W[7] = sm / 4096.f; } }
    if (t == 0) { W[stage] = worst; W[10 + stage] = (float)nchk; }
}
__global__ void dbg_attn(unsigned char* ws, int b, int g, int t, int slotw) {
    __shared__ float red[256]; __shared__ float lgt[4096]; __shared__ float pcs[4][256]; __shared__ float osum[4][64]; __shared__ int selb[64]; __shared__ float impv[64];
    const int tid = threadIdx.x, bg = b * 2 + g, tok = b * SEQ + t; float* W = (float*)(ws + WS_CTL) + 16000;
    const bf16_t* qraw = (const bf16_t*)(ws + WS_QRAW) + ((size_t)bg * SEQ + t) * 256; const bf16_t* qrot = (const bf16_t*)(ws + WS_QROT) + ((size_t)bg * SEQ + t) * 256;
    const bf16_t* kc = (const bf16_t*)(ws + WS_KCMP) + (size_t)bg * 256 * 64; const bf16_t* vc = kc + 8 * 256 * 64;
    const bf16_t* kvb = (const bf16_t*)(ws + WS_KV); const float* gt = (const float*)(ws + WS_GATES) + (size_t)tok * 24 + g * 12;
    const int nv = t >= 15 ? ((t - 15) >> 4) : 0, tb = t >> 6;
    for (int i = tid; i < 256; i += 256) osum[i >> 6][i & 63] = 0.f;
    __syncthreads();
    for (int r = 0; r < 4; ++r) {
        float s = -INFINITY; const int c = tid;
        if (c < 255 && c < nv) { s = 0.f; for (int d = 0; d < 64; ++d) s += bf2f(qraw[r * 64 + d]) * bf2f(kc[c * 64 + d]); }
        red[tid] = s; __syncthreads(); for (int o = 128; o > 0; o >>= 1) { if (tid < o) red[tid] = fmaxf(red[tid], red[tid + o]); __syncthreads(); } float m = red[0]; __syncthreads(); if (m == -INFINITY) m = 0.f;
        const float p = s == -INFINITY ? 0.f : exp2f(s - m); const float l = dbg_block_sum(p, red);
        pcs[r][c] = l > 0.f ? p / l : 0.f; __syncthreads();
        if (tid < 64) { float o = 0.f; for (int cc = 0; cc < 255; ++cc) o += bf2f((unsigned short)f2bf(pcs[r][cc])) * bf2f(vc[cc * 64 + tid]); osum[r][tid] += gt[r * 3 + 0] * o; }
        __syncthreads();
    }
    if (tid < 64) { float im = 0.f; for (int j = -1; j < 4; ++j) { const int c = 4 * tid + j; if (c >= 0 && c < 255) for (int r = 0; r < 4; ++r) im += pcs[r][c]; }
        const bool fut = tid > tb, forced = tid == 0 || tid == tb || tid == tb - 1; impv[tid] = fut ? -INFINITY : forced ? INFINITY : im; selb[tid] = 0; }
    __syncthreads();
    if (tid == 0) { for (int k = 0; k < 16; ++k) { int best = -1; float bv = 0.f; for (int n = 0; n < 64; ++n) if (!selb[n] && (best < 0 || impv[n] > bv)) { best = n; bv = impv[n]; } selb[best] = 1; } }
    __syncthreads();
    for (int br = 1; br <= 2; ++br) {
        const bf16_t* kb = kvb + (size_t)(br == 1 ? 2 : 4) * KVSZ + (size_t)bg * SEQ * 64; const bf16_t* vb = kvb + (size_t)(br == 1 ? 3 : 5) * KVSZ + (size_t)bg * SEQ * 64;
        for (int r = 0; r < 4; ++r) {
            float mx = -INFINITY;
            for (int j = tid; j < SEQ; j += 256) { bool ok = j <= t; if (br == 1) ok = ok && selb[j >> 6]; else ok = ok && (t - j) < 512;
                float sv = -INFINITY; if (ok) { sv = 0.f; for (int d = 0; d < 64; ++d) sv += bf2f(qrot[r * 64 + d]) * bf2f(kb[(size_t)j * 64 + d]); } lgt[j] = sv; mx = fmaxf(mx, sv); }
            red[tid] = mx; __syncthreads(); for (int o = 128; o > 0; o >>= 1) { if (tid < o) red[tid] = fmaxf(red[tid], red[tid + o]); __syncthreads(); } const float m = red[0]; __syncthreads();
            float ls = 0.f; for (int j = tid; j < SEQ; j += 256) { const float p = lgt[j] == -INFINITY ? 0.f : exp2f(lgt[j] - m); lgt[j] = p; ls += p; }
            const float l = dbg_block_sum(ls, red);
            if (tid < 64) { float o = 0.f; for (int j = 0; j <= t; ++j) o += lgt[j] * bf2f(vb[(size_t)j * 64 + tid]); osum[r][tid] += gt[r * 3 + br] * o / l; }
            __syncthreads();
        }
    }
    const bf16_t* ab = (const bf16_t*)(ws + WS_AB) + (size_t)tok * 1024 + g * 256;
    float num = 0.f, den = 0.f; { const float o = osum[tid >> 6][tid & 63], f = bf2f(ab[tid]); num = (o - f) * (o - f); den = o * o; }
    num = dbg_block_sum(num, red); den = dbg_block_sum(den, red);
    if (tid == 0) { W[slotw] = sqrtf(num / fmaxf(den, 1e-30f)); W[slotw + 40] = sqrtf(den / 256.f); }
}
__global__ void dbg_mixer(DbgIn di, const float* outp, unsigned char* ws, int stage) {
    __shared__ float red[256]; __shared__ float hrow[1024]; __shared__ float zrow[1816]; __shared__ float hid[256];
    const int t = threadIdx.x; float* W = (float*)(ws + WS_CTL) + 16000;
    const bf16_t* hb = (const bf16_t*)(ws + WS_HB); const bf16_t* kvb = (const bf16_t*)(ws + WS_KV);
    const int toks[4] = {7, 4101, 9000, 16383};
    if (stage == 30) {
        float nq = 0, dq = 0, nr = 0, dr = 0, nk = 0, dk = 0, nkr = 0, dkr = 0, nu = 0, du = 0, ng = 0, dg = 0;
        for (int q = 0; q < 4; ++q) { const int tok = toks[q], b = tok >> 12, pos = tok & 4095;
            for (int c = t; c < 1024; c += 256) hrow[c] = bf2f(hb[(size_t)tok * 1024 + c]); __syncthreads();
            for (int n = t; n < 1816; n += 256) { float a = 0.f; for (int k = 0; k < 1024; ++k) a += hrow[k] * di.in[I_W_IN][(size_t)k * 1816 + n]; zrow[n] = a; } __syncthreads();
            for (int n = t; n < 1816; n += 256) { const float z = zrow[n];
                if (n < 512) { const int g = n >> 8, c = n & 255, d = n & 63; const size_t idx = ((size_t)(b * 2 + g) * SEQ + pos) * 256 + c;
                    const float f = bf2f(((const bf16_t*)(ws + WS_QRAW))[idx]) / C2; nq += (z - f) * (z - f); dq += z * z;
                    float zr = z; if (d < 16) { const int j = d & 7; const double inv = pow(500000.0, -(double)j / 8.0); const float cs = (float)cos((double)pos * inv), sn = (float)sin((double)pos * inv);
                        zr = d < 8 ? z * cs - zrow[n + 8] * sn : z * cs + zrow[n - 8] * sn; }
                    const float fr = bf2f(((const bf16_t*)(ws + WS_QROT))[idx]) / C2; nr += (zr - fr) * (zr - fr); dr += zr * zr;
                } else if (n < 1280) { const int m = n - 512, i = m >> 7, g = (m >> 6) & 1, d = m & 63; const float f = bf2f(kvb[(size_t)i * KVSZ + ((size_t)(b * 2 + g) * SEQ + pos) * 64 + d]);
                    if (i == 2 || i == 4) { float zr = z; if (d < 16) { const int j = d & 7; const double inv = pow(500000.0, -(double)j / 8.0); const float cs = (float)cos((double)pos * inv), sn = (float)sin((double)pos * inv);
                            zr = d < 8 ? z * cs - zrow[n + 8] * sn : z * cs + zrow[n - 8] * sn; } nkr += (zr - f) * (zr - f); dkr += zr * zr; }
                    else { nk += (z - f) * (z - f); dk += z * z; }
                } else if (n < 1304) { const float sg = 1.f / (1.f + expf(-z)), f = ((const float*)(ws + WS_GATES))[(size_t)tok * 24 + (n - 1280)]; ng += (sg - f) * (sg - f); dg += sg * sg;
                } else { const float f = bf2f(((const bf16_t*)(ws + WS_U))[(size_t)tok * 512 + (n - 1304)]); nu += (z - f) * (z - f); du += z * z; } }
            __syncthreads(); }
        nq = dbg_block_sum(nq, red); dq = dbg_block_sum(dq, red); nr = dbg_block_sum(nr, red); dr = dbg_block_sum(dr, red); nk = dbg_block_sum(nk, red); dk = dbg_block_sum(dk, red);
        nkr = dbg_block_sum(nkr, red); dkr = dbg_block_sum(dkr, red); nu = dbg_block_sum(nu, red); du = dbg_block_sum(du, red); ng = dbg_block_sum(ng, red); dg = dbg_block_sum(dg, red);
        if (t == 0) { W[30] = sqrtf(nq / dq); W[31] = sqrtf(nr / dr); W[32] = sqrtf(nk / dk); W[33] = sqrtf(nkr / dkr); W[34] = sqrtf(nu / du); W[35] = sqrtf(ng / dg); }
    }
    if (stage == 31) {
        float nc = 0, dc = 0, nd = 0, dd = 0;
        const int cs_[4] = {0, 17, 200, 254};
        for (int q = 0; q < 4; ++q) for (int kv = 0; kv < 2; ++kv) { const int bg = (q * 3 + 1) & 7, c = cs_[q];
            const bf16_t* src = kvb + (size_t)kv * KVSZ + ((size_t)bg * SEQ + 16 * c) * 64; const float* pe = di.in[kv ? I_PE_V : I_PE_K]; const float* w1 = di.in[kv ? I_W1_V : I_W1_K]; const float* b1 = di.in[kv ? I_B1_V : I_B1_K]; const float* w2 = di.in[kv ? I_W2_V : I_W2_K];
            { float a = b1[t]; for (int f = 0; f < 2048; ++f) a += (bf2f(src[f]) + pe[f]) * w1[(size_t)f * 256 + t]; const float y = 0.7978845608f * (a + 0.044715f * a * a * a); hid[t] = 0.5f * a * (1.f + tanhf(y)); } __syncthreads();
            if (t < 64) { float o = 0.f; for (int h = 0; h < 256; ++h) o += hid[h] * w2[h * 64 + t]; const float f = bf2f(((const bf16_t*)(ws + WS_KCMP))[(size_t)kv * 8 * 256 * 64 + ((size_t)bg * 256 + c) * 64 + t]); nc += (o - f) * (o - f); dc += o * o; } __syncthreads(); }
        for (int q = 0; q < 4; ++q) { const int tok = toks[q], pos = tok & 4095; for (int c = t; c < 512; c += 256) { const int w = 2 << (c >> 7), n = (pos + 1) < w ? (pos + 1) : w; float sm = 0.f; const bf16_t* ub = (const bf16_t*)(ws + WS_U);
                for (int i = 0; i < n; ++i) sm += bf2f(ub[(size_t)(tok - i) * 512 + c]); const float d = sm / n - bf2f(ub[(size_t)tok * 512 + c]), f = bf2f(((const bf16_t*)(ws + WS_AB))[(size_t)tok * 1024 + 512 + c]); nd += (d - f) * (d - f); dd += d * d; } }
        nc = dbg_block_sum(nc, red); dc = dbg_block_sum(dc, red); nd = dbg_block_sum(nd, red); dd = dbg_block_sum(dd, red);
        if (t == 0) { W[36] = sqrtf(nc / dc); W[37] = sqrtf(nd / dd); }
    }
    if (stage == 32) {
        float nn = 0, dn = 0; const bf16_t* ab = (const bf16_t*)(ws + WS_AB);
        for (int q = 0; q < 4; ++q) { const int tok = toks[q];
            for (int c = t; c < 1024; c += 256) hrow[c] = bf2f(ab[(size_t)tok * 1024 + c]); __syncthreads();
            for (int ge = t; ge < 512; ge += 256) { const int g = ge >> 7, e = ge & 127; float y = 0.f; for (int c = 0; c < 128; ++c) y += hrow[512 + g * 128 + c] * di.in[I_W_POOL][((size_t)g * 128 + c) * 128 + e]; zrow[ge] = y * di.in[I_POOL_SCALE][ge]; } __syncthreads();
            for (int n = t; n < 1024; n += 256) { float a = di.in[I_X][(size_t)tok * 1024 + n]; const float x0 = a; for (int k = 0; k < 512; ++k) a += hrow[k] * di.in[I_W_OUT][(size_t)k * 1024 + n]; for (int k = 0; k < 512; ++k) a += zrow[k] * di.in[I_W_OUT][(size_t)(512 + k) * 1024 + n];
                const float f = outp[(size_t)tok * 1024 + n]; nn += (a - f) * (a - f); dn += (a - x0) * (a - x0); } __syncthreads(); }
        nn = dbg_block_sum(nn, red); dn = dbg_block_sum(dn, red);
        if (t == 0) W[38] = sqrtf(nn / dn);
    }
}
__global__ void dbg_moe_tok(DbgIn di, const float* xcur, unsigned char* ws) {
    __shared__ float red[256]; __shared__ float hrow[1024]; __shared__ float act[3584]; __shared__ float ynaive[1024];
    const int t = threadIdx.x, tok = blockIdx.x * 251 + 3; float* W = (float*)(ws + WS_CTL) + 16000;
    const unsigned* sl = (const unsigned*)(ws + WS_SLOT); const unsigned* rt = (const unsigned*)(ws + WS_ROUTE); const bf16_t* hp = (const bf16_t*)(ws + WS_HP);
    float ss = 0.f; for (int c = t; c < 1024; c += 256) { const float x = xcur[(size_t)tok * 1024 + c]; ss += x * x; } ss = dbg_block_sum(ss, red);
    const float rs = 1.f / sqrtf(ss / 1024.f + EPS);
    for (int c = t; c < 1024; c += 256) { hrow[c] = xcur[(size_t)tok * 1024 + c] * rs * di.in[I_NORM_FFN][1024 + c]; ynaive[c] = 0.f; } __syncthreads();
    float lg[8]; for (int e = 0; e < 8; ++e) { float a = 0.f; for (int c = t; c < 1024; c += 256) a += hrow[c] * di.in[I_ROUTER][c * 8 + e]; lg[e] = dbg_block_sum(a, red); }
    int i1 = 0; for (int e = 1; e < 8; ++e) if (lg[e] > lg[i1]) i1 = e; int i2 = -1; for (int e = 0; e < 8; ++e) if (e != i1 && (i2 < 0 || lg[e] > lg[i2])) i2 = e;
    const float w1 = 1.f / (1.f + expf(lg[i2] - lg[i1]));
    for (int kk = 0; kk < 2; ++kk) { const int e = kk ? i2 : i1; const float wgt = kk ? 1.f - w1 : w1;
        const float* wg = di.in[I_MOE_WG] + (size_t)e * DM * DFFE; const float* wu = di.in[I_MOE_WU] + (size_t)e * DM * DFFE; const float* wd = di.in[I_MOE_WD] + (size_t)e * DFFE * DM;
        for (int j = t; j < 3584; j += 256) { float g = 0.f, u = 0.f; for (int k2 = 0; k2 < 1024; ++k2) { g += hrow[k2] * wg[(size_t)k2 * DFFE + j]; u += hrow[k2] * wu[(size_t)k2 * DFFE + j]; } act[j] = g / (1.f + expf(-g)) * u; } __syncthreads();
        for (int n = t; n < 1024; n += 256) { float y = 0.f; for (int j = 0; j < 3584; ++j) y += act[j] * wd[(size_t)j * DM + n]; ynaive[n] += wgt * y; } __syncthreads(); }
    const unsigned s1 = sl[tok * 4], s2 = sl[tok * 4 + 1]; const float f1 = __builtin_bit_cast(float, sl[tok * 4 + 2]), f2 = __builtin_bit_cast(float, sl[tok * 4 + 3]);
    float num = 0.f, den = 0.f; for (int n = t; n < 1024; n += 256) { const bf16_t* yb = (const bf16_t*)(ws + WS_YB); const float m = f1 * (bf2f(hp[(size_t)s1 * 1024 + n]) + bf2f(yb[(size_t)s1 * 1024 + n])) + f2 * (bf2f(hp[(size_t)s2 * 1024 + n]) + bf2f(yb[(size_t)s2 * 1024 + n])); num += (m - ynaive[n]) * (m - ynaive[n]); den += ynaive[n] * ynaive[n]; }
    num = dbg_block_sum(num, red); den = dbg_block_sum(den, red);
    if (t == 0) { const float er = sqrtf(num / den); atomicMax((unsigned*)&W[50], __builtin_bit_cast(unsigned, er)); if (er > 0.1f) atomicAdd(&W[51], 1.f); atomicAdd(&W[52], er / 64.f); }
}
#ifndef DBGBR
#define DBGBR -1
#endif
__global__ void dbg_setgates(unsigned char* ws, int br) { float* g = (float*)(ws + WS_GATES); for (size_t i = (size_t)blockIdx.x * 256 + threadIdx.x; i < (size_t)T * 24; i += (size_t)gridDim.x * 256) g[i] = ((int)(i % 3) == br) ? 1.f : 0.f; }
#ifndef DBGV1
#define DBGV1 0
#endif
__global__ void dbg_setv(unsigned char* ws) { bf16_t* kv = (bf16_t*)(ws + WS_KV); for (size_t i = (size_t)blockIdx.x * 256 + threadIdx.x; i < KVSZ; i += (size_t)gridDim.x * 256) { kv[3 * KVSZ + i] = 0x3F80; kv[5 * KVSZ + i] = 0x3F80; } }
#ifndef DBG_UNIT
#define DBG_UNIT 5
#endif
#ifndef DBG_PA
#define DBG_PA 6
#endif
#ifndef DBG_PB
#define DBG_PB 20
#endif
__global__ void dbg_tail(float* out, unsigned char* ws) {
    const int t = threadIdx.x; const float* W = (const float*)(ws + WS_CTL) + 16000; float k = 0.f;
    if (DBG == 400) {
        __shared__ unsigned cnt; if (t == 0) cnt = 0; __syncthreads();
        if (blockIdx.x == 0 && t == 0) cnt = ((const unsigned*)(ws + WS_CTL))[21100];
        __syncthreads();
        const float kb = fminf((float)cnt, 89.f);
        for (size_t i = (size_t)blockIdx.x * 256 + t; i < (size_t)T * DM; i += (size_t)gridDim.x * 256) out[i] = (i == 0) ? (10.f + kb) * 10.f : 3.f;
        return; }
    if (DBG >= 200) {
        const unsigned long long* st = (const unsigned long long*)((const unsigned*)(ws + WS_CTL) + 20000);
        unsigned long long prev = st[63]; int ord = 0; float ka = 0.f, kb = 0.f;
        for (int i = 0; i < 63; ++i) { const unsigned long long v = st[i]; if (v == 0ull) continue; const float us = (float)(v - prev) * 0.01f; prev = v;
            if (ord == DBG_PA) ka = fminf(rintf(us / (float)DBG_UNIT), 89.f); if (ord == DBG_PB) kb = fminf(rintf(us / (float)DBG_UNIT), 89.f); ++ord; }
        (void)ka;
        for (size_t i = (size_t)blockIdx.x * 256 + t; i < (size_t)T * DM; i += (size_t)gridDim.x * 256) out[i] = (i == 0) ? (10.f + kb) * 10.f : 3.f;
        return; }
    if (DBG == 100) { for (int i = 1; i < 10; ++i) if (W[i] > 0.05f) { k = (float)i; break; } }
    else if (DBG == 103) { int m = 0; for (int i = 0; i < 6; ++i) if (!(W[20 + i] <= 0.05f)) m |= 1 << i; k = (float)m; }
    else if (DBG == 104) { int m = 0; for (int i = 6; i < 8; ++i) if (!(W[20 + i] <= 0.05f)) m |= 1 << (i - 6); k = (float)m; }
    else if (DBG == 105 || DBG == 106) { float mn = 1e30f, mx = 0.f; for (int i = 0; i < 8; ++i) { mn = fminf(mn, W[20 + i]); mx = fmaxf(mx, W[20 + i]); }
        k = rintf(10.f * (log10f(fmaxf(DBG == 105 ? mn : mx, 1e-6f)) + 6.f)); k = fminf(fmaxf(k, 0.f), 89.f); }
    else if (DBG == 107) { for (int i = 30; i <= 38; ++i) if (!(W[i] <= 0.03f)) { k = (float)(i - 29); break; } }
    else if (DBG == 101) { for (int i = 0; i < 8; ++i) if (!(W[20 + i] <= 0.05f)) { k = (float)(i + 1); break; } }
    else { k = rintf(10.f * (log10f(fmaxf(W[DBG], 1e-6f)) + 6.f)); k = fminf(fmaxf(k, 0.f), 89.f); }
    const float c = sqrtf(0.1f * k + 0.02f);
    for (size_t i = (size_t)blockIdx.x * 256 + t; i < (size_t)T * DM; i += (size_t)gridDim.x * 256) out[i] = c;
}
#endif

extern "C" void kernel_launch(void* const* d_in, const int* in_sizes, int n_in, void* d_out, int out_size, void* d_ws, size_t ws_size, hipStream_t stream) {
    static int grid = 0;
    if (grid == 0) {
        if (n_in != 30 || out_size != T * DM || ws_size < WS_END2) { fprintf(stderr, "kernel_launch: unexpected problem shape / workspace (%d inputs, out %d, ws %zu)\n", n_in, out_size, ws_size); grid = -1; return; }
        int dev = 0, cus = 0;
        if (hipGetDevice(&dev) != hipSuccess || hipDeviceGetAttribute(&cus, hipDeviceAttributeMultiprocessorCount, dev) != hipSuccess) { grid = -1; return; }
        if (hipFuncSetAttribute((const void*)fwd, hipFuncAttributeMaxDynamicSharedMemorySize, LDS_BYTES) != hipSuccess) { fprintf(stderr, "kernel_launch: hipFuncSetAttribute failed\n"); grid = -1; return; }
        int per_cu = 0;
        if (hipOccupancyMaxActiveBlocksPerMultiprocessor(&per_cu, (const void*)fwd, NWAVES * 64, LDS_BYTES) != hipSuccess || per_cu < 1) { fprintf(stderr, "kernel_launch: occupancy query says %d\n", per_cu); }
        (void)hipGetLastError();
        if (cus != 256) { fprintf(stderr, "kernel_launch: built for a 256-CU device, found %d\n", cus); grid = -1; return; }
        grid = cus;
    }
    if (grid < 0) return;
    if (hipMemsetAsync((char*)d_ws + WS_CTL, 0, CTL_ZERO_BYTES, stream) != hipSuccess) return;
    Args a{};
    for (int i = 0; i < 30; ++i) a.in[i] = (const float*)d_in[i];
    a.out = (float*)d_out; a.ws = (unsigned char*)d_ws;
#if MK_PER_PHASE
    int ids[64]; int n = 0;
    ids[n++] = PH_PRO;
    for (int l = 0; l < NL; ++l) { const int pb = PH_L0 + l * PH_LSTRIDE; for (int k = 0; k < 9; ++k) if (k != PO_N2 && k != PO_S && k != PO_PV) ids[n++] = pb + k;
        if (l == 0) { ids[n++] = pb + PO_F0 + 1; ids[n++] = pb + PO_F0 + 2; } else for (int k = 0; k < 7; ++k) ids[n++] = pb + PO_F0 + k; }
    for (int i = 0; i < n; ++i) { a.ph_lo = ids[i]; a.ph_hi = ids[i] + 1; hipLaunchKernelGGL(fwd, dim3(grid), dim3(NWAVES * 64), LDS_BYTES, stream, a);
#if DBG
        { DbgIn di; for (int q = 0; q < 30; ++q) di.in[q] = (const float*)d_in[q]; const int st = ids[i] - (PH_L0 + PH_LSTRIDE + PO_F0);
          if (st == 5) hipLaunchKernelGGL(dbg_moe_tok, dim3(64), dim3(256), 0, stream, di, (const float*)d_out, (unsigned char*)d_ws);
          if (st >= 1 && st <= 5) hipLaunchKernelGGL(dbg_check, dim3(1), dim3(256), 0, stream, di, (const float*)d_out, (unsigned char*)d_ws, st);
          if (ids[i] == PH_L0 + PO_WIN && DBGBR >= 0) hipLaunchKernelGGL(dbg_setgates, dim3(256), dim3(256), 0, stream, (unsigned char*)d_ws, DBGBR);
          if (ids[i] == PH_L0 + PO_WIN && DBGV1) hipLaunchKernelGGL(dbg_setv, dim3(256), dim3(256), 0, stream, (unsigned char*)d_ws);
          if (ids[i] == PH_L0 + PO_WIN) hipLaunchKernelGGL(dbg_mixer, dim3(1), dim3(256), 0, stream, di, (const float*)d_out, (unsigned char*)d_ws, 30);
          if (ids[i] == PH_L0 + PO_CMP) hipLaunchKernelGGL(dbg_mixer, dim3(1), dim3(256), 0, stream, di, (const float*)d_out, (unsigned char*)d_ws, 31);
          if (ids[i] == PH_L0 + PO_WOUT) hipLaunchKernelGGL(dbg_mixer, dim3(1), dim3(256), 0, stream, di, (const float*)d_out, (unsigned char*)d_ws, 32);
          if (ids[i] == PH_L0 + PO_ATT) { const int pt[8] = {5, 40, 100, 700, 1000, 1500, 3000, 4095};
            for (int q = 0; q < 8; ++q) hipLaunchKernelGGL(dbg_attn, dim3(1), dim3(256), 0, stream, (unsigned char*)d_ws, q & 3, q & 1, pt[q], 20 + q); } }
#endif
    }
#else
    a.ph_lo = 0; a.ph_hi = 1000;
    hipLaunchKernelGGL(fwd, dim3(grid), dim3(NWAVES * 64), LDS_BYTES, stream, a);
#endif
#if DBG
    hipLaunchKernelGGL(dbg_tail, dim3(64), dim3(256), 0, stream, (float*)d_out, (unsigned char*)d_ws);
#endif
}
```

```cpp
#include <hip/hip_runtime.h>
#include <cstdio>
#include <cstdint>
#include <cmath>

#ifndef DBG
#define DBG 0
#endif
#ifndef XMODE
#define XMODE 0
#endif
#ifndef XDIAG
#define XDIAG 0
#endif
#ifndef RES_BF16
#define RES_BF16 1
#endif
#ifndef REP_MASK
#define REP_MASK 0u
#endif
#define REPN(b) (((REP_MASK >> (b)) & 1u) ? 2 : 1)
#ifndef REP_ATT
#define REP_ATT 1
#endif
#ifndef REP_PRO
#define REP_PRO 1
#endif
#ifndef REP_CMP
#define REP_CMP 1
#endif
#ifndef MK_PER_PHASE
#define MK_PER_PHASE 0
#endif

#define LAS __attribute__((address_space(3)))
#define GAS __attribute__((address_space(1)))
typedef unsigned short bf16_t;
typedef short bf16x8 __attribute__((ext_vector_type(8)));
typedef short s16x4 __attribute__((ext_vector_type(4)));
typedef float f32x2 __attribute__((ext_vector_type(2)));
typedef float f32x4 __attribute__((ext_vector_type(4)));
typedef float f32x16 __attribute__((ext_vector_type(16)));
typedef unsigned u32x4 __attribute__((ext_vector_type(4)));
typedef unsigned u32x2 __attribute__((ext_vector_type(2)));

constexpr int NB = 4, SEQ = 4096, DM = 1024, T = NB * SEQ, NL = 2;
constexpr int ZW = 2048;
constexpr int DFF = 2816, DFFE = 3584, NE = 8;
constexpr int MAXT = 136, HALFT = 64, CH1T = MAXT - HALFT;
constexpr float EPS = 1e-6f;
constexpr float C2 = 0.125f * 1.4426950408889634f;
constexpr float CX = 0.0625f * 1.4426950408889634f;

constexpr size_t MiB = 1u << 20;
constexpr size_t WS_CTL = 0, CTL_ZERO_BYTES = 1 * MiB;
constexpr size_t WS_ROPE = 1 * MiB;
constexpr size_t WS_BIAS = 1 * MiB + 512 * 1024;
constexpr size_t WS_ROUTE = 2 * MiB;
constexpr size_t WS_CNTG = 2 * MiB + 512 * 1024;
constexpr size_t WS_TILE = 2 * MiB + 640 * 1024;
constexpr size_t WS_SLOT = 1 * MiB + 512 * 1024;
constexpr size_t WS_YB = 3 * MiB;
constexpr size_t WS_GATES = 4 * MiB;
constexpr size_t WS_KCMP = 6 * MiB;
constexpr size_t WS_HID = 7 * MiB;
constexpr size_t WS_MN = 9 * MiB;
constexpr size_t WS_KX = 13 * MiB;
constexpr size_t WS_VXT = 17 * MiB;
constexpr size_t WS_WIN = 21 * MiB;
constexpr size_t WS_WOUT = 29 * MiB;
constexpr size_t WS_WQ = 33 * MiB, WS_WO = 37 * MiB, WS_WK = 41 * MiB, WS_WV = 45 * MiB;
constexpr size_t WS_CW1 = 49 * MiB;
constexpr size_t WS_CW2 = 53 * MiB;
constexpr size_t WS_FGU = 54 * MiB;
constexpr size_t WS_FD = 65 * MiB;
constexpr size_t WS_MGU = 71 * MiB;
constexpr size_t WS_MD = 183 * MiB;
constexpr size_t WS_HB = 239 * MiB;
constexpr size_t WS_R = 271 * MiB;
constexpr size_t WS_QRAW = WS_R, WS_QROT = WS_R + 16 * MiB, WS_KV = WS_R + 32 * MiB  , WS_U = WS_R + 57 * MiB, WS_AB = WS_R + 73 * MiB;
constexpr size_t WS_QX = WS_R, WS_PB = WS_R + 32 * MiB, WS_OX = WS_R + 73 * MiB;
constexpr size_t WS_ACT0 = WS_R;
constexpr size_t WS_HP = WS_HB;
constexpr size_t WS_ACTC = 307 * MiB;
constexpr size_t WS_END = 433 * MiB;
constexpr size_t WS_XB2 = 433 * MiB;
constexpr size_t WS_END2 = 465 * MiB;
constexpr size_t KVSZ = (size_t)NB * 2 * SEQ * 64;
static_assert(WS_HP + (size_t)MAXT * 256 * 1024 * 2 <= WS_ACTC && WS_ACTC + (size_t)CH1T * 256 * DFFE * 2 <= WS_END && WS_YB + (size_t)MAXT * 256 * 1024 * 2 <= WS_MGU && WS_SLOT + (size_t)T * 16 <= 2 * MiB, "ws map");
static_assert(WS_MGU + (size_t)NE * 7168 * 1024 * 2 <= WS_MD && WS_MD + (size_t)NE * 1024 * DFFE * 2 <= WS_HB, "ws map");

constexpr int CW_TMO = 0, CW_BAR = 4096, CW_BIAS = 8192, CW_SS = 32768;
typedef unsigned long long ssq_t;
#define SSP(i) ((ssq_t*)((unsigned*)(ws + WS_CTL) + CW_SS) + (size_t)(i) * T)
__device__ __forceinline__ float ss_rs(const ssq_t* ss, int row) { return 1.0f / sqrtf((float)((double)ss[row] * (1.0 / 4294967296.0)) * (1.f / DM) + EPS); }
__device__ __forceinline__ ssq_t ss_fix(float v) { return (ssq_t)((double)v * 4294967296.0); }

constexpr int RING_BYTES = 131072;
constexpr int XTRA_OFF = RING_BYTES, XTRA_BYTES = 24576;
constexpr int LDSCTL_OFF = XTRA_OFF + XTRA_BYTES, LDS_BYTES = LDSCTL_OFF + 512;
constexpr int NWAVES = 8;

#define LDS_WAIT() asm volatile("s_waitcnt lgkmcnt(0)" ::: "memory")
#define VM_WAIT() asm volatile("s_waitcnt vmcnt(0)" ::: "memory")
#define RLX_AGENT __ATOMIC_RELAXED, __HIP_MEMORY_SCOPE_AGENT

__device__ __forceinline__ unsigned f2bf(float f) { unsigned u = __builtin_bit_cast(unsigned, f); return (u + 0x7fffu + ((u >> 16) & 1u)) >> 16; }
__device__ __forceinline__ unsigned pk2(float lo, float hi) { return f2bf(lo) | (f2bf(hi) << 16); }
__device__ __forceinline__ float bf2f(unsigned short h) { return __builtin_bit_cast(float, (unsigned)h << 16); }
__device__ __forceinline__ unsigned cvt_pk_bf16(float lo, float hi) { unsigned r; asm volatile("v_cvt_pk_bf16_f32 %0, %1, %2" : "=v"(r) : "v"(lo), "v"(hi)); return r; }
template <int M> __device__ __forceinline__ float xor_get(float v) {
    static_assert(M > 0 && M < 32, "xor_get: within 32 lanes");
    return __builtin_bit_cast(float, __builtin_amdgcn_ds_swizzle(__builtin_bit_cast(int, v), (M << 10) | 0x1f));
}
__device__ __forceinline__ void half_swap(float v, float& lo, float& hi) {
    unsigned a = __builtin_bit_cast(unsigned, v), b = a;
    asm volatile("s_nop 1\n\tv_permlane32_swap_b32 %0, %1\n\ts_nop 1" : "+v"(a), "+v"(b));
    lo = __builtin_bit_cast(float, a); hi = __builtin_bit_cast(float, b);
}
__device__ __forceinline__ float xor32_sum(float v) { float lo, hi; half_swap(v, lo, hi); return lo + hi; }
__device__ __forceinline__ float xor32_max(float v) { float lo, hi; half_swap(v, lo, hi); return fmaxf(lo, hi); }
__device__ __forceinline__ float wave_sum(float v) {
    v += xor_get<1>(v); v += xor_get<2>(v); v += xor_get<4>(v); v += xor_get<8>(v); v += xor_get<16>(v);
    return xor32_sum(v);
}
__device__ __forceinline__ float fast_exp2(float x) { return __builtin_amdgcn_exp2f(x); }

namespace pg8 {
constexpr int BM = 256, BK = 64, HALF = 128, HTB = HALF * BK * 2, NXCD = 8, WGM = 8;
__host__ __device__ __forceinline__ int lds_byte(int r, int c) { const int st = (r >> 4) * 2 + (c >> 5), rr = r & 15, cc = c & 31, ob = rr * 64 + cc * 2; return st * 1024 + (ob ^ (((ob >> 9) & 1) << 5)); }
__host__ __device__ __forceinline__ void stage_rc(int b, int& R, int& C) { const int st = b / 1024, sb = b % 1024, swz = sb ^ (((sb >> 9) & 1) << 5); R = (st >> 1) * 16 + swz / 64; C = (st & 1) * 32 + (swz % 64) / 2; }
__host__ __device__ __forceinline__ int perm32(int rho) { const int n = rho >> 4, i = rho & 15; return 8 * (i >> 2) + 4 * n + (i & 3); }

struct Unit { int pm, pn; long aoff, boff, coff; };
struct Gemm { const char* A; const char* Bt; int K, lda, ldb; };

struct TileOrder {
    int nM, nN, nwg, G, c;
    __device__ __forceinline__ void init(int nM_, int nN_, int G_, int c_) { nM = nM_; nN = nN_; nwg = nM * nN; G = G_; c = c_; }
    __device__ __forceinline__ bool tile(int i, int& pm, int& pn) const {
        const long L = (long)i * G + c; if (L >= nwg) return false;
        int wgid = (int)L; { const int q = nwg / NXCD, r = nwg % NXCD, xcd = wgid % NXCD, off = wgid / NXCD; wgid = (xcd < r ? xcd * (q + 1) : r * (q + 1) + (xcd - r) * q) + off; }
        const int nig = WGM * nN, gid = wgid / nig, fm = gid * WGM, gsz = (nM - fm) < WGM ? (nM - fm) : WGM;
        pm = fm + ((wgid % nig) % gsz); pn = (wgid % nig) / gsz; return true;
    }
};

template <class Epi, class Sched, bool ALIGN_EPI, bool SP2>
__device__ __forceinline__ void gemm_phase(LAS unsigned char* lds, const Gemm g, const Sched S, const Epi E, int tid_in) {
    int tid_ = tid_in; asm volatile("" : "+v"(tid_));
    const int tid = tid_, wid = __builtin_amdgcn_readfirstlane(tid >> 6), lane = tid & 63, wr = wid >> 2, wc = wid & 3, fr = lane & 15, fq = lane >> 4;
    const int K = g.K, nt = K / BK;
    unsigned voffA[2], voffB[2];
#pragma unroll
    for (int i = 0; i < 2; ++i) { int R, C; stage_rc(tid * 16 + i * 8192, R, C); const int Rb = Epi::PERM ? ((R & ~31) + perm32(R & 31)) : R;
        voffA[i] = (unsigned)(R * g.lda + C) * 2u; voffB[i] = (unsigned)(Rb * g.ldb + C) * 2u; }
    const size_t kstep = (size_t)(BK * 2);
    const size_t hstepA = (size_t)HALF * g.lda * 2, hstepB = (size_t)HALF * g.ldb * 2;
    const unsigned ldsw = (unsigned)wid * 1024u;
    const int aoff = lds_byte(wr * 64 + fr, fq * 8), boff = lds_byte(wc * 32 + fr, fq * 8);
#define PG8_SA(b, h) (((b) * 2 + (h)) * HTB)
#define PG8_SB(b, h) ((4 + (b) * 2 + (h)) * HTB)
#define PG8_STAGE(bufoff, gbase, voff) do { _Pragma("unroll") for (int _i = 0; _i < 2; ++_i) \
        __builtin_amdgcn_global_load_lds((const unsigned*)((const char*)(gbase) + (voff)[_i]), (LAS unsigned*)(lds + (bufoff) + ldsw + _i * 8192), 16, 0, 0); } while (0)
#define PG8_LDA(dst, b, h) do { _Pragma("unroll") for (int m = 0; m < 4; ++m) _Pragma("unroll") for (int k = 0; k < 2; ++k) dst[m][k] = *(const LAS bf16x8*)(lds + PG8_SA(b, h) + aoff + m * 2048 + k * 1024); } while (0)
#define PG8_LDB(dst, b, h) do { _Pragma("unroll") for (int n = 0; n < 2; ++n) _Pragma("unroll") for (int k = 0; k < 2; ++k) dst[n][k] = *(const LAS bf16x8*)(lds + PG8_SB(b, h) + boff + n * 2048 + k * 1024); } while (0)
#define PG8_MMA(ai, bj, At, Bt) do { __builtin_amdgcn_s_setprio(1); _Pragma("unroll") for (int m = 0; m < 4; ++m) _Pragma("unroll") for (int n = 0; n < 2; ++n) _Pragma("unroll") for (int k = 0; k < 2; ++k) \
        acc[ai][bj][m][n] = __builtin_amdgcn_mfma_f32_16x16x32_bf16(Bt[n][k], At[m][k], acc[ai][bj][m][n], 0, 0, 0); __builtin_amdgcn_s_setprio(0); } while (0)
#define PG8_WAIT_V(n) asm volatile("s_waitcnt vmcnt(" #n ")" ::: "memory")
#define PG8_WAIT_L(n) asm volatile("s_waitcnt lgkmcnt(" #n ")" ::: "memory")
#define PG8_BAR __builtin_amdgcn_s_barrier()
#define PG8_SCHED __builtin_amdgcn_sched_barrier(0)
    Unit cur, nxt; int ui = 0;
    if (!S.next(0, cur)) return;
    f32x4 acc[2][2][4][2];
    float zero_ = 0.f; asm volatile("" : "+v"(zero_));
#pragma unroll
    for (int a = 0; a < 2; ++a)
#pragma unroll
        for (int b = 0; b < 2; ++b)
#pragma unroll
            for (int m = 0; m < 4; ++m)
#pragma unroll
                for (int n = 0; n < 2; ++n) acc[a][b][m][n] = (f32x4){zero_, zero_, zero_, zero_};
    bf16x8 At[4][2], B0[2][2], B1[2][2];
    const char* cA = g.A + cur.aoff; const char* cB = g.Bt + cur.boff;
    if constexpr (SP2) {
        PG8_STAGE(PG8_SB(0, 0), cB, voffB); PG8_STAGE(PG8_SB(0, 1), cB + hstepB, voffB); PG8_STAGE(PG8_SA(0, 0), cA, voffA); PG8_STAGE(PG8_SA(0, 1), cA + hstepA, voffA);
        if (wr == 1) PG8_BAR;
        PG8_WAIT_V(2); PG8_BAR;
        PG8_STAGE(PG8_SB(1, 0), cB + kstep, voffB); PG8_STAGE(PG8_SA(1, 0), cA + kstep, voffA); PG8_STAGE(PG8_SB(1, 1), cB + hstepB + kstep, voffB);
        PG8_WAIT_V(6); PG8_BAR;
    } else {
        PG8_STAGE(PG8_SB(0, 0), cB, voffB); PG8_STAGE(PG8_SA(0, 0), cA, voffA); PG8_STAGE(PG8_SB(0, 1), cB + hstepB, voffB); PG8_STAGE(PG8_SA(0, 1), cA + hstepA, voffA);
        if (wr == 1) PG8_BAR;
        PG8_WAIT_V(4); PG8_BAR;
        PG8_STAGE(PG8_SB(1, 0), cB + kstep, voffB); PG8_STAGE(PG8_SA(1, 0), cA + kstep, voffA); PG8_STAGE(PG8_SB(1, 1), cB + hstepB + kstep, voffB);
        PG8_WAIT_V(6); PG8_BAR;
    }
    for (;;) {
        const bool has_next = S.next(ui + 1, nxt);
        const char* nA = has_next ? g.A + nxt.aoff : cA; const char* nB = has_next ? g.Bt + nxt.boff : cB;
#pragma unroll 1
        for (int t = 0; t < nt; t += 2) {
            const bool last = (t == nt - 2);
            const char* a1 = cA + (size_t)(t + 1) * kstep;
            const char* a2 = last ? nA : cA + (size_t)(t + 2) * kstep; const char* b2 = last ? nB : cB + (size_t)(t + 2) * kstep;
            const char* a3 = a2 + kstep; const char* b3 = b2 + kstep;
            if constexpr (SP2) {
            PG8_LDB(B0, 0, 0); PG8_LDB(B1, 0, 1); PG8_SCHED; PG8_LDA(At, 0, 0); PG8_STAGE(PG8_SA(1, 1), a1 + hstepA, voffA);
            PG8_WAIT_V(8); PG8_WAIT_L(0); PG8_BAR; PG8_MMA(0, 0, At, B0); PG8_MMA(0, 1, At, B1); PG8_BAR; PG8_SCHED;
            PG8_LDA(At, 0, 1); PG8_STAGE(PG8_SB(0, 0), b2, voffB); PG8_STAGE(PG8_SB(0, 1), b2 + hstepB, voffB); PG8_STAGE(PG8_SA(0, 0), a2, voffA);
            PG8_WAIT_V(8); PG8_WAIT_L(0); PG8_BAR; PG8_MMA(1, 0, At, B0); PG8_MMA(1, 1, At, B1); PG8_BAR; PG8_SCHED;
            PG8_LDB(B0, 1, 0); PG8_LDB(B1, 1, 1); PG8_SCHED; PG8_LDA(At, 1, 0); PG8_STAGE(PG8_SA(0, 1), a2 + hstepA, voffA);
            PG8_WAIT_V(8); PG8_WAIT_L(0); PG8_BAR; PG8_MMA(0, 0, At, B0); PG8_MMA(0, 1, At, B1); PG8_BAR; PG8_SCHED;
            PG8_LDA(At, 1, 1); PG8_STAGE(PG8_SB(1, 0), b3, voffB); PG8_STAGE(PG8_SB(1, 1), b3 + hstepB, voffB); PG8_STAGE(PG8_SA(1, 0), a3, voffA);
            PG8_WAIT_V(8); PG8_WAIT_L(0); PG8_BAR; PG8_MMA(1, 0, At, B0); PG8_MMA(1, 1, At, B1); PG8_BAR; PG8_SCHED;
            } else {
            PG8_LDB(B0, 0, 0); PG8_SCHED; PG8_LDA(At, 0, 0); PG8_STAGE(PG8_SA(1, 1), a1 + hstepA, voffA);
            PG8_WAIT_L(8); PG8_BAR; PG8_WAIT_L(0); PG8_MMA(0, 0, At, B0); PG8_BAR; PG8_SCHED;
            PG8_LDB(B1, 0, 1); PG8_STAGE(PG8_SB(0, 0), b2, voffB);
            PG8_BAR; PG8_WAIT_L(0); PG8_MMA(0, 1, At, B1); PG8_BAR;
            PG8_LDA(At, 0, 1); PG8_STAGE(PG8_SA(0, 0), a2, voffA);
            PG8_BAR; PG8_WAIT_L(0); PG8_MMA(1, 0, At, B0); PG8_BAR; PG8_SCHED;
            PG8_STAGE(PG8_SB(0, 1), b2 + hstepB, voffB);
            PG8_WAIT_V(6); PG8_BAR; PG8_MMA(1, 1, At, B1); PG8_BAR;
            PG8_LDB(B0, 1, 0); PG8_SCHED; PG8_LDA(At, 1, 0); PG8_STAGE(PG8_SA(0, 1), a2 + hstepA, voffA);
            PG8_WAIT_L(8); PG8_BAR; PG8_WAIT_L(0); PG8_MMA(0, 0, At, B0); PG8_BAR; PG8_SCHED;
            PG8_LDB(B1, 1, 1); PG8_STAGE(PG8_SB(1, 0), b3, voffB);
            PG8_BAR; PG8_WAIT_L(0); PG8_MMA(0, 1, At, B1); PG8_BAR;
            PG8_LDA(At, 1, 1); PG8_STAGE(PG8_SA(1, 0), a3, voffA);
            PG8_BAR; PG8_WAIT_L(0); PG8_MMA(1, 0, At, B0); PG8_BAR; PG8_SCHED;
            PG8_STAGE(PG8_SB(1, 1), b3 + hstepB, voffB);
            PG8_WAIT_V(6); PG8_BAR; PG8_MMA(1, 1, At, B1); PG8_BAR;
            }
        }
        if constexpr (ALIGN_EPI) { if (wr == 0) PG8_BAR; }
        if constexpr (!Epi::AFTER_DRAIN) { E(acc, cur, wr, wc, fr, fq); }
        if (!has_next) break;
#pragma unroll
        for (int a = 0; a < 2; ++a)
#pragma unroll
            for (int b = 0; b < 2; ++b)
#pragma unroll
                for (int m = 0; m < 4; ++m)
#pragma unroll
                    for (int n = 0; n < 2; ++n) acc[a][b][m][n] = (f32x4){zero_, zero_, zero_, zero_};
        cur = nxt; cA = nA; cB = nB; ++ui;
        if constexpr (ALIGN_EPI) { if (wr == 1) PG8_BAR; }
    }
    PG8_WAIT_V(0);
    if constexpr (!ALIGN_EPI) { if (wr == 0) PG8_BAR; }
    PG8_BAR;
    if constexpr (Epi::AFTER_DRAIN) { E.fused(acc, cur, wr, wc, fr, fq, lds, wid, lane); }
#undef PG8_SA
#undef PG8_SB
#undef PG8_STAGE
#undef PG8_LDA
#undef PG8_LDB
#undef PG8_MMA
#undef PG8_WAIT_V
#undef PG8_WAIT_L
#undef PG8_BAR
#undef PG8_SCHED
}
}
using pg8::Unit;
typedef const f32x4 (&AccRef)[2][2][4][2];

struct SchedPlain {
    pg8::TileOrder o; long astep, bstep;
    __device__ void init(int nM, int nN, int lda, int ldb, int G, int c) { o.init(nM, nN, G, c); astep = (long)256 * lda * 2; bstep = (long)256 * ldb * 2; }
    __device__ bool next(int i, Unit& u) const { if (!o.tile(i, u.pm, u.pn)) return false; u.aoff = u.pm * astep; u.boff = u.pn * bstep; u.coff = 0; return true; }
};
struct SchedOne { Unit u; __device__ bool next(int i, Unit& out) const { if (i > 0) return false; out = u; return true; } };
struct SchedKV {
    int G, c;
    __device__ bool next(int i, Unit& u) const {
        const int L = i * G + c; if (L >= 64 || (G == 1 && i > 0)) return false;
        const int job = L >> 4, l = job >> 1, isv = job & 1; u.pm = (L >> 2) & 3; u.pn = L & 3;
        const long mn = (long)WS_MN + (long)l * 2 * MiB, wk = (long)WS_WK + (long)l * 2 * MiB, wv = (long)WS_WV + (long)l * 2 * MiB;
        const long ts = 256L * 1024 * 2;
        if (!isv) { u.aoff = mn + u.pm * ts; u.boff = wk + u.pn * ts; u.coff = ((long)WS_KX + (long)l * 2 * MiB) / 2; }
        else { u.aoff = mn + u.pm * ts; u.boff = wv + u.pn * ts; u.coff = ((long)WS_VXT + (long)l * 2 * MiB) / 2; }
        return true;
    }
};
template <int MODE> struct SchedX {
    pg8::TileOrder o;
    __device__ void init(int G, int c) { o.init(64, 4, G, c); }
    __device__ bool next(int i, Unit& u) const {
        if (!o.tile(i, u.pm, u.pn)) return false;
        const int b = u.pm >> 4, h = u.pn;
        u.aoff = ((long)u.pm * 256 * 1024 + h * 256) * 2;
        u.boff = MODE == 0 ? ((long)b * 256 * 1024 + h * 256) * 2 : ((long)h * 256 * 1024 + b * 256) * 2;
        u.coff = 0; return true;
    }
};
struct SchedMoe {
    pg8::TileOrder o; const unsigned* texp; int t0, nn; long astep, bstep, estep, cstep, khb, khc;
    __device__ bool next(int i, Unit& u) const {
        int pm, pn; if (!o.tile(i, pm, pn)) return false;
        const int rt = t0 + pm; const int e = (int)texp[rt]; const int kh = pn >= nn ? 1 : 0; pn -= kh * nn;
        u.pm = rt; u.pn = pn; u.aoff = pm * astep + kh * khb; u.boff = e * estep + pn * bstep + kh * khb; u.coff = -(long)t0 * cstep + kh * khc; return true;
    }
};

struct EpiPlain {
    static constexpr bool PERM = true, AFTER_DRAIN = false;
    bf16_t* O; int ldc; const ssq_t* ss;
    __device__ __forceinline__ void operator()(AccRef acc, const Unit& u, int wr, int wc, int fr, int fq) const {
        const int row0 = u.pm * 256 + wr * 64 + fr;
        bf16_t* base = O + u.coff + (size_t)row0 * ldc + u.pn * 256 + wc * 32 + 8 * fq;
#pragma unroll
        for (int ai = 0; ai < 2; ++ai)
#pragma unroll
            for (int m = 0; m < 4; ++m) { const float rs = ss ? ss_rs(ss, row0 + ai * 128 + m * 16) : 1.f;
#pragma unroll
                for (int bj = 0; bj < 2; ++bj) { const f32x4 v0 = acc[ai][bj][m][0] * rs, v1 = acc[ai][bj][m][1] * rs;
                    u32x4 w; w.x = cvt_pk_bf16(v0[0], v0[1]); w.y = cvt_pk_bf16(v0[2], v0[3]); w.z = cvt_pk_bf16(v1[0], v1[1]); w.w = cvt_pk_bf16(v1[2], v1[3]);
                    *(u32x4*)(base + (size_t)(ai * 128 + m * 16) * ldc + bj * 128) = w; } }
    }
};
#ifndef ABL
#define ABL 0
#endif
template <bool SRC_F32> struct EpiResB {
    static constexpr bool PERM = true, AFTER_DRAIN = false;
    const void* src; bf16_t* xo; ssq_t* ss;
    __device__ __forceinline__ void operator()(AccRef acc, const Unit& u, int wr, int wc, int fr, int fq) const {
        const int row0 = u.pm * 256 + wr * 64 + fr;
        const size_t off0 = (size_t)row0 * DM + u.pn * 256 + wc * 32 + 8 * fq;
#pragma unroll
        for (int ai = 0; ai < 2; ++ai)
#pragma unroll
            for (int m = 0; m < 4; ++m) { float part = 0.f;
#pragma unroll
                for (int bj = 0; bj < 2; ++bj) { const size_t off = off0 + (size_t)(ai * 128 + m * 16) * DM + bj * 128;
                    f32x4 s0, s1;
                    if (SRC_F32) { s0 = *(const f32x4*)((const float*)src + off); s1 = *(const f32x4*)((const float*)src + off + 4); }
                    else { const u32x4 w = *(const u32x4*)((const bf16_t*)src + off);
                        s0 = (f32x4){__builtin_bit_cast(float, w.x << 16), __builtin_bit_cast(float, w.x & 0xffff0000u), __builtin_bit_cast(float, w.y << 16), __builtin_bit_cast(float, w.y & 0xffff0000u)};
                        s1 = (f32x4){__builtin_bit_cast(float, w.z << 16), __builtin_bit_cast(float, w.z & 0xffff0000u), __builtin_bit_cast(float, w.w << 16), __builtin_bit_cast(float, w.w & 0xffff0000u)}; }
                    s0 = s0 + acc[ai][bj][m][0]; s1 = s1 + acc[ai][bj][m][1];
                    u32x4 w; w.x = cvt_pk_bf16(s0[0], s0[1]); w.y = cvt_pk_bf16(s0[2], s0[3]); w.z = cvt_pk_bf16(s1[0], s1[1]); w.w = cvt_pk_bf16(s1[2], s1[3]); *(u32x4*)(xo + off) = w;
                    part += ((s0[0] * s0[0] + s0[1] * s0[1]) + (s0[2] * s0[2] + s0[3] * s0[3])) + ((s1[0] * s1[0] + s1[1] * s1[1]) + (s1[2] * s1[2] + s1[3] * s1[3])); }
                if (ss) { part += xor_get<16>(part); part = xor32_sum(part); if (fq == 0) atomicAdd(ss + row0 + ai * 128 + m * 16, ss_fix(part)); } }
    }
};
struct EpiRes {
    static constexpr bool PERM = true, AFTER_DRAIN = false;
    const float* src; float* out; bf16_t* xb; ssq_t* ss;
    __device__ __forceinline__ void operator()(AccRef acc, const Unit& u, int wr, int wc, int fr, int fq) const {
        const int row0 = u.pm * 256 + wr * 64 + fr;
        const size_t off0 = (size_t)row0 * DM + u.pn * 256 + wc * 32 + 8 * fq;
#pragma unroll
        for (int ai = 0; ai < 2; ++ai)
#pragma unroll
            for (int m = 0; m < 4; ++m) { float part = 0.f;
#pragma unroll
                for (int bj = 0; bj < 2; ++bj) { const size_t off = off0 + (size_t)(ai * 128 + m * 16) * DM + bj * 128;
                    const f32x4 s0 = *(const f32x4*)(src + off) + acc[ai][bj][m][0], s1 = *(const f32x4*)(src + off + 4) + acc[ai][bj][m][1];
                    *(f32x4*)(out + off) = s0; *(f32x4*)(out + off + 4) = s1;
                    if (xb) { u32x4 w; w.x = cvt_pk_bf16(s0[0], s0[1]); w.y = cvt_pk_bf16(s0[2], s0[3]); w.z = cvt_pk_bf16(s1[0], s1[1]); w.w = cvt_pk_bf16(s1[2], s1[3]); *(u32x4*)(xb + off) = w;
                        part += ((s0[0] * s0[0] + s0[1] * s0[1]) + (s0[2] * s0[2] + s0[3] * s0[3])) + ((s1[0] * s1[0] + s1[1] * s1[1]) + (s1[2] * s1[2] + s1[3] * s1[3])); } }
                if (xb) { part += xor_get<16>(part); part = xor32_sum(part); if (fq == 0) atomicAdd(ss + row0 + ai * 128 + m * 16, ss_fix(part)); } }
    }
};
__device__ __forceinline__ float gelu_tanh(float x) {
    const float y = 0.7978845608028654f * (x + 0.044715f * x * x * x);
    const float e = fast_exp2(y * 2.8853900817779268f);
    const float th = 1.f - 2.f * __builtin_amdgcn_rcpf(e + 1.f);
    return 0.5f * x * (1.f + th);
}
struct EpiHid {
    static constexpr bool PERM = true, AFTER_DRAIN = false;
    bf16_t* O; const long long* bias;
    __device__ __forceinline__ void operator()(AccRef acc, const Unit& u, int wr, int wc, int fr, int fq) const {
        bf16_t* base = O + (size_t)(u.pm * 256 + wr * 64 + fr) * 256 + wc * 32 + 8 * fq;
#pragma unroll
        for (int bj = 0; bj < 2; ++bj) { const long long* bp = bias + bj * 128 + wc * 32 + 8 * fq; f32x4 b0, b1;
#pragma unroll
            for (int j = 0; j < 4; ++j) { b0[j] = (float)((double)bp[j] * (1.0 / 1099511627776.0)); b1[j] = (float)((double)bp[4 + j] * (1.0 / 1099511627776.0)); }
#pragma unroll
            for (int ai = 0; ai < 2; ++ai)
#pragma unroll
                for (int m = 0; m < 4; ++m) { const f32x4 v0 = acc[ai][bj][m][0] + b0, v1 = acc[ai][bj][m][1] + b1;
                    u32x4 w; w.x = cvt_pk_bf16(gelu_tanh(v0[0]), gelu_tanh(v0[1])); w.y = cvt_pk_bf16(gelu_tanh(v0[2]), gelu_tanh(v0[3]));
                    w.z = cvt_pk_bf16(gelu_tanh(v1[0]), gelu_tanh(v1[1])); w.w = cvt_pk_bf16(gelu_tanh(v1[2]), gelu_tanh(v1[3]));
                    *(u32x4*)(base + (size_t)(ai * 128 + m * 16) * 256 + bj * 128) = w; } }
    }
};
struct EpiCmp2 {
    static constexpr bool PERM = true, AFTER_DRAIN = false;
    bf16_t* O;
    __device__ __forceinline__ void operator()(AccRef acc, const Unit& u, int wr, int wc, int fr, int fq) const {
        if (wc >= 2) return;
#pragma unroll
        for (int ai = 0; ai < 2; ++ai)
#pragma unroll
            for (int m = 0; m < 4; ++m) { const int row = u.pm * 256 + ai * 128 + wr * 64 + m * 16 + fr; const f32x4 v0 = acc[ai][0][m][0], v1 = acc[ai][0][m][1];
                u32x4 w; w.x = cvt_pk_bf16(v0[0], v0[1]); w.y = cvt_pk_bf16(v0[2], v0[3]); w.z = cvt_pk_bf16(v1[0], v1[1]); w.w = cvt_pk_bf16(v1[2], v1[3]);
                if ((row & 255) == 255) w = (u32x4){0u, 0u, 0u, 0u};
                *(u32x4*)(O + (size_t)row * 64 + wc * 32 + 8 * fq) = w; }
    }
};
__device__ __forceinline__ float silu_mul(float g, float u) { return g * __builtin_amdgcn_rcpf(1.f + fast_exp2(-1.4426950408889634f * g)) * u; }
struct EpiSwiglu {
    static constexpr bool PERM = true, AFTER_DRAIN = false;
    bf16_t* O; int ldc; const ssq_t* ss;
    __device__ __forceinline__ void operator()(AccRef acc, const Unit& u, int wr, int wc, int fr, int fq) const {
        const int row0 = u.pm * 256 + wr * 64 + fr;
        bf16_t* base = O + u.coff + (size_t)row0 * ldc + u.pn * 128 + wc * 32 + 8 * fq;
#pragma unroll
        for (int ai = 0; ai < 2; ++ai)
#pragma unroll
            for (int m = 0; m < 4; ++m) { const float rs = ss ? ss_rs(ss, row0 + ai * 128 + m * 16) : 1.f;
                const f32x4 g0 = acc[ai][0][m][0] * rs, g1 = acc[ai][0][m][1] * rs, u0 = acc[ai][1][m][0] * rs, u1 = acc[ai][1][m][1] * rs;
                u32x4 w; w.x = cvt_pk_bf16(silu_mul(g0[0], u0[0]), silu_mul(g0[1], u0[1])); w.y = cvt_pk_bf16(silu_mul(g0[2], u0[2]), silu_mul(g0[3], u0[3]));
                w.z = cvt_pk_bf16(silu_mul(g1[0], u1[0]), silu_mul(g1[1], u1[1])); w.w = cvt_pk_bf16(silu_mul(g1[2], u1[2]), silu_mul(g1[3], u1[3]));
                *(u32x4*)(base + (size_t)(ai * 128 + m * 16) * ldc) = w; }
    }
};
struct EpiWin {
    static constexpr bool PERM = true, AFTER_DRAIN = false;
    bf16_t *qraw, *qrot, *kv, *ub; float* gates; const float* rope; const ssq_t* ss;
    __device__ __forceinline__ void operator()(AccRef acc, const Unit& u, int wr, int wc, int fr, int fq) const {
        const int pn = u.pn;
#pragma unroll
        for (int ai = 0; ai < 2; ++ai)
#pragma unroll
            for (int m = 0; m < 4; ++m) {
                const int row = u.pm * 256 + ai * 128 + wr * 64 + m * 16 + fr, b = row >> 12, t = row & 4095;
                const float rs = ss_rs(ss, row);
#pragma unroll
                for (int bj = 0; bj < 2; ++bj) {
                    float v[8];
#pragma unroll
                    for (int j = 0; j < 4; ++j) { v[j] = acc[ai][bj][m][0][j] * rs; v[4 + j] = acc[ai][bj][m][1][j] * rs; }
                    if (pn < 2) {
                        const size_t idx = ((size_t)(b * 2 + pn) * SEQ + t) * 256 + bj * 128 + wc * 32 + 8 * fq;
                        u32x4 w; w.x = cvt_pk_bf16(v[0] * C2, v[1] * C2); w.y = cvt_pk_bf16(v[2] * C2, v[3] * C2); w.z = cvt_pk_bf16(v[4] * C2, v[5] * C2); w.w = cvt_pk_bf16(v[6] * C2, v[7] * C2);
                        *(u32x4*)(qraw + idx) = w;
                        if ((wc & 1) == 0) {
                            float p[8];
#pragma unroll
                            for (int j = 0; j < 8; ++j) p[j] = xor_get<16>(v[j]);
                            if (fq < 2) { const float* rp = rope + (size_t)t * 16;
#pragma unroll
                                for (int j = 0; j < 8; ++j) { const float cs = rp[2 * j], sn = rp[2 * j + 1]; v[j] = fq == 0 ? v[j] * cs - p[j] * sn : v[j] * cs + p[j] * sn; } }
                            w.x = cvt_pk_bf16(v[0] * C2, v[1] * C2); w.y = cvt_pk_bf16(v[2] * C2, v[3] * C2); w.z = cvt_pk_bf16(v[4] * C2, v[5] * C2); w.w = cvt_pk_bf16(v[6] * C2, v[7] * C2);
                        }
                        *(u32x4*)(qrot + idx) = w;
                    } else if (pn < 5) {
                        const int i = 2 * (pn - 2) + bj, g = wc >> 1;
                        if (bj == 0 && pn >= 3 && (wc & 1) == 0) {
                            float p[8];
#pragma unroll
                            for (int j = 0; j < 8; ++j) p[j] = xor_get<16>(v[j]);
                            if (fq < 2) { const float* rp = rope + (size_t)t * 16;
#pragma unroll
                                for (int j = 0; j < 8; ++j) { const float cs = rp[2 * j], sn = rp[2 * j + 1]; v[j] = fq == 0 ? v[j] * cs - p[j] * sn : v[j] * cs + p[j] * sn; } }
                        }
                        u32x4 w; w.x = cvt_pk_bf16(v[0], v[1]); w.y = cvt_pk_bf16(v[2], v[3]); w.z = cvt_pk_bf16(v[4], v[5]); w.w = cvt_pk_bf16(v[6], v[7]);
                        *(u32x4*)(kv + (size_t)i * KVSZ + ((size_t)(b * 2 + g) * SEQ + t) * 64 + (wc & 1) * 32 + 8 * fq) = w;
                    } else if (pn < 7) {
                        u32x4 w; w.x = cvt_pk_bf16(v[0], v[1]); w.y = cvt_pk_bf16(v[2], v[3]); w.z = cvt_pk_bf16(v[4], v[5]); w.w = cvt_pk_bf16(v[6], v[7]);
                        *(u32x4*)(ub + (size_t)row * 512 + (pn - 5) * 256 + bj * 128 + wc * 32 + 8 * fq) = w;
                    } else {
                        if (bj == 0 && wc == 0 && fq < 3) { float* gp = gates + (size_t)row * 24 + 8 * fq;
#pragma unroll
                            for (int j = 0; j < 8; ++j) gp[j] = __builtin_amdgcn_rcpf(1.f + fast_exp2(-1.4426950408889634f * v[j])); }
                    }
                }
            }
    }
};
struct EpiSoftmax {
    static constexpr bool PERM = true, AFTER_DRAIN = true;
    bf16_t* P;
    __device__ __forceinline__ void operator()(AccRef, const Unit&, int, int, int, int) const {}
    __device__ __forceinline__ void fused(f32x4 (&acc)[2][2][4][2], const Unit& u, int wr, int wc, int fr, int fq, LAS unsigned char* lds, int wid, int lane) const {
        LAS float* RM = (LAS float*)lds;
        LAS float* RS = (LAS float*)(lds + 4096);
        float mx[2][4];
#pragma unroll
        for (int ai = 0; ai < 2; ++ai)
#pragma unroll
            for (int m = 0; m < 4; ++m) { float a = -INFINITY;
#pragma unroll
                for (int bj = 0; bj < 2; ++bj)
#pragma unroll
                    for (int n = 0; n < 2; ++n)
#pragma unroll
                        for (int e = 0; e < 4; ++e) a = fmaxf(a, acc[ai][bj][m][n][e]);
                a = fmaxf(a, xor_get<16>(a)); a = xor32_max(a);
                if (fq == 0) RM[(ai * 128 + wr * 64 + m * 16 + fr) * 4 + wc] = a; }
        LDS_WAIT(); __builtin_amdgcn_s_barrier(); asm volatile("" ::: "memory");
#pragma unroll
        for (int ai = 0; ai < 2; ++ai)
#pragma unroll
            for (int m = 0; m < 4; ++m) { const int r = ai * 128 + wr * 64 + m * 16 + fr; const f32x4 q = *(const LAS f32x4*)(RM + r * 4);
                const float mm = fmaxf(fmaxf(q[0], q[1]), fmaxf(q[2], q[3])); float s = 0.f;
#pragma unroll
                for (int bj = 0; bj < 2; ++bj)
#pragma unroll
                    for (int n = 0; n < 2; ++n)
#pragma unroll
                        for (int e = 0; e < 4; ++e) { const float p = fast_exp2((acc[ai][bj][m][n][e] - mm) * CX); acc[ai][bj][m][n][e] = p; s += p; }
                s += xor_get<16>(s); s = xor32_sum(s);
                if (fq == 0) RS[r * 4 + wc] = s; }
        LDS_WAIT(); __builtin_amdgcn_s_barrier(); asm volatile("" ::: "memory");
        bf16_t* base = P + (size_t)(u.pm * 256 + wr * 64 + fr) * DM + u.pn * 256 + wc * 32 + 8 * fq;
#pragma unroll
        for (int ai = 0; ai < 2; ++ai)
#pragma unroll
            for (int m = 0; m < 4; ++m) { const int r = ai * 128 + wr * 64 + m * 16 + fr; const f32x4 q = *(const LAS f32x4*)(RS + r * 4);
                const float inv = 1.f / ((q[0] + q[1]) + (q[2] + q[3]));
#pragma unroll
                for (int bj = 0; bj < 2; ++bj) { u32x4 w;
                    const f32x4 p0 = acc[ai][bj][m][0] * inv, p1 = acc[ai][bj][m][1] * inv;
                    w.x = cvt_pk_bf16(p0[0], p0[1]); w.y = cvt_pk_bf16(p0[2], p0[3]); w.z = cvt_pk_bf16(p1[0], p1[1]); w.w = cvt_pk_bf16(p1[2], p1[3]);
                    *(u32x4*)(base + (size_t)(ai * 128 + m * 16) * DM + bj * 128) = w; } }
        LDS_WAIT(); __builtin_amdgcn_s_barrier(); asm volatile("" ::: "memory");
    }
};

namespace nsa {
constexpr int L_K = 0, L_V = 24576, L_PCS = 49152, L_OST = 114688, L_WSF = 147456, L_SEL = 149504;
static_assert(L_SEL + 512 <= LDSCTL_OFF, "attention LDS map");
__device__ __forceinline__ int crow(int r, int hi) { return (r & 3) + 8 * (r >> 2) + 4 * hi; }
__device__ __forceinline__ constexpr int ccol(int r) { return (r & 3) + 8 * (r >> 2); }
__device__ __forceinline__ unsigned cvtpk(float lo, float hi) { return cvt_pk_bf16(lo, hi); }

__device__ __forceinline__ void qkt(f32x16& p0, f32x16& p1, const LAS unsigned char* Kslot, const bf16x8* qr, int r32, int hi, float zero_) {
    const LAS unsigned char* kb = Kslot + hi * 1024 + r32 * 16;
    f32x16 z;
#pragma unroll
    for (int r = 0; r < 16; ++r) z[r] = zero_;
    p0 = z; p1 = z;
#pragma unroll
    for (int d0 = 0; d0 < 4; ++d0) {
        const bf16x8 b0 = *(const LAS bf16x8*)(kb + d0 * 2048);
        const bf16x8 b1 = *(const LAS bf16x8*)(kb + d0 * 2048 + 512);
        p0 = __builtin_amdgcn_mfma_f32_32x32x16_bf16(b0, qr[d0], p0, 0, 0, 0);
        p1 = __builtin_amdgcn_mfma_f32_32x32x16_bf16(b1, qr[d0], p1, 0, 0, 0);
    }
}
__device__ __forceinline__ void qkt_c(f32x16& p0, f32x16& p1, const LAS unsigned char* Kslot, const bf16x8* qr, int r32, int hi, const f32x16& c) {
    const LAS unsigned char* kb = Kslot + hi * 1024 + r32 * 16;
#pragma unroll
    for (int d0 = 0; d0 < 4; ++d0) {
        const bf16x8 b0 = *(const LAS bf16x8*)(kb + d0 * 2048);
        const bf16x8 b1 = *(const LAS bf16x8*)(kb + d0 * 2048 + 512);
        if (d0 == 0) { p0 = __builtin_amdgcn_mfma_f32_32x32x16_bf16(b0, qr[0], c, 0, 0, 0); p1 = __builtin_amdgcn_mfma_f32_32x32x16_bf16(b1, qr[0], c, 0, 0, 0); }
        else { p0 = __builtin_amdgcn_mfma_f32_32x32x16_bf16(b0, qr[d0], p0, 0, 0, 0); p1 = __builtin_amdgcn_mfma_f32_32x32x16_bf16(b1, qr[d0], p1, 0, 0, 0); }
    }
}
__device__ __forceinline__ void pv(f32x16* o, int vb, bf16x8 pa0, bf16x8 pa1, bf16x8 pa2, bf16x8 pa3) {
#pragma unroll
    for (int d0 = 0; d0 < 2; ++d0) { s16x4 lo[4], hi[4];
#pragma unroll
        for (int ks = 0; ks < 4; ++ks) {
            asm volatile("ds_read_b64_tr_b16 %0,%1 offset:%c2" : "=&v"(lo[ks]) : "v"(vb), "i"(d0 * 4096 + ks * 1024) : "memory");
            asm volatile("ds_read_b64_tr_b16 %0,%1 offset:%c2" : "=&v"(hi[ks]) : "v"(vb), "i"(d0 * 4096 + ks * 1024 + 512) : "memory"); }
        asm volatile("s_waitcnt lgkmcnt(0)" ::: "memory"); __builtin_amdgcn_sched_barrier(0);
#define NSA_PK(k) (bf16x8){lo[k][0], lo[k][1], lo[k][2], lo[k][3], hi[k][0], hi[k][1], hi[k][2], hi[k][3]}
        o[d0] = __builtin_amdgcn_mfma_f32_32x32x16_bf16(pa0, NSA_PK(0), o[d0], 0, 0, 0);
        o[d0] = __builtin_amdgcn_mfma_f32_32x32x16_bf16(pa1, NSA_PK(1), o[d0], 0, 0, 0);
        o[d0] = __builtin_amdgcn_mfma_f32_32x32x16_bf16(pa2, NSA_PK(2), o[d0], 0, 0, 0);
        o[d0] = __builtin_amdgcn_mfma_f32_32x32x16_bf16(pa3, NSA_PK(3), o[d0], 0, 0, 0);
#undef NSA_PK
    }
}
__device__ __forceinline__ void x_fused(f32x16* o, int vb, bf16x8 pa0, bf16x8 pa1, bf16x8 pa2, bf16x8 pa3, f32x16& p0, f32x16& p1, int ka, int qa, const f32x16& c) {
    s16x4 l0[4], h0[4], l1[4], h1[4];
#pragma unroll
    for (int ks = 0; ks < 4; ++ks) {
        asm volatile("ds_read_b64_tr_b16 %0,%1 offset:%c2" : "=&v"(l0[ks]) : "v"(vb), "i"(ks * 1024) : "memory");
        asm volatile("ds_read_b64_tr_b16 %0,%1 offset:%c2" : "=&v"(h0[ks]) : "v"(vb), "i"(ks * 1024 + 512) : "memory"); }
#pragma unroll
    for (int ks = 0; ks < 4; ++ks) {
        asm volatile("ds_read_b64_tr_b16 %0,%1 offset:%c2" : "=&v"(l1[ks]) : "v"(vb), "i"(4096 + ks * 1024) : "memory");
        asm volatile("ds_read_b64_tr_b16 %0,%1 offset:%c2" : "=&v"(h1[ks]) : "v"(vb), "i"(4096 + ks * 1024 + 512) : "memory"); }
    asm volatile("s_waitcnt lgkmcnt(8)" : "+v"(l0[0]), "+v"(l0[1]), "+v"(l0[2]), "+v"(l0[3]), "+v"(h0[0]), "+v"(h0[1]), "+v"(h0[2]), "+v"(h0[3]) :: "memory"); __builtin_amdgcn_sched_barrier(0);
#define NSA_PK2(l, h, k) (bf16x8){l[k][0], l[k][1], l[k][2], l[k][3], h[k][0], h[k][1], h[k][2], h[k][3]}
    o[0] = __builtin_amdgcn_mfma_f32_32x32x16_bf16(pa0, NSA_PK2(l0, h0, 0), o[0], 0, 0, 0);
    o[0] = __builtin_amdgcn_mfma_f32_32x32x16_bf16(pa1, NSA_PK2(l0, h0, 1), o[0], 0, 0, 0);
    o[0] = __builtin_amdgcn_mfma_f32_32x32x16_bf16(pa2, NSA_PK2(l0, h0, 2), o[0], 0, 0, 0);
    o[0] = __builtin_amdgcn_mfma_f32_32x32x16_bf16(pa3, NSA_PK2(l0, h0, 3), o[0], 0, 0, 0);
    __builtin_amdgcn_sched_barrier(0);
    bf16x8 b0[4], b1[4], qr[4];
#define NSA_RDK(d0) do { asm volatile("ds_read_b128 %0,%1 offset:%c2" : "=&v"(b0[d0]) : "v"(ka), "i"((d0) * 2048) : "memory"); \
                         asm volatile("ds_read_b128 %0,%1 offset:%c2" : "=&v"(b1[d0]) : "v"(ka), "i"((d0) * 2048 + 512) : "memory"); \
                         asm volatile("ds_read_b128 %0,%1 offset:%c2" : "=&v"(qr[d0]) : "v"(qa), "i"((d0) * 1024) : "memory"); } while (0)
    NSA_RDK(0); NSA_RDK(1);
    asm volatile("s_waitcnt lgkmcnt(6)" : "+v"(l1[0]), "+v"(l1[1]), "+v"(l1[2]), "+v"(l1[3]), "+v"(h1[0]), "+v"(h1[1]), "+v"(h1[2]), "+v"(h1[3]) :: "memory"); __builtin_amdgcn_sched_barrier(0);
    o[1] = __builtin_amdgcn_mfma_f32_32x32x16_bf16(pa0, NSA_PK2(l1, h1, 0), o[1], 0, 0, 0);
    o[1] = __builtin_amdgcn_mfma_f32_32x32x16_bf16(pa1, NSA_PK2(l1, h1, 1), o[1], 0, 0, 0);
    o[1] = __builtin_amdgcn_mfma_f32_32x32x16_bf16(pa2, NSA_PK2(l1, h1, 2), o[1], 0, 0, 0);
    o[1] = __builtin_amdgcn_mfma_f32_32x32x16_bf16(pa3, NSA_PK2(l1, h1, 3), o[1], 0, 0, 0);
#undef NSA_PK2
    __builtin_amdgcn_sched_barrier(0);
    NSA_RDK(2); NSA_RDK(3);
#undef NSA_RDK
    asm volatile("s_waitcnt lgkmcnt(9)" : "+v"(b0[0]), "+v"(b1[0]), "+v"(qr[0]) :: "memory"); __builtin_amdgcn_sched_barrier(0);
    p0 = __builtin_amdgcn_mfma_f32_32x32x16_bf16(b0[0], qr[0], c, 0, 0, 0); p1 = __builtin_amdgcn_mfma_f32_32x32x16_bf16(b1[0], qr[0], c, 0, 0, 0);
    asm volatile("s_waitcnt lgkmcnt(6)" : "+v"(b0[1]), "+v"(b1[1]), "+v"(qr[1]) :: "memory"); __builtin_amdgcn_sched_barrier(0);
    p0 = __builtin_amdgcn_mfma_f32_32x32x16_bf16(b0[1], qr[1], p0, 0, 0, 0); p1 = __builtin_amdgcn_mfma_f32_32x32x16_bf16(b1[1], qr[1], p1, 0, 0, 0);
    asm volatile("s_waitcnt lgkmcnt(3)" : "+v"(b0[2]), "+v"(b1[2]), "+v"(qr[2]) :: "memory"); __builtin_amdgcn_sched_barrier(0);
    p0 = __builtin_amdgcn_mfma_f32_32x32x16_bf16(b0[2], qr[2], p0, 0, 0, 0); p1 = __builtin_amdgcn_mfma_f32_32x32x16_bf16(b1[2], qr[2], p1, 0, 0, 0);
    asm volatile("s_waitcnt lgkmcnt(0)" : "+v"(b0[3]), "+v"(b1[3]), "+v"(qr[3]) :: "memory"); __builtin_amdgcn_sched_barrier(0);
    p0 = __builtin_amdgcn_mfma_f32_32x32x16_bf16(b0[3], qr[3], p0, 0, 0, 0); p1 = __builtin_amdgcn_mfma_f32_32x32x16_bf16(b1[3], qr[3], p1, 0, 0, 0);
}
__device__ __forceinline__ void mask_tile(f32x16& p0, f32x16& p1, int lo, int hi_, int hi) {
    int lo2 = lo - 4 * hi, hi2 = hi_ - 4 * hi; asm volatile("" : "+v"(lo2), "+v"(hi2));
#pragma unroll
    for (int r = 0; r < 16; ++r) { if (ccol(r) < lo2 || ccol(r) > hi2) p0[r] = -INFINITY; if (ccol(r) + 32 < lo2 || ccol(r) + 32 > hi2) p1[r] = -INFINITY; }
}
__device__ __forceinline__ float max3f(float a, float b, float c) { float r; asm("v_max3_f32 %0, %1, %2, %3" : "=v"(r) : "v"(a), "v"(b), "v"(c)); return r; }
__device__ __forceinline__ float tile_max(const f32x16& p0, const f32x16& p1) {
    float a = max3f(p0[0], p0[1], p1[0]), b = max3f(p0[2], p0[3], p1[1]); a = max3f(a, p1[2], p1[3]);
#pragma unroll
    for (int r = 4; r < 16; r += 4) { a = max3f(a, p0[r], p0[r + 1]); b = max3f(b, p0[r + 2], p0[r + 3]); a = max3f(a, p1[r], p1[r + 1]); b = max3f(b, p1[r + 2], p1[r + 3]); }
    float lo, hi; half_swap(max3f(a, b, b), lo, hi); return max3f(lo, hi, hi);
}
__device__ __forceinline__ void pack_p(const f32x16& p0, const f32x16& p1, bf16x8& a0, bf16x8& a1, bf16x8& a2, bf16x8& a3) {
    u32x4 w0, w1, w2, w3;
    w0 = (u32x4){cvtpk(p0[0], p0[1]), cvtpk(p0[2], p0[3]), cvtpk(p0[4], p0[5]), cvtpk(p0[6], p0[7])};
    w1 = (u32x4){cvtpk(p0[8], p0[9]), cvtpk(p0[10], p0[11]), cvtpk(p0[12], p0[13]), cvtpk(p0[14], p0[15])};
    w2 = (u32x4){cvtpk(p1[0], p1[1]), cvtpk(p1[2], p1[3]), cvtpk(p1[4], p1[5]), cvtpk(p1[6], p1[7])};
    w3 = (u32x4){cvtpk(p1[8], p1[9]), cvtpk(p1[10], p1[11]), cvtpk(p1[12], p1[13]), cvtpk(p1[14], p1[15])};
    a0 = __builtin_bit_cast(bf16x8, w0); a1 = __builtin_bit_cast(bf16x8, w1); a2 = __builtin_bit_cast(bf16x8, w2); a3 = __builtin_bit_cast(bf16x8, w3);
}
__device__ __forceinline__ void online_step(f32x16& p0, f32x16& p1, float& m, float& l, f32x16* o, LAS float* wsf, int r32, int hi) {
    const float rm = tile_max(p0, p1);
    const float mn = fmaxf(m, rm), mu = (mn == -INFINITY) ? 0.f : mn;
    const float sc = fast_exp2(m - mu);
    float s = 0.f;
#pragma unroll
    for (int r = 0; r < 16; ++r) { p0[r] = fast_exp2(p0[r] - mu); p1[r] = fast_exp2(p1[r] - mu); s += p0[r] + p1[r]; }
    l = l * sc + s; m = mn;
    if (__any(sc != 1.f)) {
        if (hi == 0) wsf[r32] = sc;
        LDS_WAIT();
#pragma unroll
        for (int r = 0; r < 16; ++r) { const float f = wsf[crow(r, hi)]; o[0][r] *= f; o[1][r] *= f; }
        LDS_WAIT();
    }
}

struct Ptrs { const bf16_t* qraw; const bf16_t* qrot; const bf16_t* kv; const bf16_t* kcmp; const bf16_t* vcmp; const float* gates; bf16_t* ab; };

template <bool WITH_V, class F>
__device__ __forceinline__ void tile_loop(int n, const bf16_t* Kb, const bf16_t* Vb, int row0, LAS unsigned char* lds, int wid, int lane, F&& body) {
    const bf16_t* ksrc = Kb + (size_t)(row0 + lane) * 64 + wid * 8;
    const bf16_t* vsrc = Vb + (size_t)(row0 + 16 * (wid & 3) + (lane >> 2)) * 64 + (wid >> 2) * 32 + (lane & 3) * 8;
#define NSA_ISSUE(i) do { const int sl_ = ((i) & 1) * 8192; \
        __builtin_amdgcn_global_load_lds((const unsigned*)(ksrc + (size_t)(i) * 4096), (LAS unsigned*)(lds + L_K + sl_ + wid * 1024), 16, 0, 0); \
        if (WITH_V) __builtin_amdgcn_global_load_lds((const unsigned*)(vsrc + (size_t)(i) * 4096), (LAS unsigned*)(lds + L_V + sl_ + wid * 1024), 16, 0, 0); } while (0)
    NSA_ISSUE(0);
    for (int i = 0; i < n; ++i) {
        VM_WAIT(); __syncthreads();
        if (i + 1 < n) NSA_ISSUE(i + 1);
        body(i, (i & 1) * 8192);
    }
    __syncthreads();
#undef NSA_ISSUE
}

template <int MODE>
__device__ __forceinline__ void branch_pipe(int n, const bf16_t* Kb, const bf16_t* Vb, int row0, LAS unsigned char* lds, int wid, int lane, int r32, int hi, int qa,
                                            unsigned long long sel, int tl, int qt, int kt0, float gate, LAS float* otl, LAS float* wsf, int vb0, float zero_) {
    const int half = wid >> 2;
    const bf16_t* ksrc = Kb + (size_t)(row0 + lane) * 64 + wid * 8;
    const bf16_t* vsrc = Vb + (size_t)(row0 + 16 * (wid & 3) + (lane >> 2)) * 64 + (wid >> 2) * 32 + (lane & 3) * 8;
#define BP_ISSUE_K(i, slot) __builtin_amdgcn_global_load_lds((const unsigned*)(ksrc + (size_t)(i) * 4096), (LAS unsigned*)(lds + L_K + (slot) + wid * 1024), 16, 0, 0)
#define BP_ISSUE_V(i, slot) __builtin_amdgcn_global_load_lds((const unsigned*)(vsrc + (size_t)(i) * 4096), (LAS unsigned*)(lds + L_V + (slot) + wid * 1024), 16, 0, 0)
#define BP_NEXT(s) ((s) == 16384 ? 0 : (s) + 8192)
#define BP_WAIT(c) do { if ((c) == 2) asm volatile("s_waitcnt vmcnt(2)" ::: "memory"); else if ((c) == 1) asm volatile("s_waitcnt vmcnt(1)" ::: "memory"); else asm volatile("s_waitcnt vmcnt(0)" ::: "memory"); } while (0)
#define BP_BAR() asm volatile("s_waitcnt lgkmcnt(0)\n\ts_barrier" ::: "memory")
    f32x16 o[2], p0, p1;
#pragma unroll
    for (int r = 0; r < 16; ++r) { o[0][r] = zero_; o[1][r] = zero_; p0[r] = zero_; p1[r] = zero_; }
    bf16x8 a0 = {0, 0, 0, 0, 0, 0, 0, 0}, a1 = a0, a2 = a0, a3 = a0;
    constexpr float THR = 8.f;
    f32x16 negm;
#pragma unroll
    for (int r = 0; r < 16; ++r) negm[r] = zero_;
    float mref = 0.f, l = 0.f; bool resc = false;
    const int kb0 = (int)(unsigned)(uintptr_t)(lds + L_K) + hi * 1024 + r32 * 16;
    BP_ISSUE_K(0, 0); if (n > 1) BP_ISSUE_K(1, 8192); BP_ISSUE_V(0, 0); VM_WAIT(); BP_BAR();
    int s0 = 0, sm1 = 16384;
    auto X = [&](int i) {
        if (i > 0) {
            if (resc) {
#pragma unroll
                for (int r = 0; r < 16; ++r) { const float f = (wsf + 4 * hi)[ccol(r)]; o[0][r] *= f; o[1][r] *= f; }
                LDS_WAIT(); }
            if (i < n) { x_fused(o, vb0 + sm1, a0, a1, a2, a3, p0, p1, kb0 + s0, qa, negm); return; }
            pv(o, vb0 + sm1, a0, a1, a2, a3);
        }
        if (i < n) { bf16x8 q4[4];
#pragma unroll
            for (int d0 = 0; d0 < 4; ++d0) q4[d0] = *(const LAS bf16x8*)(lds + L_OST + wid * 4096 + d0 * 1024 + lane * 16);
            qkt_c(p0, p1, lds + L_K + s0, q4, r32, hi, negm); }
    };
    auto Y = [&](int i) {
        int lo = 0, hi_ = 63; bool rowsel = true;
        if (MODE == 2) { rowsel = ((sel >> i) & 1ull) != 0; if (i == qt) hi_ = tl; }
        else { const int kt = kt0 + i; if (kt == qt - 8) lo = tl + 1; if (kt == qt) hi_ = tl; }
        if (!__all(lo <= 0 && hi_ >= 63)) mask_tile(p0, p1, lo, hi_, hi);
        else asm volatile("s_nop 15\n\ts_nop 7" : "+v"(p0), "+v"(p1));
        float rm = tile_max(p0, p1); if (!rowsel) rm = -INFINITY;
        resc = __any(rm > THR) != 0;
        if (resc) {
            const float dl = fmaxf(rm, 0.f); mref += dl;
#pragma unroll
            for (int r = 0; r < 16; ++r) { p0[r] -= dl; p1[r] -= dl; negm[r] = -mref; }
            const float f = fast_exp2(-dl); l *= f; if (hi == 0) wsf[r32] = f;
        }
        float sum = 0.f;
#pragma unroll
        for (int r = 0; r < 16; ++r) { p0[r] = fast_exp2(p0[r]); p1[r] = fast_exp2(p1[r]); sum += p0[r] + p1[r]; }
        l += rowsel ? sum : 0.f;
        pack_p(p0, p1, a0, a1, a2, a3);
        if (MODE == 2 && !rowsel) { const bf16x8 zz = {0, 0, 0, 0, 0, 0, 0, 0}; a0 = zz; a1 = zz; a2 = zz; a3 = zz; }
    };
    if (half == 0) {
        for (int j = 0; j <= n; ++j) {
            const int s1 = BP_NEXT(s0); int c = 0; if (j + 2 < n) { BP_ISSUE_K(j + 2, sm1); ++c; } if (j + 1 < n) { BP_ISSUE_V(j + 1, s1); ++c; }
            X(j); BP_BAR();
            if (j < n) Y(j);
            BP_WAIT(c); BP_BAR();
            sm1 = s0; s0 = s1;
        }
    } else {
        for (int j = 0; j <= n; ++j) {
            const int s1 = BP_NEXT(s0); int c = 0; if (j + 2 < n) { BP_ISSUE_K(j + 2, sm1); ++c; } if (j + 1 < n) { BP_ISSUE_V(j + 1, s1); ++c; }
            if (j > 0) Y(j - 1);
            BP_BAR();
            X(j);
            BP_WAIT(c); BP_BAR();
            sm1 = s0; s0 = s1;
        }
    }
#undef BP_WAIT
#undef BP_NEXT
    l = xor32_sum(l);
    if (hi == 0) wsf[r32] = l > 0.f ? gate / l : 0.f;
    LDS_WAIT();
#pragma unroll
    for (int r = 0; r < 16; ++r) { const float f = (wsf + 4 * hi)[ccol(r)]; otl[r * 64] += o[0][r] * f; otl[(16 + r) * 64] += o[1][r] * f; }
    LDS_WAIT();
#undef BP_ISSUE_K
#undef BP_ISSUE_V
#undef BP_BAR
}

__device__ __forceinline__ void unit(const Ptrs& P, int b, int g, int qt, LAS unsigned char* lds, int tid_in) {
    int tid_ = tid_in; asm volatile("" : "+v"(tid_));
    const int tid = tid_, lane = tid & 63, r32 = lane & 31, hi = lane >> 5; const int wid = __builtin_amdgcn_readfirstlane(tid >> 6);
    const int bg = b * 2 + g;
    const int tl = 8 * wid + (r32 >> 2), hr = r32 & 3;
    const int tpos = 64 * qt + tl;
    const size_t tok = (size_t)b * SEQ + tpos;
    LAS float* wsf = (LAS float*)(lds + L_WSF) + wid * 64;
    LAS float* pcs = (LAS float*)(lds + L_PCS);
    LAS unsigned long long* selm = (LAS unsigned long long*)(lds + L_SEL);
    const int vb0 = (int)(unsigned)(uintptr_t)(lds + L_V) + ((lane >> 4) & 1) * 32 + (lane & 3) * 8 + (4 * hi + ((lane & 15) >> 2)) * 64;
    const float* gp = P.gates + tok * 24 + (g * 4 + hr) * 3;
    const float g0 = gp[0], g1 = gp[1], g2 = gp[2];
    float zero_ = 0.f; asm volatile("" : "+v"(zero_));
    f32x16 ot[2];
#pragma unroll
    for (int r = 0; r < 16; ++r) { ot[0][r] = zero_; ot[1][r] = zero_; }
    bf16x8 qr[4];
    const size_t qoff = ((size_t)bg * SEQ + 64 * qt) * 256 + (size_t)(wid * 32 + r32) * 64 + hi * 8;
#pragma unroll
    for (int d0 = 0; d0 < 4; ++d0) qr[d0] = *(const bf16x8*)(P.qraw + qoff + d0 * 16);

    const int nv = tpos >= 15 ? ((tpos - 15) >> 4) : 0;
    const int nct = (4 * qt + 3 + 63) >> 6;
    const bf16_t* kc = P.kcmp + (size_t)bg * 256 * 64; const bf16_t* vc = P.vcmp + (size_t)bg * 256 * 64;
    float mc = -INFINITY, lc = 0.f;
    tile_loop<false>(nct, kc, vc, 0, lds, wid, lane, [&](int i, int sl) {
        f32x16 p0, p1; qkt(p0, p1, lds + L_K + sl, qr, r32, hi, zero_);
        mask_tile(p0, p1, 0, nv - 64 * i - 1, hi);
        const float rm = tile_max(p0, p1); const float mn = fmaxf(mc, rm), mu = (mn == -INFINITY) ? 0.f : mn;
        float s = 0.f;
#pragma unroll
        for (int r = 0; r < 16; ++r) s += fast_exp2(p0[r] - mu) + fast_exp2(p1[r] - mu);
        lc = lc * fast_exp2(mc - mu) + s; mc = mn;
    });
    lc = xor32_sum(lc);
    {
        const float mu = (mc == -INFINITY) ? 0.f : mc, inv = lc > 0.f ? 1.f / lc : 0.f;
        tile_loop<true>(nct, kc, vc, 0, lds, wid, lane, [&](int i, int sl) {
            f32x16 p0, p1; qkt(p0, p1, lds + L_K + sl, qr, r32, hi, zero_);
            mask_tile(p0, p1, 0, nv - 64 * i - 1, hi);
#pragma unroll
            for (int r = 0; r < 16; ++r) { p0[r] = fast_exp2(p0[r] - mu) * inv; p1[r] = fast_exp2(p1[r] - mu) * inv; }
#pragma unroll
            for (int r = 0; r < 16; ++r) {
                float a = p0[r], c = p1[r];
                a += xor_get<1>(a); a += xor_get<2>(a); c += xor_get<1>(c); c += xor_get<2>(c);
                if (hr == 0) { LAS float* pw = pcs + tl * 256 + 64 * i + 4 * hi; pw[ccol(r)] = a; pw[32 + ccol(r)] = c; }
            }
#pragma unroll
            for (int r = 0; r < 16; ++r) { p0[r] *= g0; p1[r] *= g0; }
            bf16x8 a0, a1, a2, a3; pack_p(p0, p1, a0, a1, a2, a3);
            pv(ot, vb0 + sl, a0, a1, a2, a3);
        });
    }
    LDS_WAIT(); __syncthreads();
    if (qt < 16) { if (lane < 8) selm[8 * wid + lane] = (2ull << qt) - 1ull; }
    else {
        unsigned key[8], T[8];
#pragma unroll
        for (int k = 0; k < 8; ++k) { const LAS float* pr = pcs + (8 * wid + k) * 256; key[k] = 0u; T[k] = 0u;
            if (lane <= qt) { float imp = 0.f;
#pragma unroll
                for (int j = -1; j < 4; ++j) { const int c = 4 * lane + j; if (c >= 0 && c < 255) imp += pr[c]; }
                key[k] = __builtin_bit_cast(unsigned, (lane == 0 || lane == qt || lane == qt - 1) ? INFINITY : imp) + 1u; } }
#pragma unroll
        for (int bit = 30; bit >= 0; --bit)
#pragma unroll
            for (int k = 0; k < 8; ++k) { const unsigned cand = T[k] | (1u << bit); int cnt; asm("s_bcnt1_i32_b64 %0, %1" : "=s"(cnt) : "s"(__ballot(key[k] >= cand)) : "scc");
                T[k] = cnt >= 16 ? cand : T[k]; }
#pragma unroll
        for (int k = 0; k < 8; ++k) {
            const unsigned long long eq = __ballot(key[k] == T[k]);
            const int need = 16 - __popcll(__ballot(key[k] > T[k])), below = __popcll(eq & ((1ull << lane) - 1ull));
            const unsigned long long mk = __ballot(key[k] > T[k] || (key[k] == T[k] && below < need));
            if (lane == 0) selm[8 * wid + k] = mk; }
    }
    LDS_WAIT(); __syncthreads();
    const unsigned long long sel = selm[tl];
    LAS float* otl = (LAS float*)(lds + L_PCS) + wid * 2048 + lane;
#pragma unroll
    for (int r = 0; r < 16; ++r) { otl[r * 64] = ot[0][r]; otl[(16 + r) * 64] = ot[1][r]; }
    LDS_WAIT();
#pragma unroll
    for (int d0 = 0; d0 < 4; ++d0) *(LAS bf16x8*)(lds + L_OST + wid * 4096 + d0 * 1024 + lane * 16) = *(const bf16x8*)(P.qrot + qoff + d0 * 16);
    LDS_WAIT();
    const int qa = (int)(unsigned)(uintptr_t)(lds + L_OST) + wid * 4096 + lane * 16;
    branch_pipe<2>(qt + 1, P.kv + 2 * KVSZ + (size_t)bg * SEQ * 64, P.kv + 3 * KVSZ + (size_t)bg * SEQ * 64, 0, lds, wid, lane, r32, hi, qa, sel, tl, qt, 0, g1, otl, wsf, vb0, zero_);
    { const int k0 = qt >= 8 ? qt - 8 : 0;
      branch_pipe<3>(qt - k0 + 1, P.kv + 4 * KVSZ + (size_t)bg * SEQ * 64, P.kv + 5 * KVSZ + (size_t)bg * SEQ * 64, 64 * k0, lds, wid, lane, r32, hi, qa, sel, tl, qt, k0, g2, otl, wsf, vb0, zero_); }
    {
        LAS bf16_t* stg = (LAS bf16_t*)(lds + L_OST) + wid * 2048;
#pragma unroll
        for (int r = 0; r < 16; ++r) {
#pragma unroll
            for (int d0 = 0; d0 < 2; ++d0) (stg + 4 * hi * 64 + r32)[ccol(r) * 64 + d0 * 32] = (bf16_t)f2bf(otl[(d0 * 16 + r) * 64]); }
        LDS_WAIT();
#pragma unroll
        for (int it = 0; it < 4; ++it) { const int row = it * 8 + (lane >> 3), ch = lane & 7; const u32x4 v = *(const LAS u32x4*)(stg + row * 64 + ch * 8);
            bf16_t* dst = P.ab + ((size_t)b * SEQ + 64 * qt + 8 * wid + (row >> 2)) * 1024 + g * 256 + (row & 3) * 64 + ch * 8;
            *(u32x4*)dst = v; }
        LDS_WAIT();
    }
    __syncthreads();
}

__device__ __forceinline__ void xattn_unit(const bf16_t* Q, const bf16_t* Kx, const bf16_t* Vx, bf16_t* O, int pm, int h, LAS unsigned char* lds, int tid_in) {
    int tid_ = tid_in; asm volatile("" : "+v"(tid_));
    const int tid = tid_, lane = tid & 63, r32 = lane & 31, hi = lane >> 5; const int wid = __builtin_amdgcn_readfirstlane(tid >> 6);
    constexpr int XK = 0, XV = 65536, SL = 32768;
    const int b = pm >> 4;
    const bf16_t* kbase = Kx + ((size_t)b * 256 + lane) * 1024 + h * 256 + wid * 32;
    const bf16_t* vbase = Vx + ((size_t)b * 256 + (lane >> 2)) * 1024 + h * 256 + wid * 32 + (lane & 3) * 8;
#define XA_ISSUE_K(t) do { _Pragma("unroll") for (int i_ = 0; i_ < 4; ++i_) __builtin_amdgcn_global_load_lds((const unsigned*)(kbase + (size_t)(t) * 64 * 1024 + 8 * i_), \
        (LAS unsigned*)(lds + XK + ((t) & 1) * SL + (wid * 4 + i_) * 1024), 16, 0, 0); } while (0)
#define XA_ISSUE_V(t) do { _Pragma("unroll") for (int i_ = 0; i_ < 4; ++i_) __builtin_amdgcn_global_load_lds((const unsigned*)(vbase + ((size_t)(t) * 64 + 16 * i_) * 1024), \
        (LAS unsigned*)(lds + XV + ((t) & 1) * SL + (wid * 4 + i_) * 1024), 16, 0, 0); } while (0)
#define XA_BAR() asm volatile("s_waitcnt lgkmcnt(0)\n\ts_barrier" ::: "memory")
    XA_ISSUE_K(0); XA_ISSUE_K(1); XA_ISSUE_V(0); XA_ISSUE_V(1);
    bf16x8 qr[16];
    { const bf16_t* qp = Q + (size_t)(pm * 256 + wid * 32 + r32) * 1024 + h * 256 + hi * 8;
#pragma unroll
      for (int d0 = 0; d0 < 16; ++d0) qr[d0] = *(const bf16x8*)(qp + d0 * 16); }
    float zero_ = 0.f; asm volatile("" : "+v"(zero_));
    f32x16 p[4][2];
#pragma unroll
    for (int t = 0; t < 4; ++t) {
        if (t != 1) asm volatile("s_waitcnt vmcnt(0)" ::: "memory");
        XA_BAR();
        if (t == 1) XA_ISSUE_K(2);
        if (t == 2) XA_ISSUE_K(3);
#if XDIAG
        asm volatile("s_waitcnt vmcnt(0)" ::: "memory"); XA_BAR();
#endif
        const LAS unsigned char* kb = lds + XK + (t & 1) * SL + hi * 1024 + r32 * 16;
#pragma unroll
        for (int r = 0; r < 16; ++r) { p[t][0][r] = zero_; p[t][1][r] = zero_; }
#pragma unroll
        for (int d0 = 0; d0 < 16; ++d0) {
            const bf16x8 k0 = *(const LAS bf16x8*)(kb + d0 * 2048), k1 = *(const LAS bf16x8*)(kb + d0 * 2048 + 512);
            p[t][0] = __builtin_amdgcn_mfma_f32_32x32x16_bf16(k0, qr[d0], p[t][0], 0, 0, 0);
            p[t][1] = __builtin_amdgcn_mfma_f32_32x32x16_bf16(k1, qr[d0], p[t][1], 0, 0, 0);
        }
    }
    asm volatile("s_nop 15\n\ts_nop 7" : "+v"(p[0][0]), "+v"(p[0][1]), "+v"(p[1][0]), "+v"(p[1][1]), "+v"(p[2][0]), "+v"(p[2][1]), "+v"(p[3][0]), "+v"(p[3][1]));
    float mx = -INFINITY;
#pragma unroll
    for (int t = 0; t < 4; ++t) mx = fmaxf(mx, tile_max(p[t][0], p[t][1]));
    float sum = 0.f;
#pragma unroll
    for (int t = 0; t < 4; ++t)
#pragma unroll
        for (int r = 0; r < 16; ++r) { p[t][0][r] = fast_exp2((p[t][0][r] - mx) * CX); p[t][1][r] = fast_exp2((p[t][1][r] - mx) * CX); sum += p[t][0][r] + p[t][1][r]; }
    sum = xor32_sum(sum);
    const float inv = 1.f / sum;
    bf16x8 pa[4][4];
#pragma unroll
    for (int t = 0; t < 4; ++t) {
#pragma unroll
        for (int r = 0; r < 16; ++r) { p[t][0][r] *= inv; p[t][1][r] *= inv; }
        pack_p(p[t][0], p[t][1], pa[t][0], pa[t][1], pa[t][2], pa[t][3]); }
#if XMODE == 1
    { XA_BAR(); asm volatile("s_waitcnt vmcnt(0)" ::: "memory"); XA_BAR();
      bf16_t* dst = O + (size_t)(pm * 256 + wid * 32 + (lane & 31)) * 1024 + h * 256 + (lane >> 5) * 128;
#pragma unroll
      for (int t = 0; t < 4; ++t)
#pragma unroll
          for (int k = 0; k < 4; ++k) *(bf16x8*)(dst + (t * 4 + k) * 8) = pa[t][k];
      XA_BAR(); return; }
#endif
    f32x16 o[8];
#pragma unroll
    for (int d = 0; d < 8; ++d)
#pragma unroll
        for (int r = 0; r < 16; ++r) o[d][r] = zero_;
    const int vb0 = (int)(unsigned)(uintptr_t)(lds + XV) + ((lane >> 4) & 1) * 32 + (lane & 3) * 8 + (4 * hi + ((lane & 15) >> 2)) * 64;
#pragma unroll
    for (int t = 0; t < 4; ++t) {
        if (t >= 2) asm volatile("s_waitcnt vmcnt(0)" ::: "memory");
        XA_BAR();
        if (t == 1) XA_ISSUE_V(2);
        if (t == 2) XA_ISSUE_V(3);
#if XDIAG
        asm volatile("s_waitcnt vmcnt(0)" ::: "memory"); XA_BAR();
#endif
        const int vb = vb0 + (t & 1) * SL;
#pragma unroll
        for (int d = 0; d < 8; ++d) { s16x4 lo[4], hh[4];
#pragma unroll
            for (int ks = 0; ks < 4; ++ks) {
                asm volatile("ds_read_b64_tr_b16 %0,%1 offset:%c2" : "=&v"(lo[ks]) : "v"(vb), "i"(d * 4096 + ks * 1024) : "memory");
                asm volatile("ds_read_b64_tr_b16 %0,%1 offset:%c2" : "=&v"(hh[ks]) : "v"(vb), "i"(d * 4096 + ks * 1024 + 512) : "memory"); }
            asm volatile("s_waitcnt lgkmcnt(0)" ::: "memory"); __builtin_amdgcn_sched_barrier(0);
#define XA_PK(k) (bf16x8){lo[k][0], lo[k][1], lo[k][2], lo[k][3], hh[k][0], hh[k][1], hh[k][2], hh[k][3]}
            o[d] = __builtin_amdgcn_mfma_f32_32x32x16_bf16(pa[t][0], XA_PK(0), o[d], 0, 0, 0);
            o[d] = __builtin_amdgcn_mfma_f32_32x32x16_bf16(pa[t][1], XA_PK(1), o[d], 0, 0, 0);
            o[d] = __builtin_amdgcn_mfma_f32_32x32x16_bf16(pa[t][2], XA_PK(2), o[d], 0, 0, 0);
            o[d] = __builtin_amdgcn_mfma_f32_32x32x16_bf16(pa[t][3], XA_PK(3), o[d], 0, 0, 0);
#undef XA_PK
        }
    }
    XA_BAR();
    {   LAS bf16_t* stg = (LAS bf16_t*)(lds + wid * 16384);
#pragma unroll
        for (int d = 0; d < 8; ++d)
#pragma unroll
            for (int r = 0; r < 16; ++r) stg[crow(r, hi) * 256 + d * 32 + r32] = (bf16_t)f2bf(o[d][r]);
        LDS_WAIT();
#pragma unroll
        for (int it = 0; it < 16; ++it) { const int row = it * 2 + (lane >> 5), ch = lane & 31; const u32x4 v = *(const LAS u32x4*)(stg + row * 256 + ch * 8);
            *(u32x4*)(O + (size_t)(pm * 256 + wid * 32 + row) * 1024 + h * 256 + ch * 8) = v; }
        LDS_WAIT();
    }
    XA_BAR();
#undef XA_ISSUE_K
#undef XA_ISSUE_V
#undef XA_BAR
}
}

#define XB_TMO      128
#define XB_XCNT(j)  (256  + 64 * (j))
#define XB_XSUB(j)  (1280 + 64 * (j))
#define XB_XGEN(j)  (2304 + 64 * (j))
#define XB_TOP      3328
#define XB_TOPGEN   3392
#define XCD_BAR_WORDS 3456
#define XB_SPIN_CAP (1u << 18)
__device__ __forceinline__ unsigned xb_ld(unsigned* p)              { return __hip_atomic_load(p, __ATOMIC_RELAXED, __HIP_MEMORY_SCOPE_AGENT); }
__device__ __forceinline__ unsigned xb_add(unsigned* p, unsigned v) { return __hip_atomic_fetch_add(p, v, __ATOMIC_RELAXED, __HIP_MEMORY_SCOPE_AGENT); }
__device__ __forceinline__ unsigned xb_xcc_id() { return (unsigned)__builtin_amdgcn_s_getreg((3 << 11) | 20) & 0xFu; }
#define XB_SPIN(cond, bar) do { unsigned _sp = 0; while (cond) { __builtin_amdgcn_s_sleep(1); \
    if ((++_sp & 255u) == 0u) { if (xb_ld(&(bar)[XB_TMO])) break; if (_sp > XB_SPIN_CAP) { atomicAdd(&(bar)[XB_TMO], 1u); break; } } } } while (0)
struct XcdBarrier { unsigned* bar; unsigned x; volatile LAS unsigned* st; };
__device__ __forceinline__ XcdBarrier xcd_barrier_post(unsigned* bar, volatile LAS unsigned* st) {
    XcdBarrier b; b.bar = bar; b.x = xb_xcc_id(); b.st = st;
    if (threadIdx.x == 0) (void)xb_add(&bar[XB_XCNT(b.x)], 1u);
    return b;
}
__device__ __forceinline__ void xcd_barrier_complete(unsigned* bar, unsigned x, unsigned& nloc, unsigned& nx) {
    const unsigned G = gridDim.x * gridDim.y * gridDim.z;
    unsigned sum, cnt, mine, sp = 0u;
    for (;;) {
        sum = 0u; cnt = 0u; mine = 0u;
#pragma unroll
        for (unsigned j = 0; j < 16; ++j) { const unsigned c = xb_ld(&bar[XB_XCNT(j)]); sum += c; cnt += (c > 0u) ? 1u : 0u; mine = (j == x) ? c : mine; }
        if (sum == G) break;
        __builtin_amdgcn_s_sleep(1);
        if ((++sp & 255u) == 0u) { if (xb_ld(&bar[XB_TMO])) break; if (sp > XB_SPIN_CAP) { atomicAdd(&bar[XB_TMO], 1u); break; } }
    }
    nloc = mine > 0u ? mine : 1u; nx = cnt > 0u ? cnt : 1u;
}
__device__ __forceinline__ void xcd_barrier(const XcdBarrier& b, int tid) {
    asm volatile("s_waitcnt vmcnt(0)" ::: "memory");
    __syncthreads();
    if (tid == 0) {
        unsigned* bar = b.bar;
        __builtin_amdgcn_s_waitcnt(0);
        unsigned nloc = b.st[0], nx = b.st[1];
        if (nloc == 0u) { xcd_barrier_complete(bar, b.x, nloc, nx); b.st[0] = nloc; b.st[1] = nx; }
        const unsigned old = xb_add(&bar[XB_XSUB(b.x)], 1u);
        const unsigned gen = old / nloc;
        if (old + 1u == (gen + 1u) * nloc) {
            __builtin_amdgcn_fence(__ATOMIC_RELEASE, "agent");
            asm volatile("s_waitcnt vmcnt(0)" ::: "memory");
            const unsigned og = xb_add(&bar[XB_TOP], 1u);
            const unsigned tg = og / nx;
            if (og + 1u == (tg + 1u) * nx) xb_add(&bar[XB_TOPGEN], 1u);
            else XB_SPIN(xb_ld(&bar[XB_TOPGEN]) == tg, bar);
            __builtin_amdgcn_fence(__ATOMIC_ACQUIRE, "agent");
            xb_add(&bar[XB_XGEN(b.x)], 1u);
            asm volatile("s_waitcnt vmcnt(0)" ::: "memory");
        } else {
            XB_SPIN(xb_ld(&bar[XB_XGEN(b.x)]) == gen, bar);
            __builtin_amdgcn_fence(__ATOMIC_ACQUIRE, "agent");
            asm volatile("s_waitcnt vmcnt(0)" ::: "memory");
        }
    }
    __syncthreads();
}

__device__ __forceinline__ void xpose_item(const float* W, int ldw, int k0, int n0, int ncv, bf16_t* WT, int ldt, int dr0, LAS float* scr, int lane, const float* gain = nullptr) {
    const int c = lane & 31;
#pragma unroll 8
    for (int i = 0; i < 32; ++i) { const int kk = 2 * i + (lane >> 5); scr[kk * 33 + c] = c < ncv ? W[(size_t)(k0 + kk) * ldw + n0 + c] * (gain ? gain[k0 + kk] : 1.f) : 0.f; }
    LDS_WAIT(); asm volatile("" ::: "memory");
    const int c8 = lane & 7;
#pragma unroll
    for (int j = 0; j < 4; ++j) { const int n = (lane >> 3) + 8 * j; const LAS float* s = scr + (8 * c8) * 33 + n;
        u32x4 o; o.x = pk2(s[0 * 33], s[1 * 33]); o.y = pk2(s[2 * 33], s[3 * 33]); o.z = pk2(s[4 * 33], s[5 * 33]); o.w = pk2(s[6 * 33], s[7 * 33]);
        *(u32x4*)(WT + (size_t)(dr0 + n) * ldt + k0 + 8 * c8) = o; }
    LDS_WAIT(); asm volatile("" ::: "memory");
}
__device__ __forceinline__ void xpose_item64(const float* W, int ldw, int k0, int n0, bf16_t* WT, int ldt, int dr0, LAS float* scr, int lane, const float* gain) {
    const int c4 = lane & 15, r4 = lane >> 4;
    f32x4 v[16];
#pragma unroll
    for (int i = 0; i < 16; ++i) v[i] = *(const f32x4*)(W + (size_t)(k0 + 4 * i + r4) * ldw + n0 + 4 * c4);
    if (gain) {
#pragma unroll
        for (int i = 0; i < 16; ++i) v[i] = v[i] * gain[k0 + 4 * i + r4]; }
#pragma unroll
    for (int i = 0; i < 16; ++i) { LAS float* d = scr + (4 * i + r4) * 65 + 4 * c4; d[0] = v[i].x; d[1] = v[i].y; d[2] = v[i].z; d[3] = v[i].w; }
    LDS_WAIT(); asm volatile("" ::: "memory");
    const int c8 = lane & 7;
#pragma unroll
    for (int j = 0; j < 8; ++j) { const int n = (lane >> 3) + 8 * j; const LAS float* s = scr + (8 * c8) * 65 + n;
        u32x4 o; o.x = pk2(s[0 * 65], s[1 * 65]); o.y = pk2(s[2 * 65], s[3 * 65]); o.z = pk2(s[4 * 65], s[5 * 65]); o.w = pk2(s[6 * 65], s[7 * 65]);
        *(u32x4*)(WT + (size_t)(dr0 + n) * ldt + k0 + 8 * c8) = o; }
    LDS_WAIT(); asm volatile("" ::: "memory");
}
__device__ __forceinline__ void xpose_load64(const float* W, int ldw, int k0, int n0, int lane, f32x4 (&v)[16]) {
    const int c4 = lane & 15, r4 = lane >> 4;
#pragma unroll
    for (int i = 0; i < 16; ++i) v[i] = *(const f32x4*)(W + (size_t)(k0 + 4 * i + r4) * ldw + n0 + 4 * c4);
}
__device__ __forceinline__ void xpose_store64(const f32x4 (&v)[16], int k0, bf16_t* WT, int ldt, int dr0, LAS float* scr, int lane) {
    const int c4 = lane & 15, r4 = lane >> 4;
#pragma unroll
    for (int i = 0; i < 16; ++i) { LAS float* d = scr + (4 * i + r4) * 65 + 4 * c4; d[0] = v[i].x; d[1] = v[i].y; d[2] = v[i].z; d[3] = v[i].w; }
    LDS_WAIT(); asm volatile("" ::: "memory");
    const int c8 = lane & 7;
#pragma unroll
    for (int j = 0; j < 8; ++j) { const int n = (lane >> 3) + 8 * j; const LAS float* s = scr + (8 * c8) * 65 + n;
        u32x4 o; o.x = pk2(s[0 * 65], s[1 * 65]); o.y = pk2(s[2 * 65], s[3 * 65]); o.z = pk2(s[4 * 65], s[5 * 65]); o.w = pk2(s[6 * 65], s[7 * 65]);
        *(u32x4*)(WT + (size_t)(dr0 + n) * ldt + k0 + 8 * c8) = o; }
    LDS_WAIT(); asm volatile("" ::: "memory");
}
__device__ __forceinline__ void xpose_mat(const float* W, int K, int N, bf16_t* WT, int rowmap, int item, LAS float* scr, int lane, const float* gain = nullptr) {
    const int ng = N / 64, kb = item / ng, j = item % ng, n = 64 * j;
    const int dr = rowmap == 0 ? n : (256 * (n >> 7) + (n & 127) + (rowmap == 2 ? 128 : 0));
    xpose_item64(W, N, 64 * kb, n, WT, K, dr, scr, lane, gain);
}
template <int W> __device__ __forceinline__ void pool_run(const bf16_t* ub, bf16_t* ab, int rq, int lane) {
    constexpr int CLS = W == 2 ? 0 : W == 4 ? 1 : W == 8 ? 2 : 3, NR = 15 + W;
    const int t0 = (4 * rq + (lane >> 4)) * 16, t0s = t0 & (SEQ - 1), col = 128 * CLS + 8 * (lane & 15);
    u32x4 R[NR];
#pragma unroll
    for (int j = 0; j < NR; ++j) { R[j] = (u32x4){0u, 0u, 0u, 0u}; if (t0s - (W - 1) + j >= 0) R[j] = *(const u32x4*)(ub + (size_t)(t0 - (W - 1) + j) * 512 + col); }
    float s[8];
#pragma unroll
    for (int e = 0; e < 8; ++e) s[e] = 0.f;
#pragma unroll
    for (int j = 0; j < W - 1; ++j)
#pragma unroll
        for (int e = 0; e < 4; ++e) { s[2 * e] += __builtin_bit_cast(float, R[j][e] << 16); s[2 * e + 1] += __builtin_bit_cast(float, R[j][e] & 0xffff0000u); }
#pragma unroll
    for (int i = 0; i < 16; ++i) {
        float own[8];
#pragma unroll
        for (int e = 0; e < 4; ++e) { own[2 * e] = __builtin_bit_cast(float, R[W - 1 + i][e] << 16); own[2 * e + 1] = __builtin_bit_cast(float, R[W - 1 + i][e] & 0xffff0000u); }
#pragma unroll
        for (int e = 0; e < 8; ++e) s[e] += own[e];
        if (i > 0) {
#pragma unroll
            for (int e = 0; e < 4; ++e) { s[2 * e] -= __builtin_bit_cast(float, R[i - 1][e] << 16); s[2 * e + 1] -= __builtin_bit_cast(float, R[i - 1][e] & 0xffff0000u); } }
        const int n = (t0s + i + 1) < W ? (t0s + i + 1) : W; const float inv = 1.f / (float)n;
        u32x4 o; o.x = pk2(s[0] * inv - own[0], s[1] * inv - own[1]); o.y = pk2(s[2] * inv - own[2], s[3] * inv - own[3]);
        o.z = pk2(s[4] * inv - own[4], s[5] * inv - own[5]); o.w = pk2(s[6] * inv - own[6], s[7] * inv - own[7]);
        *(u32x4*)(ab + (size_t)(t0 + i) * 1024 + 512 + col) = o;
    }
}
__device__ __forceinline__ float row_rs(const float* xrow, int lane, f32x4 (&v)[4]) {
    const f32x4* xr = (const f32x4*)xrow + lane; float s = 0.f;
#pragma unroll
    for (int j = 0; j < 4; ++j) { v[j] = xr[64 * j]; s += (v[j].x * v[j].x + v[j].y * v[j].y) + (v[j].z * v[j].z + v[j].w * v[j].w); }
    return 1.0f / sqrtf(wave_sum(s) * (1.f / DM) + EPS);
}
__device__ __forceinline__ void norm_row(const float* xrow, const float* gain, bf16_t* orow, int lane) {
    f32x4 v[4]; const float rs = row_rs(xrow, lane, v);
    const f32x4* gr = (const f32x4*)gain + lane; unsigned long long* o8 = (unsigned long long*)orow + lane;
#pragma unroll
    for (int j = 0; j < 4; ++j) { const f32x4 g = gr[64 * j];
        o8[64 * j] = (unsigned long long)pk2(v[j].x * rs * g.x, v[j].y * rs * g.y) | ((unsigned long long)pk2(v[j].z * rs * g.z, v[j].w * rs * g.w) << 32); }
}
__device__ __forceinline__ void sincos_d(double a, float& s, float& c) {
    const double n = rint(a * 0.6366197723675814);
    double r = fma(-n, 1.5707963267948966, a); r = fma(-n, 6.123233995736766e-17, r);
    const double r2 = r * r;
    double sp = -1.0 / 1307674368000.0; sp = sp * r2 + 1.0 / 6227020800.0; sp = sp * r2 - 1.0 / 39916800.0; sp = sp * r2 + 1.0 / 362880.0; sp = sp * r2 - 1.0 / 5040.0; sp = sp * r2 + 1.0 / 120.0; sp = sp * r2 - 1.0 / 6.0; sp = sp * r2 * r + r;
    double cp = 1.0 / 20922789888000.0; cp = cp * r2 - 1.0 / 87178291200.0; cp = cp * r2 + 1.0 / 479001600.0; cp = cp * r2 - 1.0 / 3628800.0; cp = cp * r2 + 1.0 / 40320.0; cp = cp * r2 - 1.0 / 720.0; cp = cp * r2 + 1.0 / 24.0; cp = cp * r2 - 0.5; cp = cp * r2 + 1.0;
    const int q = (int)n & 3;
    const double ss = (q & 1) ? cp : sp, cc = (q & 1) ? sp : cp;
    s = (float)((q & 2) ? -ss : ss); c = (float)(((q + 1) & 2) ? -cc : cc);
}

struct Args {
    const float* in[30]; float* out; unsigned char* ws; int ph_lo, ph_hi;
};
enum { I_X = 0, I_MEM, I_NORM_MIX, I_W_IN, I_PE_K, I_W1_K, I_B1_K, I_W2_K, I_PE_V, I_W1_V, I_B1_V, I_W2_V, I_W_POOL, I_POOL_SCALE, I_W_OUT, I_NORM_X, I_NORM_MEM,
       I_WQ, I_WK, I_WV, I_WO, I_NORM_FFN, I_FFN_WG, I_FFN_WU, I_FFN_WD, I_ROUTER, I_MOE_WG, I_MOE_WU, I_MOE_WD, I_NORM_FINAL };
constexpr int PH_PRO = 0, PH_KV = 1, PH_L0 = 2, PH_LSTRIDE = 20;
constexpr int PO_WIN = 0, PO_CMP = 1, PO_ATT = 2, PO_WOUT = 3, PO_N2 = 4, PO_WQ = 5, PO_S = 6, PO_PV = 7, PO_WO = 8, PO_F0 = 9;

typedef const Args __attribute__((address_space(4))) CArgs;
#if RES_BF16
__device__ __forceinline__ f32x4 xrow4(const bf16_t* xb2, const float*, size_t tok, int idx) { const u32x2 w = ((const u32x2*)(xb2 + tok * DM))[idx];
    return (f32x4){__builtin_bit_cast(float, w.x << 16), __builtin_bit_cast(float, w.x & 0xffff0000u), __builtin_bit_cast(float, w.y << 16), __builtin_bit_cast(float, w.y & 0xffff0000u)}; }
__device__ __forceinline__ float xrow1(const bf16_t* xb2, const float*, size_t tok, int idx) { return bf2f(xb2[tok * DM + idx]); }
#else
__device__ __forceinline__ f32x4 xrow4(const bf16_t*, const float* x, size_t tok, int idx) { return ((const f32x4*)(x + tok * DM))[idx]; }
__device__ __forceinline__ float xrow1(const bf16_t*, const float* x, size_t tok, int idx) { return x[tok * DM + idx]; }
#endif
#define PHASE_IDS CArgs* ap_ = (CArgs*)__builtin_amdgcn_kernarg_segment_ptr(); asm volatile("" : "+s"(ap_)); unsigned char* ws = ap_->ws; (void)ws; int tid_; asm volatile("v_mbcnt_lo_u32_b32 %0, -1, 0\n\tv_mbcnt_hi_u32_b32 %0, -1, %0" : "=v"(tid_)); tid_ += wid0 * 64; const int tid = tid_, lane = tid & 63, wid = wid0, gw = bid * NWAVES + wid; (void)lane; (void)gw;
#ifndef PHMASK
#define PHMASK 0xffffffffu
#endif
#define PM(b) ((PHMASK >> (b)) & 1u)
#define IN(k) (lo <= (k) && (k) < hi)
#if DBG >= 200
#define SEAM(k) do { if (hi > (k) + 1) xcd_barrier(bar, tid); if (bid == 0 && tid == 0) ((unsigned long long*)((unsigned*)(ws + WS_CTL) + 20000))[(k)] = __builtin_amdgcn_s_memrealtime(); } while (0)
#else
#ifndef BAR_REP
#define BAR_REP 1
#endif
#define SEAM(k) do { if (hi > (k) + 1) for (int br_ = 0; br_ < BAR_REP; ++br_) xcd_barrier(bar, tid); } while (0)
#endif
#define W16(off) ((bf16_t*)(ws + (off)))
constexpr int MOE_IT_MG = 16 * 56, MOE_IT_MD = 56 * 16, MOE_NM = 16 * MOE_IT_MG + 8 * MOE_IT_MD, MOE_S0 = 5 * 176 * 8, MOE_S1 = MOE_S0 + 3 * 128 * 8;
__device__ __forceinline__ void moe_convert(const float* wgp, const float* wup, const float* wdp, unsigned char* ws, LAS unsigned char* lds, int it_lo, int it_hi, int rank, int nranks, int wid, int lane) {
    LAS float* scr = (LAS float*)(lds + wid * 16896);
    auto ld = [&](int it, f32x4 (&v)[16]) {
        if (it < 16 * MOE_IT_MG) { const int mtx = it / MOE_IT_MG, r = it % MOE_IT_MG, e = mtx >> 1, up = mtx & 1, kb = r / 56, j = r % 56;
            xpose_load64((up ? wup : wgp) + (size_t)e * DM * DFFE, DFFE, 64 * kb, 64 * j, lane, v);
        } else { const int r0 = it - 16 * MOE_IT_MG, e = r0 / MOE_IT_MD, r = r0 % MOE_IT_MD, kb = r / 16, j = r % 16;
            xpose_load64(wdp + (size_t)e * DFFE * DM, DM, 64 * kb, 64 * j, lane, v); } };
    auto st = [&](int it, const f32x4 (&v)[16]) {
        if (it < 16 * MOE_IT_MG) { const int mtx = it / MOE_IT_MG, r = it % MOE_IT_MG, e = mtx >> 1, up = mtx & 1, kb = r / 56, j = r % 56, n = 64 * j;
            xpose_store64(v, 64 * kb, W16(WS_MGU) + (size_t)e * 7168 * DM, DM, 256 * (n >> 7) + (n & 127) + (up ? 128 : 0), scr, lane);
        } else { const int r0 = it - 16 * MOE_IT_MG, e = r0 / MOE_IT_MD, r = r0 % MOE_IT_MD, kb = r / 16, j = r % 16;
            xpose_store64(v, 64 * kb, W16(WS_MD) + (size_t)e * DM * DFFE, DFFE, 64 * j, scr, lane); } };
    int it = it_lo + rank;
    f32x4 va[16], vb[16];
    if (it < it_hi) ld(it, va);
    while (it < it_hi) {
        if (it + nranks < it_hi) ld(it + nranks, vb);
        st(it, va); it += nranks; if (it >= it_hi) break;
        if (it + nranks < it_hi) ld(it + nranks, va);
        st(it, vb); it += nranks;
    }
}
template <int layer> __device__ __forceinline__ void layer_phases(LAS unsigned char* lds, const int lo, const int hi, const XcdBarrier& bar, const int G, const int bid, const int NGW, const int wid0) {
        const int pb = PH_L0 + layer * PH_LSTRIDE;
        if (PM(2) && IN(pb + PO_WIN)) {
            PHASE_IDS
            pg8::Gemm g{(const char*)(ws + WS_HB), (const char*)(ws + WS_WIN + (size_t)layer * ZW * DM * 2), DM, DM, DM};
            SchedPlain S; S.init(T / 256, ZW / 256, DM, DM, G, bid);
            EpiWin E{W16(WS_QRAW), W16(WS_QROT), W16(WS_KV), W16(WS_U), (float*)(ws + WS_GATES), (const float*)(ws + WS_ROPE), SSP(layer == 0 ? 0 : 3)};
            for (int rep_ = 0; rep_ < REPN(2); ++rep_) pg8::gemm_phase<EpiWin, SchedPlain, true, true>(lds, g, S, E, tid);
            SEAM(pb + PO_WIN);
        }
        if (PM(3) && IN(pb + PO_CMP)) {
            PHASE_IDS
            for (int rep_ = 0; rep_ < REPN(3); ++rep_)
            if (bid < 16) {
                const int kv = bid >> 3, pm = bid & 7, mtx = layer * 2 + kv;
                {
                    pg8::Gemm g{(const char*)(ws + WS_KV + (size_t)kv * KVSZ * 2), (const char*)(ws + WS_CW1 + (size_t)mtx * 256 * 2048 * 2), 2048, 1024, 2048};
                    SchedOne S; S.u.pm = pm; S.u.pn = 0; S.u.aoff = (long)pm * 256 * 1024 * 2; S.u.boff = 0; S.u.coff = 0;
                    EpiHid E{W16(WS_HID) + (size_t)kv * 2048 * 256, (const long long*)((const unsigned*)(ws + WS_CTL) + CW_BIAS) + mtx * 256};
                    pg8::gemm_phase<EpiHid, SchedOne, false, true>(lds, g, S, E, tid);
                }
                VM_WAIT(); __syncthreads();
                __builtin_amdgcn_fence(__ATOMIC_ACQUIRE, "agent"); VM_WAIT(); __syncthreads();
                {
                    pg8::Gemm g{(const char*)(ws + WS_HID + (size_t)kv * 2048 * 256 * 2), (const char*)(ws + WS_CW2 + (size_t)mtx * 256 * 256 * 2), 256, 256, 256};
                    SchedOne S; S.u.pm = pm; S.u.pn = 0; S.u.aoff = (long)pm * 256 * 256 * 2; S.u.boff = 0; S.u.coff = 0;
                    EpiCmp2 E{W16(WS_KCMP) + (size_t)kv * 8 * 256 * 64};
                    pg8::gemm_phase<EpiCmp2, SchedOne, false, true>(lds, g, S, E, tid);
                }
            } else if (layer == 0 && bid < 80) {
                pg8::Gemm g{(const char*)ws, (const char*)ws, DM, DM, DM}; SchedKV S{1, bid - 16}; EpiPlain E{(bf16_t*)ws, DM, nullptr};
                pg8::gemm_phase<EpiPlain, SchedKV, false, true>(lds, g, S, E, tid);
            } else {
                const int nw = layer == 0 ? G - 80 : G - 16, w0 = layer == 0 ? 80 : 16;
                moe_convert(ap_->in[I_MOE_WG], ap_->in[I_MOE_WU], ap_->in[I_MOE_WD], ws, lds, layer == 0 ? 0 : MOE_S1, layer == 0 ? MOE_S0 : MOE_NM, (bid - w0) * NWAVES + wid, nw * NWAVES, wid, lane);
                const bf16_t* ub = W16(WS_U); bf16_t* ab = W16(WS_AB);
                for (int p = (bid - w0) * NWAVES + wid; p < 1024; p += nw * NWAVES) { const int rq = p & 255;
                    switch (p >> 8) { case 0: pool_run<16>(ub, ab, rq, lane); break; case 1: pool_run<8>(ub, ab, rq, lane); break; case 2: pool_run<4>(ub, ab, rq, lane); break; default: pool_run<2>(ub, ab, rq, lane); break; } }
            }
            SEAM(pb + PO_CMP);
        }
        if (PM(4) && IN(pb + PO_ATT)) {
            PHASE_IDS
            nsa::Ptrs P{W16(WS_QRAW), W16(WS_QROT), W16(WS_KV), W16(WS_KCMP), W16(WS_KCMP) + 8 * 256 * 64, (const float*)(ws + WS_GATES), W16(WS_AB)};
            const int vcu = (G % 8 == 0) ? (bid % 8) * (G / 8) + bid / 8 : bid;
            for (int rep_ = 0; rep_ < REP_ATT; ++rep_)
            for (int uix = vcu; uix < 8 * 32; uix += G) { const int bgx = uix >> 5, s = uix & 31;
                nsa::unit(P, bgx >> 1, bgx & 1, 63 - s, lds, tid);
                nsa::unit(P, bgx >> 1, bgx & 1, s, lds, tid); }
            SEAM(pb + PO_ATT);
        }
        if (PM(5) && IN(pb + PO_WOUT)) {
            PHASE_IDS
            pg8::Gemm g{(const char*)(ws + WS_AB), (const char*)(ws + WS_WOUT + (size_t)layer * DM * DM * 2), DM, DM, DM};
            SchedPlain S; S.init(T / 256, DM / 256, DM, DM, G, bid);
#if RES_BF16
            if constexpr (layer == 0) { EpiResB<true> E{ap_->in[I_X], W16(WS_HB), SSP(1)}; pg8::gemm_phase<EpiResB<true>, SchedPlain, true, true>(lds, g, S, E, tid); }
            else { EpiResB<false> E{W16(WS_HB), W16(WS_HB), SSP(4)}; pg8::gemm_phase<EpiResB<false>, SchedPlain, true, true>(lds, g, S, E, tid); }
#else
            EpiRes E{layer == 0 ? ap_->in[I_X] : ap_->out, ap_->out, W16(WS_HB), SSP(layer == 0 ? 1 : 4)};
            pg8::gemm_phase<EpiRes, SchedPlain, true, true>(lds, g, S, E, tid);
#endif
            SEAM(pb + PO_WOUT);
        }
        if (PM(7) && IN(pb + PO_WQ)) {
            PHASE_IDS
            for (int rep_ = 0; rep_ < REPN(7); ++rep_) {
            {   pg8::Gemm g{(const char*)(ws + WS_HB), (const char*)(ws + WS_WQ + (size_t)layer * DM * DM * 2), DM, DM, DM};
                SchedPlain S; S.init(T / 256, DM / 256, DM, DM, G, bid);
                EpiPlain E{W16(WS_QX), DM, SSP(layer == 0 ? 1 : 4)};
                pg8::gemm_phase<EpiPlain, SchedPlain, false, true>(lds, g, S, E, tid); }
            VM_WAIT(); __syncthreads(); __builtin_amdgcn_fence(__ATOMIC_ACQUIRE, "agent"); VM_WAIT(); __syncthreads();
            {
                pg8::TileOrder o; o.init(T / 256, DM / 256, G, bid); int pm, pn;
                if (o.tile(0, pm, pn)) { nsa::xattn_unit(W16(WS_QX), W16(WS_KX) + (size_t)layer * DM * DM, W16(WS_VXT) + (size_t)layer * DM * DM, W16(WS_OX), pm, pn, lds, tid);
#if DBG == 400
                    if (layer == 1) { nsa::xattn_unit(W16(WS_QX), W16(WS_KX) + (size_t)layer * DM * DM, W16(WS_VXT) + (size_t)layer * DM * DM, W16(WS_ACTC), pm, pn, lds, tid);
                        VM_WAIT(); __syncthreads(); __builtin_amdgcn_fence(__ATOMIC_ACQUIRE, "agent"); VM_WAIT(); __syncthreads();
                        unsigned c = 0; for (int i = tid; i < 256 * 256; i += 512) { const size_t off = (size_t)(pm * 256 + (i >> 8)) * 1024 + pn * 256 + (i & 255); c += W16(WS_OX)[off] != W16(WS_ACTC)[off]; }
                        if (c) atomicAdd((unsigned*)(ws + WS_CTL) + 21100, c); }
#endif
                } }
            if (rep_ + 1 < REPN(7)) { VM_WAIT(); __syncthreads(); }
            }
            SEAM(pb + PO_PV);
        }
        if (PM(10) && IN(pb + PO_WO)) {
            PHASE_IDS
            pg8::Gemm g{(const char*)(ws + WS_OX), (const char*)(ws + WS_WO + (size_t)layer * DM * DM * 2), DM, DM, DM};
            SchedPlain S; S.init(T / 256, DM / 256, DM, DM, G, bid);
#if RES_BF16
            EpiResB<false> E{W16(WS_HB), layer == 0 ? W16(WS_HB) : W16(WS_XB2), layer == 0 ? SSP(2) : nullptr};
            pg8::gemm_phase<EpiResB<false>, SchedPlain, true, true>(lds, g, S, E, tid);
#else
            EpiRes E{ap_->out, ap_->out, layer == 0 ? W16(WS_HB) : nullptr, SSP(2)};
            pg8::gemm_phase<EpiRes, SchedPlain, true, true>(lds, g, S, E, tid);
#endif
            SEAM(pb + PO_WO);
        }
        if constexpr (layer == 0) {
            if (PM(12) && IN(pb + PO_F0 + 1)) {
            PHASE_IDS
                pg8::Gemm g{(const char*)(ws + WS_HB), (const char*)(ws + WS_FGU), DM, DM, DM};
                SchedPlain S; S.init(T / 256, 2 * DFF / 256, DM, DM, G, bid);
                EpiSwiglu E{W16(WS_ACT0), DFF, SSP(2)};
                for (int rep_ = 0; rep_ < REPN(12); ++rep_) pg8::gemm_phase<EpiSwiglu, SchedPlain, true, true>(lds, g, S, E, tid);
                if (bid >= 128) { __syncthreads();
                    moe_convert(ap_->in[I_MOE_WG], ap_->in[I_MOE_WU], ap_->in[I_MOE_WD], ws, lds, MOE_S0, MOE_S1, (bid - 128) * NWAVES + wid, 128 * NWAVES, wid, lane); __syncthreads(); }
                SEAM(pb + PO_F0 + 1);
            }
            if (PM(13) && IN(pb + PO_F0 + 2)) {
            PHASE_IDS
                pg8::Gemm g{(const char*)(ws + WS_ACT0), (const char*)(ws + WS_FD), DFF, DFF, DFF};
                SchedPlain S; S.init(T / 256, DM / 256, DFF, DFF, G, bid);
#if RES_BF16
                EpiResB<false> E{W16(WS_HB), W16(WS_HB), SSP(3)};
                pg8::gemm_phase<EpiResB<false>, SchedPlain, true, true>(lds, g, S, E, tid);
#else
                EpiRes E{ap_->out, ap_->out, W16(WS_HB), SSP(3)};
                pg8::gemm_phase<EpiRes, SchedPlain, true, true>(lds, g, S, E, tid);
#endif
                SEAM(pb + PO_F0 + 2);
            }
        } else {
#define route ((unsigned*)(ws + WS_ROUTE))
#define cntg ((unsigned*)(ws + WS_CNTG))
#define tinfo ((unsigned*)(ws + WS_TILE))
#define slot ((unsigned*)(ws + WS_SLOT))
            LAS int* LE = (LAS int*)lds;
            LAS float* LW = (LAS float*)(lds + 512);
            LAS int* LR = (LAS int*)(lds + 1024);
            LAS int* LC = (LAS int*)(lds + 1536);
            if (PM(15) && IN(pb + PO_F0)) {
            PHASE_IDS
                const float* gain = ap_->in[I_NORM_FFN] + DM; const float* wr = ap_->in[I_ROUTER];
                float wgr[16][8];
#pragma unroll
                for (int jj = 0; jj < 16; ++jj) { const int k = lane + 64 * jj; const float gk = gain[k]; const f32x4 w0 = *(const f32x4*)(wr + (size_t)k * 8), w1 = *(const f32x4*)(wr + (size_t)k * 8 + 4);
#pragma unroll
                    for (int c = 0; c < 4; ++c) { wgr[jj][c] = gk * w0[c]; wgr[jj][4 + c] = gk * w1[c]; } }
                for (int rep_ = 0; rep_ < REPN(15); ++rep_)
                for (int tb = bid; tb < T / 64; tb += G) {
                    for (int k = 0; k < 8; ++k) { const int tl = 8 * wid + k, tok = 64 * tb + tl;
                        float xs[16], sq = 0.f;
#pragma unroll
                        for (int jj = 0; jj < 16; ++jj) { xs[jj] = xrow1(W16(WS_XB2), ap_->out, (size_t)tok, lane + 64 * jj); sq += xs[jj] * xs[jj]; }
                        const float rs = 1.0f / sqrtf(wave_sum(sq) * (1.f / DM) + EPS);
                        float lg[8];
#pragma unroll
                        for (int e = 0; e < 8; ++e) lg[e] = 0.f;
#pragma unroll
                        for (int jj = 0; jj < 16; ++jj) { const float h = xs[jj] * rs;
#pragma unroll
                            for (int e = 0; e < 8; ++e) lg[e] += h * wgr[jj][e]; }
                        { const bool b0 = lane & 1, b1 = lane & 2, b2 = lane & 4; float a4[4], a2[2], a1;
#pragma unroll
                          for (int i = 0; i < 4; ++i) a4[i] = (b0 ? lg[4 + i] : lg[i]) + xor_get<1>(b0 ? lg[i] : lg[4 + i]);
#pragma unroll
                          for (int i = 0; i < 2; ++i) a2[i] = (b1 ? a4[2 + i] : a4[i]) + xor_get<2>(b1 ? a4[i] : a4[2 + i]);
                          a1 = (b2 ? a2[1] : a2[0]) + xor_get<4>(b2 ? a2[0] : a2[1]);
                          a1 += xor_get<8>(a1); a1 += xor_get<16>(a1); a1 = xor32_sum(a1);
#pragma unroll
                          for (int e = 0; e < 8; ++e) lg[e] = __builtin_bit_cast(float, __builtin_amdgcn_readlane(__builtin_bit_cast(int, a1), ((e >> 2) & 1) | (((e >> 1) & 1) << 1) | ((e & 1) << 2))); }
                        if (lane == 0) { int i1 = 0; float v1 = lg[0];
#pragma unroll
                            for (int e = 1; e < 8; ++e) if (lg[e] > v1) { v1 = lg[e]; i1 = e; }
                            int i2 = -1; float v2 = -INFINITY;
#pragma unroll
                            for (int e = 0; e < 8; ++e) if (e != i1 && lg[e] > v2) { v2 = lg[e]; i2 = e; }
                            const float w1 = 1.f / (1.f + expf(v2 - v1));
                            LE[2 * tl] = i1; LE[2 * tl + 1] = i2; LW[2 * tl] = w1; LW[2 * tl + 1] = 1.f - w1; }
                    }
                    LDS_WAIT(); __syncthreads();
                    if (tid < 8) { int c = 0; for (int i = 0; i < 128; ++i) if (LE[i] == tid) LR[i] = c++; LC[tid] = c; }
                    LDS_WAIT(); __syncthreads();
                    if (tid < 64) { const int tok = 64 * tb + tid; u32x4 a, b2; a.x = LE[2 * tid]; a.y = LE[2 * tid + 1]; a.z = LR[2 * tid]; a.w = LR[2 * tid + 1];
                        b2.x = __builtin_bit_cast(unsigned, LW[2 * tid]); b2.y = __builtin_bit_cast(unsigned, LW[2 * tid + 1]); b2.z = 0u; b2.w = 0u;
                        *(u32x4*)(route + (size_t)tok * 8) = a; *(u32x4*)(route + (size_t)tok * 8 + 4) = b2; }
                    if (tid < 8) cntg[tb * 8 + tid] = (unsigned)LC[tid];
                    LDS_WAIT(); __syncthreads();
                }
                SEAM(pb + PO_F0);
            }
            if (PM(16) && IN(pb + PO_F0 + 1)) {
            PHASE_IDS
                LAS unsigned* CN = (LAS unsigned*)(lds + 4096);
                LAS unsigned* SB = (LAS unsigned*)(lds + 2048);
                LAS unsigned* TOTS = (LAS unsigned*)(lds + 2048 + 64);
                LAS unsigned* MYB = (LAS unsigned*)(lds + 2048 + 128);
                const float* gain = ap_->in[I_NORM_FFN] + DM;
                for (int rep_ = 0; rep_ < REPN(16); ++rep_)
                for (int tb = bid; tb < T / 64; tb += G) {
                    for (int i = tid; i < 2048; i += 512) CN[i] = cntg[i];
                    LDS_WAIT(); __syncthreads();
                    if (tid < 8) { unsigned tot = 0, myb = 0; for (int w = 0; w < 256; ++w) { const unsigned c = CN[w * 8 + tid]; if (w < tb) myb += c; tot += c; } TOTS[tid] = tot; MYB[tid] = myb; }
                    LDS_WAIT(); __syncthreads();
                    if (tid == 0) { unsigned toff = 0; for (int e = 0; e < 8; ++e) { SB[e] = toff * 256 + MYB[e]; const unsigned nte = (TOTS[e] + 255) >> 8;
                            if (tb == 0) for (unsigned k = 0; k < nte; ++k) tinfo[8 + toff + k] = e;
                            toff += nte; }
                        if (tb == 0) tinfo[0] = toff; }
                    LDS_WAIT(); __syncthreads();
                    f32x4 ggr[4];
#pragma unroll
                    for (int j = 0; j < 4; ++j) ggr[j] = ((const f32x4*)gain)[lane + 64 * j];
#pragma unroll 1
                    for (int k0 = 0; k0 < 8; k0 += 4) {
                        u32x4 ra[4], rb[4]; f32x4 xv[4][4];
#pragma unroll
                        for (int q = 0; q < 4; ++q) { const int tok = 64 * tb + 8 * wid + k0 + q; ra[q] = *(const u32x4*)(route + (size_t)tok * 8); rb[q] = *(const u32x4*)(route + (size_t)tok * 8 + 4);
#pragma unroll
                            for (int j = 0; j < 4; ++j) xv[q][j] = xrow4(W16(WS_XB2), ap_->out, (size_t)tok, lane + 64 * j); }
#pragma unroll
                        for (int q = 0; q < 4; ++q) { const int tok = 64 * tb + 8 * wid + k0 + q;
                            const unsigned s1 = SB[ra[q].x] + ra[q].z, s2 = SB[ra[q].y] + ra[q].w;
                            if (lane == 0) { u32x4 o; o.x = s1; o.y = s2; o.z = rb[q].x; o.w = rb[q].y; *(u32x4*)(slot + (size_t)tok * 4) = o; }
                            float sq = 0.f;
#pragma unroll
                            for (int j = 0; j < 4; ++j) { const f32x4 v = xv[q][j]; sq += (v.x * v.x + v.y * v.y) + (v.z * v.z + v.w * v.w); }
                            const float rs = 1.0f / sqrtf(wave_sum(sq) * (1.f / DM) + EPS);
                            unsigned long long* o1 = (unsigned long long*)(W16(WS_HP) + (size_t)s1 * DM) + lane; unsigned long long* o2 = (unsigned long long*)(W16(WS_HP) + (size_t)s2 * DM) + lane;
#pragma unroll
                            for (int j = 0; j < 4; ++j) { const f32x4 v = xv[q][j], gg = ggr[j];
                                const unsigned long long pk = (unsigned long long)pk2(v.x * rs * gg.x, v.y * rs * gg.y) | ((unsigned long long)pk2(v.z * rs * gg.z, v.w * rs * gg.w) << 32);
                                o1[64 * j] = pk; o2[64 * j] = pk; } }
                    }
                    LDS_WAIT(); __syncthreads();
                }
                SEAM(pb + PO_F0 + 1);
            }
#pragma unroll 1
            for (int ch = 0; ch < 2; ++ch) {
                const int t0 = ch * HALFT;
#define MOE_NM int nm = (int)tinfo[0] - t0; if (ch == 0) nm = nm > HALFT ? HALFT : nm; nm = nm < 0 ? 0 : (nm > CH1T ? CH1T : nm);
                if (PM(17) && IN(pb + PO_F0 + 2 + 2 * ch)) {
            PHASE_IDS
                    MOE_NM
                    pg8::Gemm g{(const char*)(ws + WS_HP + (size_t)t0 * 256 * DM * 2), (const char*)(ws + WS_MGU), DM, DM, DM};
                    SchedMoe S; S.o.init(nm, 2 * DFFE / 256, G, bid); S.texp = tinfo + 8; S.t0 = t0; S.nn = 2 * DFFE / 256; S.astep = 256L * DM * 2; S.bstep = 256L * DM * 2; S.estep = 7168L * DM * 2; S.cstep = 256L * DFFE; S.khb = 0; S.khc = 0;
                    EpiSwiglu E{W16(WS_ACTC), DFFE, nullptr};
                    for (int rep_ = 0; rep_ < REPN(17); ++rep_) pg8::gemm_phase<EpiSwiglu, SchedMoe, true, true>(lds, g, S, E, tid);
                    SEAM(pb + PO_F0 + 2 + 2 * ch);
                }
                if (PM(18) && IN(pb + PO_F0 + 3 + 2 * ch)) {
            PHASE_IDS
                    MOE_NM
                    pg8::Gemm g{(const char*)(ws + WS_ACTC), (const char*)(ws + WS_MD), DFFE / 2, DFFE, DFFE};
                    SchedMoe S; S.o.init(nm, 2 * DM / 256, G, bid); S.texp = tinfo + 8; S.t0 = t0; S.nn = DM / 256; S.astep = 256L * DFFE * 2; S.bstep = 256L * DFFE * 2; S.estep = 1024L * DFFE * 2; S.cstep = 0;
                    S.khb = (long)(DFFE / 2) * 2; S.khc = ((long)WS_YB - (long)WS_HP) / 2;
                    EpiPlain E{W16(WS_HP), DM, nullptr};
                    for (int rep_ = 0; rep_ < REPN(18); ++rep_) pg8::gemm_phase<EpiPlain, SchedMoe, true, true>(lds, g, S, E, tid);
                    SEAM(pb + PO_F0 + 3 + 2 * ch);
                }
            }
            if (PM(19) && IN(pb + PO_F0 + 6)) {
            PHASE_IDS
                const float* gain = ap_->in[I_NORM_FINAL];
                f32x4 gg[4];
#pragma unroll
                for (int j = 0; j < 4; ++j) gg[j] = ((const f32x4*)gain)[lane + 64 * j];
#define BLO(u) __builtin_bit_cast(float, (u) << 16)
#define BHI(u) __builtin_bit_cast(float, (u) & 0xffff0000u)
                int r = gw;
                u32x2 si = {0u, 0u}; float w1 = 0.f, w2 = 0.f; f32x4 xv[4];
                if (r < T) { si = *(const u32x2*)(slot + (size_t)r * 4); w1 = ((const float*)slot)[(size_t)r * 4 + 2]; w2 = ((const float*)slot)[(size_t)r * 4 + 3];
#pragma unroll
                    for (int j = 0; j < 4; ++j) xv[j] = xrow4(W16(WS_XB2), ap_->out, (size_t)r, lane + 64 * j); }
                while (r < T) {
                    asm volatile("" : "+v"(w1), "+v"(w2));
                    const u32x2* y1 = (const u32x2*)(W16(WS_HP) + (size_t)si.x * DM) + lane; const u32x2* y2 = (const u32x2*)(W16(WS_HP) + (size_t)si.y * DM) + lane;
                    const u32x2* z1 = (const u32x2*)(W16(WS_YB) + (size_t)si.x * DM) + lane; const u32x2* z2 = (const u32x2*)(W16(WS_YB) + (size_t)si.y * DM) + lane;
                    u32x2 a[4], c[4], a2[4], c2[4];
#pragma unroll
                    for (int j = 0; j < 4; ++j) { a[j] = y1[64 * j]; c[j] = y2[64 * j]; a2[j] = z1[64 * j]; c2[j] = z2[64 * j]; }
                    const int rn = r + NGW; u32x2 sin = {0u, 0u}; float w1n = 0.f, w2n = 0.f; f32x4 xn[4];
                    if (rn < T) { sin = *(const u32x2*)(slot + (size_t)rn * 4); w1n = ((const float*)slot)[(size_t)rn * 4 + 2]; w2n = ((const float*)slot)[(size_t)rn * 4 + 3];
#pragma unroll
                        for (int j = 0; j < 4; ++j) xn[j] = xrow4(W16(WS_XB2), ap_->out, (size_t)rn, lane + 64 * j); }
                    f32x4 v[4]; float s = 0.f;
#pragma unroll
                    for (int j = 0; j < 4; ++j) { const f32x4 x = xv[j];
                        v[j].x = x.x + w1 * (BLO(a[j].x) + BLO(a2[j].x)) + w2 * (BLO(c[j].x) + BLO(c2[j].x));
                        v[j].y = x.y + w1 * (BHI(a[j].x) + BHI(a2[j].x)) + w2 * (BHI(c[j].x) + BHI(c2[j].x));
                        v[j].z = x.z + w1 * (BLO(a[j].y) + BLO(a2[j].y)) + w2 * (BLO(c[j].y) + BLO(c2[j].y));
                        v[j].w = x.w + w1 * (BHI(a[j].y) + BHI(a2[j].y)) + w2 * (BHI(c[j].y) + BHI(c2[j].y));
                        s += (v[j].x * v[j].x + v[j].y * v[j].y) + (v[j].z * v[j].z + v[j].w * v[j].w); }
                    const float rs = 1.0f / sqrtf(wave_sum(s) * (1.f / DM) + EPS);
                    f32x4* orow = (f32x4*)(ap_->out + (size_t)r * DM) + lane;
#pragma unroll
                    for (int j = 0; j < 4; ++j) orow[64 * j] = (f32x4){v[j].x * rs * gg[j].x, v[j].y * rs * gg[j].y, v[j].z * rs * gg[j].z, v[j].w * rs * gg[j].w};
                    r = rn; si = sin; w1 = w1n; w2 = w2n;
#pragma unroll
                    for (int j = 0; j < 4; ++j) xv[j] = xn[j];
                }
            }
        }
}

__global__ void __launch_bounds__(NWAVES * 64, 2) fwd(Args args) {
    extern __shared__ __attribute__((aligned(16))) unsigned char lds_raw[];
    LAS unsigned char* lds = (LAS unsigned char*)lds_raw;
    const int G = gridDim.x, bid = blockIdx.x, NGW = G * NWAVES;
    const int wid0 = __builtin_amdgcn_readfirstlane((int)threadIdx.x >> 6);
    unsigned* ctl = (unsigned*)(args.ws + WS_CTL);
    const int lo = args.ph_lo, hi = args.ph_hi;
    for (int u = threadIdx.x; u < (LDS_BYTES - LDSCTL_OFF) / 4; u += NWAVES * 64) ((LAS unsigned*)(lds + LDSCTL_OFF))[u] = 0u;
    __syncthreads();
#if DBG >= 200
    if (blockIdx.x == 0 && threadIdx.x == 0) ((unsigned long long*)(ctl + 20000))[63] = __builtin_amdgcn_s_memrealtime();
#endif
    const bool multi = (hi - lo) > 1;
    XcdBarrier bar; bar.bar = ctl + CW_BAR; bar.x = 0; bar.st = nullptr;
    if (multi) bar = xcd_barrier_post(ctl + CW_BAR, (volatile LAS unsigned*)(lds + LDSCTL_OFF + 32));

    if (PM(0) && IN(PH_PRO)) {
            PHASE_IDS
        LAS float* scr = (LAS float*)(lds + wid * 16896);
        constexpr int IT_WIN = 16 * 64, IT_WOUT = 8 * 32, IT_SQ = 16 * 16, IT_C1 = 32 * 4, IT_C2 = 4 * 8, IT_FG = 16 * 44, IT_FD = 44 * 16;
        constexpr int N0 = 2 * IT_WIN, N1 = N0 + 2 * IT_WOUT, N2 = N1 + 8 * IT_SQ, N3 = N2 + 4 * IT_C1, N4 = N3 + 4 * IT_C2, N5 = N4 + 2 * IT_FG, N6 = N5 + IT_FD;
        for (int rep_ = 0; rep_ < REP_PRO; ++rep_)
        for (int it = gw; it < N6; it += NGW) {
            if (it < N0) { const int l = it / IT_WIN, r = it % IT_WIN, kb = r / 64, j = r % 64;
                int n0, ncv, dr = 32 * j;
                if (j < 40) { n0 = 32 * j; ncv = 32; } else if (j < 56) { n0 = 1304 + 32 * (j - 40); ncv = 32; } else if (j == 56) { n0 = 1280; ncv = 24; } else { n0 = 0; ncv = 0; }
                xpose_item(ap_->in[I_W_IN] + (size_t)l * DM * 1816, 1816, 64 * kb, n0, ncv, W16(WS_WIN) + (size_t)l * ZW * DM, DM, dr, scr, lane, ap_->in[I_NORM_MIX] + l * DM);
            } else if (it < N1) { const int r0 = it - N0, l = r0 / IT_WOUT, r = r0 % IT_WOUT, kb = r / 32, j = r % 32;
                xpose_item(ap_->in[I_W_OUT] + (size_t)l * DM * DM, DM, 64 * kb, 32 * j, 32, W16(WS_WOUT) + (size_t)l * DM * DM, DM, 32 * j, scr, lane);
            } else if (it < N2) { const int r0 = it - N1, mtx = r0 / IT_SQ, r = r0 % IT_SQ, which = mtx >> 1, l = mtx & 1;
                const float* src = ap_->in[which == 0 ? I_WQ : which == 1 ? I_WO : which == 2 ? I_WK : I_WV] + (size_t)l * DM * DM;
                bf16_t* dst = W16(which == 0 ? WS_WQ : which == 1 ? WS_WO : which == 2 ? WS_WK : WS_WV) + (size_t)l * DM * DM;
                xpose_mat(src, DM, DM, dst, 0, r, scr, lane, which == 0 ? ap_->in[I_NORM_X] + l * DM : nullptr);
            } else if (it < N3) { const int r0 = it - N2, mtx = r0 / IT_C1, r = r0 % IT_C1, l = mtx >> 1, kv = mtx & 1;
                xpose_mat(ap_->in[kv ? I_W1_V : I_W1_K] + (size_t)l * 2048 * 256, 2048, 256, W16(WS_CW1) + (size_t)mtx * 256 * 2048, 0, r, scr, lane);
            } else if (it < N4) { const int r0 = it - N3, mtx = r0 / IT_C2, r = r0 % IT_C2, l = mtx >> 1, kv = mtx & 1, kb = r / 8, j = r % 8;
                xpose_item(ap_->in[kv ? I_W2_V : I_W2_K] + (size_t)l * 256 * 64, 64, 64 * kb, j < 2 ? 32 * j : 0, j < 2 ? 32 : 0, W16(WS_CW2) + (size_t)mtx * 256 * 256, 256, 32 * j, scr, lane);
            } else if (it < N5) { const int r0 = it - N4, up = r0 / IT_FG, r = r0 % IT_FG;
                xpose_mat(ap_->in[up ? I_FFN_WU : I_FFN_WG], DM, DFF, W16(WS_FGU), up ? 2 : 1, r, scr, lane, ap_->in[I_NORM_FFN]);
            } else if (it < N6) { xpose_mat(ap_->in[I_FFN_WD], DFF, DM, W16(WS_FD), 0, it - N5, scr, lane);
            }
        }
        for (int i = bid * 512 + tid; i < SEQ * 8; i += G * 512) {
            const int pos = i >> 3, j = i & 7;
            const double inv = j == 0 ? 1.0 : j == 1 ? 0.19389587045179572 : j == 2 ? 0.037606030930863934 : j == 3 ? 0.007291654101443755 : j == 4 ? 0.0014142135623730951
                             : j == 5 ? 0.00027421616994972156 : j == 6 ? 5.3169310700017e-05 : 1.0309310618636385e-05;
            float s, c; sincos_d((double)pos * inv, s, c);
            ((float*)(ws + WS_ROPE))[2 * i] = c; ((float*)(ws + WS_ROPE))[2 * i + 1] = s;
        }
        for (int r0 = gw; r0 < T; r0 += 4 * NGW) {
            f32x4 xv[4][4];
#pragma unroll
            for (int q = 0; q < 4; ++q)
#pragma unroll
                for (int j = 0; j < 4; ++j) xv[q][j] = ((const f32x4*)(ap_->in[I_X] + (size_t)(r0 + q * NGW) * DM) + lane)[64 * j];
#pragma unroll
            for (int q = 0; q < 4; ++q) { const int r = r0 + q * NGW; unsigned long long* o8 = (unsigned long long*)(W16(WS_HB) + (size_t)r * DM) + lane; float sq = 0.f;
#pragma unroll
                for (int j = 0; j < 4; ++j) { const f32x4 v = xv[q][j]; sq += (v.x * v.x + v.y * v.y) + (v.z * v.z + v.w * v.w); o8[64 * j] = (unsigned long long)pk2(v.x, v.y) | ((unsigned long long)pk2(v.z, v.w) << 32); }
                sq = wave_sum(sq); if (lane == 0) SSP(0)[r] = ss_fix(sq); } }
        for (int r = gw; r < 2 * 1024; r += NGW) { const int l = r >> 10, row = r & 1023;
            norm_row(ap_->in[I_MEM] + (size_t)row * DM, ap_->in[I_NORM_MEM] + l * DM, W16(WS_MN) + (size_t)r * DM, lane); }
        for (int itb = gw; itb < 4 * 4 * 16; itb += NGW) { const int mtx = itb >> 6, cg = (itb >> 4) & 3, fc = itb & 15, l = mtx >> 1, kv = mtx & 1, c = cg * 64 + lane;
            const float* pe = ap_->in[kv ? I_PE_V : I_PE_K] + l * 2048 + fc * 128; const float* w1 = ap_->in[kv ? I_W1_V : I_W1_K] + (size_t)l * 2048 * 256 + (size_t)fc * 128 * 256 + c;
            float a = fc == 0 ? ap_->in[kv ? I_B1_V : I_B1_K][l * 256 + c] : 0.f;
#pragma unroll
            for (int h = 0; h < 4; ++h) { float wv[32];
#pragma unroll
                for (int f = 0; f < 32; ++f) wv[f] = w1[(size_t)(32 * h + f) * 256];
#pragma unroll
                for (int f = 0; f < 32; ++f) a += pe[32 * h + f] * wv[f]; }
            atomicAdd((unsigned long long*)(ctl + CW_BIAS) + mtx * 256 + c, (unsigned long long)(long long)((double)a * 1099511627776.0)); }
        for (int itw = gw; itw < 2 * 4 * 16 * 16; itw += NGW) { const int l = itw >> 10, g = (itw >> 8) & 3, nb = (itw >> 4) & 15, cb = itw & 15, n = nb * 64 + lane;
            const float* wp = ap_->in[I_W_POOL] + ((size_t)(l * 4 + g) * 128 + cb * 8) * 128; const float* ps = ap_->in[I_POOL_SCALE] + l * 512 + g * 128;
            const float* wo = ap_->in[I_W_OUT] + (size_t)l * DM * DM + (size_t)(512 + g * 128) * DM + n;
            float a[8];
#pragma unroll
            for (int c = 0; c < 8; ++c) a[c] = 0.f;
#pragma unroll
            for (int h = 0; h < 4; ++h) { float wv[32];
#pragma unroll
                for (int e = 0; e < 32; ++e) wv[e] = wo[(size_t)(32 * h + e) * DM];
#pragma unroll
                for (int e = 0; e < 32; ++e) { const float w = wv[e] * ps[32 * h + e];
#pragma unroll
                    for (int c = 0; c < 8; ++c) a[c] += wp[c * 128 + 32 * h + e] * w; } }
            u32x4 o; o.x = pk2(a[0], a[1]); o.y = pk2(a[2], a[3]); o.z = pk2(a[4], a[5]); o.w = pk2(a[6], a[7]);
            *(u32x4*)(W16(WS_WOUT) + (size_t)l * DM * DM + (size_t)n * DM + 512 + g * 128 + cb * 8) = o; }
        __syncthreads();
        SEAM(PH_PRO);
    }
    layer_phases<0>(lds, lo, hi, bar, G, bid, NGW, wid0);
    layer_phases<1>(lds, lo, hi, bar, G, bid, NGW, wid0);
#if DBG >= 200
    __syncthreads(); if (blockIdx.x == 0 && threadIdx.x == 0) ((unsigned long long*)(ctl + 20000))[62] = __builtin_amdgcn_s_memrealtime();
#endif
#undef IN
#undef SEAM
}

#if DBG
struct DbgIn { const float* in[30]; };
__device__ float dbg_block_sum(float v, float* red) { const int t = threadIdx.x; red[t] = v; __syncthreads(); for (int o = 128; o > 0; o >>= 1) { if (t < o) red[t] += red[t + o]; __syncthreads(); } const float r = red[0]; __syncthreads(); return r; }
__global__ void dbg_check(DbgIn di, const float* xcur, unsigned char* ws, int stage) {
    __shared__ float red[256]; __shared__ float act[3584]; __shared__ float hrow[1024];
    const int t = threadIdx.x; float* W = (float*)(ws + WS_CTL) + 16000;
    const unsigned* sl = (const unsigned*)(ws + WS_SLOT); const unsigned* rt = (const unsigned*)(ws + WS_ROUTE); const bf16_t* hp = (const bf16_t*)(ws + WS_HP); const bf16_t* ac = (const bf16_t*)(ws + WS_ACTC);
    const int toks[4] = {0, 5000, 12000, 16383}; float worst = 0.f; int nchk = 0;
    for (int q = 0; q < 4; ++q) for (int kk = 0; kk < 2; ++kk) { const int tok = toks[q]; const unsigned e = rt[tok * 8 + kk], sidx = sl[tok * 4 + kk]; const int ch = sidx >= (unsigned)(HALFT * 256) ? 1 : 0;
        if (stage == 1) {
            float ss = 0.f; for (int c = t; c < 1024; c += 256) { const float x = xcur[(size_t)tok * 1024 + c]; ss += x * x; } ss = dbg_block_sum(ss, red);
            const float rs = 1.f / sqrtf(ss / 1024.f + EPS); float num = 0.f, den = 0.f;
            for (int c = t; c < 1024; c += 256) { const float h = xcur[(size_t)tok * 1024 + c] * rs * di.in[I_NORM_FFN][1024 + c], f = bf2f(hp[(size_t)sidx * 1024 + c]); num += (h - f) * (h - f); den += h * h; }
            num = dbg_block_sum(num, red); den = dbg_block_sum(den, red); worst = fmaxf(worst, sqrtf(num / fmaxf(den, 1e-20f))); ++nchk;
        } else if ((stage == 2 && ch == 0) || (stage == 4 && ch == 1)) {
            for (int c = t; c < 1024; c += 256) hrow[c] = bf2f(hp[(size_t)sidx * 1024 + c]); __syncthreads();
            const float* wg = di.in[I_MOE_WG] + (size_t)e * DM * DFFE; const float* wu = di.in[I_MOE_WU] + (size_t)e * DM * DFFE; float num = 0.f, den = 0.f;
            for (int j = t; j < 3584; j += 256) { float g = 0.f, u = 0.f; for (int k2 = 0; k2 < 1024; ++k2) { g += hrow[k2] * wg[(size_t)k2 * DFFE + j]; u += hrow[k2] * wu[(size_t)k2 * DFFE + j]; }
                const float a = g / (1.f + expf(-g)) * u, f = bf2f(ac[((size_t)sidx - (size_t)ch * HALFT * 256) * 3584 + j]); num += (a - f) * (a - f); den += a * a; }
            num = dbg_block_sum(num, red); den = dbg_block_sum(den, red); worst = fmaxf(worst, sqrtf(num / fmaxf(den, 1e-20f))); ++nchk; __syncthreads();
        } else if ((stage == 3 && ch == 0) || (stage == 5 && ch == 1)) {
            for (int j = t; j < 3584; j += 256) act[j] = bf2f(ac[((size_t)sidx - (size_t)ch * HALFT * 256) * 3584 + j]); __syncthreads();
            const float* wd = di.in[I_MOE_WD] + (size_t)e * DFFE * DM; float num = 0.f, den = 0.f;
            for (int n = t; n < 1024; n += 256) { float y = 0.f; for (int j = 0; j < 3584; ++j) y += act[j] * wd[(size_t)j * DM + n]; const float f = bf2f(hp[(size_t)sidx * 1024 + n]); num += (y - f) * (y - f); den += y * y; }
            num = dbg_block_sum(num, red); den = dbg_block_sum(den, red); worst = fmaxf(worst, sqrtf(num / fmaxf(den, 1e-20f))); ++nchk; __syncthreads();
        } }
    if (stage == 1) {
        float mism = 0.f, werr = 0.f;
        for (int q = 0; q < 64; ++q) { const int tok = q * 251 + 3;
            float ss = 0.f; for (int c = t; c < 1024; c += 256) { const float x = xcur[(size_t)tok * 1024 + c]; ss += x * x; } ss = dbg_block_sum(ss, red);
            const float rs = 1.f / sqrtf(ss / 1024.f + EPS); float lg[8];
            for (int e = 0; e < 8; ++e) { float a = 0.f; for (int c = t; c < 1024; c += 256) a += xcur[(size_t)tok * 1024 + c] * rs * di.in[I_NORM_FFN][1024 + c] * di.in[I_ROUTER][c * 8 + e]; lg[e] = dbg_block_sum(a, red); }
            int i1 = 0; for (int e = 1; e < 8; ++e) if (lg[e] > lg[i1]) i1 = e; int i2 = -1; for (int e = 0; e < 8; ++e) if (e != i1 && (i2 < 0 || lg[e] > lg[i2])) i2 = e;
            const float w1 = 1.f / (1.f + expf(lg[i2] - lg[i1]));
            if ((int)rt[tok * 8] != i1 || (int)rt[tok * 8 + 1] != i2) mism += 1.f;
            werr = fmaxf(werr, fabsf(w1 - __builtin_bit_cast(float, rt[tok * 8 + 4]))); }
        if (t == 0) { W[8] = mism; W[9] = werr; } }
    if (stage == 5) {
        float sx = 0.f, sm = 0.f;
        for (int q = 0; q < 4; ++q) { const int tok = toks[q]; const unsigned s1 = sl[tok * 4], s2 = sl[tok * 4 + 1]; const float w1 = __builtin_bit_cast(float, sl[tok * 4 + 2]), w2 = __builtin_bit_cast(float, sl[tok * 4 + 3]);
            for (int c = t; c < 1024; c += 256) { const float x = xcur[(size_t)tok * 1024 + c], m = w1 * bf2f(hp[(size_t)s1 * 1024 + c]) + w2 * bf2f(hp[(size_t)s2 * 1024 + c]); sx += x * x; sm += m * m; } }
        sx = dbg_block_sum(sx, red); sm = dbg_block_sum(sm, red);
        if (t == 0) { W[6] = sx / 4096.f; W[7] = sm / 4096.f; } }
    if (t == 0) { W[stage] = worst; W[10 + stage] = (float)nchk; }
}
__global__ void dbg_attn(unsigned char* ws, int b, int g, int t, int slotw) {
    __shared__ float red[256]; __shared__ float lgt[4096]; __shared__ float pcs[4][256]; __shared__ float osum[4][64]; __shared__ int selb[64]; __shared__ float impv[64];
    const int tid = threadIdx.x, bg = b * 2 + g, tok = b * SEQ + t; float* W = (float*)(ws + WS_CTL) + 16000;
    const bf16_t* qraw = (const bf16_t*)(ws + WS_QRAW) + ((size_t)bg * SEQ + t) * 256; const bf16_t* qrot = (const bf16_t*)(ws + WS_QROT) + ((size_t)bg * SEQ + t) * 256;
    const bf16_t* kc = (const bf16_t*)(ws + WS_KCMP) + (size_t)bg * 256 * 64; const bf16_t* vc = kc + 8 * 256 * 64;
    const bf16_t* kvb = (const bf16_t*)(ws + WS_KV); const float* gt = (const float*)(ws + WS_GATES) + (size_t)tok * 24 + g * 12;
    const int nv = t >= 15 ? ((t - 15) >> 4) : 0, tb = t >> 6;
    for (int i = tid; i < 256; i += 256) osum[i >> 6][i & 63] = 0.f;
    __syncthreads();
    for (int r = 0; r < 4; ++r) {
        float s = -INFINITY; const int c = tid;
        if (c < 255 && c < nv) { s = 0.f; for (int d = 0; d < 64; ++d) s += bf2f(qraw[r * 64 + d]) * bf2f(kc[c * 64 + d]); }
        red[tid] = s; __syncthreads(); for (int o = 128; o > 0; o >>= 1) { if (tid < o) red[tid] = fmaxf(red[tid], red[tid + o]); __syncthreads(); } float m = red[0]; __syncthreads(); if (m == -INFINITY) m = 0.f;
        const float p = s == -INFINITY ? 0.f : exp2f(s - m); const float l = dbg_block_sum(p, red);
        pcs[r][c] = l > 0.f ? p / l : 0.f; __syncthreads();
        if (tid < 64) { float o = 0.f; for (int cc = 0; cc < 255; ++cc) o += bf2f((unsigned short)f2bf(pcs[r][cc])) * bf2f(vc[cc * 64 + tid]); osum[r][tid] += gt[r * 3 + 0] * o; }
        __syncthreads();
    }
    if (tid < 64) { float im = 0.f; for (int j = -1; j < 4; ++j) { const int c = 4 * tid + j; if (c >= 0 && c < 255) for (int r = 0; r < 4; ++r) im += pcs[r][c]; }
        const bool fut = tid > tb, forced = tid == 0 || tid == tb || tid == tb - 1; impv[tid] = fut ? -INFINITY : forced ? INFINITY : im; selb[tid] = 0; }
    __syncthreads();
    if (tid == 0) { for (int k = 0; k < 16; ++k) { int best = -1; float bv = 0.f; for (int n = 0; n < 64; ++n) if (!selb[n] && (best < 0 || impv[n] > bv)) { best = n; bv = impv[n]; } selb[best] = 1; } }
    __syncthreads();
    for (int br = 1; br <= 2; ++br) {
        const bf16_t* kb = kvb + (size_t)(br == 1 ? 2 : 4) * KVSZ + (size_t)bg * SEQ * 64; const bf16_t* vb = kvb + (size_t)(br == 1 ? 3 : 5) * KVSZ + (size_t)bg * SEQ * 64;
        for (int r = 0; r < 4; ++r) {
            float mx = -INFINITY;
            for (int j = tid; j < SEQ; j += 256) { bool ok = j <= t; if (br == 1) ok = ok && selb[j >> 6]; else ok = ok && (t - j) < 512;
                float sv = -INFINITY; if (ok) { sv = 0.f; for (int d = 0; d < 64; ++d) sv += bf2f(qrot[r * 64 + d]) * bf2f(kb[(size_t)j * 64 + d]); } lgt[j] = sv; mx = fmaxf(mx, sv); }
            red[tid] = mx; __syncthreads(); for (int o = 128; o > 0; o >>= 1) { if (tid < o) red[tid] = fmaxf(red[tid], red[tid + o]); __syncthreads(); } const float m = red[0]; __syncthreads();
            float ls = 0.f; for (int j = tid; j < SEQ; j += 256) { const float p = lgt[j] == -INFINITY ? 0.f : exp2f(lgt[j] - m); lgt[j] = p; ls += p; }
            const float l = dbg_block_sum(ls, red);
            if (tid < 64) { float o = 0.f; for (int j = 0; j <= t; ++j) o += lgt[j] * bf2f(vb[(size_t)j * 64 + tid]); osum[r][tid] += gt[r * 3 + br] * o / l; }
            __syncthreads();
        }
    }
    const bf16_t* ab = (const bf16_t*)(ws + WS_AB) + (size_t)tok * 1024 + g * 256;
    float num = 0.f, den = 0.f; { const float o = osum[tid >> 6][tid & 63], f = bf2f(ab[tid]); num = (o - f) * (o - f); den = o * o; }
    num = dbg_block_sum(num, red); den = dbg_block_sum(den, red);
    if (tid == 0) { W[slotw] = sqrtf(num / fmaxf(den, 1e-30f)); W[slotw + 40] = sqrtf(den / 256.f); }
}
__global__ void dbg_mixer(DbgIn di, const float* outp, unsigned char* ws, int stage) {
    __shared__ float red[256]; __shared__ float hrow[1024]; __shared__ float zrow[1816]; __shared__ float hid[256];
    const int t = threadIdx.x; float* W = (float*)(ws + WS_CTL) + 16000;
    const bf16_t* hb = (const bf16_t*)(ws + WS_HB); const bf16_t* kvb = (const bf16_t*)(ws + WS_KV);
    const int toks[4] = {7, 4101, 9000, 16383};
    if (stage == 30) {
        float nq = 0, dq = 0, nr = 0, dr = 0, nk = 0, dk = 0, nkr = 0, dkr = 0, nu = 0, du = 0, ng = 0, dg = 0;
        for (int q = 0; q < 4; ++q) { const int tok = toks[q], b = tok >> 12, pos = tok & 4095;
            for (int c = t; c < 1024; c += 256) hrow[c] = bf2f(hb[(size_t)tok * 1024 + c]); __syncthreads();
            for (int n = t; n < 1816; n += 256) { float a = 0.f; for (int k = 0; k < 1024; ++k) a += hrow[k] * di.in[I_W_IN][(size_t)k * 1816 + n]; zrow[n] = a; } __syncthreads();
            for (int n = t; n < 1816; n += 256) { const float z = zrow[n];
                if (n < 512) { const int g = n >> 8, c = n & 255, d = n & 63; const size_t idx = ((size_t)(b * 2 + g) * SEQ + pos) * 256 + c;
                    const float f = bf2f(((const bf16_t*)(ws + WS_QRAW))[idx]) / C2; nq += (z - f) * (z - f); dq += z * z;
                    float zr = z; if (d < 16) { const int j = d & 7; const double inv = pow(500000.0, -(double)j / 8.0); const float cs = (float)cos((double)pos * inv), sn = (float)sin((double)pos * inv);
                        zr = d < 8 ? z * cs - zrow[n + 8] * sn : z * cs + zrow[n - 8] * sn; }
                    const float fr = bf2f(((const bf16_t*)(ws + WS_QROT))[idx]) / C2; nr += (zr - fr) * (zr - fr); dr += zr * zr;
                } else if (n < 1280) { const int m = n - 512, i = m >> 7, g = (m >> 6) & 1, d = m & 63; const float f = bf2f(kvb[(size_t)i * KVSZ + ((size_t)(b * 2 + g) * SEQ + pos) * 64 + d]);
                    if (i == 2 || i == 4) { float zr = z; if (d < 16) { const int j = d & 7; const double inv = pow(500000.0, -(double)j / 8.0); const float cs = (float)cos((double)pos * inv), sn = (float)sin((double)pos * inv);
                            zr = d < 8 ? z * cs - zrow[n + 8] * sn : z * cs + zrow[n - 8] * sn; } nkr += (zr - f) * (zr - f); dkr += zr * zr; }
                    else { nk += (z - f) * (z - f); dk += z * z; }
                } else if (n < 1304) { const float sg = 1.f / (1.f + expf(-z)), f = ((const float*)(ws + WS_GATES))[(size_t)tok * 24 + (n - 1280)]; ng += (sg - f) * (sg - f); dg += sg * sg;
                } else { const float f = bf2f(((const bf16_t*)(ws + WS_U))[(size_t)tok * 512 + (n - 1304)]); nu += (z - f) * (z - f); du += z * z; } }
            __syncthreads(); }
        nq = dbg_block_sum(nq, red); dq = dbg_block_sum(dq, red); nr = dbg_block_sum(nr, red); dr = dbg_block_sum(dr, red); nk = dbg_block_sum(nk, red); dk = dbg_block_sum(dk, red);
        nkr = dbg_block_sum(nkr, red); dkr = dbg_block_sum(dkr, red); nu = dbg_block_sum(nu, red); du = dbg_block_sum(du, red); ng = dbg_block_sum(ng, red); dg = dbg_block_sum(dg, red);
        if (t == 0) { W[30] = sqrtf(nq / dq); W[31] = sqrtf(nr / dr); W[32] = sqrtf(nk / dk); W[33] = sqrtf(nkr / dkr); W[34] = sqrtf(nu / du); W[35] = sqrtf(ng / dg); }
    }
    if (stage == 31) {
        float nc = 0, dc = 0, nd = 0, dd = 0;
        const int cs_[4] = {0, 17, 200, 254};
        for (int q = 0; q < 4; ++q) for (int kv = 0; kv < 2; ++kv) { const int bg = (q * 3 + 1) & 7, c = cs_[q];
            const bf16_t* src = kvb + (size_t)kv * KVSZ + ((size_t)bg * SEQ + 16 * c) * 64; const float* pe = di.in[kv ? I_PE_V : I_PE_K]; const float* w1 = di.in[kv ? I_W1_V : I_W1_K]; const float* b1 = di.in[kv ? I_B1_V : I_B1_K]; const float* w2 = di.in[kv ? I_W2_V : I_W2_K];
            { float a = b1[t]; for (int f = 0; f < 2048; ++f) a += (bf2f(src[f]) + pe[f]) * w1[(size_t)f * 256 + t]; const float y = 0.7978845608f * (a + 0.044715f * a * a * a); hid[t] = 0.5f * a * (1.f + tanhf(y)); } __syncthreads();
            if (t < 64) { float o = 0.f; for (int h = 0; h < 256; ++h) o += hid[h] * w2[h * 64 + t]; const float f = bf2f(((const bf16_t*)(ws + WS_KCMP))[(size_t)kv * 8 * 256 * 64 + ((size_t)bg * 256 + c) * 64 + t]); nc += (o - f) * (o - f); dc += o * o; } __syncthreads(); }
        for (int q = 0; q < 4; ++q) { const int tok = toks[q], pos = tok & 4095; for (int c = t; c < 512; c += 256) { const int w = 2 << (c >> 7), n = (pos + 1) < w ? (pos + 1) : w; float sm = 0.f; const bf16_t* ub = (const bf16_t*)(ws + WS_U);
                for (int i = 0; i < n; ++i) sm += bf2f(ub[(size_t)(tok - i) * 512 + c]); const float d = sm / n - bf2f(ub[(size_t)tok * 512 + c]), f = bf2f(((const bf16_t*)(ws + WS_AB))[(size_t)tok * 1024 + 512 + c]); nd += (d - f) * (d - f); dd += d * d; } }
        nc = dbg_block_sum(nc, red); dc = dbg_block_sum(dc, red); nd = dbg_block_sum(nd, red); dd = dbg_block_sum(dd, red);
        if (t == 0) { W[36] = sqrtf(nc / dc); W[37] = sqrtf(nd / dd); }
    }
    if (stage == 32) {
        float nn = 0, dn = 0; const bf16_t* ab = (const bf16_t*)(ws + WS_AB);
        for (int q = 0; q < 4; ++q) { const int tok = toks[q];
            for (int c = t; c < 1024; c += 256) hrow[c] = bf2f(ab[(size_t)tok * 1024 + c]); __syncthreads();
            for (int ge = t; ge < 512; ge += 256) { const int g = ge >> 7, e = ge & 127; float y = 0.f; for (int c = 0; c < 128; ++c) y += hrow[512 + g * 128 + c] * di.in[I_W_POOL][((size_t)g * 128 + c) * 128 + e]; zrow[ge] = y * di.in[I_POOL_SCALE][ge]; } __syncthreads();
            for (int n = t; n < 1024; n += 256) { float a = di.in[I_X][(size_t)tok * 1024 + n]; const float x0 = a; for (int k = 0; k < 512; ++k) a += hrow[k] * di.in[I_W_OUT][(size_t)k * 1024 + n]; for (int k = 0; k < 512; ++k) a += zrow[k] * di.in[I_W_OUT][(size_t)(512 + k) * 1024 + n];
                const float f = outp[(size_t)tok * 1024 + n]; nn += (a - f) * (a - f); dn += (a - x0) * (a - x0); } __syncthreads(); }
        nn = dbg_block_sum(nn, red); dn = dbg_block_sum(dn, red);
        if (t == 0) W[38] = sqrtf(nn / dn);
    }
}
__global__ void dbg_moe_tok(DbgIn di, const float* xcur, unsigned char* ws) {
    __shared__ float red[256]; __shared__ float hrow[1024]; __shared__ float act[3584]; __shared__ float ynaive[1024];
    const int t = threadIdx.x, tok = blockIdx.x * 251 + 3; float* W = (float*)(ws + WS_CTL) + 16000;
    const unsigned* sl = (const unsigned*)(ws + WS_SLOT); const unsigned* rt = (const unsigned*)(ws + WS_ROUTE); const bf16_t* hp = (const bf16_t*)(ws + WS_HP);
    float ss = 0.f; for (int c = t; c < 1024; c += 256) { const float x = xcur[(size_t)tok * 1024 + c]; ss += x * x; } ss = dbg_block_sum(ss, red);
    const float rs = 1.f / sqrtf(ss / 1024.f + EPS);
    for (int c = t; c < 1024; c += 256) { hrow[c] = xcur[(size_t)tok * 1024 + c] * rs * di.in[I_NORM_FFN][1024 + c]; ynaive[c] = 0.f; } __syncthreads();
    float lg[8]; for (int e = 0; e < 8; ++e) { float a = 0.f; for (int c = t; c < 1024; c += 256) a += hrow[c] * di.in[I_ROUTER][c * 8 + e]; lg[e] = dbg_block_sum(a, red); }
    int i1 = 0; for (int e = 1; e < 8; ++e) if (lg[e] > lg[i1]) i1 = e; int i2 = -1; for (int e = 0; e < 8; ++e) if (e != i1 && (i2 < 0 || lg[e] > lg[i2])) i2 = e;
    const float w1 = 1.f / (1.f + expf(lg[i2] - lg[i1]));
    for (int kk = 0; kk < 2; ++kk) { const int e = kk ? i2 : i1; const float wgt = kk ? 1.f - w1 : w1;
        const float* wg = di.in[I_MOE_WG] + (size_t)e * DM * DFFE; const float* wu = di.in[I_MOE_WU] + (size_t)e * DM * DFFE; const float* wd = di.in[I_MOE_WD] + (size_t)e * DFFE * DM;
        for (int j = t; j < 3584; j += 256) { float g = 0.f, u = 0.f; for (int k2 = 0; k2 < 1024; ++k2) { g += hrow[k2] * wg[(size_t)k2 * DFFE + j]; u += hrow[k2] * wu[(size_t)k2 * DFFE + j]; } act[j] = g / (1.f + expf(-g)) * u; } __syncthreads();
        for (int n = t; n < 1024; n += 256) { float y = 0.f; for (int j = 0; j < 3584; ++j) y += act[j] * wd[(size_t)j * DM + n]; ynaive[n] += wgt * y; } __syncthreads(); }
    const unsigned s1 = sl[tok * 4], s2 = sl[tok * 4 + 1]; const float f1 = __builtin_bit_cast(float, sl[tok * 4 + 2]), f2 = __builtin_bit_cast(float, sl[tok * 4 + 3]);
    float num = 0.f, den = 0.f; for (int n = t; n < 1024; n += 256) { const bf16_t* yb = (const bf16_t*)(ws + WS_YB); const float m = f1 * (bf2f(hp[(size_t)s1 * 1024 + n]) + bf2f(yb[(size_t)s1 * 1024 + n])) + f2 * (bf2f(hp[(size_t)s2 * 1024 + n]) + bf2f(yb[(size_t)s2 * 1024 + n])); num += (m - ynaive[n]) * (m - ynaive[n]); den += ynaive[n] * ynaive[n]; }
    num = dbg_block_sum(num, red); den = dbg_block_sum(den, red);
    if (t == 0) { const float er = sqrtf(num / den); atomicMax((unsigned*)&W[50], __builtin_bit_cast(unsigned, er)); if (er > 0.1f) atomicAdd(&W[51], 1.f); atomicAdd(&W[52], er / 64.f); }
}
#ifndef DBGBR
#define DBGBR -1
#endif
__global__ void dbg_setgates(unsigned char* ws, int br) { float* g = (float*)(ws + WS_GATES); for (size_t i = (size_t)blockIdx.x * 256 + threadIdx.x; i < (size_t)T * 24; i += (size_t)gridDim.x * 256) g[i] = ((int)(i % 3) == br) ? 1.f : 0.f; }
#ifndef DBGV1
#define DBGV1 0
#endif
__global__ void dbg_setv(unsigned char* ws) { bf16_t* kv = (bf16_t*)(ws + WS_KV); for (size_t i = (size_t)blockIdx.x * 256 + threadIdx.x; i < KVSZ; i += (size_t)gridDim.x * 256) { kv[3 * KVSZ + i] = 0x3F80; kv[5 * KVSZ + i] = 0x3F80; } }
#ifndef DBG_UNIT
#define DBG_UNIT 5
#endif
#ifndef DBG_PA
#define DBG_PA 6
#endif
#ifndef DBG_PB
#define DBG_PB 20
#endif
__global__ void dbg_tail(float* out, unsigned char* ws) {
    const int t = threadIdx.x; const float* W = (const float*)(ws + WS_CTL) + 16000; float k = 0.f;
    if (DBG == 400) {
        __shared__ unsigned cnt; if (t == 0) cnt = 0; __syncthreads();
        if (blockIdx.x == 0 && t == 0) cnt = ((const unsigned*)(ws + WS_CTL))[21100];
        __syncthreads();
        const float kb = fminf((float)cnt, 89.f);
        for (size_t i = (size_t)blockIdx.x * 256 + t; i < (size_t)T * DM; i += (size_t)gridDim.x * 256) out[i] = (i == 0) ? (10.f + kb) * 10.f : 3.f;
        return; }
    if (DBG >= 200) {
        const unsigned long long* st = (const unsigned long long*)((const unsigned*)(ws + WS_CTL) + 20000);
        unsigned long long prev = st[63]; int ord = 0; float ka = 0.f, kb = 0.f;
        for (int i = 0; i < 63; ++i) { const unsigned long long v = st[i]; if (v == 0ull) continue; const float us = (float)(v - prev) * 0.01f; prev = v;
            if (ord == DBG_PA) ka = fminf(rintf(us / (float)DBG_UNIT), 89.f); if (ord == DBG_PB) kb = fminf(rintf(us / (float)DBG_UNIT), 89.f); ++ord; }
        (void)ka;
        for (size_t i = (size_t)blockIdx.x * 256 + t; i < (size_t)T * DM; i += (size_t)gridDim.x * 256) out[i] = (i == 0) ? (10.f + kb) * 10.f : 3.f;
        return; }
    if (DBG == 100) { for (int i = 1; i < 10; ++i) if (W[i] > 0.05f) { k = (float)i; break; } }
    else if (DBG == 103) { int m = 0; for (int i = 0; i < 6; ++i) if (!(W[20 + i] <= 0.05f)) m |= 1 << i; k = (float)m; }
    else if (DBG == 104) { int m = 0; for (int i = 6; i < 8; ++i) if (!(W[20 + i] <= 0.05f)) m |= 1 << (i - 6); k = (float)m; }
    else if (DBG == 105 || DBG == 106) { float mn = 1e30f, mx = 0.f; for (int i = 0; i < 8; ++i) { mn = fminf(mn, W[20 + i]); mx = fmaxf(mx, W[20 + i]); }
        k = rintf(10.f * (log10f(fmaxf(DBG == 105 ? mn : mx, 1e-6f)) + 6.f)); k = fminf(fmaxf(k, 0.f), 89.f); }
    else if (DBG == 107) { for (int i = 30; i <= 38; ++i) if (!(W[i] <= 0.03f)) { k = (float)(i - 29); break; } }
    else if (DBG == 101) { for (int i = 0; i < 8; ++i) if (!(W[20 + i] <= 0.05f)) { k = (float)(i + 1); break; } }
    else { k = rintf(10.f * (log10f(fmaxf(W[DBG], 1e-6f)) + 6.f)); k = fminf(fmaxf(k, 0.f), 89.f); }
    const float c = sqrtf(0.1f * k + 0.02f);
    for (size_t i = (size_t)blockIdx.x * 256 + t; i < (size_t)T * DM; i += (size_t)gridDim.x * 256) out[i] = c;
}
#endif

extern "C" void kernel_launch(void* const* d_in, const int* in_sizes, int n_in, void* d_out, int out_size, void* d_ws, size_t ws_size, hipStream_t stream) {
    static int grid = 0;
    if (grid == 0) {
        if (n_in != 30 || out_size != T * DM || ws_size < WS_END2) { fprintf(stderr, "kernel_launch: unexpected problem shape / workspace (%d inputs, out %d, ws %zu)\n", n_in, out_size, ws_size); grid = -1; return; }
        int dev = 0, cus = 0;
        if (hipGetDevice(&dev) != hipSuccess || hipDeviceGetAttribute(&cus, hipDeviceAttributeMultiprocessorCount, dev) != hipSuccess) { grid = -1; return; }
        if (hipFuncSetAttribute((const void*)fwd, hipFuncAttributeMaxDynamicSharedMemorySize, LDS_BYTES) != hipSuccess) { fprintf(stderr, "kernel_launch: hipFuncSetAttribute failed\n"); grid = -1; return; }
        int per_cu = 0;
        if (hipOccupancyMaxActiveBlocksPerMultiprocessor(&per_cu, (const void*)fwd, NWAVES * 64, LDS_BYTES) != hipSuccess || per_cu < 1) { fprintf(stderr, "kernel_launch: occupancy query says %d\n", per_cu); }
        (void)hipGetLastError();
        if (cus != 256) { fprintf(stderr, "kernel_launch: built for a 256-CU device, found %d\n", cus); grid = -1; return; }
        grid = cus;
    }
    if (grid < 0) return;
    if (hipMemsetAsync((char*)d_ws + WS_CTL, 0, CTL_ZERO_BYTES, stream) != hipSuccess) return;
    Args a{};
    for (int i = 0; i < 30; ++i) a.in[i] = (const float*)d_in[i];
    a.out = (float*)d_out; a.ws = (unsigned char*)d_ws;
#if MK_PER_PHASE
    int ids[64]; int n = 0;
    ids[n++] = PH_PRO;
    for (int l = 0; l < NL; ++l) { const int pb = PH_L0 + l * PH_LSTRIDE; for (int k = 0; k < 9; ++k) if (k != PO_N2 && k != PO_S && k != PO_PV) ids[n++] = pb + k;
        if (l == 0) { ids[n++] = pb + PO_F0 + 1; ids[n++] = pb + PO_F0 + 2; } else for (int k = 0; k < 7; ++k) ids[n++] = pb + PO_F0 + k; }
    for (int i = 0; i < n; ++i) { a.ph_lo = ids[i]; a.ph_hi = ids[i] + 1; hipLaunchKernelGGL(fwd, dim3(grid), dim3(NWAVES * 64), LDS_BYTES, stream, a);
#if DBG
        { DbgIn di; for (int q = 0; q < 30; ++q) di.in[q] = (const float*)d_in[q]; const int st = ids[i] - (PH_L0 + PH_LSTRIDE + PO_F0);
          if (st == 5) hipLaunchKernelGGL(dbg_moe_tok, dim3(64), dim3(256), 0, stream, di, (const float*)d_out, (unsigned char*)d_ws);
          if (st >= 1 && st <= 5) hipLaunchKernelGGL(dbg_check, dim3(1), dim3(256), 0, stream, di, (const float*)d_out, (unsigned char*)d_ws, st);
          if (ids[i] == PH_L0 + PO_WIN && DBGBR >= 0) hipLaunchKernelGGL(dbg_setgates, dim3(256), dim3(256), 0, stream, (unsigned char*)d_ws, DBGBR);
          if (ids[i] == PH_L0 + PO_WIN && DBGV1) hipLaunchKernelGGL(dbg_setv, dim3(256), dim3(256), 0, stream, (unsigned char*)d_ws);
          if (ids[i] == PH_L0 + PO_WIN) hipLaunchKernelGGL(dbg_mixer, dim3(1), dim3(256), 0, stream, di, (const float*)d_out, (unsigned char*)d_ws, 30);
          if (ids[i] == PH_L0 + PO_CMP) hipLaunchKernelGGL(dbg_mixer, dim3(1), dim3(256), 0, stream, di, (const float*)d_out, (unsigned char*)d_ws, 31);
          if (ids[i] == PH_L0 + PO_WOUT) hipLaunchKernelGGL(dbg_mixer, dim3(1), dim3(256), 0, stream, di, (const float*)d_out, (unsigned char*)d_ws, 32);
          if (ids[i] == PH_L0 + PO_ATT) { const int pt[8] = {5, 40, 100, 700, 1000, 1500, 3000, 4095};
            for (int q = 0; q < 8; ++q) hipLaunchKernelGGL(dbg_attn, dim3(1), dim3(256), 0, stream, (unsigned char*)d_ws, q & 3, q & 1, pt[q], 20 + q); } }
#endif
    }
#else
    a.ph_lo = 0; a.ph_hi = 1000;
    hipLaunchKernelGGL(fwd, dim3(grid), dim3(NWAVES * 64), LDS_BYTES, stream, a);
#endif
#if DBG
    hipLaunchKernelGGL(dbg_tail, dim3(64), dim3(256), 0, stream, (float*)d_out, (unsigned char*)d_ws);
#endif
}
```

```cpp
#include <hip/hip_runtime.h>
#include <cstdio>
#include <cstdint>
#include <cmath>

#ifndef DBG
#define DBG 0
#endif
#ifndef XMODE
#define XMODE 0
#endif
#ifndef XDIAG
#define XDIAG 0
#endif
#ifndef RES_BF16
#define RES_BF16 1
#endif
#ifndef REP_MASK
#define REP_MASK 0u
#endif
#define REPN(b) (((REP_MASK >> (b)) & 1u) ? 2 : 1)
#ifndef REP_ATT
#define REP_ATT 1
#endif
#ifndef REP_PRO
#define REP_PRO 1
#endif
#ifndef REP_CMP
#define REP_CMP 1
#endif
#ifndef MK_PER_PHASE
#define MK_PER_PHASE 0
#endif

#define LAS __attribute__((address_space(3)))
#define GAS __attribute__((address_space(1)))
typedef unsigned short bf16_t;
typedef short bf16x8 __attribute__((ext_vector_type(8)));
typedef short s16x4 __attribute__((ext_vector_type(4)));
typedef float f32x2 __attribute__((ext_vector_type(2)));
typedef float f32x4 __attribute__((ext_vector_type(4)));
typedef float f32x16 __attribute__((ext_vector_type(16)));
typedef unsigned u32x4 __attribute__((ext_vector_type(4)));
typedef unsigned u32x2 __attribute__((ext_vector_type(2)));

constexpr int NB = 4, SEQ = 4096, DM = 1024, T = NB * SEQ, NL = 2;
constexpr int ZW = 2048;
constexpr int DFF = 2816, DFFE = 3584, NE = 8;
constexpr int MAXT = 136, HALFT = 64, CH1T = MAXT - HALFT;
constexpr float EPS = 1e-6f;
constexpr float C2 = 0.125f * 1.4426950408889634f;
constexpr float CX = 0.0625f * 1.4426950408889634f;

constexpr size_t MiB = 1u << 20;
constexpr size_t WS_CTL = 0, CTL_ZERO_BYTES = 1 * MiB;
constexpr size_t WS_ROPE = 1 * MiB;
constexpr size_t WS_BIAS = 1 * MiB + 512 * 1024;
constexpr size_t WS_ROUTE = 2 * MiB;
constexpr size_t WS_CNTG = 2 * MiB + 512 * 1024;
constexpr size_t WS_TILE = 2 * MiB + 640 * 1024;
constexpr size_t WS_SLOT = 1 * MiB + 512 * 1024;
constexpr size_t WS_YB = 3 * MiB;
constexpr size_t WS_GATES = 4 * MiB;
constexpr size_t WS_KCMP = 6 * MiB;
constexpr size_t WS_HID = 7 * MiB;
constexpr size_t WS_MN = 9 * MiB;
constexpr size_t WS_KX = 13 * MiB;
constexpr size_t WS_VXT = 17 * MiB;
constexpr size_t WS_WIN = 21 * MiB;
constexpr size_t WS_WOUT = 29 * MiB;
constexpr size_t WS_WQ = 33 * MiB, WS_WO = 37 * MiB, WS_WK = 41 * MiB, WS_WV = 45 * MiB;
constexpr size_t WS_CW1 = 49 * MiB;
constexpr size_t WS_CW2 = 53 * MiB;
constexpr size_t WS_FGU = 54 * MiB;
constexpr size_t WS_FD = 65 * MiB;
constexpr size_t WS_MGU = 71 * MiB;
constexpr size_t WS_MD = 183 * MiB;
constexpr size_t WS_HB = 239 * MiB;
constexpr size_t WS_R = 271 * MiB;
constexpr size_t WS_QRAW = WS_R, WS_QROT = WS_R + 16 * MiB, WS_KV = WS_R + 32 * MiB  , WS_U = WS_R + 57 * MiB, WS_AB = WS_R + 73 * MiB;
constexpr size_t WS_QX = WS_R, WS_PB = WS_R + 32 * MiB, WS_OX = WS_R + 73 * MiB;
constexpr size_t WS_ACT0 = WS_R;
constexpr size_t WS_HP = WS_HB;
constexpr size_t WS_ACTC = 307 * MiB;
constexpr size_t WS_END = 433 * MiB;
constexpr size_t WS_XB2 = 433 * MiB;
constexpr size_t WS_END2 = 465 * MiB;
constexpr size_t KVSZ = (size_t)NB * 2 * SEQ * 64;
static_assert(WS_HP + (size_t)MAXT * 256 * 1024 * 2 <= WS_ACTC && WS_ACTC + (size_t)CH1T * 256 * DFFE * 2 <= WS_END && WS_YB + (size_t)MAXT * 256 * 1024 * 2 <= WS_MGU && WS_SLOT + (size_t)T * 16 <= 2 * MiB, "ws map");
static_assert(WS_MGU + (size_t)NE * 7168 * 1024 * 2 <= WS_MD && WS_MD + (size_t)NE * 1024 * DFFE * 2 <= WS_HB, "ws map");

constexpr int CW_TMO = 0, CW_BAR = 4096, CW_BIAS = 8192, CW_SS = 32768;
typedef unsigned long long ssq_t;
#define SSP(i) ((ssq_t*)((unsigned*)(ws + WS_CTL) + CW_SS) + (size_t)(i) * T)
__device__ __forceinline__ float ss_rs(const ssq_t* ss, int row) { return 1.0f / sqrtf((float)((double)ss[row] * (1.0 / 4294967296.0)) * (1.f / DM) + EPS); }
__device__ __forceinline__ ssq_t ss_fix(float v) { return (ssq_t)((double)v * 4294967296.0); }

constexpr int RING_BYTES = 131072;
constexpr int XTRA_OFF = RING_BYTES, XTRA_BYTES = 24576;
constexpr int LDSCTL_OFF = XTRA_OFF + XTRA_BYTES, LDS_BYTES = LDSCTL_OFF + 512;
constexpr int NWAVES = 8;

#define LDS_WAIT() asm volatile("s_waitcnt lgkmcnt(0)" ::: "memory")
#define VM_WAIT() asm volatile("s_waitcnt vmcnt(0)" ::: "memory")
#define RLX_AGENT __ATOMIC_RELAXED, __HIP_MEMORY_SCOPE_AGENT

__device__ __forceinline__ unsigned f2bf(float f) { unsigned u = __builtin_bit_cast(unsigned, f); return (u + 0x7fffu + ((u >> 16) & 1u)) >> 16; }
__device__ __forceinline__ unsigned pk2(float lo, float hi) { return f2bf(lo) | (f2bf(hi) << 16); }
__device__ __forceinline__ float bf2f(unsigned short h) { return __builtin_bit_cast(float, (unsigned)h << 16); }
__device__ __forceinline__ unsigned cvt_pk_bf16(float lo, float hi) { unsigned r; asm volatile("v_cvt_pk_bf16_f32 %0, %1, %2" : "=v"(r) : "v"(lo), "v"(hi)); return r; }
template <int M> __device__ __forceinline__ float xor_get(float v) {
    static_assert(M > 0 && M < 32, "xor_get: within 32 lanes");
    return __builtin_bit_cast(float, __builtin_amdgcn_ds_swizzle(__builtin_bit_cast(int, v), (M << 10) | 0x1f));
}
__device__ __forceinline__ void half_swap(float v, float& lo, float& hi) {
    unsigned a = __builtin_bit_cast(unsigned, v), b = a;
    asm volatile("s_nop 1\n\tv_permlane32_swap_b32 %0, %1\n\ts_nop 1" : "+v"(a), "+v"(b));
    lo = __builtin_bit_cast(float, a); hi = __builtin_bit_cast(float, b);
}
__device__ __forceinline__ float xor32_sum(float v) { float lo, hi; half_swap(v, lo, hi); return lo + hi; }
__device__ __forceinline__ float xor32_max(float v) { float lo, hi; half_swap(v, lo, hi); return fmaxf(lo, hi); }
__device__ __forceinline__ float wave_sum(float v) {
    v += xor_get<1>(v); v += xor_get<2>(v); v += xor_get<4>(v); v += xor_get<8>(v); v += xor_get<16>(v);
    return xor32_sum(v);
}
__device__ __forceinline__ float fast_exp2(float x) { return __builtin_amdgcn_exp2f(x); }

namespace pg8 {
constexpr int BM = 256, BK = 64, HALF = 128, HTB = HALF * BK * 2, NXCD = 8, WGM = 8;
__host__ __device__ __forceinline__ int lds_byte(int r, int c) { const int st = (r >> 4) * 2 + (c >> 5), rr = r & 15, cc = c & 31, ob = rr * 64 + cc * 2; return st * 1024 + (ob ^ (((ob >> 9) & 1) << 5)); }
__host__ __device__ __forceinline__ void stage_rc(int b, int& R, int& C) { const int st = b / 1024, sb = b % 1024, swz = sb ^ (((sb >> 9) & 1) << 5); R = (st >> 1) * 16 + swz / 64; C = (st & 1) * 32 + (swz % 64) / 2; }
__host__ __device__ __forceinline__ int perm32(int rho) { const int n = rho >> 4, i = rho & 15; return 8 * (i >> 2) + 4 * n + (i & 3); }

struct Unit { int pm, pn; long aoff, boff, coff; int ord; };
struct Gemm { const char* A; const char* Bt; int K, lda, ldb; };

struct TileOrder {
    int nM, nN, nwg, G, c;
    __device__ __forceinline__ void init(int nM_, int nN_, int G_, int c_) { nM = nM_; nN = nN_; nwg = nM * nN; G = G_; c = c_; }
    __device__ __forceinline__ bool tile(int i, int& pm, int& pn) const {
        const long L = (long)i * G + c; if (L >= nwg) return false;
        int wgid = (int)L; { const int q = nwg / NXCD, r = nwg % NXCD, xcd = wgid % NXCD, off = wgid / NXCD; wgid = (xcd < r ? xcd * (q + 1) : r * (q + 1) + (xcd - r) * q) + off; }
        const int nig = WGM * nN, gid = wgid / nig, fm = gid * WGM, gsz = (nM - fm) < WGM ? (nM - fm) : WGM;
        pm = fm + ((wgid % nig) % gsz); pn = (wgid % nig) / gsz; return true;
    }
};

template <class Epi, class Sched, bool ALIGN_EPI, bool SP2>
__device__ __forceinline__ void gemm_phase(LAS unsigned char* lds, const Gemm g, const Sched S, const Epi E, int tid_in) {
    int tid_ = tid_in; asm volatile("" : "+v"(tid_));
    const int tid = tid_, wid = __builtin_amdgcn_readfirstlane(tid >> 6), lane = tid & 63, wr = wid >> 2, wc = wid & 3, fr = lane & 15, fq = lane >> 4;
    const int K = g.K, nt = K / BK;
    unsigned voffA[2], voffB[2];
#pragma unroll
    for (int i = 0; i < 2; ++i) { int R, C; stage_rc(tid * 16 + i * 8192, R, C); const int Rb = Epi::PERM ? ((R & ~31) + perm32(R & 31)) : R;
        voffA[i] = (unsigned)(R * g.lda + C) * 2u; voffB[i] = (unsigned)(Rb * g.ldb + C) * 2u; }
    const size_t kstep = (size_t)(BK * 2);
    const size_t hstepA = (size_t)HALF * g.lda * 2, hstepB = (size_t)HALF * g.ldb * 2;
    const unsigned ldsw = (unsigned)wid * 1024u;
    const int aoff = lds_byte(wr * 64 + fr, fq * 8), boff = lds_byte(wc * 32 + fr, fq * 8);
#define PG8_SA(b, h) (((b) * 2 + (h)) * HTB)
#define PG8_SB(b, h) ((4 + (b) * 2 + (h)) * HTB)
#define PG8_STAGE(bufoff, gbase, voff) do { _Pragma("unroll") for (int _i = 0; _i < 2; ++_i) \
        __builtin_amdgcn_global_load_lds((const unsigned*)((const char*)(gbase) + (voff)[_i]), (LAS unsigned*)(lds + (bufoff) + ldsw + _i * 8192), 16, 0, 0); } while (0)
#define PG8_LDA(dst, b, h) do { _Pragma("unroll") for (int m = 0; m < 4; ++m) _Pragma("unroll") for (int k = 0; k < 2; ++k) dst[m][k] = *(const LAS bf16x8*)(lds + PG8_SA(b, h) + aoff + m * 2048 + k * 1024); } while (0)
#define PG8_LDB(dst, b, h) do { _Pragma("unroll") for (int n = 0; n < 2; ++n) _Pragma("unroll") for (int k = 0; k < 2; ++k) dst[n][k] = *(const LAS bf16x8*)(lds + PG8_SB(b, h) + boff + n * 2048 + k * 1024); } while (0)
#define PG8_MMA(ai, bj, At, Bt) do { __builtin_amdgcn_s_setprio(1); _Pragma("unroll") for (int m = 0; m < 4; ++m) _Pragma("unroll") for (int n = 0; n < 2; ++n) _Pragma("unroll") for (int k = 0; k < 2; ++k) \
        acc[ai][bj][m][n] = __builtin_amdgcn_mfma_f32_16x16x32_bf16(Bt[n][k], At[m][k], acc[ai][bj][m][n], 0, 0, 0); __builtin_amdgcn_s_setprio(0); } while (0)
#define PG8_WAIT_V(n) asm volatile("s_waitcnt vmcnt(" #n ")" ::: "memory")
#define PG8_WAIT_L(n) asm volatile("s_waitcnt lgkmcnt(" #n ")" ::: "memory")
#define PG8_BAR __builtin_amdgcn_s_barrier()
#define PG8_SCHED __builtin_amdgcn_sched_barrier(0)
    Unit cur, nxt; int ui = 0;
    if (!S.next(0, cur)) return;
    f32x4 acc[2][2][4][2];
    float zero_ = 0.f; asm volatile("" : "+v"(zero_));
#pragma unroll
    for (int a = 0; a < 2; ++a)
#pragma unroll
        for (int b = 0; b < 2; ++b)
#pragma unroll
            for (int m = 0; m < 4; ++m)
#pragma unroll
                for (int n = 0; n < 2; ++n) acc[a][b][m][n] = (f32x4){zero_, zero_, zero_, zero_};
    bf16x8 At[4][2], B0[2][2], B1[2][2];
    const char* cA = g.A + cur.aoff; const char* cB = g.Bt + cur.boff;
    if constexpr (SP2) {
        PG8_STAGE(PG8_SB(0, 0), cB, voffB); PG8_STAGE(PG8_SB(0, 1), cB + hstepB, voffB); PG8_STAGE(PG8_SA(0, 0), cA, voffA); PG8_STAGE(PG8_SA(0, 1), cA + hstepA, voffA);
        if (wr == 1) PG8_BAR;
        PG8_WAIT_V(2); PG8_BAR;
        PG8_STAGE(PG8_SB(1, 0), cB + kstep, voffB); PG8_STAGE(PG8_SA(1, 0), cA + kstep, voffA); PG8_STAGE(PG8_SB(1, 1), cB + hstepB + kstep, voffB);
        PG8_WAIT_V(6); PG8_BAR;
    } else {
        PG8_STAGE(PG8_SB(0, 0), cB, voffB); PG8_STAGE(PG8_SA(0, 0), cA, voffA); PG8_STAGE(PG8_SB(0, 1), cB + hstepB, voffB); PG8_STAGE(PG8_SA(0, 1), cA + hstepA, voffA);
        if (wr == 1) PG8_BAR;
        PG8_WAIT_V(4); PG8_BAR;
        PG8_STAGE(PG8_SB(1, 0), cB + kstep, voffB); PG8_STAGE(PG8_SA(1, 0), cA + kstep, voffA); PG8_STAGE(PG8_SB(1, 1), cB + hstepB + kstep, voffB);
        PG8_WAIT_V(6); PG8_BAR;
    }
    for (;;) {
        const bool has_next = S.next(ui + 1, nxt);
        const char* nA = has_next ? g.A + nxt.aoff : cA; const char* nB = has_next ? g.Bt + nxt.boff : cB;
#pragma unroll 1
        for (int t = 0; t < nt; t += 2) {
            const bool last = (t == nt - 2);
            const char* a1 = cA + (size_t)(t + 1) * kstep;
            const char* a2 = last ? nA : cA + (size_t)(t + 2) * kstep; const char* b2 = last ? nB : cB + (size_t)(t + 2) * kstep;
            const char* a3 = a2 + kstep; const char* b3 = b2 + kstep;
            if constexpr (SP2) {
            PG8_LDB(B0, 0, 0); PG8_LDB(B1, 0, 1); PG8_SCHED; PG8_LDA(At, 0, 0); PG8_STAGE(PG8_SA(1, 1), a1 + hstepA, voffA);
            PG8_WAIT_V(8); PG8_WAIT_L(0); PG8_BAR; PG8_MMA(0, 0, At, B0); PG8_MMA(0, 1, At, B1); PG8_BAR; PG8_SCHED;
            PG8_LDA(At, 0, 1); PG8_STAGE(PG8_SB(0, 0), b2, voffB); PG8_STAGE(PG8_SB(0, 1), b2 + hstepB, voffB); PG8_STAGE(PG8_SA(0, 0), a2, voffA);
            PG8_WAIT_V(8); PG8_WAIT_L(0); PG8_BAR; PG8_MMA(1, 0, At, B0); PG8_MMA(1, 1, At, B1); PG8_BAR; PG8_SCHED;
            PG8_LDB(B0, 1, 0); PG8_LDB(B1, 1, 1); PG8_SCHED; PG8_LDA(At, 1, 0); PG8_STAGE(PG8_SA(0, 1), a2 + hstepA, voffA);
            PG8_WAIT_V(8); PG8_WAIT_L(0); PG8_BAR; PG8_MMA(0, 0, At, B0); PG8_MMA(0, 1, At, B1); PG8_BAR; PG8_SCHED;
            PG8_LDA(At, 1, 1); PG8_STAGE(PG8_SB(1, 0), b3, voffB); PG8_STAGE(PG8_SB(1, 1), b3 + hstepB, voffB); PG8_STAGE(PG8_SA(1, 0), a3, voffA);
            PG8_WAIT_V(8); PG8_WAIT_L(0); PG8_BAR; PG8_MMA(1, 0, At, B0); PG8_MMA(1, 1, At, B1); PG8_BAR; PG8_SCHED;
            } else {
            PG8_LDB(B0, 0, 0); PG8_SCHED; PG8_LDA(At, 0, 0); PG8_STAGE(PG8_SA(1, 1), a1 + hstepA, voffA);
            PG8_WAIT_L(8); PG8_BAR; PG8_WAIT_L(0); PG8_MMA(0, 0, At, B0); PG8_BAR; PG8_SCHED;
            PG8_LDB(B1, 0, 1); PG8_STAGE(PG8_SB(0, 0), b2, voffB);
            PG8_BAR; PG8_WAIT_L(0); PG8_MMA(0, 1, At, B1); PG8_BAR;
            PG8_LDA(At, 0, 1); PG8_STAGE(PG8_SA(0, 0), a2, voffA);
            PG8_BAR; PG8_WAIT_L(0); PG8_MMA(1, 0, At, B0); PG8_BAR; PG8_SCHED;
            PG8_STAGE(PG8_SB(0, 1), b2 + hstepB, voffB);
            PG8_WAIT_V(6); PG8_BAR; PG8_MMA(1, 1, At, B1); PG8_BAR;
            PG8_LDB(B0, 1, 0); PG8_SCHED; PG8_LDA(At, 1, 0); PG8_STAGE(PG8_SA(0, 1), a2 + hstepA, voffA);
            PG8_WAIT_L(8); PG8_BAR; PG8_WAIT_L(0); PG8_MMA(0, 0, At, B0); PG8_BAR; PG8_SCHED;
            PG8_LDB(B1, 1, 1); PG8_STAGE(PG8_SB(1, 0), b3, voffB);
            PG8_BAR; PG8_WAIT_L(0); PG8_MMA(0, 1, At, B1); PG8_BAR;
            PG8_LDA(At, 1, 1); PG8_STAGE(PG8_SA(1, 0), a3, voffA);
            PG8_BAR; PG8_WAIT_L(0); PG8_MMA(1, 0, At, B0); PG8_BAR; PG8_SCHED;
            PG8_STAGE(PG8_SB(1, 1), b3 + hstepB, voffB);
            PG8_WAIT_V(6); PG8_BAR; PG8_MMA(1, 1, At, B1); PG8_BAR;
            }
        }
        if constexpr (ALIGN_EPI) { if (wr == 0) PG8_BAR; }
        if constexpr (!Epi::AFTER_DRAIN) { E(acc, cur, wr, wc, fr, fq); }
        if (!has_next) break;
#pragma unroll
        for (int a = 0; a < 2; ++a)
#pragma unroll
            for (int b = 0; b < 2; ++b)
#pragma unroll
                for (int m = 0; m < 4; ++m)
#pragma unroll
                    for (int n = 0; n < 2; ++n) acc[a][b][m][n] = (f32x4){zero_, zero_, zero_, zero_};
        cur = nxt; cA = nA; cB = nB; ++ui;
        if constexpr (ALIGN_EPI) { if (wr == 1) PG8_BAR; }
    }
    PG8_WAIT_V(0);
    if constexpr (!ALIGN_EPI) { if (wr == 0) PG8_BAR; }
    PG8_BAR;
    if constexpr (Epi::AFTER_DRAIN) { E.fused(acc, cur, wr, wc, fr, fq, lds, wid, lane); }
#undef PG8_SA
#undef PG8_SB
#undef PG8_STAGE
#undef PG8_LDA
#undef PG8_LDB
#undef PG8_MMA
#undef PG8_WAIT_V
#undef PG8_WAIT_L
#undef PG8_BAR
#undef PG8_SCHED
}
}
using pg8::Unit;
typedef const f32x4 (&AccRef)[2][2][4][2];

struct SchedPlain {
    pg8::TileOrder o; long astep, bstep;
    __device__ void init(int nM, int nN, int lda, int ldb, int G, int c) { o.init(nM, nN, G, c); astep = (long)256 * lda * 2; bstep = (long)256 * ldb * 2; }
    __device__ bool next(int i, Unit& u) const { if (!o.tile(i, u.pm, u.pn)) return false; u.aoff = u.pm * astep; u.boff = u.pn * bstep; u.coff = 0; u.ord = i; return true; }
};
struct SchedOne { Unit u; __device__ bool next(int i, Unit& out) const { if (i > 0) return false; out = u; return true; } };
struct SchedKV {
    int G, c;
    __device__ bool next(int i, Unit& u) const {
        const int L = i * G + c; if (L >= 64 || (G == 1 && i > 0)) return false;
        const int job = L >> 4, l = job >> 1, isv = job & 1; u.pm = (L >> 2) & 3; u.pn = L & 3;
        const long mn = (long)WS_MN + (long)l * 2 * MiB, wk = (long)WS_WK + (long)l * 2 * MiB, wv = (long)WS_WV + (long)l * 2 * MiB;
        const long ts = 256L * 1024 * 2;
        if (!isv) { u.aoff = mn + u.pm * ts; u.boff = wk + u.pn * ts; u.coff = ((long)WS_KX + (long)l * 2 * MiB) / 2; }
        else { u.aoff = mn + u.pm * ts; u.boff = wv + u.pn * ts; u.coff = ((long)WS_VXT + (long)l * 2 * MiB) / 2; }
        return true;
    }
};
template <int MODE> struct SchedX {
    pg8::TileOrder o;
    __device__ void init(int G, int c) { o.init(64, 4, G, c); }
    __device__ bool next(int i, Unit& u) const {
        if (!o.tile(i, u.pm, u.pn)) return false;
        const int b = u.pm >> 4, h = u.pn;
        u.aoff = ((long)u.pm * 256 * 1024 + h * 256) * 2;
        u.boff = MODE == 0 ? ((long)b * 256 * 1024 + h * 256) * 2 : ((long)h * 256 * 1024 + b * 256) * 2;
        u.coff = 0; return true;
    }
};
struct SchedMoe {
    pg8::TileOrder o; const unsigned* texp; int t0, nn; long astep, bstep, estep, cstep, khb, khc;
    __device__ bool next(int i, Unit& u) const {
        int pm, pn; if (!o.tile(i, pm, pn)) return false;
        const int rt = t0 + pm; const int e = (int)texp[rt]; const int kh = pn >= nn ? 1 : 0; pn -= kh * nn;
        u.pm = rt; u.pn = pn; u.aoff = pm * astep + kh * khb; u.boff = e * estep + pn * bstep + kh * khb; u.coff = -(long)t0 * cstep + kh * khc; return true;
    }
};

struct EpiPlain {
    static constexpr bool PERM = true, AFTER_DRAIN = false;
    bf16_t* O; int ldc; const ssq_t* ss;
    __device__ __forceinline__ void operator()(AccRef acc, const Unit& u, int wr, int wc, int fr, int fq) const {
        const int row0 = u.pm * 256 + wr * 64 + fr;
        bf16_t* base = O + u.coff + (size_t)row0 * ldc + u.pn * 256 + wc * 32 + 8 * fq;
#pragma unroll
        for (int ai = 0; ai < 2; ++ai)
#pragma unroll
            for (int m = 0; m < 4; ++m) { const float rs = ss ? ss_rs(ss, row0 + ai * 128 + m * 16) : 1.f;
#pragma unroll
                for (int bj = 0; bj < 2; ++bj) { const f32x4 v0 = acc[ai][bj][m][0] * rs, v1 = acc[ai][bj][m][1] * rs;
                    u32x4 w; w.x = cvt_pk_bf16(v0[0], v0[1]); w.y = cvt_pk_bf16(v0[2], v0[3]); w.z = cvt_pk_bf16(v1[0], v1[1]); w.w = cvt_pk_bf16(v1[2], v1[3]);
                    *(u32x4*)(base + (size_t)(ai * 128 + m * 16) * ldc + bj * 128) = w; } }
    }
};
#ifndef ABL
#define ABL 0
#endif
template <bool SRC_F32> struct EpiResB {
    static constexpr bool PERM = true, AFTER_DRAIN = false;
    const void* src; bf16_t* xo; ssq_t* ss;
    __device__ __forceinline__ void operator()(AccRef acc, const Unit& u, int wr, int wc, int fr, int fq) const {
        const int row0 = u.pm * 256 + wr * 64 + fr;
        const size_t off0 = (size_t)row0 * DM + u.pn * 256 + wc * 32 + 8 * fq;
#pragma unroll
        for (int ai = 0; ai < 2; ++ai)
#pragma unroll
            for (int m = 0; m < 4; ++m) { float part = 0.f;
#pragma unroll
                for (int bj = 0; bj < 2; ++bj) { const size_t off = off0 + (size_t)(ai * 128 + m * 16) * DM + bj * 128;
                    f32x4 s0, s1;
                    if (SRC_F32) { s0 = *(const f32x4*)((const float*)src + off); s1 = *(const f32x4*)((const float*)src + off + 4); }
                    else { const u32x4 w = *(const u32x4*)((const bf16_t*)src + off);
                        s0 = (f32x4){__builtin_bit_cast(float, w.x << 16), __builtin_bit_cast(float, w.x & 0xffff0000u), __builtin_bit_cast(float, w.y << 16), __builtin_bit_cast(float, w.y & 0xffff0000u)};
                        s1 = (f32x4){__builtin_bit_cast(float, w.z << 16), __builtin_bit_cast(float, w.z & 0xffff0000u), __builtin_bit_cast(float, w.w << 16), __builtin_bit_cast(float, w.w & 0xffff0000u)}; }
                    s0 = s0 + acc[ai][bj][m][0]; s1 = s1 + acc[ai][bj][m][1];
                    u32x4 w; w.x = cvt_pk_bf16(s0[0], s0[1]); w.y = cvt_pk_bf16(s0[2], s0[3]); w.z = cvt_pk_bf16(s1[0], s1[1]); w.w = cvt_pk_bf16(s1[2], s1[3]); *(u32x4*)(xo + off) = w;
                    part += ((s0[0] * s0[0] + s0[1] * s0[1]) + (s0[2] * s0[2] + s0[3] * s0[3])) + ((s1[0] * s1[0] + s1[1] * s1[1]) + (s1[2] * s1[2] + s1[3] * s1[3])); }
                if (ss) { part += xor_get<16>(part); part = xor32_sum(part); if (fq == 0) atomicAdd(ss + row0 + ai * 128 + m * 16, ss_fix(part)); } }
    }
};
struct EpiRes {
    static constexpr bool PERM = true, AFTER_DRAIN = false;
    const float* src; float* out; bf16_t* xb; ssq_t* ss;
    __device__ __forceinline__ void operator()(AccRef acc, const Unit& u, int wr, int wc, int fr, int fq) const {
        const int row0 = u.pm * 256 + wr * 64 + fr;
        const size_t off0 = (size_t)row0 * DM + u.pn * 256 + wc * 32 + 8 * fq;
#pragma unroll
        for (int ai = 0; ai < 2; ++ai)
#pragma unroll
            for (int m = 0; m < 4; ++m) { float part = 0.f;
#pragma unroll
                for (int bj = 0; bj < 2; ++bj) { const size_t off = off0 + (size_t)(ai * 128 + m * 16) * DM + bj * 128;
                    const f32x4 s0 = *(const f32x4*)(src + off) + acc[ai][bj][m][0], s1 = *(const f32x4*)(src + off + 4) + acc[ai][bj][m][1];
                    *(f32x4*)(out + off) = s0; *(f32x4*)(out + off + 4) = s1;
                    if (xb) { u32x4 w; w.x = cvt_pk_bf16(s0[0], s0[1]); w.y = cvt_pk_bf16(s0[2], s0[3]); w.z = cvt_pk_bf16(s1[0], s1[1]); w.w = cvt_pk_bf16(s1[2], s1[3]); *(u32x4*)(xb + off) = w;
                        part += ((s0[0] * s0[0] + s0[1] * s0[1]) + (s0[2] * s0[2] + s0[3] * s0[3])) + ((s1[0] * s1[0] + s1[1] * s1[1]) + (s1[2] * s1[2] + s1[3] * s1[3])); } }
                if (xb) { part += xor_get<16>(part); part = xor32_sum(part); if (fq == 0) atomicAdd(ss + row0 + ai * 128 + m * 16, ss_fix(part)); } }
    }
};
__device__ __forceinline__ float gelu_tanh(float x) {
    const float y = 0.7978845608028654f * (x + 0.044715f * x * x * x);
    const float e = fast_exp2(y * 2.8853900817779268f);
    const float th = 1.f - 2.f * __builtin_amdgcn_rcpf(e + 1.f);
    return 0.5f * x * (1.f + th);
}
struct EpiHid {
    static constexpr bool PERM = true, AFTER_DRAIN = false;
    bf16_t* O; const long long* bias;
    __device__ __forceinline__ void operator()(AccRef acc, const Unit& u, int wr, int wc, int fr, int fq) const {
        bf16_t* base = O + (size_t)(u.pm * 256 + wr * 64 + fr) * 256 + wc * 32 + 8 * fq;
#pragma unroll
        for (int bj = 0; bj < 2; ++bj) { const long long* bp = bias + bj * 128 + wc * 32 + 8 * fq; f32x4 b0, b1;
#pragma unroll
            for (int j = 0; j < 4; ++j) { b0[j] = (float)((double)bp[j] * (1.0 / 1099511627776.0)); b1[j] = (float)((double)bp[4 + j] * (1.0 / 1099511627776.0)); }
#pragma unroll
            for (int ai = 0; ai < 2; ++ai)
#pragma unroll
                for (int m = 0; m < 4; ++m) { const f32x4 v0 = acc[ai][bj][m][0] + b0, v1 = acc[ai][bj][m][1] + b1;
                    u32x4 w; w.x = cvt_pk_bf16(gelu_tanh(v0[0]), gelu_tanh(v0[1])); w.y = cvt_pk_bf16(gelu_tanh(v0[2]), gelu_tanh(v0[3]));
                    w.z = cvt_pk_bf16(gelu_tanh(v1[0]), gelu_tanh(v1[1])); w.w = cvt_pk_bf16(gelu_tanh(v1[2]), gelu_tanh(v1[3]));
                    *(u32x4*)(base + (size_t)(ai * 128 + m * 16) * 256 + bj * 128) = w; } }
    }
};
struct EpiCmp2 {
    static constexpr bool PERM = true, AFTER_DRAIN = false;
    bf16_t* O;
    __device__ __forceinline__ void operator()(AccRef acc, const Unit& u, int wr, int wc, int fr, int fq) const {
        if (wc >= 2) return;
#pragma unroll
        for (int ai = 0; ai < 2; ++ai)
#pragma unroll
            for (int m = 0; m < 4; ++m) { const int row = u.pm * 256 + ai * 128 + wr * 64 + m * 16 + fr; const f32x4 v0 = acc[ai][0][m][0], v1 = acc[ai][0][m][1];
                u32x4 w; w.x = cvt_pk_bf16(v0[0], v0[1]); w.y = cvt_pk_bf16(v0[2], v0[3]); w.z = cvt_pk_bf16(v1[0], v1[1]); w.w = cvt_pk_bf16(v1[2], v1[3]);
                if ((row & 255) == 255) w = (u32x4){0u, 0u, 0u, 0u};
                *(u32x4*)(O + (size_t)row * 64 + wc * 32 + 8 * fq) = w; }
    }
};
__device__ __forceinline__ float silu_mul(float g, float u) { return g * __builtin_amdgcn_rcpf(1.f + fast_exp2(-1.4426950408889634f * g)) * u; }
template <int RS>
struct EpiSwiglu {
    static constexpr bool PERM = true, AFTER_DRAIN = false;
    bf16_t* O; int ldc; const LAS float* rsl; const ssq_t* ss;
    __device__ __forceinline__ void operator()(AccRef acc, const Unit& u, int wr, int wc, int fr, int fq) const {
        const int row0 = u.pm * 256 + wr * 64 + fr;
        bf16_t* base = O + u.coff + (size_t)row0 * ldc + u.pn * 128 + wc * 32 + 8 * fq;
#pragma unroll
        for (int ai = 0; ai < 2; ++ai)
#pragma unroll
            for (int m = 0; m < 4; ++m) { f32x4 g0 = acc[ai][0][m][0], g1 = acc[ai][0][m][1], u0 = acc[ai][1][m][0], u1 = acc[ai][1][m][1];
                if constexpr (RS == 1) { const float rs = rsl[256 * u.ord + wr * 64 + fr + ai * 128 + m * 16]; g0 *= rs; g1 *= rs; u0 *= rs; u1 *= rs; }
                if constexpr (RS == 2) { const float rs = ss_rs(ss, row0 + ai * 128 + m * 16); g0 *= rs; g1 *= rs; u0 *= rs; u1 *= rs; }
                u32x4 w; w.x = cvt_pk_bf16(silu_mul(g0[0], u0[0]), silu_mul(g0[1], u0[1])); w.y = cvt_pk_bf16(silu_mul(g0[2], u0[2]), silu_mul(g0[3], u0[3]));
                w.z = cvt_pk_bf16(silu_mul(g1[0], u1[0]), silu_mul(g1[1], u1[1])); w.w = cvt_pk_bf16(silu_mul(g1[2], u1[2]), silu_mul(g1[3], u1[3]));
                *(u32x4*)(base + (size_t)(ai * 128 + m * 16) * ldc) = w; }
    }
};
struct EpiWin {
    static constexpr bool PERM = true, AFTER_DRAIN = false;
    bf16_t *qraw, *qrot, *kv, *ub; float* gates; const float* rope; const ssq_t* ss;
    __device__ __forceinline__ void operator()(AccRef acc, const Unit& u, int wr, int wc, int fr, int fq) const {
        const int pn = u.pn;
#pragma unroll
        for (int ai = 0; ai < 2; ++ai)
#pragma unroll
            for (int m = 0; m < 4; ++m) {
                const int row = u.pm * 256 + ai * 128 + wr * 64 + m * 16 + fr, b = row >> 12, t = row & 4095;
                const float rs = ss_rs(ss, row);
#pragma unroll
                for (int bj = 0; bj < 2; ++bj) {
                    float v[8];
#pragma unroll
                    for (int j = 0; j < 4; ++j) { v[j] = acc[ai][bj][m][0][j] * rs; v[4 + j] = acc[ai][bj][m][1][j] * rs; }
                    if (pn < 2) {
                        const size_t idx = ((size_t)(b * 2 + pn) * SEQ + t) * 256 + bj * 128 + wc * 32 + 8 * fq;
                        u32x4 w; w.x = cvt_pk_bf16(v[0] * C2, v[1] * C2); w.y = cvt_pk_bf16(v[2] * C2, v[3] * C2); w.z = cvt_pk_bf16(v[4] * C2, v[5] * C2); w.w = cvt_pk_bf16(v[6] * C2, v[7] * C2);
                        *(u32x4*)(qraw + idx) = w;
                        if ((wc & 1) == 0) {
                            float p[8];
#pragma unroll
                            for (int j = 0; j < 8; ++j) p[j] = xor_get<16>(v[j]);
                            if (fq < 2) { const float* rp = rope + (size_t)t * 16;
#pragma unroll
                                for (int j = 0; j < 8; ++j) { const float cs = rp[2 * j], sn = rp[2 * j + 1]; v[j] = fq == 0 ? v[j] * cs - p[j] * sn : v[j] * cs + p[j] * sn; } }
                            w.x = cvt_pk_bf16(v[0] * C2, v[1] * C2); w.y = cvt_pk_bf16(v[2] * C2, v[3] * C2); w.z = cvt_pk_bf16(v[4] * C2, v[5] * C2); w.w = cvt_pk_bf16(v[6] * C2, v[7] * C2);
                        }
                        *(u32x4*)(qrot + idx) = w;
                    } else if (pn < 5) {
                        const int i = 2 * (pn - 2) + bj, g = wc >> 1;
                        if (bj == 0 && pn >= 3 && (wc & 1) == 0) {
                            float p[8];
#pragma unroll
                            for (int j = 0; j < 8; ++j) p[j] = xor_get<16>(v[j]);
                            if (fq < 2) { const float* rp = rope + (size_t)t * 16;
#pragma unroll
                                for (int j = 0; j < 8; ++j) { const float cs = rp[2 * j], sn = rp[2 * j + 1]; v[j] = fq == 0 ? v[j] * cs - p[j] * sn : v[j] * cs + p[j] * sn; } }
                        }
                        u32x4 w; w.x = cvt_pk_bf16(v[0], v[1]); w.y = cvt_pk_bf16(v[2], v[3]); w.z = cvt_pk_bf16(v[4], v[5]); w.w = cvt_pk_bf16(v[6], v[7]);
                        *(u32x4*)(kv + (size_t)i * KVSZ + ((size_t)(b * 2 + g) * SEQ + t) * 64 + (wc & 1) * 32 + 8 * fq) = w;
                    } else if (pn < 7) {
                        u32x4 w; w.x = cvt_pk_bf16(v[0], v[1]); w.y = cvt_pk_bf16(v[2], v[3]); w.z = cvt_pk_bf16(v[4], v[5]); w.w = cvt_pk_bf16(v[6], v[7]);
                        *(u32x4*)(ub + (size_t)row * 512 + (pn - 5) * 256 + bj * 128 + wc * 32 + 8 * fq) = w;
                    } else {
                        if (bj == 0 && wc == 0 && fq < 3) { float* gp = gates + (size_t)row * 24 + 8 * fq;
#pragma unroll
                            for (int j = 0; j < 8; ++j) gp[j] = __builtin_amdgcn_rcpf(1.f + fast_exp2(-1.4426950408889634f * v[j])); }
                    }
                }
            }
    }
};
struct EpiSoftmax {
    static constexpr bool PERM = true, AFTER_DRAIN = true;
    bf16_t* P;
    __device__ __forceinline__ void operator()(AccRef, const Unit&, int, int, int, int) const {}
    __device__ __forceinline__ void fused(f32x4 (&acc)[2][2][4][2], const Unit& u, int wr, int wc, int fr, int fq, LAS unsigned char* lds, int wid, int lane) const {
        LAS float* RM = (LAS float*)lds;
        LAS float* RS = (LAS float*)(lds + 4096);
        float mx[2][4];
#pragma unroll
        for (int ai = 0; ai < 2; ++ai)
#pragma unroll
            for (int m = 0; m < 4; ++m) { float a = -INFINITY;
#pragma unroll
                for (int bj = 0; bj < 2; ++bj)
#pragma unroll
                    for (int n = 0; n < 2; ++n)
#pragma unroll
                        for (int e = 0; e < 4; ++e) a = fmaxf(a, acc[ai][bj][m][n][e]);
                a = fmaxf(a, xor_get<16>(a)); a = xor32_max(a);
                if (fq == 0) RM[(ai * 128 + wr * 64 + m * 16 + fr) * 4 + wc] = a; }
        LDS_WAIT(); __builtin_amdgcn_s_barrier(); asm volatile("" ::: "memory");
#pragma unroll
        for (int ai = 0; ai < 2; ++ai)
#pragma unroll
            for (int m = 0; m < 4; ++m) { const int r = ai * 128 + wr * 64 + m * 16 + fr; const f32x4 q = *(const LAS f32x4*)(RM + r * 4);
                const float mm = fmaxf(fmaxf(q[0], q[1]), fmaxf(q[2], q[3])); float s = 0.f;
#pragma unroll
                for (int bj = 0; bj < 2; ++bj)
#pragma unroll
                    for (int n = 0; n < 2; ++n)
#pragma unroll
                        for (int e = 0; e < 4; ++e) { const float p = fast_exp2((acc[ai][bj][m][n][e] - mm) * CX); acc[ai][bj][m][n][e] = p; s += p; }
                s += xor_get<16>(s); s = xor32_sum(s);
                if (fq == 0) RS[r * 4 + wc] = s; }
        LDS_WAIT(); __builtin_amdgcn_s_barrier(); asm volatile("" ::: "memory");
        bf16_t* base = P + (size_t)(u.pm * 256 + wr * 64 + fr) * DM + u.pn * 256 + wc * 32 + 8 * fq;
#pragma unroll
        for (int ai = 0; ai < 2; ++ai)
#pragma unroll
            for (int m = 0; m < 4; ++m) { const int r = ai * 128 + wr * 64 + m * 16 + fr; const f32x4 q = *(const LAS f32x4*)(RS + r * 4);
                const float inv = 1.f / ((q[0] + q[1]) + (q[2] + q[3]));
#pragma unroll
                for (int bj = 0; bj < 2; ++bj) { u32x4 w;
                    const f32x4 p0 = acc[ai][bj][m][0] * inv, p1 = acc[ai][bj][m][1] * inv;
                    w.x = cvt_pk_bf16(p0[0], p0[1]); w.y = cvt_pk_bf16(p0[2], p0[3]); w.z = cvt_pk_bf16(p1[0], p1[1]); w.w = cvt_pk_bf16(p1[2], p1[3]);
                    *(u32x4*)(base + (size_t)(ai * 128 + m * 16) * DM + bj * 128) = w; } }
        LDS_WAIT(); __builtin_amdgcn_s_barrier(); asm volatile("" ::: "memory");
    }
};

namespace nsa {
constexpr int L_K = 0, L_V = 24576, L_PCS = 49152, L_OST = 114688, L_WSF = 147456, L_SEL = 149504;
static_assert(L_SEL + 512 <= LDSCTL_OFF, "attention LDS map");
__device__ __forceinline__ int crow(int r, int hi) { return (r & 3) + 8 * (r >> 2) + 4 * hi; }
__device__ __forceinline__ constexpr int ccol(int r) { return (r & 3) + 8 * (r >> 2); }
__device__ __forceinline__ unsigned cvtpk(float lo, float hi) { return cvt_pk_bf16(lo, hi); }

__device__ __forceinline__ void qkt(f32x16& p0, f32x16& p1, const LAS unsigned char* Kslot, const bf16x8* qr, int r32, int hi, float zero_) {
    const LAS unsigned char* kb = Kslot + hi * 1024 + r32 * 16;
    f32x16 z;
#pragma unroll
    for (int r = 0; r < 16; ++r) z[r] = zero_;
    p0 = z; p1 = z;
#pragma unroll
    for (int d0 = 0; d0 < 4; ++d0) {
        const bf16x8 b0 = *(const LAS bf16x8*)(kb + d0 * 2048);
        const bf16x8 b1 = *(const LAS bf16x8*)(kb + d0 * 2048 + 512);
        p0 = __builtin_amdgcn_mfma_f32_32x32x16_bf16(b0, qr[d0], p0, 0, 0, 0);
        p1 = __builtin_amdgcn_mfma_f32_32x32x16_bf16(b1, qr[d0], p1, 0, 0, 0);
    }
}
__device__ __forceinline__ void qkt_c(f32x16& p0, f32x16& p1, const LAS unsigned char* Kslot, const bf16x8* qr, int r32, int hi, const f32x16& c) {
    const LAS unsigned char* kb = Kslot + hi * 1024 + r32 * 16;
#pragma unroll
    for (int d0 = 0; d0 < 4; ++d0) {
        const bf16x8 b0 = *(const LAS bf16x8*)(kb + d0 * 2048);
        const bf16x8 b1 = *(const LAS bf16x8*)(kb + d0 * 2048 + 512);
        if (d0 == 0) { p0 = __builtin_amdgcn_mfma_f32_32x32x16_bf16(b0, qr[0], c, 0, 0, 0); p1 = __builtin_amdgcn_mfma_f32_32x32x16_bf16(b1, qr[0], c, 0, 0, 0); }
        else { p0 = __builtin_amdgcn_mfma_f32_32x32x16_bf16(b0, qr[d0], p0, 0, 0, 0); p1 = __builtin_amdgcn_mfma_f32_32x32x16_bf16(b1, qr[d0], p1, 0, 0, 0); }
    }
}
__device__ __forceinline__ void pv(f32x16* o, int vb, bf16x8 pa0, bf16x8 pa1, bf16x8 pa2, bf16x8 pa3) {
#pragma unroll
    for (int d0 = 0; d0 < 2; ++d0) { s16x4 lo[4], hi[4];
#pragma unroll
        for (int ks = 0; ks < 4; ++ks) {
            asm volatile("ds_read_b64_tr_b16 %0,%1 offset:%c2" : "=&v"(lo[ks]) : "v"(vb), "i"(d0 * 4096 + ks * 1024) : "memory");
            asm volatile("ds_read_b64_tr_b16 %0,%1 offset:%c2" : "=&v"(hi[ks]) : "v"(vb), "i"(d0 * 4096 + ks * 1024 + 512) : "memory"); }
        asm volatile("s_waitcnt lgkmcnt(0)" ::: "memory"); __builtin_amdgcn_sched_barrier(0);
#define NSA_PK(k) (bf16x8){lo[k][0], lo[k][1], lo[k][2], lo[k][3], hi[k][0], hi[k][1], hi[k][2], hi[k][3]}
        o[d0] = __builtin_amdgcn_mfma_f32_32x32x16_bf16(pa0, NSA_PK(0), o[d0], 0, 0, 0);
        o[d0] = __builtin_amdgcn_mfma_f32_32x32x16_bf16(pa1, NSA_PK(1), o[d0], 0, 0, 0);
        o[d0] = __builtin_amdgcn_mfma_f32_32x32x16_bf16(pa2, NSA_PK(2), o[d0], 0, 0, 0);
        o[d0] = __builtin_amdgcn_mfma_f32_32x32x16_bf16(pa3, NSA_PK(3), o[d0], 0, 0, 0);
#undef NSA_PK
    }
}
__device__ __forceinline__ void x_fused(f32x16* o, int vb, bf16x8 pa0, bf16x8 pa1, bf16x8 pa2, bf16x8 pa3, f32x16& p0, f32x16& p1, int ka, int qa, const f32x16& c) {
    s16x4 l0[4], h0[4], l1[4], h1[4];
#pragma unroll
    for (int ks = 0; ks < 4; ++ks) {
        asm volatile("ds_read_b64_tr_b16 %0,%1 offset:%c2" : "=&v"(l0[ks]) : "v"(vb), "i"(ks * 1024) : "memory");
        asm volatile("ds_read_b64_tr_b16 %0,%1 offset:%c2" : "=&v"(h0[ks]) : "v"(vb), "i"(ks * 1024 + 512) : "memory"); }
#pragma unroll
    for (int ks = 0; ks < 4; ++ks) {
        asm volatile("ds_read_b64_tr_b16 %0,%1 offset:%c2" : "=&v"(l1[ks]) : "v"(vb), "i"(4096 + ks * 1024) : "memory");
        asm volatile("ds_read_b64_tr_b16 %0,%1 offset:%c2" : "=&v"(h1[ks]) : "v"(vb), "i"(4096 + ks * 1024 + 512) : "memory"); }
    asm volatile("s_waitcnt lgkmcnt(8)" : "+v"(l0[0]), "+v"(l0[1]), "+v"(l0[2]), "+v"(l0[3]), "+v"(h0[0]), "+v"(h0[1]), "+v"(h0[2]), "+v"(h0[3]) :: "memory"); __builtin_amdgcn_sched_barrier(0);
#define NSA_PK2(l, h, k) (bf16x8){l[k][0], l[k][1], l[k][2], l[k][3], h[k][0], h[k][1], h[k][2], h[k][3]}
    o[0] = __builtin_amdgcn_mfma_f32_32x32x16_bf16(pa0, NSA_PK2(l0, h0, 0), o[0], 0, 0, 0);
    o[0] = __builtin_amdgcn_mfma_f32_32x32x16_bf16(pa1, NSA_PK2(l0, h0, 1), o[0], 0, 0, 0);
    o[0] = __builtin_amdgcn_mfma_f32_32x32x16_bf16(pa2, NSA_PK2(l0, h0, 2), o[0], 0, 0, 0);
    o[0] = __builtin_amdgcn_mfma_f32_32x32x16_bf16(pa3, NSA_PK2(l0, h0, 3), o[0], 0, 0, 0);
    __builtin_amdgcn_sched_barrier(0);
    bf16x8 b0[4], b1[4], qr[4];
#define NSA_RDK(d0) do { asm volatile("ds_read_b128 %0,%1 offset:%c2" : "=&v"(b0[d0]) : "v"(ka), "i"((d0) * 2048) : "memory"); \
                         asm volatile("ds_read_b128 %0,%1 offset:%c2" : "=&v"(b1[d0]) : "v"(ka), "i"((d0) * 2048 + 512) : "memory"); \
                         asm volatile("ds_read_b128 %0,%1 offset:%c2" : "=&v"(qr[d0]) : "v"(qa), "i"((d0) * 1024) : "memory"); } while (0)
    NSA_RDK(0); NSA_RDK(1);
    asm volatile("s_waitcnt lgkmcnt(6)" : "+v"(l1[0]), "+v"(l1[1]), "+v"(l1[2]), "+v"(l1[3]), "+v"(h1[0]), "+v"(h1[1]), "+v"(h1[2]), "+v"(h1[3]) :: "memory"); __builtin_amdgcn_sched_barrier(0);
    o[1] = __builtin_amdgcn_mfma_f32_32x32x16_bf16(pa0, NSA_PK2(l1, h1, 0), o[1], 0, 0, 0);
    o[1] = __builtin_amdgcn_mfma_f32_32x32x16_bf16(pa1, NSA_PK2(l1, h1, 1), o[1], 0, 0, 0);
    o[1] = __builtin_amdgcn_mfma_f32_32x32x16_bf16(pa2, NSA_PK2(l1, h1, 2), o[1], 0, 0, 0);
    o[1] = __builtin_amdgcn_mfma_f32_32x32x16_bf16(pa3, NSA_PK2(l1, h1, 3), o[1], 0, 0, 0);
#undef NSA_PK2
    __builtin_amdgcn_sched_barrier(0);
    NSA_RDK(2); NSA_RDK(3);
#undef NSA_RDK
    asm volatile("s_waitcnt lgkmcnt(9)" : "+v"(b0[0]), "+v"(b1[0]), "+v"(qr[0]) :: "memory"); __builtin_amdgcn_sched_barrier(0);
    p0 = __builtin_amdgcn_mfma_f32_32x32x16_bf16(b0[0], qr[0], c, 0, 0, 0); p1 = __builtin_amdgcn_mfma_f32_32x32x16_bf16(b1[0], qr[0], c, 0, 0, 0);
    asm volatile("s_waitcnt lgkmcnt(6)" : "+v"(b0[1]), "+v"(b1[1]), "+v"(qr[1]) :: "memory"); __builtin_amdgcn_sched_barrier(0);
    p0 = __builtin_amdgcn_mfma_f32_32x32x16_bf16(b0[1], qr[1], p0, 0, 0, 0); p1 = __builtin_amdgcn_mfma_f32_32x32x16_bf16(b1[1], qr[1], p1, 0, 0, 0);
    asm volatile("s_waitcnt lgkmcnt(3)" : "+v"(b0[2]), "+v"(b1[2]), "+v"(qr[2]) :: "memory"); __builtin_amdgcn_sched_barrier(0);
    p0 = __builtin_amdgcn_mfma_f32_32x32x16_bf16(b0[2], qr[2], p0, 0, 0, 0); p1 = __builtin_amdgcn_mfma_f32_32x32x16_bf16(b1[2], qr[2], p1, 0, 0, 0);
    asm volatile("s_waitcnt lgkmcnt(0)" : "+v"(b0[3]), "+v"(b1[3]), "+v"(qr[3]) :: "memory"); __builtin_amdgcn_sched_barrier(0);
    p0 = __builtin_amdgcn_mfma_f32_32x32x16_bf16(b0[3], qr[3], p0, 0, 0, 0); p1 = __builtin_amdgcn_mfma_f32_32x32x16_bf16(b1[3], qr[3], p1, 0, 0, 0);
}
__device__ __forceinline__ void mask_tile(f32x16& p0, f32x16& p1, int lo, int hi_, int hi) {
    int lo2 = lo - 4 * hi, hi2 = hi_ - 4 * hi; asm volatile("" : "+v"(lo2), "+v"(hi2));
#pragma unroll
    for (int r = 0; r < 16; ++r) { if (ccol(r) < lo2 || ccol(r) > hi2) p0[r] = -INFINITY; if (ccol(r) + 32 < lo2 || ccol(r) + 32 > hi2) p1[r] = -INFINITY; }
}
__device__ __forceinline__ float max3f(float a, float b, float c) { float r; asm("v_max3_f32 %0, %1, %2, %3" : "=v"(r) : "v"(a), "v"(b), "v"(c)); return r; }
__device__ __forceinline__ float tile_max(const f32x16& p0, const f32x16& p1) {
    float a = max3f(p0[0], p0[1], p1[0]), b = max3f(p0[2], p0[3], p1[1]); a = max3f(a, p1[2], p1[3]);
#pragma unroll
    for (int r = 4; r < 16; r += 4) { a = max3f(a, p0[r], p0[r + 1]); b = max3f(b, p0[r + 2], p0[r + 3]); a = max3f(a, p1[r], p1[r + 1]); b = max3f(b, p1[r + 2], p1[r + 3]); }
    float lo, hi; half_swap(max3f(a, b, b), lo, hi); return max3f(lo, hi, hi);
}
__device__ __forceinline__ void pack_p(const f32x16& p0, const f32x16& p1, bf16x8& a0, bf16x8& a1, bf16x8& a2, bf16x8& a3) {
    u32x4 w0, w1, w2, w3;
    w0 = (u32x4){cvtpk(p0[0], p0[1]), cvtpk(p0[2], p0[3]), cvtpk(p0[4], p0[5]), cvtpk(p0[6], p0[7])};
    w1 = (u32x4){cvtpk(p0[8], p0[9]), cvtpk(p0[10], p0[11]), cvtpk(p0[12], p0[13]), cvtpk(p0[14], p0[15])};
    w2 = (u32x4){cvtpk(p1[0], p1[1]), cvtpk(p1[2], p1[3]), cvtpk(p1[4], p1[5]), cvtpk(p1[6], p1[7])};
    w3 = (u32x4){cvtpk(p1[8], p1[9]), cvtpk(p1[10], p1[11]), cvtpk(p1[12], p1[13]), cvtpk(p1[14], p1[15])};
    a0 = __builtin_bit_cast(bf16x8, w0); a1 = __builtin_bit_cast(bf16x8, w1); a2 = __builtin_bit_cast(bf16x8, w2); a3 = __builtin_bit_cast(bf16x8, w3);
}
__device__ __forceinline__ void online_step(f32x16& p0, f32x16& p1, float& m, float& l, f32x16* o, LAS float* wsf, int r32, int hi) {
    const float rm = tile_max(p0, p1);
    const float mn = fmaxf(m, rm), mu = (mn == -INFINITY) ? 0.f : mn;
    const float sc = fast_exp2(m - mu);
    float s = 0.f;
#pragma unroll
    for (int r = 0; r < 16; ++r) { p0[r] = fast_exp2(p0[r] - mu); p1[r] = fast_exp2(p1[r] - mu); s += p0[r] + p1[r]; }
    l = l * sc + s; m = mn;
    if (__any(sc != 1.f)) {
        if (hi == 0) wsf[r32] = sc;
        LDS_WAIT();
#pragma unroll
        for (int r = 0; r < 16; ++r) { const float f = wsf[crow(r, hi)]; o[0][r] *= f; o[1][r] *= f; }
        LDS_WAIT();
    }
}

struct Ptrs { const bf16_t* qraw; const bf16_t* qrot; const bf16_t* kv; const bf16_t* kcmp; const bf16_t* vcmp; const float* gates; bf16_t* ab; };

template <bool WITH_V, class F>
__device__ __forceinline__ void tile_loop(int n, const bf16_t* Kb, const bf16_t* Vb, int row0, LAS unsigned char* lds, int wid, int lane, F&& body) {
    const bf16_t* ksrc = Kb + (size_t)(row0 + lane) * 64 + wid * 8;
    const bf16_t* vsrc = Vb + (size_t)(row0 + 16 * (wid & 3) + (lane >> 2)) * 64 + (wid >> 2) * 32 + (lane & 3) * 8;
#define NSA_ISSUE(i) do { const int sl_ = ((i) & 1) * 8192; \
        __builtin_amdgcn_global_load_lds((const unsigned*)(ksrc + (size_t)(i) * 4096), (LAS unsigned*)(lds + L_K + sl_ + wid * 1024), 16, 0, 0); \
        if (WITH_V) __builtin_amdgcn_global_load_lds((const unsigned*)(vsrc + (size_t)(i) * 4096), (LAS unsigned*)(lds + L_V + sl_ + wid * 1024), 16, 0, 0); } while (0)
    NSA_ISSUE(0);
    for (int i = 0; i < n; ++i) {
        VM_WAIT(); __syncthreads();
        if (i + 1 < n) NSA_ISSUE(i + 1);
        body(i, (i & 1) * 8192);
    }
    __syncthreads();
#undef NSA_ISSUE
}

template <int MODE>
__device__ __forceinline__ void branch_pipe(int n, const bf16_t* Kb, const bf16_t* Vb, int row0, LAS unsigned char* lds, int wid, int lane, int r32, int hi, int qa,
                                            unsigned long long sel, int tl, int qt, int kt0, float gate, LAS float* otl, LAS float* wsf, int vb0, float zero_) {
    const int half = wid >> 2;
    const bf16_t* ksrc = Kb + (size_t)(row0 + lane) * 64 + wid * 8;
    const bf16_t* vsrc = Vb + (size_t)(row0 + 16 * (wid & 3) + (lane >> 2)) * 64 + (wid >> 2) * 32 + (lane & 3) * 8;
#define BP_ISSUE_K(i, slot) __builtin_amdgcn_global_load_lds((const unsigned*)(ksrc + (size_t)(i) * 4096), (LAS unsigned*)(lds + L_K + (slot) + wid * 1024), 16, 0, 0)
#define BP_ISSUE_V(i, slot) __builtin_amdgcn_global_load_lds((const unsigned*)(vsrc + (size_t)(i) * 4096), (LAS unsigned*)(lds + L_V + (slot) + wid * 1024), 16, 0, 0)
#define BP_NEXT(s) ((s) == 16384 ? 0 : (s) + 8192)
#define BP_WAIT(c) do { if ((c) == 2) asm volatile("s_waitcnt vmcnt(2)" ::: "memory"); else if ((c) == 1) asm volatile("s_waitcnt vmcnt(1)" ::: "memory"); else asm volatile("s_waitcnt vmcnt(0)" ::: "memory"); } while (0)
#define BP_BAR() asm volatile("s_waitcnt lgkmcnt(0)\n\ts_barrier" ::: "memory")
    f32x16 o[2], p0, p1;
#pragma unroll
    for (int r = 0; r < 16; ++r) { o[0][r] = zero_; o[1][r] = zero_; p0[r] = zero_; p1[r] = zero_; }
    bf16x8 a0 = {0, 0, 0, 0, 0, 0, 0, 0}, a1 = a0, a2 = a0, a3 = a0;
    constexpr float THR = 8.f;
    f32x16 negm;
#pragma unroll
    for (int r = 0; r < 16; ++r) negm[r] = zero_;
    float mref = 0.f, l = 0.f; bool resc = false;
    const int kb0 = (int)(unsigned)(uintptr_t)(lds + L_K) + hi * 1024 + r32 * 16;
    BP_ISSUE_K(0, 0); if (n > 1) BP_ISSUE_K(1, 8192); BP_ISSUE_V(0, 0); VM_WAIT(); BP_BAR();
    int s0 = 0, sm1 = 16384;
    auto X = [&](int i) {
        if (i > 0) {
            if (resc) {
#pragma unroll
                for (int r = 0; r < 16; ++r) { const float f = (wsf + 4 * hi)[ccol(r)]; o[0][r] *= f; o[1][r] *= f; }
                LDS_WAIT(); }
            if (i < n) { x_fused(o, vb0 + sm1, a0, a1, a2, a3, p0, p1, kb0 + s0, qa, negm); return; }
            pv(o, vb0 + sm1, a0, a1, a2, a3);
        }
        if (i < n) { bf16x8 q4[4];
#pragma unroll
            for (int d0 = 0; d0 < 4; ++d0) q4[d0] = *(const LAS bf16x8*)(lds + L_OST + wid * 4096 + d0 * 1024 + lane * 16);
            qkt_c(p0, p1, lds + L_K + s0, q4, r32, hi, negm); }
    };
    auto Y = [&](int i) {
        int lo = 0, hi_ = 63; bool rowsel = true;
        if (MODE == 2) { rowsel = ((sel >> i) & 1ull) != 0; if (i == qt) hi_ = tl; }
        else { const int kt = kt0 + i; if (kt == qt - 8) lo = tl + 1; if (kt == qt) hi_ = tl; }
        if (!__all(lo <= 0 && hi_ >= 63)) mask_tile(p0, p1, lo, hi_, hi);
        else asm volatile("s_nop 15\n\ts_nop 7" : "+v"(p0), "+v"(p1));
        float rm = tile_max(p0, p1); if (!rowsel) rm = -INFINITY;
        resc = __any(rm > THR) != 0;
        if (resc) {
            const float dl = fmaxf(rm, 0.f); mref += dl;
#pragma unroll
            for (int r = 0; r < 16; ++r) { p0[r] -= dl; p1[r] -= dl; negm[r] = -mref; }
            const float f = fast_exp2(-dl); l *= f; if (hi == 0) wsf[r32] = f;
        }
        float sum = 0.f;
#pragma unroll
        for (int r = 0; r < 16; ++r) { p0[r] = fast_exp2(p0[r]); p1[r] = fast_exp2(p1[r]); sum += p0[r] + p1[r]; }
        l += rowsel ? sum : 0.f;
        pack_p(p0, p1, a0, a1, a2, a3);
        if (MODE == 2 && !rowsel) { const bf16x8 zz = {0, 0, 0, 0, 0, 0, 0, 0}; a0 = zz; a1 = zz; a2 = zz; a3 = zz; }
    };
    if (half == 0) {
        for (int j = 0; j <= n; ++j) {
            const int s1 = BP_NEXT(s0); int c = 0; if (j + 2 < n) { BP_ISSUE_K(j + 2, sm1); ++c; } if (j + 1 < n) { BP_ISSUE_V(j + 1, s1); ++c; }
            X(j); BP_BAR();
            if (j < n) Y(j);
            BP_WAIT(c); BP_BAR();
            sm1 = s0; s0 = s1;
        }
    } else {
        for (int j = 0; j <= n; ++j) {
            const int s1 = BP_NEXT(s0); int c = 0; if (j + 2 < n) { BP_ISSUE_K(j + 2, sm1); ++c; } if (j + 1 < n) { BP_ISSUE_V(j + 1, s1); ++c; }
            if (j > 0) Y(j - 1);
            BP_BAR();
            X(j);
            BP_WAIT(c); BP_BAR();
            sm1 = s0; s0 = s1;
        }
    }
#undef BP_WAIT
#undef BP_NEXT
    l = xor32_sum(l);
    if (hi == 0) wsf[r32] = l > 0.f ? gate / l : 0.f;
    LDS_WAIT();
#pragma unroll
    for (int r = 0; r < 16; ++r) { const float f = (wsf + 4 * hi)[ccol(r)]; otl[r * 64] += o[0][r] * f; otl[(16 + r) * 64] += o[1][r] * f; }
    LDS_WAIT();
#undef BP_ISSUE_K
#undef BP_ISSUE_V
#undef BP_BAR
}

__device__ __forceinline__ void unit(const Ptrs& P, int b, int g, int qt, LAS unsigned char* lds, int tid_in) {
    int tid_ = tid_in; asm volatile("" : "+v"(tid_));
    const int tid = tid_, lane = tid & 63, r32 = lane & 31, hi = lane >> 5; const int wid = __builtin_amdgcn_readfirstlane(tid >> 6);
    const int bg = b * 2 + g;
    const int tl = 8 * wid + (r32 >> 2), hr = r32 & 3;
    const int tpos = 64 * qt + tl;
    const size_t tok = (size_t)b * SEQ + tpos;
    LAS float* wsf = (LAS float*)(lds + L_WSF) + wid * 64;
    LAS float* pcs = (LAS float*)(lds + L_PCS);
    LAS unsigned long long* selm = (LAS unsigned long long*)(lds + L_SEL);
    const int vb0 = (int)(unsigned)(uintptr_t)(lds + L_V) + ((lane >> 4) & 1) * 32 + (lane & 3) * 8 + (4 * hi + ((lane & 15) >> 2)) * 64;
    const float* gp = P.gates + tok * 24 + (g * 4 + hr) * 3;
    const float g0 = gp[0], g1 = gp[1], g2 = gp[2];
    float zero_ = 0.f; asm volatile("" : "+v"(zero_));
    f32x16 ot[2];
#pragma unroll
    for (int r = 0; r < 16; ++r) { ot[0][r] = zero_; ot[1][r] = zero_; }
    bf16x8 qr[4];
    const size_t qoff = ((size_t)bg * SEQ + 64 * qt) * 256 + (size_t)(wid * 32 + r32) * 64 + hi * 8;
#pragma unroll
    for (int d0 = 0; d0 < 4; ++d0) qr[d0] = *(const bf16x8*)(P.qraw + qoff + d0 * 16);

    const int nv = tpos >= 15 ? ((tpos - 15) >> 4) : 0;
    const int nct = (4 * qt + 3 + 63) >> 6;
    const bf16_t* kc = P.kcmp + (size_t)bg * 256 * 64; const bf16_t* vc = P.vcmp + (size_t)bg * 256 * 64;
    float mc = -INFINITY, lc = 0.f;
    tile_loop<false>(nct, kc, vc, 0, lds, wid, lane, [&](int i, int sl) {
        f32x16 p0, p1; qkt(p0, p1, lds + L_K + sl, qr, r32, hi, zero_);
        mask_tile(p0, p1, 0, nv - 64 * i - 1, hi);
        const float rm = tile_max(p0, p1); const float mn = fmaxf(mc, rm), mu = (mn == -INFINITY) ? 0.f : mn;
        float s = 0.f;
#pragma unroll
        for (int r = 0; r < 16; ++r) s += fast_exp2(p0[r] - mu) + fast_exp2(p1[r] - mu);
        lc = lc * fast_exp2(mc - mu) + s; mc = mn;
    });
    lc = xor32_sum(lc);
    {
        const float mu = (mc == -INFINITY) ? 0.f : mc, inv = lc > 0.f ? 1.f / lc : 0.f;
        tile_loop<true>(nct, kc, vc, 0, lds, wid, lane, [&](int i, int sl) {
            f32x16 p0, p1; qkt(p0, p1, lds + L_K + sl, qr, r32, hi, zero_);
            mask_tile(p0, p1, 0, nv - 64 * i - 1, hi);
#pragma unroll
            for (int r = 0; r < 16; ++r) { p0[r] = fast_exp2(p0[r] - mu) * inv; p1[r] = fast_exp2(p1[r] - mu) * inv; }
#pragma unroll
            for (int r = 0; r < 16; ++r) {
                float a = p0[r], c = p1[r];
                a += xor_get<1>(a); a += xor_get<2>(a); c += xor_get<1>(c); c += xor_get<2>(c);
                if (hr == 0) { LAS float* pw = pcs + tl * 256 + 64 * i + 4 * hi; pw[ccol(r)] = a; pw[32 + ccol(r)] = c; }
            }
#pragma unroll
            for (int r = 0; r < 16; ++r) { p0[r] *= g0; p1[r] *= g0; }
            bf16x8 a0, a1, a2, a3; pack_p(p0, p1, a0, a1, a2, a3);
            pv(ot, vb0 + sl, a0, a1, a2, a3);
        });
    }
    LDS_WAIT(); __syncthreads();
    if (qt < 16) { if (lane < 8) selm[8 * wid + lane] = (2ull << qt) - 1ull; }
    else {
        unsigned key[8], T[8];
#pragma unroll
        for (int k = 0; k < 8; ++k) { const LAS float* pr = pcs + (8 * wid + k) * 256; key[k] = 0u; T[k] = 0u;
            if (lane <= qt) { float imp = 0.f;
#pragma unroll
                for (int j = -1; j < 4; ++j) { const int c = 4 * lane + j; if (c >= 0 && c < 255) imp += pr[c]; }
                key[k] = __builtin_bit_cast(unsigned, (lane == 0 || lane == qt || lane == qt - 1) ? INFINITY : imp) + 1u; } }
#pragma unroll
        for (int bit = 30; bit >= 0; --bit)
#pragma unroll
            for (int k = 0; k < 8; ++k) { const unsigned cand = T[k] | (1u << bit); int cnt; asm("s_bcnt1_i32_b64 %0, %1" : "=s"(cnt) : "s"(__ballot(key[k] >= cand)) : "scc");
                T[k] = cnt >= 16 ? cand : T[k]; }
#pragma unroll
        for (int k = 0; k < 8; ++k) {
            const unsigned long long eq = __ballot(key[k] == T[k]);
            const int need = 16 - __popcll(__ballot(key[k] > T[k])), below = __popcll(eq & ((1ull << lane) - 1ull));
            const unsigned long long mk = __ballot(key[k] > T[k] || (key[k] == T[k] && below < need));
            if (lane == 0) selm[8 * wid + k] = mk; }
    }
    LDS_WAIT(); __syncthreads();
    const unsigned long long sel = selm[tl];
    LAS float* otl = (LAS float*)(lds + L_PCS) + wid * 2048 + lane;
#pragma unroll
    for (int r = 0; r < 16; ++r) { otl[r * 64] = ot[0][r]; otl[(16 + r) * 64] = ot[1][r]; }
    LDS_WAIT();
#pragma unroll
    for (int d0 = 0; d0 < 4; ++d0) *(LAS bf16x8*)(lds + L_OST + wid * 4096 + d0 * 1024 + lane * 16) = *(const bf16x8*)(P.qrot + qoff + d0 * 16);
    LDS_WAIT();
    const int qa = (int)(unsigned)(uintptr_t)(lds + L_OST) + wid * 4096 + lane * 16;
    branch_pipe<2>(qt + 1, P.kv + 2 * KVSZ + (size_t)bg * SEQ * 64, P.kv + 3 * KVSZ + (size_t)bg * SEQ * 64, 0, lds, wid, lane, r32, hi, qa, sel, tl, qt, 0, g1, otl, wsf, vb0, zero_);
    { const int k0 = qt >= 8 ? qt - 8 : 0;
      branch_pipe<3>(qt - k0 + 1, P.kv + 4 * KVSZ + (size_t)bg * SEQ * 64, P.kv + 5 * KVSZ + (size_t)bg * SEQ * 64, 64 * k0, lds, wid, lane, r32, hi, qa, sel, tl, qt, k0, g2, otl, wsf, vb0, zero_); }
    {
        LAS bf16_t* stg = (LAS bf16_t*)(lds + L_OST) + wid * 2048;
#pragma unroll
        for (int r = 0; r < 16; ++r) {
#pragma unroll
            for (int d0 = 0; d0 < 2; ++d0) (stg + 4 * hi * 64 + r32)[ccol(r) * 64 + d0 * 32] = (bf16_t)f2bf(otl[(d0 * 16 + r) * 64]); }
        LDS_WAIT();
#pragma unroll
        for (int it = 0; it < 4; ++it) { const int row = it * 8 + (lane >> 3), ch = lane & 7; const u32x4 v = *(const LAS u32x4*)(stg + row * 64 + ch * 8);
            bf16_t* dst = P.ab + ((size_t)b * SEQ + 64 * qt + 8 * wid + (row >> 2)) * 1024 + g * 256 + (row & 3) * 64 + ch * 8;
            *(u32x4*)dst = v; }
        LDS_WAIT();
    }
    __syncthreads();
}

__device__ __forceinline__ void xattn_unit(const bf16_t* Q, const bf16_t* Kx, const bf16_t* Vx, bf16_t* O, int pm, int h, LAS unsigned char* lds, int tid_in) {
    int tid_ = tid_in; asm volatile("" : "+v"(tid_));
    const int tid = tid_, lane = tid & 63, r32 = lane & 31, hi = lane >> 5; const int wid = __builtin_amdgcn_readfirstlane(tid >> 6);
    constexpr int XK = 0, XV = 65536, SL = 32768;
    const int b = pm >> 4;
    const bf16_t* kbase = Kx + ((size_t)b * 256 + lane) * 1024 + h * 256 + wid * 32;
    const bf16_t* vbase = Vx + ((size_t)b * 256 + (lane >> 2)) * 1024 + h * 256 + wid * 32 + (lane & 3) * 8;
#define XA_ISSUE_K(t) do { _Pragma("unroll") for (int i_ = 0; i_ < 4; ++i_) __builtin_amdgcn_global_load_lds((const unsigned*)(kbase + (size_t)(t) * 64 * 1024 + 8 * i_), \
        (LAS unsigned*)(lds + XK + ((t) & 1) * SL + (wid * 4 + i_) * 1024), 16, 0, 0); } while (0)
#define XA_ISSUE_V(t) do { _Pragma("unroll") for (int i_ = 0; i_ < 4; ++i_) __builtin_amdgcn_global_load_lds((const unsigned*)(vbase + ((size_t)(t) * 64 + 16 * i_) * 1024), \
        (LAS unsigned*)(lds + XV + ((t) & 1) * SL + (wid * 4 + i_) * 1024), 16, 0, 0); } while (0)
#define XA_BAR() asm volatile("s_waitcnt lgkmcnt(0)\n\ts_barrier" ::: "memory")
    XA_ISSUE_K(0); XA_ISSUE_K(1); XA_ISSUE_V(0); XA_ISSUE_V(1);
    bf16x8 qr[16];
    { const bf16_t* qp = Q + (size_t)(pm * 256 + wid * 32 + r32) * 1024 + h * 256 + hi * 8;
#pragma unroll
      for (int d0 = 0; d0 < 16; ++d0) qr[d0] = *(const bf16x8*)(qp + d0 * 16); }
    float zero_ = 0.f; asm volatile("" : "+v"(zero_));
    f32x16 p[4][2];
#pragma unroll
    for (int t = 0; t < 4; ++t) {
        if (t != 1) asm volatile("s_waitcnt vmcnt(0)" ::: "memory");
        XA_BAR();
        if (t == 1) XA_ISSUE_K(2);
        if (t == 2) XA_ISSUE_K(3);
#if XDIAG
        asm volatile("s_waitcnt vmcnt(0)" ::: "memory"); XA_BAR();
#endif
        const LAS unsigned char* kb = lds + XK + (t & 1) * SL + hi * 1024 + r32 * 16;
#pragma unroll
        for (int r = 0; r < 16; ++r) { p[t][0][r] = zero_; p[t][1][r] = zero_; }
#pragma unroll
        for (int d0 = 0; d0 < 16; ++d0) {
            const bf16x8 k0 = *(const LAS bf16x8*)(kb + d0 * 2048), k1 = *(const LAS bf16x8*)(kb + d0 * 2048 + 512);
            p[t][0] = __builtin_amdgcn_mfma_f32_32x32x16_bf16(k0, qr[d0], p[t][0], 0, 0, 0);
            p[t][1] = __builtin_amdgcn_mfma_f32_32x32x16_bf16(k1, qr[d0], p[t][1], 0, 0, 0);
        }
    }
    asm volatile("s_nop 15\n\ts_nop 7" : "+v"(p[0][0]), "+v"(p[0][1]), "+v"(p[1][0]), "+v"(p[1][1]), "+v"(p[2][0]), "+v"(p[2][1]), "+v"(p[3][0]), "+v"(p[3][1]));
    float mx = -INFINITY;
#pragma unroll
    for (int t = 0; t < 4; ++t) mx = fmaxf(mx, tile_max(p[t][0], p[t][1]));
    float sum = 0.f;
#pragma unroll
    for (int t = 0; t < 4; ++t)
#pragma unroll
        for (int r = 0; r < 16; ++r) { p[t][0][r] = fast_exp2((p[t][0][r] - mx) * CX); p[t][1][r] = fast_exp2((p[t][1][r] - mx) * CX); sum += p[t][0][r] + p[t][1][r]; }
    sum = xor32_sum(sum);
    const float inv = 1.f / sum;
    bf16x8 pa[4][4];
#pragma unroll
    for (int t = 0; t < 4; ++t) {
#pragma unroll
        for (int r = 0; r < 16; ++r) { p[t][0][r] *= inv; p[t][1][r] *= inv; }
        pack_p(p[t][0], p[t][1], pa[t][0], pa[t][1], pa[t][2], pa[t][3]); }
#if XMODE == 1
    { XA_BAR(); asm volatile("s_waitcnt vmcnt(0)" ::: "memory"); XA_BAR();
      bf16_t* dst = O + (size_t)(pm * 256 + wid * 32 + (lane & 31)) * 1024 + h * 256 + (lane >> 5) * 128;
#pragma unroll
      for (int t = 0; t < 4; ++t)
#pragma unroll
          for (int k = 0; k < 4; ++k) *(bf16x8*)(dst + (t * 4 + k) * 8) = pa[t][k];
      XA_BAR(); return; }
#endif
    f32x16 o[8];
#pragma unroll
    for (int d = 0; d < 8; ++d)
#pragma unroll
        for (int r = 0; r < 16; ++r) o[d][r] = zero_;
    const int vb0 = (int)(unsigned)(uintptr_t)(lds + XV) + ((lane >> 4) & 1) * 32 + (lane & 3) * 8 + (4 * hi + ((lane & 15) >> 2)) * 64;
#pragma unroll
    for (int t = 0; t < 4; ++t) {
        if (t >= 2) asm volatile("s_waitcnt vmcnt(0)" ::: "memory");
        XA_BAR();
        if (t == 1) XA_ISSUE_V(2);
        if (t == 2) XA_ISSUE_V(3);
#if XDIAG
        asm volatile("s_waitcnt vmcnt(0)" ::: "memory"); XA_BAR();
#endif
        const int vb = vb0 + (t & 1) * SL;
#pragma unroll
        for (int d = 0; d < 8; ++d) { s16x4 lo[4], hh[4];
#pragma unroll
            for (int ks = 0; ks < 4; ++ks) {
                asm volatile("ds_read_b64_tr_b16 %0,%1 offset:%c2" : "=&v"(lo[ks]) : "v"(vb), "i"(d * 4096 + ks * 1024) : "memory");
                asm volatile("ds_read_b64_tr_b16 %0,%1 offset:%c2" : "=&v"(hh[ks]) : "v"(vb), "i"(d * 4096 + ks * 1024 + 512) : "memory"); }
            asm volatile("s_waitcnt lgkmcnt(0)" ::: "memory"); __builtin_amdgcn_sched_barrier(0);
#define XA_PK(k) (bf16x8){lo[k][0], lo[k][1], lo[k][2], lo[k][3], hh[k][0], hh[k][1], hh[k][2], hh[k][3]}
            o[d] = __builtin_amdgcn_mfma_f32_32x32x16_bf16(pa[t][0], XA_PK(0), o[d], 0, 0, 0);
            o[d] = __builtin_amdgcn_mfma_f32_32x32x16_bf16(pa[t][1], XA_PK(1), o[d], 0, 0, 0);
            o[d] = __builtin_amdgcn_mfma_f32_32x32x16_bf16(pa[t][2], XA_PK(2), o[d], 0, 0, 0);
            o[d] = __builtin_amdgcn_mfma_f32_32x32x16_bf16(pa[t][3], XA_PK(3), o[d], 0, 0, 0);
#undef XA_PK
        }
    }
    XA_BAR();
    {   LAS bf16_t* stg = (LAS bf16_t*)(lds + wid * 16384);
#pragma unroll
        for (int d = 0; d < 8; ++d)
#pragma unroll
            for (int r = 0; r < 16; ++r) stg[crow(r, hi) * 256 + d * 32 + r32] = (bf16_t)f2bf(o[d][r]);
        LDS_WAIT();
#pragma unroll
        for (int it = 0; it < 16; ++it) { const int row = it * 2 + (lane >> 5), ch = lane & 31; const u32x4 v = *(const LAS u32x4*)(stg + row * 256 + ch * 8);
            *(u32x4*)(O + (size_t)(pm * 256 + wid * 32 + row) * 1024 + h * 256 + ch * 8) = v; }
        LDS_WAIT();
    }
    XA_BAR();
#undef XA_ISSUE_K
#undef XA_ISSUE_V
#undef XA_BAR
}
}

#define XB_TMO      128
#define XB_XCNT(j)  (256  + 64 * (j))
#define XB_XSUB(j)  (1280 + 64 * (j))
#define XB_XGEN(j)  (2304 + 64 * (j))
#define XB_TOP      3328
#define XB_TOPGEN   3392
#define XCD_BAR_WORDS 3456
#define XB_SPIN_CAP (1u << 18)
__device__ __forceinline__ unsigned xb_ld(unsigned* p)              { return __hip_atomic_load(p, __ATOMIC_RELAXED, __HIP_MEMORY_SCOPE_AGENT); }
__device__ __forceinline__ unsigned xb_add(unsigned* p, unsigned v) { return __hip_atomic_fetch_add(p, v, __ATOMIC_RELAXED, __HIP_MEMORY_SCOPE_AGENT); }
__device__ __forceinline__ unsigned xb_xcc_id() { return (unsigned)__builtin_amdgcn_s_getreg((3 << 11) | 20) & 0xFu; }
#define XB_SPIN(cond, bar) do { unsigned _sp = 0; while (cond) { __builtin_amdgcn_s_sleep(1); \
    if ((++_sp & 255u) == 0u) { if (xb_ld(&(bar)[XB_TMO])) break; if (_sp > XB_SPIN_CAP) { atomicAdd(&(bar)[XB_TMO], 1u); break; } } } } while (0)
struct XcdBarrier { unsigned* bar; unsigned x; volatile LAS unsigned* st; };
__device__ __forceinline__ XcdBarrier xcd_barrier_post(unsigned* bar, volatile LAS unsigned* st) {
    XcdBarrier b; b.bar = bar; b.x = xb_xcc_id(); b.st = st;
    if (threadIdx.x == 0) (void)xb_add(&bar[XB_XCNT(b.x)], 1u);
    return b;
}
__device__ __forceinline__ void xcd_barrier_complete(unsigned* bar, unsigned x, unsigned& nloc, unsigned& nx) {
    const unsigned G = gridDim.x * gridDim.y * gridDim.z;
    unsigned sum, cnt, mine, sp = 0u;
    for (;;) {
        sum = 0u; cnt = 0u; mine = 0u;
#pragma unroll
        for (unsigned j = 0; j < 16; ++j) { const unsigned c = xb_ld(&bar[XB_XCNT(j)]); sum += c; cnt += (c > 0u) ? 1u : 0u; mine = (j == x) ? c : mine; }
        if (sum == G) break;
        __builtin_amdgcn_s_sleep(1);
        if ((++sp & 255u) == 0u) { if (xb_ld(&bar[XB_TMO])) break; if (sp > XB_SPIN_CAP) { atomicAdd(&bar[XB_TMO], 1u); break; } }
    }
    nloc = mine > 0u ? mine : 1u; nx = cnt > 0u ? cnt : 1u;
}
__device__ __forceinline__ void xcd_barrier(const XcdBarrier& b, int tid) {
    asm volatile("s_waitcnt vmcnt(0)" ::: "memory");
    __syncthreads();
    if (tid == 0) {
        unsigned* bar = b.bar;
        __builtin_amdgcn_s_waitcnt(0);
        unsigned nloc = b.st[0], nx = b.st[1];
        if (nloc == 0u) { xcd_barrier_complete(bar, b.x, nloc, nx); b.st[0] = nloc; b.st[1] = nx; }
        const unsigned old = xb_add(&bar[XB_XSUB(b.x)], 1u);
        const unsigned gen = old / nloc;
        if (old + 1u == (gen + 1u) * nloc) {
            __builtin_amdgcn_fence(__ATOMIC_RELEASE, "agent");
            asm volatile("s_waitcnt vmcnt(0)" ::: "memory");
            const unsigned og = xb_add(&bar[XB_TOP], 1u);
            const unsigned tg = og / nx;
            if (og + 1u == (tg + 1u) * nx) xb_add(&bar[XB_TOPGEN], 1u);
            else XB_SPIN(xb_ld(&bar[XB_TOPGEN]) == tg, bar);
            __builtin_amdgcn_fence(__ATOMIC_ACQUIRE, "agent");
            xb_add(&bar[XB_XGEN(b.x)], 1u);
            asm volatile("s_waitcnt vmcnt(0)" ::: "memory");
        } else {
            XB_SPIN(xb_ld(&bar[XB_XGEN(b.x)]) == gen, bar);
            __builtin_amdgcn_fence(__ATOMIC_ACQUIRE, "agent");
            asm volatile("s_waitcnt vmcnt(0)" ::: "memory");
        }
    }
    __syncthreads();
}

__device__ __forceinline__ void xpose_item(const float* W, int ldw, int k0, int n0, int ncv, bf16_t* WT, int ldt, int dr0, LAS float* scr, int lane, const float* gain = nullptr) {
    const int c = lane & 31;
#pragma unroll 8
    for (int i = 0; i < 32; ++i) { const int kk = 2 * i + (lane >> 5); scr[kk * 33 + c] = c < ncv ? W[(size_t)(k0 + kk) * ldw + n0 + c] * (gain ? gain[k0 + kk] : 1.f) : 0.f; }
    LDS_WAIT(); asm volatile("" ::: "memory");
    const int c8 = lane & 7;
#pragma unroll
    for (int j = 0; j < 4; ++j) { const int n = (lane >> 3) + 8 * j; const LAS float* s = scr + (8 * c8) * 33 + n;
        u32x4 o; o.x = pk2(s[0 * 33], s[1 * 33]); o.y = pk2(s[2 * 33], s[3 * 33]); o.z = pk2(s[4 * 33], s[5 * 33]); o.w = pk2(s[6 * 33], s[7 * 33]);
        *(u32x4*)(WT + (size_t)(dr0 + n) * ldt + k0 + 8 * c8) = o; }
    LDS_WAIT(); asm volatile("" ::: "memory");
}
__device__ __forceinline__ void xpose_item64(const float* W, int ldw, int k0, int n0, bf16_t* WT, int ldt, int dr0, LAS float* scr, int lane, const float* gain) {
    const int c4 = lane & 15, r4 = lane >> 4;
    f32x4 v[16];
#pragma unroll
    for (int i = 0; i < 16; ++i) v[i] = *(const f32x4*)(W + (size_t)(k0 + 4 * i + r4) * ldw + n0 + 4 * c4);
    if (gain) {
#pragma unroll
        for (int i = 0; i < 16; ++i) v[i] = v[i] * gain[k0 + 4 * i + r4]; }
#pragma unroll
    for (int i = 0; i < 16; ++i) { LAS float* d = scr + (4 * i + r4) * 65 + 4 * c4; d[0] = v[i].x; d[1] = v[i].y; d[2] = v[i].z; d[3] = v[i].w; }
    LDS_WAIT(); asm volatile("" ::: "memory");
    const int c8 = lane & 7;
#pragma unroll
    for (int j = 0; j < 8; ++j) { const int n = (lane >> 3) + 8 * j; const LAS float* s = scr + (8 * c8) * 65 + n;
        u32x4 o; o.x = pk2(s[0 * 65], s[1 * 65]); o.y = pk2(s[2 * 65], s[3 * 65]); o.z = pk2(s[4 * 65], s[5 * 65]); o.w = pk2(s[6 * 65], s[7 * 65]);
        *(u32x4*)(WT + (size_t)(dr0 + n) * ldt + k0 + 8 * c8) = o; }
    LDS_WAIT(); asm volatile("" ::: "memory");
}
__device__ __forceinline__ void xpose_load64(const float* W, int ldw, int k0, int n0, int lane, f32x4 (&v)[16]) {
    const int c4 = lane & 15, r4 = lane >> 4;
#pragma unroll
    for (int i = 0; i < 16; ++i) v[i] = *(const f32x4*)(W + (size_t)(k0 + 4 * i + r4) * ldw + n0 + 4 * c4);
}
__device__ __forceinline__ void xpose_store64(const f32x4 (&v)[16], int k0, bf16_t* WT, int ldt, int dr0, LAS float* scr, int lane) {
    const int c4 = lane & 15, r4 = lane >> 4;
#pragma unroll
    for (int i = 0; i < 16; ++i) { LAS float* d = scr + (4 * i + r4) * 65 + 4 * c4; d[0] = v[i].x; d[1] = v[i].y; d[2] = v[i].z; d[3] = v[i].w; }
    LDS_WAIT(); asm volatile("" ::: "memory");
    const int c8 = lane & 7;
#pragma unroll
    for (int j = 0; j < 8; ++j) { const int n = (lane >> 3) + 8 * j; const LAS float* s = scr + (8 * c8) * 65 + n;
        u32x4 o; o.x = pk2(s[0 * 65], s[1 * 65]); o.y = pk2(s[2 * 65], s[3 * 65]); o.z = pk2(s[4 * 65], s[5 * 65]); o.w = pk2(s[6 * 65], s[7 * 65]);
        *(u32x4*)(WT + (size_t)(dr0 + n) * ldt + k0 + 8 * c8) = o; }
    LDS_WAIT(); asm volatile("" ::: "memory");
}
__device__ __forceinline__ void xpose_mat(const float* W, int K, int N, bf16_t* WT, int rowmap, int item, LAS float* scr, int lane, const float* gain = nullptr) {
    const int ng = N / 64, kb = item / ng, j = item % ng, n = 64 * j;
    const int dr = rowmap == 0 ? n : (256 * (n >> 7) + (n & 127) + (rowmap == 2 ? 128 : 0));
    xpose_item64(W, N, 64 * kb, n, WT, K, dr, scr, lane, gain);
}
template <int W> __device__ __forceinline__ void pool_run(const bf16_t* ub, bf16_t* ab, int rq, int lane) {
    constexpr int CLS = W == 2 ? 0 : W == 4 ? 1 : W == 8 ? 2 : 3, NR = 15 + W;
    const int t0 = (4 * rq + (lane >> 4)) * 16, t0s = t0 & (SEQ - 1), col = 128 * CLS + 8 * (lane & 15);
    u32x4 R[NR];
#pragma unroll
    for (int j = 0; j < NR; ++j) { R[j] = (u32x4){0u, 0u, 0u, 0u}; if (t0s - (W - 1) + j >= 0) R[j] = *(const u32x4*)(ub + (size_t)(t0 - (W - 1) + j) * 512 + col); }
    float s[8];
#pragma unroll
    for (int e = 0; e < 8; ++e) s[e] = 0.f;
#pragma unroll
    for (int j = 0; j < W - 1; ++j)
#pragma unroll
        for (int e = 0; e < 4; ++e) { s[2 * e] += __builtin_bit_cast(float, R[j][e] << 16); s[2 * e + 1] += __builtin_bit_cast(float, R[j][e] & 0xffff0000u); }
#pragma unroll
    for (int i = 0; i < 16; ++i) {
        float own[8];
#pragma unroll
        for (int e = 0; e < 4; ++e) { own[2 * e] = __builtin_bit_cast(float, R[W - 1 + i][e] << 16); own[2 * e + 1] = __builtin_bit_cast(float, R[W - 1 + i][e] & 0xffff0000u); }
#pragma unroll
        for (int e = 0; e < 8; ++e) s[e] += own[e];
        if (i > 0) {
#pragma unroll
            for (int e = 0; e < 4; ++e) { s[2 * e] -= __builtin_bit_cast(float, R[i - 1][e] << 16); s[2 * e + 1] -= __builtin_bit_cast(float, R[i - 1][e] & 0xffff0000u); } }
        const int n = (t0s + i + 1) < W ? (t0s + i + 1) : W; const float inv = 1.f / (float)n;
        u32x4 o; o.x = pk2(s[0] * inv - own[0], s[1] * inv - own[1]); o.y = pk2(s[2] * inv - own[2], s[3] * inv - own[3]);
        o.z = pk2(s[4] * inv - own[4], s[5] * inv - own[5]); o.w = pk2(s[6] * inv - own[6], s[7] * inv - own[7]);
        *(u32x4*)(ab + (size_t)(t0 + i) * 1024 + 512 + col) = o;
    }
}
__device__ __forceinline__ float row_rs(const float* xrow, int lane, f32x4 (&v)[4]) {
    const f32x4* xr = (const f32x4*)xrow + lane; float s = 0.f;
#pragma unroll
    for (int j = 0; j < 4; ++j) { v[j] = xr[64 * j]; s += (v[j].x * v[j].x + v[j].y * v[j].y) + (v[j].z * v[j].z + v[j].w * v[j].w); }
    return 1.0f / sqrtf(wave_sum(s) * (1.f / DM) + EPS);
}
__device__ __forceinline__ void norm_row(const float* xrow, const float* gain, bf16_t* orow, int lane) {
    f32x4 v[4]; const float rs = row_rs(xrow, lane, v);
    const f32x4* gr = (const f32x4*)gain + lane; unsigned long long* o8 = (unsigned long long*)orow + lane;
#pragma unroll
    for (int j = 0; j < 4; ++j) { const f32x4 g = gr[64 * j];
        o8[64 * j] = (unsigned long long)pk2(v[j].x * rs * g.x, v[j].y * rs * g.y) | ((unsigned long long)pk2(v[j].z * rs * g.z, v[j].w * rs * g.w) << 32); }
}
__device__ __forceinline__ void sincos_d(double a, float& s, float& c) {
    const double n = rint(a * 0.6366197723675814);
    double r = fma(-n, 1.5707963267948966, a); r = fma(-n, 6.123233995736766e-17, r);
    const double r2 = r * r;
    double sp = -1.0 / 1307674368000.0; sp = sp * r2 + 1.0 / 6227020800.0; sp = sp * r2 - 1.0 / 39916800.0; sp = sp * r2 + 1.0 / 362880.0; sp = sp * r2 - 1.0 / 5040.0; sp = sp * r2 + 1.0 / 120.0; sp = sp * r2 - 1.0 / 6.0; sp = sp * r2 * r + r;
    double cp = 1.0 / 20922789888000.0; cp = cp * r2 - 1.0 / 87178291200.0; cp = cp * r2 + 1.0 / 479001600.0; cp = cp * r2 - 1.0 / 3628800.0; cp = cp * r2 + 1.0 / 40320.0; cp = cp * r2 - 1.0 / 720.0; cp = cp * r2 + 1.0 / 24.0; cp = cp * r2 - 0.5; cp = cp * r2 + 1.0;
    const int q = (int)n & 3;
    const double ss = (q & 1) ? cp : sp, cc = (q & 1) ? sp : cp;
    s = (float)((q & 2) ? -ss : ss); c = (float)(((q + 1) & 2) ? -cc : cc);
}

struct Args {
    const float* in[30]; float* out; unsigned char* ws; int ph_lo, ph_hi;
};
enum { I_X = 0, I_MEM, I_NORM_MIX, I_W_IN, I_PE_K, I_W1_K, I_B1_K, I_W2_K, I_PE_V, I_W1_V, I_B1_V, I_W2_V, I_W_POOL, I_POOL_SCALE, I_W_OUT, I_NORM_X, I_NORM_MEM,
       I_WQ, I_WK, I_WV, I_WO, I_NORM_FFN, I_FFN_WG, I_FFN_WU, I_FFN_WD, I_ROUTER, I_MOE_WG, I_MOE_WU, I_MOE_WD, I_NORM_FINAL };
constexpr int PH_PRO = 0, PH_KV = 1, PH_L0 = 2, PH_LSTRIDE = 20;
constexpr int PO_WIN = 0, PO_CMP = 1, PO_ATT = 2, PO_WOUT = 3, PO_N2 = 4, PO_WQ = 5, PO_S = 6, PO_PV = 7, PO_WO = 8, PO_F0 = 9;

typedef const Args __attribute__((address_space(4))) CArgs;
#if RES_BF16
__device__ __forceinline__ f32x4 xrow4(const bf16_t* xb2, const float*, size_t tok, int idx) { const u32x2 w = ((const u32x2*)(xb2 + tok * DM))[idx];
    return (f32x4){__builtin_bit_cast(float, w.x << 16), __builtin_bit_cast(float, w.x & 0xffff0000u), __builtin_bit_cast(float, w.y << 16), __builtin_bit_cast(float, w.y & 0xffff0000u)}; }
__device__ __forceinline__ float xrow1(const bf16_t* xb2, const float*, size_t tok, int idx) { return bf2f(xb2[tok * DM + idx]); }
#else
__device__ __forceinline__ f32x4 xrow4(const bf16_t*, const float* x, size_t tok, int idx) { return ((const f32x4*)(x + tok * DM))[idx]; }
__device__ __forceinline__ float xrow1(const bf16_t*, const float* x, size_t tok, int idx) { return x[tok * DM + idx]; }
#endif
#define PHASE_IDS CArgs* ap_ = (CArgs*)__builtin_amdgcn_kernarg_segment_ptr(); asm volatile("" : "+s"(ap_)); unsigned char* ws = ap_->ws; (void)ws; int tid_; asm volatile("v_mbcnt_lo_u32_b32 %0, -1, 0\n\tv_mbcnt_hi_u32_b32 %0, -1, %0" : "=v"(tid_)); tid_ += wid0 * 64; const int tid = tid_, lane = tid & 63, wid = wid0, gw = bid * NWAVES + wid; (void)lane; (void)gw;
#ifndef PHMASK
#define PHMASK 0xffffffffu
#endif
#define PM(b) ((PHMASK >> (b)) & 1u)
#define IN(k) (lo <= (k) && (k) < hi)
#if DBG >= 200
#define SEAM(k) do { if (hi > (k) + 1) xcd_barrier(bar, tid); if (bid == 0 && tid == 0) ((unsigned long long*)((unsigned*)(ws + WS_CTL) + 20000))[(k)] = __builtin_amdgcn_s_memrealtime(); } while (0)
#else
#ifndef BAR_REP
#define BAR_REP 1
#endif
#define SEAM(k) do { if (hi > (k) + 1) for (int br_ = 0; br_ < BAR_REP; ++br_) xcd_barrier(bar, tid); } while (0)
#endif
#define W16(off) ((bf16_t*)(ws + (off)))
constexpr int MOE_IT_MG = 16 * 56, MOE_IT_MD = 56 * 16, MOE_NM = 16 * MOE_IT_MG + 8 * MOE_IT_MD, MOE_S0 = 5 * 176 * 8, MOE_S1 = MOE_S0 + 3 * 128 * 8;
__device__ __forceinline__ void moe_convert(const float* wgp, const float* wup, const float* wdp, unsigned char* ws, LAS unsigned char* lds, int it_lo, int it_hi, int rank, int nranks, int wid, int lane) {
    LAS float* scr = (LAS float*)(lds + wid * 16896);
    auto ld = [&](int it, f32x4 (&v)[16]) {
        if (it < 16 * MOE_IT_MG) { const int mtx = it / MOE_IT_MG, r = it % MOE_IT_MG, e = mtx >> 1, up = mtx & 1, kb = r / 56, j = r % 56;
            xpose_load64((up ? wup : wgp) + (size_t)e * DM * DFFE, DFFE, 64 * kb, 64 * j, lane, v);
        } else { const int r0 = it - 16 * MOE_IT_MG, e = r0 / MOE_IT_MD, r = r0 % MOE_IT_MD, kb = r / 16, j = r % 16;
            xpose_load64(wdp + (size_t)e * DFFE * DM, DM, 64 * kb, 64 * j, lane, v); } };
    auto st = [&](int it, const f32x4 (&v)[16]) {
        if (it < 16 * MOE_IT_MG) { const int mtx = it / MOE_IT_MG, r = it % MOE_IT_MG, e = mtx >> 1, up = mtx & 1, kb = r / 56, j = r % 56, n = 64 * j;
            xpose_store64(v, 64 * kb, W16(WS_MGU) + (size_t)e * 7168 * DM, DM, 256 * (n >> 7) + (n & 127) + (up ? 128 : 0), scr, lane);
        } else { const int r0 = it - 16 * MOE_IT_MG, e = r0 / MOE_IT_MD, r = r0 % MOE_IT_MD, kb = r / 16, j = r % 16;
            xpose_store64(v, 64 * kb, W16(WS_MD) + (size_t)e * DM * DFFE, DFFE, 64 * j, scr, lane); } };
    int it = it_lo + rank;
    f32x4 va[16], vb[16];
    if (it < it_hi) ld(it, va);
    while (it < it_hi) {
        if (it + nranks < it_hi) ld(it + nranks, vb);
        st(it, va); it += nranks; if (it >= it_hi) break;
        if (it + nranks < it_hi) ld(it + nranks, va);
        st(it, vb); it += nranks;
    }
}
template <int layer> __device__ __forceinline__ void layer_phases(LAS unsigned char* lds, const int lo, const int hi, const XcdBarrier& bar, const int G, const int bid, const int NGW, const int wid0) {
        const int pb = PH_L0 + layer * PH_LSTRIDE;
        if (PM(2) && IN(pb + PO_WIN)) {
            PHASE_IDS
            pg8::Gemm g{(const char*)(ws + WS_HB), (const char*)(ws + WS_WIN + (size_t)layer * ZW * DM * 2), DM, DM, DM};
            SchedPlain S; S.init(T / 256, ZW / 256, DM, DM, G, bid);
            EpiWin E{W16(WS_QRAW), W16(WS_QROT), W16(WS_KV), W16(WS_U), (float*)(ws + WS_GATES), (const float*)(ws + WS_ROPE), SSP(layer == 0 ? 0 : 3)};
            for (int rep_ = 0; rep_ < REPN(2); ++rep_) pg8::gemm_phase<EpiWin, SchedPlain, true, true>(lds, g, S, E, tid);
            SEAM(pb + PO_WIN);
        }
        if (PM(3) && IN(pb + PO_CMP)) {
            PHASE_IDS
            for (int rep_ = 0; rep_ < REPN(3); ++rep_)
            if (bid < 16) {
                const int kv = bid >> 3, pm = bid & 7, mtx = layer * 2 + kv;
                {
                    pg8::Gemm g{(const char*)(ws + WS_KV + (size_t)kv * KVSZ * 2), (const char*)(ws + WS_CW1 + (size_t)mtx * 256 * 2048 * 2), 2048, 1024, 2048};
                    SchedOne S; S.u.pm = pm; S.u.pn = 0; S.u.aoff = (long)pm * 256 * 1024 * 2; S.u.boff = 0; S.u.coff = 0;
                    EpiHid E{W16(WS_HID) + (size_t)kv * 2048 * 256, (const long long*)((const unsigned*)(ws + WS_CTL) + CW_BIAS) + mtx * 256};
                    pg8::gemm_phase<EpiHid, SchedOne, false, true>(lds, g, S, E, tid);
                }
                VM_WAIT(); __syncthreads();
                __builtin_amdgcn_fence(__ATOMIC_ACQUIRE, "agent"); VM_WAIT(); __syncthreads();
                {
                    pg8::Gemm g{(const char*)(ws + WS_HID + (size_t)kv * 2048 * 256 * 2), (const char*)(ws + WS_CW2 + (size_t)mtx * 256 * 256 * 2), 256, 256, 256};
                    SchedOne S; S.u.pm = pm; S.u.pn = 0; S.u.aoff = (long)pm * 256 * 256 * 2; S.u.boff = 0; S.u.coff = 0;
                    EpiCmp2 E{W16(WS_KCMP) + (size_t)kv * 8 * 256 * 64};
                    pg8::gemm_phase<EpiCmp2, SchedOne, false, true>(lds, g, S, E, tid);
                }
            } else if (layer == 0 && bid < 80) {
                pg8::Gemm g{(const char*)ws, (const char*)ws, DM, DM, DM}; SchedKV S{1, bid - 16}; EpiPlain E{(bf16_t*)ws, DM, nullptr};
                pg8::gemm_phase<EpiPlain, SchedKV, false, true>(lds, g, S, E, tid);
            } else {
                const int nw = layer == 0 ? G - 80 : G - 16, w0 = layer == 0 ? 80 : 16;
                moe_convert(ap_->in[I_MOE_WG], ap_->in[I_MOE_WU], ap_->in[I_MOE_WD], ws, lds, layer == 0 ? 0 : MOE_S1, layer == 0 ? MOE_S0 : MOE_NM, (bid - w0) * NWAVES + wid, nw * NWAVES, wid, lane);
                const bf16_t* ub = W16(WS_U); bf16_t* ab = W16(WS_AB);
                for (int p = (bid - w0) * NWAVES + wid; p < 1024; p += nw * NWAVES) { const int rq = p & 255;
                    switch (p >> 8) { case 0: pool_run<16>(ub, ab, rq, lane); break; case 1: pool_run<8>(ub, ab, rq, lane); break; case 2: pool_run<4>(ub, ab, rq, lane); break; default: pool_run<2>(ub, ab, rq, lane); break; } }
            }
            SEAM(pb + PO_CMP);
        }
        if (PM(4) && IN(pb + PO_ATT)) {
            PHASE_IDS
            nsa::Ptrs P{W16(WS_QRAW), W16(WS_QROT), W16(WS_KV), W16(WS_KCMP), W16(WS_KCMP) + 8 * 256 * 64, (const float*)(ws + WS_GATES), W16(WS_AB)};
            const int vcu = (G % 8 == 0) ? (bid % 8) * (G / 8) + bid / 8 : bid;
            for (int rep_ = 0; rep_ < REP_ATT; ++rep_)
            for (int uix = vcu; uix < 8 * 32; uix += G) { const int bgx = uix >> 5, s = uix & 31;
                nsa::unit(P, bgx >> 1, bgx & 1, 63 - s, lds, tid);
                nsa::unit(P, bgx >> 1, bgx & 1, s, lds, tid); }
            SEAM(pb + PO_ATT);
        }
        if (PM(5) && IN(pb + PO_WOUT)) {
            PHASE_IDS
            pg8::Gemm g{(const char*)(ws + WS_AB), (const char*)(ws + WS_WOUT + (size_t)layer * DM * DM * 2), DM, DM, DM};
            SchedPlain S; S.init(T / 256, DM / 256, DM, DM, G, bid);
#if RES_BF16
            if constexpr (layer == 0) { EpiResB<true> E{ap_->in[I_X], W16(WS_HB), SSP(1)}; pg8::gemm_phase<EpiResB<true>, SchedPlain, true, true>(lds, g, S, E, tid); }
            else { EpiResB<false> E{W16(WS_HB), W16(WS_HB), SSP(4)}; pg8::gemm_phase<EpiResB<false>, SchedPlain, true, true>(lds, g, S, E, tid); }
#else
            EpiRes E{layer == 0 ? ap_->in[I_X] : ap_->out, ap_->out, W16(WS_HB), SSP(layer == 0 ? 1 : 4)};
            pg8::gemm_phase<EpiRes, SchedPlain, true, true>(lds, g, S, E, tid);
#endif
            SEAM(pb + PO_WOUT);
        }
        if (PM(7) && IN(pb + PO_WQ)) {
            PHASE_IDS
            for (int rep_ = 0; rep_ < REPN(7); ++rep_) {
            {   pg8::Gemm g{(const char*)(ws + WS_HB), (const char*)(ws + WS_WQ + (size_t)layer * DM * DM * 2), DM, DM, DM};
                SchedPlain S; S.init(T / 256, DM / 256, DM, DM, G, bid);
                EpiPlain E{W16(WS_QX), DM, SSP(layer == 0 ? 1 : 4)};
                pg8::gemm_phase<EpiPlain, SchedPlain, false, true>(lds, g, S, E, tid); }
            VM_WAIT(); __syncthreads(); __builtin_amdgcn_fence(__ATOMIC_ACQUIRE, "agent"); VM_WAIT(); __syncthreads();
            {
                pg8::TileOrder o; o.init(T / 256, DM / 256, G, bid); int pm, pn;
                if (o.tile(0, pm, pn)) { nsa::xattn_unit(W16(WS_QX), W16(WS_KX) + (size_t)layer * DM * DM, W16(WS_VXT) + (size_t)layer * DM * DM, W16(WS_OX), pm, pn, lds, tid);
#if DBG == 400
                    if (layer == 1) { nsa::xattn_unit(W16(WS_QX), W16(WS_KX) + (size_t)layer * DM * DM, W16(WS_VXT) + (size_t)layer * DM * DM, W16(WS_ACTC), pm, pn, lds, tid);
                        VM_WAIT(); __syncthreads(); __builtin_amdgcn_fence(__ATOMIC_ACQUIRE, "agent"); VM_WAIT(); __syncthreads();
                        unsigned c = 0; for (int i = tid; i < 256 * 256; i += 512) { const size_t off = (size_t)(pm * 256 + (i >> 8)) * 1024 + pn * 256 + (i & 255); c += W16(WS_OX)[off] != W16(WS_ACTC)[off]; }
                        if (c) atomicAdd((unsigned*)(ws + WS_CTL) + 21100, c); }
#endif
                } }
            if (rep_ + 1 < REPN(7)) { VM_WAIT(); __syncthreads(); }
            }
            SEAM(pb + PO_PV);
        }
        if (PM(10) && IN(pb + PO_WO)) {
            PHASE_IDS
            pg8::Gemm g{(const char*)(ws + WS_OX), (const char*)(ws + WS_WO + (size_t)layer * DM * DM * 2), DM, DM, DM};
            SchedPlain S; S.init(T / 256, DM / 256, DM, DM, G, bid);
#if RES_BF16
            EpiResB<false> E{W16(WS_HB), layer == 0 ? W16(WS_HB) : W16(WS_XB2), layer == 0 ? SSP(2) : nullptr};
            pg8::gemm_phase<EpiResB<false>, SchedPlain, true, true>(lds, g, S, E, tid);
#else
            EpiRes E{ap_->out, ap_->out, layer == 0 ? W16(WS_HB) : nullptr, SSP(2)};
            pg8::gemm_phase<EpiRes, SchedPlain, true, true>(lds, g, S, E, tid);
#endif
            SEAM(pb + PO_WO);
        }
        if constexpr (layer == 0) {
            if (PM(12) && IN(pb + PO_F0 + 1)) {
            PHASE_IDS
                pg8::Gemm g{(const char*)(ws + WS_HB), (const char*)(ws + WS_FGU), DM, DM, DM};
                SchedPlain S; S.init(T / 256, 2 * DFF / 256, DM, DM, G, bid);
                EpiSwiglu<2> E{W16(WS_ACT0), DFF, nullptr, SSP(2)};
                for (int rep_ = 0; rep_ < REPN(12); ++rep_) pg8::gemm_phase<EpiSwiglu<2>, SchedPlain, true, true>(lds, g, S, E, tid);
                if (bid >= 128) { __syncthreads();
                    moe_convert(ap_->in[I_MOE_WG], ap_->in[I_MOE_WU], ap_->in[I_MOE_WD], ws, lds, MOE_S0, MOE_S1, (bid - 128) * NWAVES + wid, 128 * NWAVES, wid, lane); __syncthreads(); }
                SEAM(pb + PO_F0 + 1);
            }
            if (PM(13) && IN(pb + PO_F0 + 2)) {
            PHASE_IDS
                pg8::Gemm g{(const char*)(ws + WS_ACT0), (const char*)(ws + WS_FD), DFF, DFF, DFF};
                SchedPlain S; S.init(T / 256, DM / 256, DFF, DFF, G, bid);
#if RES_BF16
                EpiResB<false> E{W16(WS_HB), W16(WS_HB), SSP(3)};
                pg8::gemm_phase<EpiResB<false>, SchedPlain, true, true>(lds, g, S, E, tid);
#else
                EpiRes E{ap_->out, ap_->out, W16(WS_HB), SSP(3)};
                pg8::gemm_phase<EpiRes, SchedPlain, true, true>(lds, g, S, E, tid);
#endif
                SEAM(pb + PO_F0 + 2);
            }
        } else {
#define route ((unsigned*)(ws + WS_ROUTE))
#define cntg ((unsigned*)(ws + WS_CNTG))
#define tinfo ((unsigned*)(ws + WS_TILE))
#define slot ((unsigned*)(ws + WS_SLOT))
            LAS int* LE = (LAS int*)lds;
            LAS float* LW = (LAS float*)(lds + 512);
            LAS int* LR = (LAS int*)(lds + 1024);
            LAS int* LC = (LAS int*)(lds + 1536);
            if (PM(15) && IN(pb + PO_F0)) {
            PHASE_IDS
                const float* gain = ap_->in[I_NORM_FFN] + DM; const float* wr = ap_->in[I_ROUTER];
                float wgr[16][8];
#pragma unroll
                for (int jj = 0; jj < 16; ++jj) { const int k = lane + 64 * jj; const float gk = gain[k]; const f32x4 w0 = *(const f32x4*)(wr + (size_t)k * 8), w1 = *(const f32x4*)(wr + (size_t)k * 8 + 4);
#pragma unroll
                    for (int c = 0; c < 4; ++c) { wgr[jj][c] = gk * w0[c]; wgr[jj][4 + c] = gk * w1[c]; } }
                for (int rep_ = 0; rep_ < REPN(15); ++rep_)
                for (int tb = bid; tb < T / 64; tb += G) {
                    for (int k = 0; k < 8; ++k) { const int tl = 8 * wid + k, tok = 64 * tb + tl;
                        float xs[16], sq = 0.f;
#pragma unroll
                        for (int jj = 0; jj < 16; ++jj) { xs[jj] = xrow1(W16(WS_XB2), ap_->out, (size_t)tok, lane + 64 * jj); sq += xs[jj] * xs[jj]; }
                        const float rs = 1.0f / sqrtf(wave_sum(sq) * (1.f / DM) + EPS);
                        float lg[8];
#pragma unroll
                        for (int e = 0; e < 8; ++e) lg[e] = 0.f;
#pragma unroll
                        for (int jj = 0; jj < 16; ++jj) { const float h = xs[jj] * rs;
#pragma unroll
                            for (int e = 0; e < 8; ++e) lg[e] += h * wgr[jj][e]; }
                        { const bool b0 = lane & 1, b1 = lane & 2, b2 = lane & 4; float a4[4], a2[2], a1;
#pragma unroll
                          for (int i = 0; i < 4; ++i) a4[i] = (b0 ? lg[4 + i] : lg[i]) + xor_get<1>(b0 ? lg[i] : lg[4 + i]);
#pragma unroll
                          for (int i = 0; i < 2; ++i) a2[i] = (b1 ? a4[2 + i] : a4[i]) + xor_get<2>(b1 ? a4[i] : a4[2 + i]);
                          a1 = (b2 ? a2[1] : a2[0]) + xor_get<4>(b2 ? a2[0] : a2[1]);
                          a1 += xor_get<8>(a1); a1 += xor_get<16>(a1); a1 = xor32_sum(a1);
#pragma unroll
                          for (int e = 0; e < 8; ++e) lg[e] = __builtin_bit_cast(float, __builtin_amdgcn_readlane(__builtin_bit_cast(int, a1), ((e >> 2) & 1) | (((e >> 1) & 1) << 1) | ((e & 1) << 2))); }
                        if (lane == 0) { int i1 = 0; float v1 = lg[0];
#pragma unroll
                            for (int e = 1; e < 8; ++e) if (lg[e] > v1) { v1 = lg[e]; i1 = e; }
                            int i2 = -1; float v2 = -INFINITY;
#pragma unroll
                            for (int e = 0; e < 8; ++e) if (e != i1 && lg[e] > v2) { v2 = lg[e]; i2 = e; }
                            const float w1 = 1.f / (1.f + expf(v2 - v1));
                            LE[2 * tl] = i1; LE[2 * tl + 1] = i2; LW[2 * tl] = w1; LW[2 * tl + 1] = 1.f - w1; }
                    }
                    LDS_WAIT(); __syncthreads();
                    if (tid < 8) { int c = 0; for (int i = 0; i < 128; ++i) if (LE[i] == tid) LR[i] = c++; LC[tid] = c; }
                    LDS_WAIT(); __syncthreads();
                    if (tid < 64) { const int tok = 64 * tb + tid; u32x4 a, b2; a.x = LE[2 * tid]; a.y = LE[2 * tid + 1]; a.z = LR[2 * tid]; a.w = LR[2 * tid + 1];
                        b2.x = __builtin_bit_cast(unsigned, LW[2 * tid]); b2.y = __builtin_bit_cast(unsigned, LW[2 * tid + 1]); b2.z = 0u; b2.w = 0u;
                        *(u32x4*)(route + (size_t)tok * 8) = a; *(u32x4*)(route + (size_t)tok * 8 + 4) = b2; }
                    if (tid < 8) cntg[tb * 8 + tid] = (unsigned)LC[tid];
                    LDS_WAIT(); __syncthreads();
                }
                SEAM(pb + PO_F0);
            }
            if (PM(16) && IN(pb + PO_F0 + 1)) {
            PHASE_IDS
                LAS unsigned* CN = (LAS unsigned*)(lds + 4096);
                LAS unsigned* SB = (LAS unsigned*)(lds + 2048);
                LAS unsigned* TOTS = (LAS unsigned*)(lds + 2048 + 64);
                LAS unsigned* MYB = (LAS unsigned*)(lds + 2048 + 128);
                const float* gain = ap_->in[I_NORM_FFN] + DM;
                for (int rep_ = 0; rep_ < REPN(16); ++rep_)
                for (int tb = bid; tb < T / 64; tb += G) {
                    for (int i = tid; i < 2048; i += 512) CN[i] = cntg[i];
                    LDS_WAIT(); __syncthreads();
                    if (tid < 8) { unsigned tot = 0, myb = 0; for (int w = 0; w < 256; ++w) { const unsigned c = CN[w * 8 + tid]; if (w < tb) myb += c; tot += c; } TOTS[tid] = tot; MYB[tid] = myb; }
                    LDS_WAIT(); __syncthreads();
                    if (tid == 0) { unsigned toff = 0; for (int e = 0; e < 8; ++e) { SB[e] = toff * 256 + MYB[e]; const unsigned nte = (TOTS[e] + 255) >> 8;
                            if (tb == 0) for (unsigned k = 0; k < nte; ++k) tinfo[8 + toff + k] = e;
                            toff += nte; }
                        if (tb == 0) tinfo[0] = toff; }
                    LDS_WAIT(); __syncthreads();
                    f32x4 ggr[4];
#pragma unroll
                    for (int j = 0; j < 4; ++j) ggr[j] = ((const f32x4*)gain)[lane + 64 * j];
#pragma unroll 1
                    for (int k0 = 0; k0 < 8; k0 += 4) {
                        u32x4 ra[4], rb[4]; f32x4 xv[4][4];
#pragma unroll
                        for (int q = 0; q < 4; ++q) { const int tok = 64 * tb + 8 * wid + k0 + q; ra[q] = *(const u32x4*)(route + (size_t)tok * 8); rb[q] = *(const u32x4*)(route + (size_t)tok * 8 + 4);
#pragma unroll
                            for (int j = 0; j < 4; ++j) xv[q][j] = xrow4(W16(WS_XB2), ap_->out, (size_t)tok, lane + 64 * j); }
#pragma unroll
                        for (int q = 0; q < 4; ++q) { const int tok = 64 * tb + 8 * wid + k0 + q;
                            const unsigned s1 = SB[ra[q].x] + ra[q].z, s2 = SB[ra[q].y] + ra[q].w;
                            if (lane == 0) { u32x4 o; o.x = s1; o.y = s2; o.z = rb[q].x; o.w = rb[q].y; *(u32x4*)(slot + (size_t)tok * 4) = o; }
                            float sq = 0.f;
#pragma unroll
                            for (int j = 0; j < 4; ++j) { const f32x4 v = xv[q][j]; sq += (v.x * v.x + v.y * v.y) + (v.z * v.z + v.w * v.w); }
                            const float rs = 1.0f / sqrtf(wave_sum(sq) * (1.f / DM) + EPS);
                            unsigned long long* o1 = (unsigned long long*)(W16(WS_HP) + (size_t)s1 * DM) + lane; unsigned long long* o2 = (unsigned long long*)(W16(WS_HP) + (size_t)s2 * DM) + lane;
#pragma unroll
                            for (int j = 0; j < 4; ++j) { const f32x4 v = xv[q][j], gg = ggr[j];
                                const unsigned long long pk = (unsigned long long)pk2(v.x * rs * gg.x, v.y * rs * gg.y) | ((unsigned long long)pk2(v.z * rs * gg.z, v.w * rs * gg.w) << 32);
                                o1[64 * j] = pk; o2[64 * j] = pk; } }
                    }
                    LDS_WAIT(); __syncthreads();
                }
                SEAM(pb + PO_F0 + 1);
            }
#pragma unroll 1
            for (int ch = 0; ch < 2; ++ch) {
                const int t0 = ch * HALFT;
#define MOE_NM int nm = (int)tinfo[0] - t0; if (ch == 0) nm = nm > HALFT ? HALFT : nm; nm = nm < 0 ? 0 : (nm > CH1T ? CH1T : nm);
                if (PM(17) && IN(pb + PO_F0 + 2 + 2 * ch)) {
            PHASE_IDS
                    MOE_NM
                    pg8::Gemm g{(const char*)(ws + WS_HP + (size_t)t0 * 256 * DM * 2), (const char*)(ws + WS_MGU), DM, DM, DM};
                    SchedMoe S; S.o.init(nm, 2 * DFFE / 256, G, bid); S.texp = tinfo + 8; S.t0 = t0; S.nn = 2 * DFFE / 256; S.astep = 256L * DM * 2; S.bstep = 256L * DM * 2; S.estep = 7168L * DM * 2; S.cstep = 256L * DFFE; S.khb = 0; S.khc = 0;
                    EpiSwiglu<0> E{W16(WS_ACTC), DFFE, nullptr};
                    for (int rep_ = 0; rep_ < REPN(17); ++rep_) pg8::gemm_phase<EpiSwiglu<0>, SchedMoe, true, true>(lds, g, S, E, tid);
                    SEAM(pb + PO_F0 + 2 + 2 * ch);
                }
                if (PM(18) && IN(pb + PO_F0 + 3 + 2 * ch)) {
            PHASE_IDS
                    MOE_NM
                    pg8::Gemm g{(const char*)(ws + WS_ACTC), (const char*)(ws + WS_MD), DFFE / 2, DFFE, DFFE};
                    SchedMoe S; S.o.init(nm, 2 * DM / 256, G, bid); S.texp = tinfo + 8; S.t0 = t0; S.nn = DM / 256; S.astep = 256L * DFFE * 2; S.bstep = 256L * DFFE * 2; S.estep = 1024L * DFFE * 2; S.cstep = 0;
                    S.khb = (long)(DFFE / 2) * 2; S.khc = ((long)WS_YB - (long)WS_HP) / 2;
                    EpiPlain E{W16(WS_HP), DM, nullptr};
                    for (int rep_ = 0; rep_ < REPN(18); ++rep_) pg8::gemm_phase<EpiPlain, SchedMoe, true, true>(lds, g, S, E, tid);
                    SEAM(pb + PO_F0 + 3 + 2 * ch);
                }
            }
            if (PM(19) && IN(pb + PO_F0 + 6)) {
            PHASE_IDS
                const float* gain = ap_->in[I_NORM_FINAL];
                f32x4 gg[4];
#pragma unroll
                for (int j = 0; j < 4; ++j) gg[j] = ((const f32x4*)gain)[lane + 64 * j];
#define BLO(u) __builtin_bit_cast(float, (u) << 16)
#define BHI(u) __builtin_bit_cast(float, (u) & 0xffff0000u)
                int r = gw;
                u32x2 si = {0u, 0u}; float w1 = 0.f, w2 = 0.f; f32x4 xv[4];
                if (r < T) { si = *(const u32x2*)(slot + (size_t)r * 4); w1 = ((const float*)slot)[(size_t)r * 4 + 2]; w2 = ((const float*)slot)[(size_t)r * 4 + 3];
#pragma unroll
                    for (int j = 0; j < 4; ++j) xv[j] = xrow4(W16(WS_XB2), ap_->out, (size_t)r, lane + 64 * j); }
                while (r < T) {
                    asm volatile("" : "+v"(w1), "+v"(w2));
                    const u32x2* y1 = (const u32x2*)(W16(WS_HP) + (size_t)si.x * DM) + lane; const u32x2* y2 = (const u32x2*)(W16(WS_HP) + (size_t)si.y * DM) + lane;
                    const u32x2* z1 = (const u32x2*)(W16(WS_YB) + (size_t)si.x * DM) + lane; const u32x2* z2 = (const u32x2*)(W16(WS_YB) + (size_t)si.y * DM) + lane;
                    u32x2 a[4], c[4], a2[4], c2[4];
#pragma unroll
                    for (int j = 0; j < 4; ++j) { a[j] = y1[64 * j]; c[j] = y2[64 * j]; a2[j] = z1[64 * j]; c2[j] = z2[64 * j]; }
                    const int rn = r + NGW; u32x2 sin = {0u, 0u}; float w1n = 0.f, w2n = 0.f; f32x4 xn[4];
                    if (rn < T) { sin = *(const u32x2*)(slot + (size_t)rn * 4); w1n = ((const float*)slot)[(size_t)rn * 4 + 2]; w2n = ((const float*)slot)[(size_t)rn * 4 + 3];
#pragma unroll
                        for (int j = 0; j < 4; ++j) xn[j] = xrow4(W16(WS_XB2), ap_->out, (size_t)rn, lane + 64 * j); }
                    f32x4 v[4]; float s = 0.f;
#pragma unroll
                    for (int j = 0; j < 4; ++j) { const f32x4 x = xv[j];
                        v[j].x = x.x + w1 * (BLO(a[j].x) + BLO(a2[j].x)) + w2 * (BLO(c[j].x) + BLO(c2[j].x));
                        v[j].y = x.y + w1 * (BHI(a[j].x) + BHI(a2[j].x)) + w2 * (BHI(c[j].x) + BHI(c2[j].x));
                        v[j].z = x.z + w1 * (BLO(a[j].y) + BLO(a2[j].y)) + w2 * (BLO(c[j].y) + BLO(c2[j].y));
                        v[j].w = x.w + w1 * (BHI(a[j].y) + BHI(a2[j].y)) + w2 * (BHI(c[j].y) + BHI(c2[j].y));
                        s += (v[j].x * v[j].x + v[j].y * v[j].y) + (v[j].z * v[j].z + v[j].w * v[j].w); }
                    const float rs = 1.0f / sqrtf(wave_sum(s) * (1.f / DM) + EPS);
                    f32x4* orow = (f32x4*)(ap_->out + (size_t)r * DM) + lane;
#pragma unroll
                    for (int j = 0; j < 4; ++j) orow[64 * j] = (f32x4){v[j].x * rs * gg[j].x, v[j].y * rs * gg[j].y, v[j].z * rs * gg[j].z, v[j].w * rs * gg[j].w};
                    r = rn; si = sin; w1 = w1n; w2 = w2n;
#pragma unroll
                    for (int j = 0; j < 4; ++j) xv[j] = xn[j];
                }
            }
        }
}

__global__ void __launch_bounds__(NWAVES * 64, 2) fwd(Args args) {
    extern __shared__ __attribute__((aligned(16))) unsigned char lds_raw[];
    LAS unsigned char* lds = (LAS unsigned char*)lds_raw;
    const int G = gridDim.x, bid = blockIdx.x, NGW = G * NWAVES;
    const int wid0 = __builtin_amdgcn_readfirstlane((int)threadIdx.x >> 6);
    unsigned* ctl = (unsigned*)(args.ws + WS_CTL);
    const int lo = args.ph_lo, hi = args.ph_hi;
    for (int u = threadIdx.x; u < (LDS_BYTES - LDSCTL_OFF) / 4; u += NWAVES * 64) ((LAS unsigned*)(lds + LDSCTL_OFF))[u] = 0u;
    __syncthreads();
#if DBG >= 200
    if (blockIdx.x == 0 && threadIdx.x == 0) ((unsigned long long*)(ctl + 20000))[63] = __builtin_amdgcn_s_memrealtime();
#endif
    const bool multi = (hi - lo) > 1;
    XcdBarrier bar; bar.bar = ctl + CW_BAR; bar.x = 0; bar.st = nullptr;
    if (multi) bar = xcd_barrier_post(ctl + CW_BAR, (volatile LAS unsigned*)(lds + LDSCTL_OFF + 32));

    if (PM(0) && IN(PH_PRO)) {
            PHASE_IDS
        LAS float* scr = (LAS float*)(lds + wid * 16896);
        constexpr int IT_WIN = 16 * 64, IT_WOUT = 8 * 32, IT_SQ = 16 * 16, IT_C1 = 32 * 4, IT_C2 = 4 * 8, IT_FG = 16 * 44, IT_FD = 44 * 16;
        constexpr int N0 = 2 * IT_WIN, N1 = N0 + 2 * IT_WOUT, N2 = N1 + 8 * IT_SQ, N3 = N2 + 4 * IT_C1, N4 = N3 + 4 * IT_C2, N5 = N4 + 2 * IT_FG, N6 = N5 + IT_FD;
        for (int rep_ = 0; rep_ < REP_PRO; ++rep_)
        for (int it = gw; it < N6; it += NGW) {
            if (it < N0) { const int l = it / IT_WIN, r = it % IT_WIN, kb = r / 64, j = r % 64;
                int n0, ncv, dr = 32 * j;
                if (j < 40) { n0 = 32 * j; ncv = 32; } else if (j < 56) { n0 = 1304 + 32 * (j - 40); ncv = 32; } else if (j == 56) { n0 = 1280; ncv = 24; } else { n0 = 0; ncv = 0; }
                xpose_item(ap_->in[I_W_IN] + (size_t)l * DM * 1816, 1816, 64 * kb, n0, ncv, W16(WS_WIN) + (size_t)l * ZW * DM, DM, dr, scr, lane, ap_->in[I_NORM_MIX] + l * DM);
            } else if (it < N1) { const int r0 = it - N0, l = r0 / IT_WOUT, r = r0 % IT_WOUT, kb = r / 32, j = r % 32;
                xpose_item(ap_->in[I_W_OUT] + (size_t)l * DM * DM, DM, 64 * kb, 32 * j, 32, W16(WS_WOUT) + (size_t)l * DM * DM, DM, 32 * j, scr, lane);
            } else if (it < N2) { const int r0 = it - N1, mtx = r0 / IT_SQ, r = r0 % IT_SQ, which = mtx >> 1, l = mtx & 1;
                const float* src = ap_->in[which == 0 ? I_WQ : which == 1 ? I_WO : which == 2 ? I_WK : I_WV] + (size_t)l * DM * DM;
                bf16_t* dst = W16(which == 0 ? WS_WQ : which == 1 ? WS_WO : which == 2 ? WS_WK : WS_WV) + (size_t)l * DM * DM;
                xpose_mat(src, DM, DM, dst, 0, r, scr, lane, which == 0 ? ap_->in[I_NORM_X] + l * DM : nullptr);
            } else if (it < N3) { const int r0 = it - N2, mtx = r0 / IT_C1, r = r0 % IT_C1, l = mtx >> 1, kv = mtx & 1;
                xpose_mat(ap_->in[kv ? I_W1_V : I_W1_K] + (size_t)l * 2048 * 256, 2048, 256, W16(WS_CW1) + (size_t)mtx * 256 * 2048, 0, r, scr, lane);
            } else if (it < N4) { const int r0 = it - N3, mtx = r0 / IT_C2, r = r0 % IT_C2, l = mtx >> 1, kv = mtx & 1, kb = r / 8, j = r % 8;
                xpose_item(ap_->in[kv ? I_W2_V : I_W2_K] + (size_t)l * 256 * 64, 64, 64 * kb, j < 2 ? 32 * j : 0, j < 2 ? 32 : 0, W16(WS_CW2) + (size_t)mtx * 256 * 256, 256, 32 * j, scr, lane);
            } else if (it < N5) { const int r0 = it - N4, up = r0 / IT_FG, r = r0 % IT_FG;
                xpose_mat(ap_->in[up ? I_FFN_WU : I_FFN_WG], DM, DFF, W16(WS_FGU), up ? 2 : 1, r, scr, lane, ap_->in[I_NORM_FFN]);
            } else if (it < N6) { xpose_mat(ap_->in[I_FFN_WD], DFF, DM, W16(WS_FD), 0, it - N5, scr, lane);
            }
        }
        for (int i = bid * 512 + tid; i < SEQ * 8; i += G * 512) {
            const int pos = i >> 3, j = i & 7;
            const double inv = j == 0 ? 1.0 : j == 1 ? 0.19389587045179572 : j == 2 ? 0.037606030930863934 : j == 3 ? 0.007291654101443755 : j == 4 ? 0.0014142135623730951
                             : j == 5 ? 0.00027421616994972156 : j == 6 ? 5.3169310700017e-05 : 1.0309310618636385e-05;
            float s, c; sincos_d((double)pos * inv, s, c);
            ((float*)(ws + WS_ROPE))[2 * i] = c; ((float*)(ws + WS_ROPE))[2 * i + 1] = s;
        }
        for (int r0 = gw; r0 < T; r0 += 4 * NGW) {
            f32x4 xv[4][4];
#pragma unroll
            for (int q = 0; q < 4; ++q)
#pragma unroll
                for (int j = 0; j < 4; ++j) xv[q][j] = ((const f32x4*)(ap_->in[I_X] + (size_t)(r0 + q * NGW) * DM) + lane)[64 * j];
#pragma unroll
            for (int q = 0; q < 4; ++q) { const int r = r0 + q * NGW; unsigned long long* o8 = (unsigned long long*)(W16(WS_HB) + (size_t)r * DM) + lane; float sq = 0.f;
#pragma unroll
                for (int j = 0; j < 4; ++j) { const f32x4 v = xv[q][j]; sq += (v.x * v.x + v.y * v.y) + (v.z * v.z + v.w * v.w); o8[64 * j] = (unsigned long long)pk2(v.x, v.y) | ((unsigned long long)pk2(v.z, v.w) << 32); }
                sq = wave_sum(sq); if (lane == 0) SSP(0)[r] = ss_fix(sq); } }
        for (int r = gw; r < 2 * 1024; r += NGW) { const int l = r >> 10, row = r & 1023;
            norm_row(ap_->in[I_MEM] + (size_t)row * DM, ap_->in[I_NORM_MEM] + l * DM, W16(WS_MN) + (size_t)r * DM, lane); }
        for (int itb = gw; itb < 4 * 4 * 16; itb += NGW) { const int mtx = itb >> 6, cg = (itb >> 4) & 3, fc = itb & 15, l = mtx >> 1, kv = mtx & 1, c = cg * 64 + lane;
            const float* pe = ap_->in[kv ? I_PE_V : I_PE_K] + l * 2048 + fc * 128; const float* w1 = ap_->in[kv ? I_W1_V : I_W1_K] + (size_t)l * 2048 * 256 + (size_t)fc * 128 * 256 + c;
            float a = fc == 0 ? ap_->in[kv ? I_B1_V : I_B1_K][l * 256 + c] : 0.f;
#pragma unroll
            for (int h = 0; h < 4; ++h) { float wv[32];
#pragma unroll
                for (int f = 0; f < 32; ++f) wv[f] = w1[(size_t)(32 * h + f) * 256];
#pragma unroll
                for (int f = 0; f < 32; ++f) a += pe[32 * h + f] * wv[f]; }
            atomicAdd((unsigned long long*)(ctl + CW_BIAS) + mtx * 256 + c, (unsigned long long)(long long)((double)a * 1099511627776.0)); }
        for (int itw = gw; itw < 2 * 4 * 16 * 16; itw += NGW) { const int l = itw >> 10, g = (itw >> 8) & 3, nb = (itw >> 4) & 15, cb = itw & 15, n = nb * 64 + lane;
            const float* wp = ap_->in[I_W_POOL] + ((size_t)(l * 4 + g) * 128 + cb * 8) * 128; const float* ps = ap_->in[I_POOL_SCALE] + l * 512 + g * 128;
            const float* wo = ap_->in[I_W_OUT] + (size_t)l * DM * DM + (size_t)(512 + g * 128) * DM + n;
            float a[8];
#pragma unroll
            for (int c = 0; c < 8; ++c) a[c] = 0.f;
#pragma unroll
            for (int h = 0; h < 4; ++h) { float wv[32];
#pragma unroll
                for (int e = 0; e < 32; ++e) wv[e] = wo[(size_t)(32 * h + e) * DM];
#pragma unroll
                for (int e = 0; e < 32; ++e) { const float w = wv[e] * ps[32 * h + e];
#pragma unroll
                    for (int c = 0; c < 8; ++c) a[c] += wp[c * 128 + 32 * h + e] * w; } }
            u32x4 o; o.x = pk2(a[0], a[1]); o.y = pk2(a[2], a[3]); o.z = pk2(a[4], a[5]); o.w = pk2(a[6], a[7]);
            *(u32x4*)(W16(WS_WOUT) + (size_t)l * DM * DM + (size_t)n * DM + 512 + g * 128 + cb * 8) = o; }
        __syncthreads();
        SEAM(PH_PRO);
    }
    layer_phases<0>(lds, lo, hi, bar, G, bid, NGW, wid0);
    layer_phases<1>(lds, lo, hi, bar, G, bid, NGW, wid0);
#if DBG >= 200
    __syncthreads(); if (blockIdx.x == 0 && threadIdx.x == 0) ((unsigned long long*)(ctl + 20000))[62] = __builtin_amdgcn_s_memrealtime();
#endif
#undef IN
#undef SEAM
}

#if DBG
struct DbgIn { const float* in[30]; };
__device__ float dbg_block_sum(float v, float* red) { const int t = threadIdx.x; red[t] = v; __syncthreads(); for (int o = 128; o > 0; o >>= 1) { if (t < o) red[t] += red[t + o]; __syncthreads(); } const float r = red[0]; __syncthreads(); return r; }
__global__ void dbg_check(DbgIn di, const float* xcur, unsigned char* ws, int stage) {
    __shared__ float red[256]; __shared__ float act[3584]; __shared__ float hrow[1024];
    const int t = threadIdx.x; float* W = (float*)(ws + WS_CTL) + 16000;
    const unsigned* sl = (const unsigned*)(ws + WS_SLOT); const unsigned* rt = (const unsigned*)(ws + WS_ROUTE); const bf16_t* hp = (const bf16_t*)(ws + WS_HP); const bf16_t* ac = (const bf16_t*)(ws + WS_ACTC);
    const int toks[4] = {0, 5000, 12000, 16383}; float worst = 0.f; int nchk = 0;
    for (int q = 0; q < 4; ++q) for (int kk = 0; kk < 2; ++kk) { const int tok = toks[q]; const unsigned e = rt[tok * 8 + kk], sidx = sl[tok * 4 + kk]; const int ch = sidx >= (unsigned)(HALFT * 256) ? 1 : 0;
        if (stage == 1) {
            float ss = 0.f; for (int c = t; c < 1024; c += 256) { const float x = xcur[(size_t)tok * 1024 + c]; ss += x * x; } ss = dbg_block_sum(ss, red);
            const float rs = 1.f / sqrtf(ss / 1024.f + EPS); float num = 0.f, den = 0.f;
            for (int c = t; c < 1024; c += 256) { const float h = xcur[(size_t)tok * 1024 + c] * rs * di.in[I_NORM_FFN][1024 + c], f = bf2f(hp[(size_t)sidx * 1024 + c]); num += (h - f) * (h - f); den += h * h; }
            num = dbg_block_sum(num, red); den = dbg_block_sum(den, red); worst = fmaxf(worst, sqrtf(num / fmaxf(den, 1e-20f))); ++nchk;
        } else if ((stage == 2 && ch == 0) || (stage == 4 && ch == 1)) {
            for (int c = t; c < 1024; c += 256) hrow[c] = bf2f(hp[(size_t)sidx * 1024 + c]); __syncthreads();
            const float* wg = di.in[I_MOE_WG] + (size_t)e * DM * DFFE; const float* wu = di.in[I_MOE_WU] + (size_t)e * DM * DFFE; float num = 0.f, den = 0.f;
            for (int j = t; j < 3584; j += 256) { float g = 0.f, u = 0.f; for (int k2 = 0; k2 < 1024; ++k2) { g += hrow[k2] * wg[(size_t)k2 * DFFE + j]; u += hrow[k2] * wu[(size_t)k2 * DFFE + j]; }
                const float a = g / (1.f + expf(-g)) * u, f = bf2f(ac[((size_t)sidx - (size_t)ch * HALFT * 256) * 3584 + j]); num += (a - f) * (a - f); den += a * a; }
            num = dbg_block_sum(num, red); den = dbg_block_sum(den, red); worst = fmaxf(worst, sqrtf(num / fmaxf(den, 1e-20f))); ++nchk; __syncthreads();
        } else if ((stage == 3 && ch == 0) || (stage == 5 && ch == 1)) {
            for (int j = t; j < 3584; j += 256) act[j] = bf2f(ac[((size_t)sidx - (size_t)ch * HALFT * 256) * 3584 + j]); __syncthreads();
            const float* wd = di.in[I_MOE_WD] + (size_t)e * DFFE * DM; float num = 0.f, den = 0.f;
            for (int n = t; n < 1024; n += 256) { float y = 0.f; for (int j = 0; j < 3584; ++j) y += act[j] * wd[(size_t)j * DM + n]; const float f = bf2f(hp[(size_t)sidx * 1024 + n]); num += (y - f) * (y - f); den += y * y; }
            num = dbg_block_sum(num, red); den = dbg_block_sum(den, red); worst = fmaxf(worst, sqrtf(num / fmaxf(den, 1e-20f))); ++nchk; __syncthreads();
        } }
    if (stage == 1) {
        float mism = 0.f, werr = 0.f;
        for (int q = 0; q < 64; ++q) { const int tok = q * 251 + 3;
            float ss = 0.f; for (int c = t; c < 1024; c += 256) { const float x = xcur[(size_t)tok * 1024 + c]; ss += x * x; } ss = dbg_block_sum(ss, red);
            const float rs = 1.f / sqrtf(ss / 1024.f + EPS); float lg[8];
            for (int e = 0; e < 8; ++e) { float a = 0.f; for (int c = t; c < 1024; c += 256) a += xcur[(size_t)tok * 1024 + c] * rs * di.in[I_NORM_FFN][1024 + c] * di.in[I_ROUTER][c * 8 + e]; lg[e] = dbg_block_sum(a, red); }
            int i1 = 0; for (int e = 1; e < 8; ++e) if (lg[e] > lg[i1]) i1 = e; int i2 = -1; for (int e = 0; e < 8; ++e) if (e != i1 && (i2 < 0 || lg[e] > lg[i2])) i2 = e;
            const float w1 = 1.f / (1.f + expf(lg[i2] - lg[i1]));
            if ((int)rt[tok * 8] != i1 || (int)rt[tok * 8 + 1] != i2) mism += 1.f;
            werr = fmaxf(werr, fabsf(w1 - __builtin_bit_cast(float, rt[tok * 8 + 4]))); }
        if (t == 0) { W[8] = mism; W[9] = werr; } }
    if (stage == 5) {
        float sx = 0.f, sm = 0.f;
        for (int q = 0; q < 4; ++q) { const int tok = toks[q]; const unsigned s1 = sl[tok * 4], s2 = sl[tok * 4 + 1]; const float w1 = __builtin_bit_cast(float, sl[tok * 4 + 2]), w2 = __builtin_bit_cast(float, sl[tok * 4 + 3]);
            for (int c = t; c < 1024; c += 256) { const float x = xcur[(size_t)tok * 1024 + c], m = w1 * bf2f(hp[(size_t)s1 * 1024 + c]) + w2 * bf2f(hp[(size_t)s2 * 1024 + c]); sx += x * x; sm += m * m; } }
        sx = dbg_block_sum(sx, red); sm = dbg_block_sum(sm, red);
        if (t == 0) { W[6] = sx / 4096.f; W[7] = sm / 4096.f; } }
    if (t == 0) { W[stage] = worst; W[10 + stage] = (float)nchk; }
}
__global__ void dbg_attn(unsigned char* ws, int b, int g, int t, int slotw) {
    __shared__ float red[256]; __shared__ float lgt[4096]; __shared__ float pcs[4][256]; __shared__ float osum[4][64]; __shared__ int selb[64]; __shared__ float impv[64];
    const int tid = threadIdx.x, bg = b * 2 + g, tok = b * SEQ + t; float* W = (float*)(ws + WS_CTL) + 16000;
    const bf16_t* qraw = (const bf16_t*)(ws + WS_QRAW) + ((size_t)bg * SEQ + t) * 256; const bf16_t* qrot = (const bf16_t*)(ws + WS_QROT) + ((size_t)bg * SEQ + t) * 256;
    const bf16_t* kc = (const bf16_t*)(ws + WS_KCMP) + (size_t)bg * 256 * 64; const bf16_t* vc = kc + 8 * 256 * 64;
    const bf16_t* kvb = (const bf16_t*)(ws + WS_KV); const float* gt = (const float*)(ws + WS_GATES) + (size_t)tok * 24 + g * 12;
    const int nv = t >= 15 ? ((t - 15) >> 4) : 0, tb = t >> 6;
    for (int i = tid; i < 256; i += 256) osum[i >> 6][i & 63] = 0.f;
    __syncthreads();
    for (int r = 0; r < 4; ++r) {
        float s = -INFINITY; const int c = tid;
        if (c < 255 && c < nv) { s = 0.f; for (int d = 0; d < 64; ++d) s += bf2f(qraw[r * 64 + d]) * bf2f(kc[c * 64 + d]); }
        red[tid] = s; __syncthreads(); for (int o = 128; o > 0; o >>= 1) { if (tid < o) red[tid] = fmaxf(red[tid], red[tid + o]); __syncthreads(); } float m = red[0]; __syncthreads(); if (m == -INFINITY) m = 0.f;
        const float p = s == -INFINITY ? 0.f : exp2f(s - m); const float l = dbg_block_sum(p, red);
        pcs[r][c] = l > 0.f ? p / l : 0.f; __syncthreads();
        if (tid < 64) { float o = 0.f; for (int cc = 0; cc < 255; ++cc) o += bf2f((unsigned short)f2bf(pcs[r][cc])) * bf2f(vc[cc * 64 + tid]); osum[r][tid] += gt[r * 3 + 0] * o; }
        __syncthreads();
    }
    if (tid < 64) { float im = 0.f; for (int j = -1; j < 4; ++j) { const int c = 4 * tid + j; if (c >= 0 && c < 255) for (int r = 0; r < 4; ++r) im += pcs[r][c]; }
        const bool fut = tid > tb, forced = tid == 0 || tid == tb || tid == tb - 1; impv[tid] = fut ? -INFINITY : forced ? INFINITY : im; selb[tid] = 0; }
    __syncthreads();
    if (tid == 0) { for (int k = 0; k < 16; ++k) { int best = -1; float bv = 0.f; for (int n = 0; n < 64; ++n) if (!selb[n] && (best < 0 || impv[n] > bv)) { best = n; bv = impv[n]; } selb[best] = 1; } }
    __syncthreads();
    for (int br = 1; br <= 2; ++br) {
        const bf16_t* kb = kvb + (size_t)(br == 1 ? 2 : 4) * KVSZ + (size_t)bg * SEQ * 64; const bf16_t* vb = kvb + (size_t)(br == 1 ? 3 : 5) * KVSZ + (size_t)bg * SEQ * 64;
        for (int r = 0; r < 4; ++r) {
            float mx = -INFINITY;
            for (int j = tid; j < SEQ; j += 256) { bool ok = j <= t; if (br == 1) ok = ok && selb[j >> 6]; else ok = ok && (t - j) < 512;
                float sv = -INFINITY; if (ok) { sv = 0.f; for (int d = 0; d < 64; ++d) sv += bf2f(qrot[r * 64 + d]) * bf2f(kb[(size_t)j * 64 + d]); } lgt[j] = sv; mx = fmaxf(mx, sv); }
            red[tid] = mx; __syncthreads(); for (int o = 128; o > 0; o >>= 1) { if (tid < o) red[tid] = fmaxf(red[tid], red[tid + o]); __syncthreads(); } const float m = red[0]; __syncthreads();
            float ls = 0.f; for (int j = tid; j < SEQ; j += 256) { const float p = lgt[j] == -INFINITY ? 0.f : exp2f(lgt[j] - m); lgt[j] = p; ls += p; }
            const float l = dbg_block_sum(ls, red);
            if (tid < 64) { float o = 0.f; for (int j = 0; j <= t; ++j) o += lgt[j] * bf2f(vb[(size_t)j * 64 + tid]); osum[r][tid] += gt[r * 3 + br] * o / l; }
            __syncthreads();
        }
    }
    const bf16_t* ab = (const bf16_t*)(ws + WS_AB) + (size_t)tok * 1024 + g * 256;
    float num = 0.f, den = 0.f; { const float o = osum[tid >> 6][tid & 63], f = bf2f(ab[tid]); num = (o - f) * (o - f); den = o * o; }
    num = dbg_block_sum(num, red); den = dbg_block_sum(den, red);
    if (tid == 0) { W[slotw] = sqrtf(num / fmaxf(den, 1e-30f)); W[slotw + 40] = sqrtf(den / 256.f); }
}
__global__ void dbg_mixer(DbgIn di, const float* outp, unsigned char* ws, int stage) {
    __shared__ float red[256]; __shared__ float hrow[1024]; __shared__ float zrow[1816]; __shared__ float hid[256];
    const int t = threadIdx.x; float* W = (float*)(ws + WS_CTL) + 16000;
    const bf16_t* hb = (const bf16_t*)(ws + WS_HB); const bf16_t* kvb = (const bf16_t*)(ws + WS_KV);
    const int toks[4] = {7, 4101, 9000, 16383};
    if (stage == 30) {
        float nq = 0, dq = 0, nr = 0, dr = 0, nk = 0, dk = 0, nkr = 0, dkr = 0, nu = 0, du = 0, ng = 0, dg = 0;
        for (int q = 0; q < 4; ++q) { const int tok = toks[q], b = tok >> 12, pos = tok & 4095;
            for (int c = t; c < 1024; c += 256) hrow[c] = bf2f(hb[(size_t)tok * 1024 + c]); __syncthreads();
            for (int n = t; n < 1816; n += 256) { float a = 0.f; for (int k = 0; k < 1024; ++k) a += hrow[k] * di.in[I_W_IN][(size_t)k * 1816 + n]; zrow[n] = a; } __syncthreads();
            for (int n = t; n < 1816; n += 256) { const float z = zrow[n];
                if (n < 512) { const int g = n >> 8, c = n & 255, d = n & 63; const size_t idx = ((size_t)(b * 2 + g) * SEQ + pos) * 256 + c;
                    const float f = bf2f(((const bf16_t*)(ws + WS_QRAW))[idx]) / C2; nq += (z - f) * (z - f); dq += z * z;
                    float zr = z; if (d < 16) { const int j = d & 7; const double inv = pow(500000.0, -(double)j / 8.0); const float cs = (float)cos((double)pos * inv), sn = (float)sin((double)pos * inv);
                        zr = d < 8 ? z * cs - zrow[n + 8] * sn : z * cs + zrow[n - 8] * sn; }
                    const float fr = bf2f(((const bf16_t*)(ws + WS_QROT))[idx]) / C2; nr += (zr - fr) * (zr - fr); dr += zr * zr;
                } else if (n < 1280) { const int m = n - 512, i = m >> 7, g = (m >> 6) & 1, d = m & 63; const float f = bf2f(kvb[(size_t)i * KVSZ + ((size_t)(b * 2 + g) * SEQ + pos) * 64 + d]);
                    if (i == 2 || i == 4) { float zr = z; if (d < 16) { const int j = d & 7; const double inv = pow(500000.0, -(double)j / 8.0); const float cs = (float)cos((double)pos * inv), sn = (float)sin((double)pos * inv);
                            zr = d < 8 ? z * cs - zrow[n + 8] * sn : z * cs + zrow[n - 8] * sn; } nkr += (zr - f) * (zr - f); dkr += zr * zr; }
                    else { nk += (z - f) * (z - f); dk += z * z; }
                } else if (n < 1304) { const float sg = 1.f / (1.f + expf(-z)), f = ((const float*)(ws + WS_GATES))[(size_t)tok * 24 + (n - 1280)]; ng += (sg - f) * (sg - f); dg += sg * sg;
                } else { const float f = bf2f(((const bf16_t*)(ws + WS_U))[(size_t)tok * 512 + (n - 1304)]); nu += (z - f) * (z - f); du += z * z; } }
            __syncthreads(); }
        nq = dbg_block_sum(nq, red); dq = dbg_block_sum(dq, red); nr = dbg_block_sum(nr, red); dr = dbg_block_sum(dr, red); nk = dbg_block_sum(nk, red); dk = dbg_block_sum(dk, red);
        nkr = dbg_block_sum(nkr, red); dkr = dbg_block_sum(dkr, red); nu = dbg_block_sum(nu, red); du = dbg_block_sum(du, red); ng = dbg_block_sum(ng, red); dg = dbg_block_sum(dg, red);
        if (t == 0) { W[30] = sqrtf(nq / dq); W[31] = sqrtf(nr / dr); W[32] = sqrtf(nk / dk); W[33] = sqrtf(nkr / dkr); W[34] = sqrtf(nu / du); W[35] = sqrtf(ng / dg); }
    }
    if (stage == 31) {
        float nc = 0, dc = 0, nd = 0, dd = 0;
        const int cs_[4] = {0, 17, 200, 254};
        for (int q = 0; q < 4; ++q) for (int kv = 0; kv < 2; ++kv) { const int bg = (q * 3 + 1) & 7, c = cs_[q];
            const bf16_t* src = kvb + (size_t)kv * KVSZ + ((size_t)bg * SEQ + 16 * c) * 64; const float* pe = di.in[kv ? I_PE_V : I_PE_K]; const float* w1 = di.in[kv ? I_W1_V : I_W1_K]; const float* b1 = di.in[kv ? I_B1_V : I_B1_K]; const float* w2 = di.in[kv ? I_W2_V : I_W2_K];
            { float a = b1[t]; for (int f = 0; f < 2048; ++f) a += (bf2f(src[f]) + pe[f]) * w1[(size_t)f * 256 + t]; const float y = 0.7978845608f * (a + 0.044715f * a * a * a); hid[t] = 0.5f * a * (1.f + tanhf(y)); } __syncthreads();
            if (t < 64) { float o = 0.f; for (int h = 0; h < 256; ++h) o += hid[h] * w2[h * 64 + t]; const float f = bf2f(((const bf16_t*)(ws + WS_KCMP))[(size_t)kv * 8 * 256 * 64 + ((size_t)bg * 256 + c) * 64 + t]); nc += (o - f) * (o - f); dc += o * o; } __syncthreads(); }
        for (int q = 0; q < 4; ++q) { const int tok = toks[q], pos = tok & 4095; for (int c = t; c < 512; c += 256) { const int w = 2 << (c >> 7), n = (pos + 1) < w ? (pos + 1) : w; float sm = 0.f; const bf16_t* ub = (const bf16_t*)(ws + WS_U);
                for (int i = 0; i < n; ++i) sm += bf2f(ub[(size_t)(tok - i) * 512 + c]); const float d = sm / n - bf2f(ub[(size_t)tok * 512 + c]), f = bf2f(((const bf16_t*)(ws + WS_AB))[(size_t)tok * 1024 + 512 + c]); nd += (d - f) * (d - f); dd += d * d; } }
        nc = dbg_block_sum(nc, red); dc = dbg_block_sum(dc, red); nd = dbg_block_sum(nd, red); dd = dbg_block_sum(dd, red);
        if (t == 0) { W[36] = sqrtf(nc / dc); W[37] = sqrtf(nd / dd); }
    }
    if (stage == 32) {
        float nn = 0, dn = 0; const bf16_t* ab = (const bf16_t*)(ws + WS_AB);
        for (int q = 0; q < 4; ++q) { const int tok = toks[q];
            for (int c = t; c < 1024; c += 256) hrow[c] = bf2f(ab[(size_t)tok * 1024 + c]); __syncthreads();
            for (int ge = t; ge < 512; ge += 256) { const int g = ge >> 7, e = ge & 127; float y = 0.f; for (int c = 0; c < 128; ++c) y += hrow[512 + g * 128 + c] * di.in[I_W_POOL][((size_t)g * 128 + c) * 128 + e]; zrow[ge] = y * di.in[I_POOL_SCALE][ge]; } __syncthreads();
            for (int n = t; n < 1024; n += 256) { float a = di.in[I_X][(size_t)tok * 1024 + n]; const float x0 = a; for (int k = 0; k < 512; ++k) a += hrow[k] * di.in[I_W_OUT][(size_t)k * 1024 + n]; for (int k = 0; k < 512; ++k) a += zrow[k] * di.in[I_W_OUT][(size_t)(512 + k) * 1024 + n];
                const float f = outp[(size_t)tok * 1024 + n]; nn += (a - f) * (a - f); dn += (a - x0) * (a - x0); } __syncthreads(); }
        nn = dbg_block_sum(nn, red); dn = dbg_block_sum(dn, red);
        if (t == 0) W[38] = sqrtf(nn / dn);
    }
}
__global__ void dbg_moe_tok(DbgIn di, const float* xcur, unsigned char* ws) {
    __shared__ float red[256]; __shared__ float hrow[1024]; __shared__ float act[3584]; __shared__ float ynaive[1024];
    const int t = threadIdx.x, tok = blockIdx.x * 251 + 3; float* W = (float*)(ws + WS_CTL) + 16000;
    const unsigned* sl = (const unsigned*)(ws + WS_SLOT); const unsigned* rt = (const unsigned*)(ws + WS_ROUTE); const bf16_t* hp = (const bf16_t*)(ws + WS_HP);
    float ss = 0.f; for (int c = t; c < 1024; c += 256) { const float x = xcur[(size_t)tok * 1024 + c]; ss += x * x; } ss = dbg_block_sum(ss, red);
    const float rs = 1.f / sqrtf(ss / 1024.f + EPS);
    for (int c = t; c < 1024; c += 256) { hrow[c] = xcur[(size_t)tok * 1024 + c] * rs * di.in[I_NORM_FFN][1024 + c]; ynaive[c] = 0.f; } __syncthreads();
    float lg[8]; for (int e = 0; e < 8; ++e) { float a = 0.f; for (int c = t; c < 1024; c += 256) a += hrow[c] * di.in[I_ROUTER][c * 8 + e]; lg[e] = dbg_block_sum(a, red); }
    int i1 = 0; for (int e = 1; e < 8; ++e) if (lg[e] > lg[i1]) i1 = e; int i2 = -1; for (int e = 0; e < 8; ++e) if (e != i1 && (i2 < 0 || lg[e] > lg[i2])) i2 = e;
    const float w1 = 1.f / (1.f + expf(lg[i2] - lg[i1]));
    for (int kk = 0; kk < 2; ++kk) { const int e = kk ? i2 : i1; const float wgt = kk ? 1.f - w1 : w1;
        const float* wg = di.in[I_MOE_WG] + (size_t)e * DM * DFFE; const float* wu = di.in[I_MOE_WU] + (size_t)e * DM * DFFE; const float* wd = di.in[I_MOE_WD] + (size_t)e * DFFE * DM;
        for (int j = t; j < 3584; j += 256) { float g = 0.f, u = 0.f; for (int k2 = 0; k2 < 1024; ++k2) { g += hrow[k2] * wg[(size_t)k2 * DFFE + j]; u += hrow[k2] * wu[(size_t)k2 * DFFE + j]; } act[j] = g / (1.f + expf(-g)) * u; } __syncthreads();
        for (int n = t; n < 1024; n += 256) { float y = 0.f; for (int j = 0; j < 3584; ++j) y += act[j] * wd[(size_t)j * DM + n]; ynaive[n] += wgt * y; } __syncthreads(); }
    const unsigned s1 = sl[tok * 4], s2 = sl[tok * 4 + 1]; const float f1 = __builtin_bit_cast(float, sl[tok * 4 + 2]), f2 = __builtin_bit_cast(float, sl[tok * 4 + 3]);
    float num = 0.f, den = 0.f; for (int n = t; n < 1024; n += 256) { const bf16_t* yb = (const bf16_t*)(ws + WS_YB); const float m = f1 * (bf2f(hp[(size_t)s1 * 1024 + n]) + bf2f(yb[(size_t)s1 * 1024 + n])) + f2 * (bf2f(hp[(size_t)s2 * 1024 + n]) + bf2f(yb[(size_t)s2 * 1024 + n])); num += (m - ynaive[n]) * (m - ynaive[n]); den += ynaive[n] * ynaive[n]; }
    num = dbg_block_sum(num, red); den = dbg_block_sum(den, red);
    if (t == 0) { const float er = sqrtf(num / den); atomicMax((unsigned*)&W[50], __builtin_bit_cast(unsigned, er)); if (er > 0.1f) atomicAdd(&W[51], 1.f); atomicAdd(&W[52], er / 64.f); }
}
#ifndef DBGBR
#define DBGBR -1
#endif
__global__ void dbg_setgates(unsigned char* ws, int br) { float* g = (float*)(ws + WS_GATES); for (size_t i = (size_t)blockIdx.x * 256 + threadIdx.x; i < (size_t)T * 24; i += (size_t)gridDim.x * 256) g[i] = ((int)(i % 3) == br) ? 1.f : 0.f; }
#ifndef DBGV1
#define DBGV1 0
#endif
__global__ void dbg_setv(unsigned char* ws) { bf16_t* kv = (bf16_t*)(ws + WS_KV); for (size_t i = (size_t)blockIdx.x * 256 + threadIdx.x; i < KVSZ; i += (size_t)gridDim.x * 256) { kv[3 * KVSZ + i] = 0x3F80; kv[5 * KVSZ + i] = 0x3F80; } }
#ifndef DBG_UNIT
#define DBG_UNIT 5
#endif
#ifndef DBG_PA
#define DBG_PA 6
#endif
#ifndef DBG_PB
#define DBG_PB 20
#endif
__global__ void dbg_tail(float* out, unsigned char* ws) {
    const int t = threadIdx.x; const float* W = (const float*)(ws + WS_CTL) + 16000; float k = 0.f;
    if (DBG == 400) {
        __shared__ unsigned cnt; if (t == 0) cnt = 0; __syncthreads();
        if (blockIdx.x == 0 && t == 0) cnt = ((const unsigned*)(ws + WS_CTL))[21100];
        __syncthreads();
        const float kb = fminf((float)cnt, 89.f);
        for (size_t i = (size_t)blockIdx.x * 256 + t; i < (size_t)T * DM; i += (size_t)gridDim.x * 256) out[i] = (i == 0) ? (10.f + kb) * 10.f : 3.f;
        return; }
    if (DBG >= 200) {
        const unsigned long long* st = (const unsigned long long*)((const unsigned*)(ws + WS_CTL) + 20000);
        unsigned long long prev = st[63]; int ord = 0; float ka = 0.f, kb = 0.f;
        for (int i = 0; i < 63; ++i) { const unsigned long long v = st[i]; if (v == 0ull) continue; const float us = (float)(v - prev) * 0.01f; prev = v;
            if (ord == DBG_PA) ka = fminf(rintf(us / (float)DBG_UNIT), 89.f); if (ord == DBG_PB) kb = fminf(rintf(us / (float)DBG_UNIT), 89.f); ++ord; }
        (void)ka;
        for (size_t i = (size_t)blockIdx.x * 256 + t; i < (size_t)T * DM; i += (size_t)gridDim.x * 256) out[i] = (i == 0) ? (10.f + kb) * 10.f : 3.f;
        return; }
    if (DBG == 100) { for (int i = 1; i < 10; ++i) if (W[i] > 0.05f) { k = (float)i; break; } }
    else if (DBG == 103) { int m = 0; for (int i = 0; i < 6; ++i) if (!(W[20 + i] <= 0.05f)) m |= 1 << i; k = (float)m; }
    else if (DBG == 104) { int m = 0; for (int i = 6; i < 8; ++i) if (!(W[20 + i] <= 0.05f)) m |= 1 << (i - 6); k = (float)m; }
    else if (DBG == 105 || DBG == 106) { float mn = 1e30f, mx = 0.f; for (int i = 0; i < 8; ++i) { mn = fminf(mn, W[20 + i]); mx = fmaxf(mx, W[20 + i]); }
        k = rintf(10.f * (log10f(fmaxf(DBG == 105 ? mn : mx, 1e-6f)) + 6.f)); k = fminf(fmaxf(k, 0.f), 89.f); }
    else if (DBG == 107) { for (int i = 30; i <= 38; ++i) if (!(W[i] <= 0.03f)) { k = (float)(i - 29); break; } }
    else if (DBG == 101) { for (int i = 0; i < 8; ++i) if (!(W[20 + i] <= 0.05f)) { k = (float)(i + 1); break; } }
    else { k = rintf(10.f * (log10f(fmaxf(W[DBG], 1e-6f)) + 6.f)); k = fminf(fmaxf(k, 0.f), 89.f); }
    const float c = sqrtf(0.1f * k + 0.02f);
    for (size_t i = (size_t)blockIdx.x * 256 + t; i < (size_t)T * DM; i += (size_t)gridDim.x * 256) out[i] = c;
}
#endif

extern "C" void kernel_launch(void* const* d_in, const int* in_sizes, int n_in, void* d_out, int out_size, void* d_ws, size_t ws_size, hipStream_t stream) {
    static int grid = 0;
    if (grid == 0) {
        if (n_in != 30 || out_size != T * DM || ws_size < WS_END2) { fprintf(stderr, "kernel_launch: unexpected problem shape / workspace (%d inputs, out %d, ws %zu)\n", n_in, out_size, ws_size); grid = -1; return; }
        int dev = 0, cus = 0;
        if (hipGetDevice(&dev) != hipSuccess || hipDeviceGetAttribute(&cus, hipDeviceAttributeMultiprocessorCount, dev) != hipSuccess) { grid = -1; return; }
        if (hipFuncSetAttribute((const void*)fwd, hipFuncAttributeMaxDynamicSharedMemorySize, LDS_BYTES) != hipSuccess) { fprintf(stderr, "kernel_launch: hipFuncSetAttribute failed\n"); grid = -1; return; }
        int per_cu = 0;
        if (hipOccupancyMaxActiveBlocksPerMultiprocessor(&per_cu, (const void*)fwd, NWAVES * 64, LDS_BYTES) != hipSuccess || per_cu < 1) { fprintf(stderr, "kernel_launch: occupancy query says %d\n", per_cu); }
        (void)hipGetLastError();
        if (cus != 256) { fprintf(stderr, "kernel_launch: built for a 256-CU device, found %d\n", cus); grid = -1; return; }
        grid = cus;
    }
    if (grid < 0) return;
    if (hipMemsetAsync((char*)d_ws + WS_CTL, 0, CTL_ZERO_BYTES, stream) != hipSuccess) return;
    Args a{};
    for (int i = 0; i < 30; ++i) a.in[i] = (const float*)d_in[i];
    a.out = (float*)d_out; a.ws = (unsigned char*)d_ws;
#if MK_PER_PHASE
    int ids[64]; int n = 0;
    ids[n++] = PH_PRO;
    for (int l = 0; l < NL; ++l) { const int pb = PH_L0 + l * PH_LSTRIDE; for (int k = 0; k < 9; ++k) if (k != PO_N2 && k != PO_S && k != PO_PV) ids[n++] = pb + k;
        if (l == 0) { ids[n++] = pb + PO_F0 + 1; ids[n++] = pb + PO_F0 + 2; } else for (int k = 0; k < 7; ++k) ids[n++] = pb + PO_F0 + k; }
    for (int i = 0; i < n; ++i) { a.ph_lo = ids[i]; a.ph_hi = ids[i] + 1; hipLaunchKernelGGL(fwd, dim3(grid), dim3(NWAVES * 64), LDS_BYTES, stream, a);
#if DBG
        { DbgIn di; for (int q = 0; q < 30; ++q) di.in[q] = (const float*)d_in[q]; const int st = ids[i] - (PH_L0 + PH_LSTRIDE + PO_F0);
          if (st == 5) hipLaunchKernelGGL(dbg_moe_tok, dim3(64), dim3(256), 0, stream, di, (const float*)d_out, (unsigned char*)d_ws);
          if (st >= 1 && st <= 5) hipLaunchKernelGGL(dbg_check, dim3(1), dim3(256), 0, stream, di, (const float*)d_out, (unsigned char*)d_ws, st);
          if (ids[i] == PH_L0 + PO_WIN && DBGBR >= 0) hipLaunchKernelGGL(dbg_setgates, dim3(256), dim3(256), 0, stream, (unsigned char*)d_ws, DBGBR);
          if (ids[i] == PH_L0 + PO_WIN && DBGV1) hipLaunchKernelGGL(dbg_setv, dim3(256), dim3(256), 0, stream, (unsigned char*)d_ws);
          if (ids[i] == PH_L0 + PO_WIN) hipLaunchKernelGGL(dbg_mixer, dim3(1), dim3(256), 0, stream, di, (const float*)d_out, (unsigned char*)d_ws, 30);
          if (ids[i] == PH_L0 + PO_CMP) hipLaunchKernelGGL(dbg_mixer, dim3(1), dim3(256), 0, stream, di, (const float*)d_out, (unsigned char*)d_ws, 31);
          if (ids[i] == PH_L0 + PO_WOUT) hipLaunchKernelGGL(dbg_mixer, dim3(1), dim3(256), 0, stream, di, (const float*)d_out, (unsigned char*)d_ws, 32);
          if (ids[i] == PH_L0 + PO_ATT) { const int pt[8] = {5, 40, 100, 700, 1000, 1500, 3000, 4095};
            for (int q = 0; q < 8; ++q) hipLaunchKernelGGL(dbg_attn, dim3(1), dim3(256), 0, stream, (unsigned char*)d_ws, q & 3, q & 1, pt[q], 20 + q); } }
#endif
    }
#else
    a.ph_lo = 0; a.ph_hi = 1000;
    hipLaunchKernelGGL(fwd, dim3(grid), dim3(NWAVES * 64), LDS_BYTES, stream, a);
#endif
#if DBG
    hipLaunchKernelGGL(dbg_tail, dim3(64), dim3(256), 0, stream, (float*)d_out, (unsigned char*)d_ws);
#endif
}
```

```cpp
#include <hip/hip_runtime.h>
#include <cstdio>
#include <cstdint>
#include <cmath>

#ifndef DBG
#define DBG 0
#endif
#ifndef XMODE
#define XMODE 0
#endif
#ifndef XDIAG
#define XDIAG 0
#endif
#ifndef RES_BF16
#define RES_BF16 1
#endif
#ifndef REP_MASK
#define REP_MASK 0u
#endif
#define REPN(b) (((REP_MASK >> (b)) & 1u) ? 2 : 1)
#ifndef REP_ATT
#define REP_ATT 1
#endif
#ifndef REP_PRO
#define REP_PRO 1
#endif
#ifndef REP_CMP
#define REP_CMP 1
#endif
#ifndef MK_PER_PHASE
#define MK_PER_PHASE 0
#endif

#define LAS __attribute__((address_space(3)))
#define GAS __attribute__((address_space(1)))
typedef unsigned short bf16_t;
typedef short bf16x8 __attribute__((ext_vector_type(8)));
typedef short s16x4 __attribute__((ext_vector_type(4)));
typedef float f32x2 __attribute__((ext_vector_type(2)));
typedef float f32x4 __attribute__((ext_vector_type(4)));
typedef float f32x16 __attribute__((ext_vector_type(16)));
typedef unsigned u32x4 __attribute__((ext_vector_type(4)));
typedef unsigned u32x2 __attribute__((ext_vector_type(2)));

constexpr int NB = 4, SEQ = 4096, DM = 1024, T = NB * SEQ, NL = 2;
constexpr int ZW = 2048;
constexpr int DFF = 2816, DFFE = 3584, NE = 8;
constexpr int MAXT = 136, HALFT = 64, CH1T = MAXT - HALFT;
constexpr float EPS = 1e-6f;
constexpr float C2 = 0.125f * 1.4426950408889634f;
constexpr float CX = 0.0625f * 1.4426950408889634f;

constexpr size_t MiB = 1u << 20;
constexpr size_t WS_CTL = 0, CTL_ZERO_BYTES = 1 * MiB;
constexpr size_t WS_ROPE = 1 * MiB;
constexpr size_t WS_BIAS = 1 * MiB + 512 * 1024;
constexpr size_t WS_ROUTE = 2 * MiB;
constexpr size_t WS_CNTG = 2 * MiB + 512 * 1024;
constexpr size_t WS_TILE = 2 * MiB + 640 * 1024;
constexpr size_t WS_SLOT = 1 * MiB + 512 * 1024;
constexpr size_t WS_YB = 3 * MiB;
constexpr size_t WS_GATES = 4 * MiB;
constexpr size_t WS_KCMP = 6 * MiB;
constexpr size_t WS_HID = 7 * MiB;
constexpr size_t WS_MN = 9 * MiB;
constexpr size_t WS_KX = 13 * MiB;
constexpr size_t WS_VXT = 17 * MiB;
constexpr size_t WS_WIN = 21 * MiB;
constexpr size_t WS_WOUT = 29 * MiB;
constexpr size_t WS_WQ = 33 * MiB, WS_WO = 37 * MiB, WS_WK = 41 * MiB, WS_WV = 45 * MiB;
constexpr size_t WS_CW1 = 49 * MiB;
constexpr size_t WS_CW2 = 53 * MiB;
constexpr size_t WS_FGU = 54 * MiB;
constexpr size_t WS_FD = 65 * MiB;
constexpr size_t WS_MGU = 71 * MiB;
constexpr size_t WS_MD = 183 * MiB;
constexpr size_t WS_HB = 239 * MiB;
constexpr size_t WS_R = 271 * MiB;
constexpr size_t WS_QRAW = WS_R, WS_QROT = WS_R + 16 * MiB, WS_KV = WS_R + 32 * MiB  , WS_U = WS_R + 57 * MiB, WS_AB = WS_R + 73 * MiB;
constexpr size_t WS_QX = WS_R, WS_PB = WS_R + 32 * MiB, WS_OX = WS_R + 73 * MiB;
constexpr size_t WS_ACT0 = WS_R;
constexpr size_t WS_HP = WS_HB;
constexpr size_t WS_ACTC = 307 * MiB;
constexpr size_t WS_END = 433 * MiB;
constexpr size_t WS_XB2 = 433 * MiB;
constexpr size_t WS_END2 = 465 * MiB;
constexpr size_t KVSZ = (size_t)NB * 2 * SEQ * 64;
static_assert(WS_HP + (size_t)MAXT * 256 * 1024 * 2 <= WS_ACTC && WS_ACTC + (size_t)CH1T * 256 * DFFE * 2 <= WS_END && WS_YB + (size_t)MAXT * 256 * 1024 * 2 <= WS_MGU && WS_SLOT + (size_t)T * 16 <= 2 * MiB, "ws map");
static_assert(WS_MGU + (size_t)NE * 7168 * 1024 * 2 <= WS_MD && WS_MD + (size_t)NE * 1024 * DFFE * 2 <= WS_HB, "ws map");

constexpr int CW_TMO = 0, CW_BAR = 4096, CW_BIAS = 8192, CW_SS = 32768;
typedef unsigned long long ssq_t;
#define SSP(i) ((ssq_t*)((unsigned*)(ws + WS_CTL) + CW_SS) + (size_t)(i) * T)
__device__ __forceinline__ float ss_rs(const ssq_t* ss, int row) { return 1.0f / sqrtf((float)((double)ss[row] * (1.0 / 4294967296.0)) * (1.f / DM) + EPS); }
__device__ __forceinline__ ssq_t ss_fix(float v) { return (ssq_t)((double)v * 4294967296.0); }

constexpr int RING_BYTES = 131072;
constexpr int XTRA_OFF = RING_BYTES, XTRA_BYTES = 24576;
constexpr int LDSCTL_OFF = XTRA_OFF + XTRA_BYTES, LDS_BYTES = LDSCTL_OFF + 512;
constexpr int NWAVES = 8;

#define LDS_WAIT() asm volatile("s_waitcnt lgkmcnt(0)" ::: "memory")
#define VM_WAIT() asm volatile("s_waitcnt vmcnt(0)" ::: "memory")
#define RLX_AGENT __ATOMIC_RELAXED, __HIP_MEMORY_SCOPE_AGENT

__device__ __forceinline__ unsigned f2bf(float f) { unsigned u = __builtin_bit_cast(unsigned, f); return (u + 0x7fffu + ((u >> 16) & 1u)) >> 16; }
__device__ __forceinline__ unsigned pk2(float lo, float hi) { return f2bf(lo) | (f2bf(hi) << 16); }
__device__ __forceinline__ float bf2f(unsigned short h) { return __builtin_bit_cast(float, (unsigned)h << 16); }
__device__ __forceinline__ unsigned cvt_pk_bf16(float lo, float hi) { unsigned r; asm volatile("v_cvt_pk_bf16_f32 %0, %1, %2" : "=v"(r) : "v"(lo), "v"(hi)); return r; }
template <int M> __device__ __forceinline__ float xor_get(float v) {
    static_assert(M > 0 && M < 32, "xor_get: within 32 lanes");
    return __builtin_bit_cast(float, __builtin_amdgcn_ds_swizzle(__builtin_bit_cast(int, v), (M << 10) | 0x1f));
}
__device__ __forceinline__ void half_swap(float v, float& lo, float& hi) {
    unsigned a = __builtin_bit_cast(unsigned, v), b = a;
    asm volatile("s_nop 1\n\tv_permlane32_swap_b32 %0, %1\n\ts_nop 1" : "+v"(a), "+v"(b));
    lo = __builtin_bit_cast(float, a); hi = __builtin_bit_cast(float, b);
}
__device__ __forceinline__ float xor32_sum(float v) { float lo, hi; half_swap(v, lo, hi); return lo + hi; }
__device__ __forceinline__ float xor32_max(float v) { float lo, hi; half_swap(v, lo, hi); return fmaxf(lo, hi); }
__device__ __forceinline__ float wave_sum(float v) {
    v += xor_get<1>(v); v += xor_get<2>(v); v += xor_get<4>(v); v += xor_get<8>(v); v += xor_get<16>(v);
    return xor32_sum(v);
}
__device__ __forceinline__ float fast_exp2(float x) { return __builtin_amdgcn_exp2f(x); }

namespace pg8 {
constexpr int BM = 256, BK = 64, HALF = 128, HTB = HALF * BK * 2, NXCD = 8, WGM = 8;
__host__ __device__ __forceinline__ int lds_byte(int r, int c) { const int st = (r >> 4) * 2 + (c >> 5), rr = r & 15, cc = c & 31, ob = rr * 64 + cc * 2; return st * 1024 + (ob ^ (((ob >> 9) & 1) << 5)); }
__host__ __device__ __forceinline__ void stage_rc(int b, int& R, int& C) { const int st = b / 1024, sb = b % 1024, swz = sb ^ (((sb >> 9) & 1) << 5); R = (st >> 1) * 16 + swz / 64; C = (st & 1) * 32 + (swz % 64) / 2; }
__host__ __device__ __forceinline__ int perm32(int rho) { const int n = rho >> 4, i = rho & 15; return 8 * (i >> 2) + 4 * n + (i & 3); }

struct Unit { int pm, pn; long aoff, boff, coff; int ord; };
struct Gemm { const char* A; const char* Bt; int K, lda, ldb; };

struct TileOrder {
    int nM, nN, nwg, G, c;
    __device__ __forceinline__ void init(int nM_, int nN_, int G_, int c_) { nM = nM_; nN = nN_; nwg = nM * nN; G = G_; c = c_; }
    __device__ __forceinline__ bool tile(int i, int& pm, int& pn) const {
        const long L = (long)i * G + c; if (L >= nwg) return false;
        int wgid = (int)L; { const int q = nwg / NXCD, r = nwg % NXCD, xcd = wgid % NXCD, off = wgid / NXCD; wgid = (xcd < r ? xcd * (q + 1) : r * (q + 1) + (xcd - r) * q) + off; }
        const int nig = WGM * nN, gid = wgid / nig, fm = gid * WGM, gsz = (nM - fm) < WGM ? (nM - fm) : WGM;
        pm = fm + ((wgid % nig) % gsz); pn = (wgid % nig) / gsz; return true;
    }
};

template <class Epi, class Sched, bool ALIGN_EPI, bool SP2>
__device__ __forceinline__ void gemm_phase(LAS unsigned char* lds, const Gemm g, const Sched S, const Epi E, int tid_in) {
    int tid_ = tid_in; asm volatile("" : "+v"(tid_));
    const int tid = tid_, wid = __builtin_amdgcn_readfirstlane(tid >> 6), lane = tid & 63, wr = wid >> 2, wc = wid & 3, fr = lane & 15, fq = lane >> 4;
    const int K = g.K, nt = K / BK;
    unsigned voffA[2], voffB[2];
#pragma unroll
    for (int i = 0; i < 2; ++i) { int R, C; stage_rc(tid * 16 + i * 8192, R, C); const int Rb = Epi::PERM ? ((R & ~31) + perm32(R & 31)) : R;
        voffA[i] = (unsigned)(R * g.lda + C) * 2u; voffB[i] = (unsigned)(Rb * g.ldb + C) * 2u; }
    const size_t kstep = (size_t)(BK * 2);
    const size_t hstepA = (size_t)HALF * g.lda * 2, hstepB = (size_t)HALF * g.ldb * 2;
    const unsigned ldsw = (unsigned)wid * 1024u;
    const int aoff = lds_byte(wr * 64 + fr, fq * 8), boff = lds_byte(wc * 32 + fr, fq * 8);
#define PG8_SA(b, h) (((b) * 2 + (h)) * HTB)
#define PG8_SB(b, h) ((4 + (b) * 2 + (h)) * HTB)
#define PG8_STAGE(bufoff, gbase, voff) do { _Pragma("unroll") for (int _i = 0; _i < 2; ++_i) \
        __builtin_amdgcn_global_load_lds((const unsigned*)((const char*)(gbase) + (voff)[_i]), (LAS unsigned*)(lds + (bufoff) + ldsw + _i * 8192), 16, 0, 0); } while (0)
#define PG8_LDA(dst, b, h) do { _Pragma("unroll") for (int m = 0; m < 4; ++m) _Pragma("unroll") for (int k = 0; k < 2; ++k) dst[m][k] = *(const LAS bf16x8*)(lds + PG8_SA(b, h) + aoff + m * 2048 + k * 1024); } while (0)
#define PG8_LDB(dst, b, h) do { _Pragma("unroll") for (int n = 0; n < 2; ++n) _Pragma("unroll") for (int k = 0; k < 2; ++k) dst[n][k] = *(const LAS bf16x8*)(lds + PG8_SB(b, h) + boff + n * 2048 + k * 1024); } while (0)
#define PG8_MMA(ai, bj, At, Bt) do { __builtin_amdgcn_s_setprio(1); _Pragma("unroll") for (int m = 0; m < 4; ++m) _Pragma("unroll") for (int n = 0; n < 2; ++n) _Pragma("unroll") for (int k = 0; k < 2; ++k) \
        acc[ai][bj][m][n] = __builtin_amdgcn_mfma_f32_16x16x32_bf16(Bt[n][k], At[m][k], acc[ai][bj][m][n], 0, 0, 0); __builtin_amdgcn_s_setprio(0); } while (0)
#define PG8_WAIT_V(n) asm volatile("s_waitcnt vmcnt(" #n ")" ::: "memory")
#define PG8_WAIT_L(n) asm volatile("s_waitcnt lgkmcnt(" #n ")" ::: "memory")
#define PG8_BAR __builtin_amdgcn_s_barrier()
#define PG8_SCHED __builtin_amdgcn_sched_barrier(0)
    Unit cur, nxt; int ui = 0;
    if (!S.next(0, cur)) return;
    f32x4 acc[2][2][4][2];
    float zero_ = 0.f; asm volatile("" : "+v"(zero_));
#pragma unroll
    for (int a = 0; a < 2; ++a)
#pragma unroll
        for (int b = 0; b < 2; ++b)
#pragma unroll
            for (int m = 0; m < 4; ++m)
#pragma unroll
                for (int n = 0; n < 2; ++n) acc[a][b][m][n] = (f32x4){zero_, zero_, zero_, zero_};
    bf16x8 At[4][2], B0[2][2], B1[2][2];
    const char* cA = g.A + cur.aoff; const char* cB = g.Bt + cur.boff;
    if constexpr (SP2) {
        PG8_STAGE(PG8_SB(0, 0), cB, voffB); PG8_STAGE(PG8_SB(0, 1), cB + hstepB, voffB); PG8_STAGE(PG8_SA(0, 0), cA, voffA); PG8_STAGE(PG8_SA(0, 1), cA + hstepA, voffA);
        if (wr == 1) PG8_BAR;
        PG8_WAIT_V(2); PG8_BAR;
        PG8_STAGE(PG8_SB(1, 0), cB + kstep, voffB); PG8_STAGE(PG8_SA(1, 0), cA + kstep, voffA); PG8_STAGE(PG8_SB(1, 1), cB + hstepB + kstep, voffB);
        PG8_WAIT_V(6); PG8_BAR;
    } else {
        PG8_STAGE(PG8_SB(0, 0), cB, voffB); PG8_STAGE(PG8_SA(0, 0), cA, voffA); PG8_STAGE(PG8_SB(0, 1), cB + hstepB, voffB); PG8_STAGE(PG8_SA(0, 1), cA + hstepA, voffA);
        if (wr == 1) PG8_BAR;
        PG8_WAIT_V(4); PG8_BAR;
        PG8_STAGE(PG8_SB(1, 0), cB + kstep, voffB); PG8_STAGE(PG8_SA(1, 0), cA + kstep, voffA); PG8_STAGE(PG8_SB(1, 1), cB + hstepB + kstep, voffB);
        PG8_WAIT_V(6); PG8_BAR;
    }
    for (;;) {
        const bool has_next = S.next(ui + 1, nxt);
        const char* nA = has_next ? g.A + nxt.aoff : cA; const char* nB = has_next ? g.Bt + nxt.boff : cB;
#pragma unroll 1
        for (int t = 0; t < nt; t += 2) {
            const bool last = (t == nt - 2);
            const char* a1 = cA + (size_t)(t + 1) * kstep;
            const char* a2 = last ? nA : cA + (size_t)(t + 2) * kstep; const char* b2 = last ? nB : cB + (size_t)(t + 2) * kstep;
            const char* a3 = a2 + kstep; const char* b3 = b2 + kstep;
            if constexpr (SP2) {
            PG8_LDB(B0, 0, 0); PG8_LDB(B1, 0, 1); PG8_SCHED; PG8_LDA(At, 0, 0); PG8_STAGE(PG8_SA(1, 1), a1 + hstepA, voffA);
            PG8_WAIT_V(8); PG8_WAIT_L(0); PG8_BAR; PG8_MMA(0, 0, At, B0); PG8_MMA(0, 1, At, B1); PG8_BAR; PG8_SCHED;
            PG8_LDA(At, 0, 1); PG8_STAGE(PG8_SB(0, 0), b2, voffB); PG8_STAGE(PG8_SB(0, 1), b2 + hstepB, voffB); PG8_STAGE(PG8_SA(0, 0), a2, voffA);
            PG8_WAIT_V(8); PG8_WAIT_L(0); PG8_BAR; PG8_MMA(1, 0, At, B0); PG8_MMA(1, 1, At, B1); PG8_BAR; PG8_SCHED;
            PG8_LDB(B0, 1, 0); PG8_LDB(B1, 1, 1); PG8_SCHED; PG8_LDA(At, 1, 0); PG8_STAGE(PG8_SA(0, 1), a2 + hstepA, voffA);
            PG8_WAIT_V(8); PG8_WAIT_L(0); PG8_BAR; PG8_MMA(0, 0, At, B0); PG8_MMA(0, 1, At, B1); PG8_BAR; PG8_SCHED;
            PG8_LDA(At, 1, 1); PG8_STAGE(PG8_SB(1, 0), b3, voffB); PG8_STAGE(PG8_SB(1, 1), b3 + hstepB, voffB); PG8_STAGE(PG8_SA(1, 0), a3, voffA);
            PG8_WAIT_V(8); PG8_WAIT_L(0); PG8_BAR; PG8_MMA(1, 0, At, B0); PG8_MMA(1, 1, At, B1); PG8_BAR; PG8_SCHED;
            } else {
            PG8_LDB(B0, 0, 0); PG8_SCHED; PG8_LDA(At, 0, 0); PG8_STAGE(PG8_SA(1, 1), a1 + hstepA, voffA);
            PG8_WAIT_L(8); PG8_BAR; PG8_WAIT_L(0); PG8_MMA(0, 0, At, B0); PG8_BAR; PG8_SCHED;
            PG8_LDB(B1, 0, 1); PG8_STAGE(PG8_SB(0, 0), b2, voffB);
            PG8_BAR; PG8_WAIT_L(0); PG8_MMA(0, 1, At, B1); PG8_BAR;
            PG8_LDA(At, 0, 1); PG8_STAGE(PG8_SA(0, 0), a2, voffA);
            PG8_BAR; PG8_WAIT_L(0); PG8_MMA(1, 0, At, B0); PG8_BAR; PG8_SCHED;
            PG8_STAGE(PG8_SB(0, 1), b2 + hstepB, voffB);
            PG8_WAIT_V(6); PG8_BAR; PG8_MMA(1, 1, At, B1); PG8_BAR;
            PG8_LDB(B0, 1, 0); PG8_SCHED; PG8_LDA(At, 1, 0); PG8_STAGE(PG8_SA(0, 1), a2 + hstepA, voffA);
            PG8_WAIT_L(8); PG8_BAR; PG8_WAIT_L(0); PG8_MMA(0, 0, At, B0); PG8_BAR; PG8_SCHED;
            PG8_LDB(B1, 1, 1); PG8_STAGE(PG8_SB(1, 0), b3, voffB);
            PG8_BAR; PG8_WAIT_L(0); PG8_MMA(0, 1, At, B1); PG8_BAR;
            PG8_LDA(At, 1, 1); PG8_STAGE(PG8_SA(1, 0), a3, voffA);
            PG8_BAR; PG8_WAIT_L(0); PG8_MMA(1, 0, At, B0); PG8_BAR; PG8_SCHED;
            PG8_STAGE(PG8_SB(1, 1), b3 + hstepB, voffB);
            PG8_WAIT_V(6); PG8_BAR; PG8_MMA(1, 1, At, B1); PG8_BAR;
            }
        }
        if constexpr (ALIGN_EPI) { if (wr == 0) PG8_BAR; }
        if constexpr (!Epi::AFTER_DRAIN) { E(acc, cur, wr, wc, fr, fq); }
        if (!has_next) break;
#pragma unroll
        for (int a = 0; a < 2; ++a)
#pragma unroll
            for (int b = 0; b < 2; ++b)
#pragma unroll
                for (int m = 0; m < 4; ++m)
#pragma unroll
                    for (int n = 0; n < 2; ++n) acc[a][b][m][n] = (f32x4){zero_, zero_, zero_, zero_};
        cur = nxt; cA = nA; cB = nB; ++ui;
        if constexpr (ALIGN_EPI) { if (wr == 1) PG8_BAR; }
    }
    PG8_WAIT_V(0);
    if constexpr (!ALIGN_EPI) { if (wr == 0) PG8_BAR; }
    PG8_BAR;
    if constexpr (Epi::AFTER_DRAIN) { E.fused(acc, cur, wr, wc, fr, fq, lds, wid, lane); }
#undef PG8_SA
#undef PG8_SB
#undef PG8_STAGE
#undef PG8_LDA
#undef PG8_LDB
#undef PG8_MMA
#undef PG8_WAIT_V
#undef PG8_WAIT_L
#undef PG8_BAR
#undef PG8_SCHED
}
}
using pg8::Unit;
typedef const f32x4 (&AccRef)[2][2][4][2];

struct SchedPlain {
    pg8::TileOrder o; long astep, bstep;
    __device__ void init(int nM, int nN, int lda, int ldb, int G, int c) { o.init(nM, nN, G, c); astep = (long)256 * lda * 2; bstep = (long)256 * ldb * 2; }
    __device__ bool next(int i, Unit& u) const { if (!o.tile(i, u.pm, u.pn)) return false; u.aoff = u.pm * astep; u.boff = u.pn * bstep; u.coff = 0; u.ord = i; return true; }
};
struct SchedOne { Unit u; __device__ bool next(int i, Unit& out) const { if (i > 0) return false; out = u; return true; } };
struct SchedKV {
    int G, c;
    __device__ bool next(int i, Unit& u) const {
        const int L = i * G + c; if (L >= 64 || (G == 1 && i > 0)) return false;
        const int job = L >> 4, l = job >> 1, isv = job & 1; u.pm = (L >> 2) & 3; u.pn = L & 3;
        const long mn = (long)WS_MN + (long)l * 2 * MiB, wk = (long)WS_WK + (long)l * 2 * MiB, wv = (long)WS_WV + (long)l * 2 * MiB;
        const long ts = 256L * 1024 * 2;
        if (!isv) { u.aoff = mn + u.pm * ts; u.boff = wk + u.pn * ts; u.coff = ((long)WS_KX + (long)l * 2 * MiB) / 2; }
        else { u.aoff = mn + u.pm * ts; u.boff = wv + u.pn * ts; u.coff = ((long)WS_VXT + (long)l * 2 * MiB) / 2; }
        return true;
    }
};
template <int MODE> struct SchedX {
    pg8::TileOrder o;
    __device__ void init(int G, int c) { o.init(64, 4, G, c); }
    __device__ bool next(int i, Unit& u) const {
        if (!o.tile(i, u.pm, u.pn)) return false;
        const int b = u.pm >> 4, h = u.pn;
        u.aoff = ((long)u.pm * 256 * 1024 + h * 256) * 2;
        u.boff = MODE == 0 ? ((long)b * 256 * 1024 + h * 256) * 2 : ((long)h * 256 * 1024 + b * 256) * 2;
        u.coff = 0; return true;
    }
};
struct SchedMoe {
    pg8::TileOrder o; const unsigned* texp; int t0, nn; long astep, bstep, estep, cstep, khb, khc;
    __device__ bool next(int i, Unit& u) const {
        int pm, pn; if (!o.tile(i, pm, pn)) return false;
        const int rt = t0 + pm; const int e = (int)texp[rt]; const int kh = pn >= nn ? 1 : 0; pn -= kh * nn;
        u.pm = rt; u.pn = pn; u.aoff = pm * astep + kh * khb; u.boff = e * estep + pn * bstep + kh * khb; u.coff = -(long)t0 * cstep + kh * khc; return true;
    }
};

struct EpiPlain {
    static constexpr bool PERM = true, AFTER_DRAIN = false;
    bf16_t* O; int ldc; const ssq_t* ss;
    __device__ __forceinline__ void operator()(AccRef acc, const Unit& u, int wr, int wc, int fr, int fq) const {
        const int row0 = u.pm * 256 + wr * 64 + fr;
        bf16_t* base = O + u.coff + (size_t)row0 * ldc + u.pn * 256 + wc * 32 + 8 * fq;
#pragma unroll
        for (int ai = 0; ai < 2; ++ai)
#pragma unroll
            for (int m = 0; m < 4; ++m) { const float rs = ss ? ss_rs(ss, row0 + ai * 128 + m * 16) : 1.f;
#pragma unroll
                for (int bj = 0; bj < 2; ++bj) { const f32x4 v0 = acc[ai][bj][m][0] * rs, v1 = acc[ai][bj][m][1] * rs;
                    u32x4 w; w.x = cvt_pk_bf16(v0[0], v0[1]); w.y = cvt_pk_bf16(v0[2], v0[3]); w.z = cvt_pk_bf16(v1[0], v1[1]); w.w = cvt_pk_bf16(v1[2], v1[3]);
                    *(u32x4*)(base + (size_t)(ai * 128 + m * 16) * ldc + bj * 128) = w; } }
    }
};
#ifndef ABL
#define ABL 0
#endif
template <bool SRC_F32> struct EpiResB {
    static constexpr bool PERM = true, AFTER_DRAIN = false;
    const void* src; bf16_t* xo; ssq_t* ss;
    __device__ __forceinline__ void operator()(AccRef acc, const Unit& u, int wr, int wc, int fr, int fq) const {
        const int row0 = u.pm * 256 + wr * 64 + fr;
        const size_t off0 = (size_t)row0 * DM + u.pn * 256 + wc * 32 + 8 * fq;
#pragma unroll
        for (int ai = 0; ai < 2; ++ai)
#pragma unroll
            for (int m = 0; m < 4; ++m) { float part = 0.f;
#pragma unroll
                for (int bj = 0; bj < 2; ++bj) { const size_t off = off0 + (size_t)(ai * 128 + m * 16) * DM + bj * 128;
                    f32x4 s0, s1;
                    if (SRC_F32) { s0 = *(const f32x4*)((const float*)src + off); s1 = *(const f32x4*)((const float*)src + off + 4); }
                    else { const u32x4 w = *(const u32x4*)((const bf16_t*)src + off);
                        s0 = (f32x4){__builtin_bit_cast(float, w.x << 16), __builtin_bit_cast(float, w.x & 0xffff0000u), __builtin_bit_cast(float, w.y << 16), __builtin_bit_cast(float, w.y & 0xffff0000u)};
                        s1 = (f32x4){__builtin_bit_cast(float, w.z << 16), __builtin_bit_cast(float, w.z & 0xffff0000u), __builtin_bit_cast(float, w.w << 16), __builtin_bit_cast(float, w.w & 0xffff0000u)}; }
                    s0 = s0 + acc[ai][bj][m][0]; s1 = s1 + acc[ai][bj][m][1];
                    u32x4 w; w.x = cvt_pk_bf16(s0[0], s0[1]); w.y = cvt_pk_bf16(s0[2], s0[3]); w.z = cvt_pk_bf16(s1[0], s1[1]); w.w = cvt_pk_bf16(s1[2], s1[3]); *(u32x4*)(xo + off) = w;
                    part += ((s0[0] * s0[0] + s0[1] * s0[1]) + (s0[2] * s0[2] + s0[3] * s0[3])) + ((s1[0] * s1[0] + s1[1] * s1[1]) + (s1[2] * s1[2] + s1[3] * s1[3])); }
                if (ss) { part += xor_get<16>(part); part = xor32_sum(part); if (fq == 0) atomicAdd(ss + row0 + ai * 128 + m * 16, ss_fix(part)); } }
    }
};
struct EpiRes {
    static constexpr bool PERM = true, AFTER_DRAIN = false;
    const float* src; float* out; bf16_t* xb; ssq_t* ss;
    __device__ __forceinline__ void operator()(AccRef acc, const Unit& u, int wr, int wc, int fr, int fq) const {
        const int row0 = u.pm * 256 + wr * 64 + fr;
        const size_t off0 = (size_t)row0 * DM + u.pn * 256 + wc * 32 + 8 * fq;
#pragma unroll
        for (int ai = 0; ai < 2; ++ai)
#pragma unroll
            for (int m = 0; m < 4; ++m) { float part = 0.f;
#pragma unroll
                for (int bj = 0; bj < 2; ++bj) { const size_t off = off0 + (size_t)(ai * 128 + m * 16) * DM + bj * 128;
                    const f32x4 s0 = *(const f32x4*)(src + off) + acc[ai][bj][m][0], s1 = *(const f32x4*)(src + off + 4) + acc[ai][bj][m][1];
                    *(f32x4*)(out + off) = s0; *(f32x4*)(out + off + 4) = s1;
                    if (xb) { u32x4 w; w.x = cvt_pk_bf16(s0[0], s0[1]); w.y = cvt_pk_bf16(s0[2], s0[3]); w.z = cvt_pk_bf16(s1[0], s1[1]); w.w = cvt_pk_bf16(s1[2], s1[3]); *(u32x4*)(xb + off) = w;
                        part += ((s0[0] * s0[0] + s0[1] * s0[1]) + (s0[2] * s0[2] + s0[3] * s0[3])) + ((s1[0] * s1[0] + s1[1] * s1[1]) + (s1[2] * s1[2] + s1[3] * s1[3])); } }
                if (xb) { part += xor_get<16>(part); part = xor32_sum(part); if (fq == 0) atomicAdd(ss + row0 + ai * 128 + m * 16, ss_fix(part)); } }
    }
};
__device__ __forceinline__ float gelu_tanh(float x) {
    const float y = 0.7978845608028654f * (x + 0.044715f * x * x * x);
    const float e = fast_exp2(y * 2.8853900817779268f);
    const float th = 1.f - 2.f * __builtin_amdgcn_rcpf(e + 1.f);
    return 0.5f * x * (1.f + th);
}
struct EpiHid {
    static constexpr bool PERM = true, AFTER_DRAIN = false;
    bf16_t* O; const long long* bias;
    __device__ __forceinline__ void operator()(AccRef acc, const Unit& u, int wr, int wc, int fr, int fq) const {
        bf16_t* base = O + (size_t)(u.pm * 256 + wr * 64 + fr) * 256 + wc * 32 + 8 * fq;
#pragma unroll
        for (int bj = 0; bj < 2; ++bj) { const long long* bp = bias + bj * 128 + wc * 32 + 8 * fq; f32x4 b0, b1;
#pragma unroll
            for (int j = 0; j < 4; ++j) { b0[j] = (float)((double)bp[j] * (1.0 / 1099511627776.0)); b1[j] = (float)((double)bp[4 + j] * (1.0 / 1099511627776.0)); }
#pragma unroll
            for (int ai = 0; ai < 2; ++ai)
#pragma unroll
                for (int m = 0; m < 4; ++m) { const f32x4 v0 = acc[ai][bj][m][0] + b0, v1 = acc[ai][bj][m][1] + b1;
                    u32x4 w; w.x = cvt_pk_bf16(gelu_tanh(v0[0]), gelu_tanh(v0[1])); w.y = cvt_pk_bf16(gelu_tanh(v0[2]), gelu_tanh(v0[3]));
                    w.z = cvt_pk_bf16(gelu_tanh(v1[0]), gelu_tanh(v1[1])); w.w = cvt_pk_bf16(gelu_tanh(v1[2]), gelu_tanh(v1[3]));
                    *(u32x4*)(base + (size_t)(ai * 128 + m * 16) * 256 + bj * 128) = w; } }
    }
};
struct EpiCmp2 {
    static constexpr bool PERM = true, AFTER_DRAIN = false;
    bf16_t* O;
    __device__ __forceinline__ void operator()(AccRef acc, const Unit& u, int wr, int wc, int fr, int fq) const {
        if (wc >= 2) return;
#pragma unroll
        for (int ai = 0; ai < 2; ++ai)
#pragma unroll
            for (int m = 0; m < 4; ++m) { const int row = u.pm * 256 + ai * 128 + wr * 64 + m * 16 + fr; const f32x4 v0 = acc[ai][0][m][0], v1 = acc[ai][0][m][1];
                u32x4 w; w.x = cvt_pk_bf16(v0[0], v0[1]); w.y = cvt_pk_bf16(v0[2], v0[3]); w.z = cvt_pk_bf16(v1[0], v1[1]); w.w = cvt_pk_bf16(v1[2], v1[3]);
                if ((row & 255) == 255) w = (u32x4){0u, 0u, 0u, 0u};
                *(u32x4*)(O + (size_t)row * 64 + wc * 32 + 8 * fq) = w; }
    }
};
__device__ __forceinline__ float silu_mul(float g, float u) { return g * __builtin_amdgcn_rcpf(1.f + fast_exp2(-1.4426950408889634f * g)) * u; }
template <int RS>
struct EpiSwiglu {
    static constexpr bool PERM = true, AFTER_DRAIN = false;
    bf16_t* O; int ldc; const LAS float* rsl; const ssq_t* ss;
    __device__ __forceinline__ void operator()(AccRef acc, const Unit& u, int wr, int wc, int fr, int fq) const {
        const int row0 = u.pm * 256 + wr * 64 + fr;
        bf16_t* base = O + u.coff + (size_t)row0 * ldc + u.pn * 128 + wc * 32 + 8 * fq;
#pragma unroll
        for (int ai = 0; ai < 2; ++ai)
#pragma unroll
            for (int m = 0; m < 4; ++m) { f32x4 g0 = acc[ai][0][m][0], g1 = acc[ai][0][m][1], u0 = acc[ai][1][m][0], u1 = acc[ai][1][m][1];
                if constexpr (RS == 1) { const float rs = rsl[256 * u.ord + wr * 64 + fr + ai * 128 + m * 16]; g0 *= rs; g1 *= rs; u0 *= rs; u1 *= rs; }
                if constexpr (RS == 2) { const float rs = ss_rs(ss, row0 + ai * 128 + m * 16); g0 *= rs; g1 *= rs; u0 *= rs; u1 *= rs; }
                u32x4 w; w.x = cvt_pk_bf16(silu_mul(g0[0], u0[0]), silu_mul(g0[1], u0[1])); w.y = cvt_pk_bf16(silu_mul(g0[2], u0[2]), silu_mul(g0[3], u0[3]));
                w.z = cvt_pk_bf16(silu_mul(g1[0], u1[0]), silu_mul(g1[1], u1[1])); w.w = cvt_pk_bf16(silu_mul(g1[2], u1[2]), silu_mul(g1[3], u1[3]));
                *(u32x4*)(base + (size_t)(ai * 128 + m * 16) * ldc) = w; }
    }
};
struct EpiWin {
    static constexpr bool PERM = true, AFTER_DRAIN = false;
    bf16_t *qraw, *qrot, *kv, *ub; float* gates; const float* rope; const ssq_t* ss;
    __device__ __forceinline__ void operator()(AccRef acc, const Unit& u, int wr, int wc, int fr, int fq) const {
        const int pn = u.pn;
#pragma unroll
        for (int ai = 0; ai < 2; ++ai)
#pragma unroll
            for (int m = 0; m < 4; ++m) {
                const int row = u.pm * 256 + ai * 128 + wr * 64 + m * 16 + fr, b = row >> 12, t = row & 4095;
                const float rs = ss_rs(ss, row);
#pragma unroll
                for (int bj = 0; bj < 2; ++bj) {
                    float v[8];
#pragma unroll
                    for (int j = 0; j < 4; ++j) { v[j] = acc[ai][bj][m][0][j] * rs; v[4 + j] = acc[ai][bj][m][1][j] * rs; }
                    if (pn < 2) {
                        const size_t idx = ((size_t)(b * 2 + pn) * SEQ + t) * 256 + bj * 128 + wc * 32 + 8 * fq;
                        u32x4 w; w.x = cvt_pk_bf16(v[0] * C2, v[1] * C2); w.y = cvt_pk_bf16(v[2] * C2, v[3] * C2); w.z = cvt_pk_bf16(v[4] * C2, v[5] * C2); w.w = cvt_pk_bf16(v[6] * C2, v[7] * C2);
                        *(u32x4*)(qraw + idx) = w;
                        if ((wc & 1) == 0) {
                            float p[8];
#pragma unroll
                            for (int j = 0; j < 8; ++j) p[j] = xor_get<16>(v[j]);
                            if (fq < 2) { const float* rp = rope + (size_t)t * 16;
#pragma unroll
                                for (int j = 0; j < 8; ++j) { const float cs = rp[2 * j], sn = rp[2 * j + 1]; v[j] = fq == 0 ? v[j] * cs - p[j] * sn : v[j] * cs + p[j] * sn; } }
                            w.x = cvt_pk_bf16(v[0] * C2, v[1] * C2); w.y = cvt_pk_bf16(v[2] * C2, v[3] * C2); w.z = cvt_pk_bf16(v[4] * C2, v[5] * C2); w.w = cvt_pk_bf16(v[6] * C2, v[7] * C2);
                        }
                        *(u32x4*)(qrot + idx) = w;
                    } else if (pn < 5) {
                        const int i = 2 * (pn - 2) + bj, g = wc >> 1;
                        if (bj == 0 && pn >= 3 && (wc & 1) == 0) {
                            float p[8];
#pragma unroll
                            for (int j = 0; j < 8; ++j) p[j] = xor_get<16>(v[j]);
                            if (fq < 2) { const float* rp = rope + (size_t)t * 16;
#pragma unroll
                                for (int j = 0; j < 8; ++j) { const float cs = rp[2 * j], sn = rp[2 * j + 1]; v[j] = fq == 0 ? v[j] * cs - p[j] * sn : v[j] * cs + p[j] * sn; } }
                        }
                        u32x4 w; w.x = cvt_pk_bf16(v[0], v[1]); w.y = cvt_pk_bf16(v[2], v[3]); w.z = cvt_pk_bf16(v[4], v[5]); w.w = cvt_pk_bf16(v[6], v[7]);
                        *(u32x4*)(kv + (size_t)i * KVSZ + ((size_t)(b * 2 + g) * SEQ + t) * 64 + (wc & 1) * 32 + 8 * fq) = w;
                    } else if (pn < 7) {
                        u32x4 w; w.x = cvt_pk_bf16(v[0], v[1]); w.y = cvt_pk_bf16(v[2], v[3]); w.z = cvt_pk_bf16(v[4], v[5]); w.w = cvt_pk_bf16(v[6], v[7]);
                        *(u32x4*)(ub + (size_t)row * 512 + (pn - 5) * 256 + bj * 128 + wc * 32 + 8 * fq) = w;
                    } else {
                        if (bj == 0 && wc == 0 && fq < 3) { float* gp = gates + (size_t)row * 24 + 8 * fq;
#pragma unroll
                            for (int j = 0; j < 8; ++j) gp[j] = __builtin_amdgcn_rcpf(1.f + fast_exp2(-1.4426950408889634f * v[j])); }
                    }
                }
            }
    }
};
struct EpiSoftmax {
    static constexpr bool PERM = true, AFTER_DRAIN = true;
    bf16_t* P;
    __device__ __forceinline__ void operator()(AccRef, const Unit&, int, int, int, int) const {}
    __device__ __forceinline__ void fused(f32x4 (&acc)[2][2][4][2], const Unit& u, int wr, int wc, int fr, int fq, LAS unsigned char* lds, int wid, int lane) const {
        LAS float* RM = (LAS float*)lds;
        LAS float* RS = (LAS float*)(lds + 4096);
        float mx[2][4];
#pragma unroll
        for (int ai = 0; ai < 2; ++ai)
#pragma unroll
            for (int m = 0; m < 4; ++m) { float a = -INFINITY;
#pragma unroll
                for (int bj = 0; bj < 2; ++bj)
#pragma unroll
                    for (int n = 0; n < 2; ++n)
#pragma unroll
                        for (int e = 0; e < 4; ++e) a = fmaxf(a, acc[ai][bj][m][n][e]);
                a = fmaxf(a, xor_get<16>(a)); a = xor32_max(a);
                if (fq == 0) RM[(ai * 128 + wr * 64 + m * 16 + fr) * 4 + wc] = a; }
        LDS_WAIT(); __builtin_amdgcn_s_barrier(); asm volatile("" ::: "memory");
#pragma unroll
        for (int ai = 0; ai < 2; ++ai)
#pragma unroll
            for (int m = 0; m < 4; ++m) { const int r = ai * 128 + wr * 64 + m * 16 + fr; const f32x4 q = *(const LAS f32x4*)(RM + r * 4);
                const float mm = fmaxf(fmaxf(q[0], q[1]), fmaxf(q[2], q[3])); float s = 0.f;
#pragma unroll
                for (int bj = 0; bj < 2; ++bj)
#pragma unroll
                    for (int n = 0; n < 2; ++n)
#pragma unroll
                        for (int e = 0; e < 4; ++e) { const float p = fast_exp2((acc[ai][bj][m][n][e] - mm) * CX); acc[ai][bj][m][n][e] = p; s += p; }
                s += xor_get<16>(s); s = xor32_sum(s);
                if (fq == 0) RS[r * 4 + wc] = s; }
        LDS_WAIT(); __builtin_amdgcn_s_barrier(); asm volatile("" ::: "memory");
        bf16_t* base = P + (size_t)(u.pm * 256 + wr * 64 + fr) * DM + u.pn * 256 + wc * 32 + 8 * fq;
#pragma unroll
        for (int ai = 0; ai < 2; ++ai)
#pragma unroll
            for (int m = 0; m < 4; ++m) { const int r = ai * 128 + wr * 64 + m * 16 + fr; const f32x4 q = *(const LAS f32x4*)(RS + r * 4);
                const float inv = 1.f / ((q[0] + q[1]) + (q[2] + q[3]));
#pragma unroll
                for (int bj = 0; bj < 2; ++bj) { u32x4 w;
                    const f32x4 p0 = acc[ai][bj][m][0] * inv, p1 = acc[ai][bj][m][1] * inv;
                    w.x = cvt_pk_bf16(p0[0], p0[1]); w.y = cvt_pk_bf16(p0[2], p0[3]); w.z = cvt_pk_bf16(p1[0], p1[1]); w.w = cvt_pk_bf16(p1[2], p1[3]);
                    *(u32x4*)(base + (size_t)(ai * 128 + m * 16) * DM + bj * 128) = w; } }
        LDS_WAIT(); __builtin_amdgcn_s_barrier(); asm volatile("" ::: "memory");
    }
};

namespace nsa {
constexpr int L_K = 0, L_V = 24576, L_PCS = 49152, L_OST = 114688, L_WSF = 147456, L_SEL = 149504;
static_assert(L_SEL + 512 <= LDSCTL_OFF, "attention LDS map");
__device__ __forceinline__ int crow(int r, int hi) { return (r & 3) + 8 * (r >> 2) + 4 * hi; }
__device__ __forceinline__ constexpr int ccol(int r) { return (r & 3) + 8 * (r >> 2); }
__device__ __forceinline__ unsigned cvtpk(float lo, float hi) { return cvt_pk_bf16(lo, hi); }

__device__ __forceinline__ void qkt(f32x16& p0, f32x16& p1, const LAS unsigned char* Kslot, const bf16x8* qr, int r32, int hi, float zero_) {
    const LAS unsigned char* kb = Kslot + hi * 1024 + r32 * 16;
    f32x16 z;
#pragma unroll
    for (int r = 0; r < 16; ++r) z[r] = zero_;
    p0 = z; p1 = z;
#pragma unroll
    for (int d0 = 0; d0 < 4; ++d0) {
        const bf16x8 b0 = *(const LAS bf16x8*)(kb + d0 * 2048);
        const bf16x8 b1 = *(const LAS bf16x8*)(kb + d0 * 2048 + 512);
        p0 = __builtin_amdgcn_mfma_f32_32x32x16_bf16(b0, qr[d0], p0, 0, 0, 0);
        p1 = __builtin_amdgcn_mfma_f32_32x32x16_bf16(b1, qr[d0], p1, 0, 0, 0);
    }
}
__device__ __forceinline__ void qkt_c(f32x16& p0, f32x16& p1, const LAS unsigned char* Kslot, const bf16x8* qr, int r32, int hi, const f32x16& c) {
    const LAS unsigned char* kb = Kslot + hi * 1024 + r32 * 16;
#pragma unroll
    for (int d0 = 0; d0 < 4; ++d0) {
        const bf16x8 b0 = *(const LAS bf16x8*)(kb + d0 * 2048);
        const bf16x8 b1 = *(const LAS bf16x8*)(kb + d0 * 2048 + 512);
        if (d0 == 0) { p0 = __builtin_amdgcn_mfma_f32_32x32x16_bf16(b0, qr[0], c, 0, 0, 0); p1 = __builtin_amdgcn_mfma_f32_32x32x16_bf16(b1, qr[0], c, 0, 0, 0); }
        else { p0 = __builtin_amdgcn_mfma_f32_32x32x16_bf16(b0, qr[d0], p0, 0, 0, 0); p1 = __builtin_amdgcn_mfma_f32_32x32x16_bf16(b1, qr[d0], p1, 0, 0, 0); }
    }
}
__device__ __forceinline__ void pv(f32x16* o, int vb, bf16x8 pa0, bf16x8 pa1, bf16x8 pa2, bf16x8 pa3) {
#pragma unroll
    for (int d0 = 0; d0 < 2; ++d0) { s16x4 lo[4], hi[4];
#pragma unroll
        for (int ks = 0; ks < 4; ++ks) {
            asm volatile("ds_read_b64_tr_b16 %0,%1 offset:%c2" : "=&v"(lo[ks]) : "v"(vb), "i"(d0 * 4096 + ks * 1024) : "memory");
            asm volatile("ds_read_b64_tr_b16 %0,%1 offset:%c2" : "=&v"(hi[ks]) : "v"(vb), "i"(d0 * 4096 + ks * 1024 + 512) : "memory"); }
        asm volatile("s_waitcnt lgkmcnt(0)" ::: "memory"); __builtin_amdgcn_sched_barrier(0);
#define NSA_PK(k) (bf16x8){lo[k][0], lo[k][1], lo[k][2], lo[k][3], hi[k][0], hi[k][1], hi[k][2], hi[k][3]}
        o[d0] = __builtin_amdgcn_mfma_f32_32x32x16_bf16(pa0, NSA_PK(0), o[d0], 0, 0, 0);
        o[d0] = __builtin_amdgcn_mfma_f32_32x32x16_bf16(pa1, NSA_PK(1), o[d0], 0, 0, 0);
        o[d0] = __builtin_amdgcn_mfma_f32_32x32x16_bf16(pa2, NSA_PK(2), o[d0], 0, 0, 0);
        o[d0] = __builtin_amdgcn_mfma_f32_32x32x16_bf16(pa3, NSA_PK(3), o[d0], 0, 0, 0);
#undef NSA_PK
    }
}
__device__ __forceinline__ void x_fused(f32x16* o, int vb, bf16x8 pa0, bf16x8 pa1, bf16x8 pa2, bf16x8 pa3, f32x16& p0, f32x16& p1, int ka, int qa, const f32x16& c) {
    s16x4 l0[4], h0[4], l1[4], h1[4];
#pragma unroll
    for (int ks = 0; ks < 4; ++ks) {
        asm volatile("ds_read_b64_tr_b16 %0,%1 offset:%c2" : "=&v"(l0[ks]) : "v"(vb), "i"(ks * 1024) : "memory");
        asm volatile("ds_read_b64_tr_b16 %0,%1 offset:%c2" : "=&v"(h0[ks]) : "v"(vb), "i"(ks * 1024 + 512) : "memory"); }
#pragma unroll
    for (int ks = 0; ks < 4; ++ks) {
        asm volatile("ds_read_b64_tr_b16 %0,%1 offset:%c2" : "=&v"(l1[ks]) : "v"(vb), "i"(4096 + ks * 1024) : "memory");
        asm volatile("ds_read_b64_tr_b16 %0,%1 offset:%c2" : "=&v"(h1[ks]) : "v"(vb), "i"(4096 + ks * 1024 + 512) : "memory"); }
    asm volatile("s_waitcnt lgkmcnt(8)" : "+v"(l0[0]), "+v"(l0[1]), "+v"(l0[2]), "+v"(l0[3]), "+v"(h0[0]), "+v"(h0[1]), "+v"(h0[2]), "+v"(h0[3]) :: "memory"); __builtin_amdgcn_sched_barrier(0);
#define NSA_PK2(l, h, k) (bf16x8){l[k][0], l[k][1], l[k][2], l[k][3], h[k][0], h[k][1], h[k][2], h[k][3]}
    o[0] = __builtin_amdgcn_mfma_f32_32x32x16_bf16(pa0, NSA_PK2(l0, h0, 0), o[0], 0, 0, 0);
    o[0] = __builtin_amdgcn_mfma_f32_32x32x16_bf16(pa1, NSA_PK2(l0, h0, 1), o[0], 0, 0, 0);
    o[0] = __builtin_amdgcn_mfma_f32_32x32x16_bf16(pa2, NSA_PK2(l0, h0, 2), o[0], 0, 0, 0);
    o[0] = __builtin_amdgcn_mfma_f32_32x32x16_bf16(pa3, NSA_PK2(l0, h0, 3), o[0], 0, 0, 0);
    __builtin_amdgcn_sched_barrier(0);
    bf16x8 b0[4], b1[4], qr[4];
#define NSA_RDK(d0) do { asm volatile("ds_read_b128 %0,%1 offset:%c2" : "=&v"(b0[d0]) : "v"(ka), "i"((d0) * 2048) : "memory"); \
                         asm volatile("ds_read_b128 %0,%1 offset:%c2" : "=&v"(b1[d0]) : "v"(ka), "i"((d0) * 2048 + 512) : "memory"); \
                         asm volatile("ds_read_b128 %0,%1 offset:%c2" : "=&v"(qr[d0]) : "v"(qa), "i"((d0) * 1024) : "memory"); } while (0)
    NSA_RDK(0); NSA_RDK(1);
    asm volatile("s_waitcnt lgkmcnt(6)" : "+v"(l1[0]), "+v"(l1[1]), "+v"(l1[2]), "+v"(l1[3]), "+v"(h1[0]), "+v"(h1[1]), "+v"(h1[2]), "+v"(h1[3]) :: "memory"); __builtin_amdgcn_sched_barrier(0);
    o[1] = __builtin_amdgcn_mfma_f32_32x32x16_bf16(pa0, NSA_PK2(l1, h1, 0), o[1], 0, 0, 0);
    o[1] = __builtin_amdgcn_mfma_f32_32x32x16_bf16(pa1, NSA_PK2(l1, h1, 1), o[1], 0, 0, 0);
    o[1] = __builtin_amdgcn_mfma_f32_32x32x16_bf16(pa2, NSA_PK2(l1, h1, 2), o[1], 0, 0, 0);
    o[1] = __builtin_amdgcn_mfma_f32_32x32x16_bf16(pa3, NSA_PK2(l1, h1, 3), o[1], 0, 0, 0);
#undef NSA_PK2
    __builtin_amdgcn_sched_barrier(0);
    NSA_RDK(2); NSA_RDK(3);
#undef NSA_RDK
    asm volatile("s_waitcnt lgkmcnt(9)" : "+v"(b0[0]), "+v"(b1[0]), "+v"(qr[0]) :: "memory"); __builtin_amdgcn_sched_barrier(0);
    p0 = __builtin_amdgcn_mfma_f32_32x32x16_bf16(b0[0], qr[0], c, 0, 0, 0); p1 = __builtin_amdgcn_mfma_f32_32x32x16_bf16(b1[0], qr[0], c, 0, 0, 0);
    asm volatile("s_waitcnt lgkmcnt(6)" : "+v"(b0[1]), "+v"(b1[1]), "+v"(qr[1]) :: "memory"); __builtin_amdgcn_sched_barrier(0);
    p0 = __builtin_amdgcn_mfma_f32_32x32x16_bf16(b0[1], qr[1], p0, 0, 0, 0); p1 = __builtin_amdgcn_mfma_f32_32x32x16_bf16(b1[1], qr[1], p1, 0, 0, 0);
    asm volatile("s_waitcnt lgkmcnt(3)" : "+v"(b0[2]), "+v"(b1[2]), "+v"(qr[2]) :: "memory"); __builtin_amdgcn_sched_barrier(0);
    p0 = __builtin_amdgcn_mfma_f32_32x32x16_bf16(b0[2], qr[2], p0, 0, 0, 0); p1 = __builtin_amdgcn_mfma_f32_32x32x16_bf16(b1[2], qr[2], p1, 0, 0, 0);
    asm volatile("s_waitcnt lgkmcnt(0)" : "+v"(b0[3]), "+v"(b1[3]), "+v"(qr[3]) :: "memory"); __builtin_amdgcn_sched_barrier(0);
    p0 = __builtin_amdgcn_mfma_f32_32x32x16_bf16(b0[3], qr[3], p0, 0, 0, 0); p1 = __builtin_amdgcn_mfma_f32_32x32x16_bf16(b1[3], qr[3], p1, 0, 0, 0);
}
__device__ __forceinline__ void mask_tile(f32x16& p0, f32x16& p1, int lo, int hi_, int hi) {
    int lo2 = lo - 4 * hi, hi2 = hi_ - 4 * hi; asm volatile("" : "+v"(lo2), "+v"(hi2));
#pragma unroll
    for (int r = 0; r < 16; ++r) { if (ccol(r) < lo2 || ccol(r) > hi2) p0[r] = -INFINITY; if (ccol(r) + 32 < lo2 || ccol(r) + 32 > hi2) p1[r] = -INFINITY; }
}
__device__ __forceinline__ float max3f(float a, float b, float c) { float r; asm("v_max3_f32 %0, %1, %2, %3" : "=v"(r) : "v"(a), "v"(b), "v"(c)); return r; }
__device__ __forceinline__ float tile_max(const f32x16& p0, const f32x16& p1) {
    float a = max3f(p0[0], p0[1], p1[0]), b = max3f(p0[2], p0[3], p1[1]); a = max3f(a, p1[2], p1[3]);
#pragma unroll
    for (int r = 4; r < 16; r += 4) { a = max3f(a, p0[r], p0[r + 1]); b = max3f(b, p0[r + 2], p0[r + 3]); a = max3f(a, p1[r], p1[r + 1]); b = max3f(b, p1[r + 2], p1[r + 3]); }
    float lo, hi; half_swap(max3f(a, b, b), lo, hi); return max3f(lo, hi, hi);
}
__device__ __forceinline__ void pack_p(const f32x16& p0, const f32x16& p1, bf16x8& a0, bf16x8& a1, bf16x8& a2, bf16x8& a3) {
    u32x4 w0, w1, w2, w3;
    w0 = (u32x4){cvtpk(p0[0], p0[1]), cvtpk(p0[2], p0[3]), cvtpk(p0[4], p0[5]), cvtpk(p0[6], p0[7])};
    w1 = (u32x4){cvtpk(p0[8], p0[9]), cvtpk(p0[10], p0[11]), cvtpk(p0[12], p0[13]), cvtpk(p0[14], p0[15])};
    w2 = (u32x4){cvtpk(p1[0], p1[1]), cvtpk(p1[2], p1[3]), cvtpk(p1[4], p1[5]), cvtpk(p1[6], p1[7])};
    w3 = (u32x4){cvtpk(p1[8], p1[9]), cvtpk(p1[10], p1[11]), cvtpk(p1[12], p1[13]), cvtpk(p1[14], p1[15])};
    a0 = __builtin_bit_cast(bf16x8, w0); a1 = __builtin_bit_cast(bf16x8, w1); a2 = __builtin_bit_cast(bf16x8, w2); a3 = __builtin_bit_cast(bf16x8, w3);
}
__device__ __forceinline__ void online_step(f32x16& p0, f32x16& p1, float& m, float& l, f32x16* o, LAS float* wsf, int r32, int hi) {
    const float rm = tile_max(p0, p1);
    const float mn = fmaxf(m, rm), mu = (mn == -INFINITY) ? 0.f : mn;
    const float sc = fast_exp2(m - mu);
    float s = 0.f;
#pragma unroll
    for (int r = 0; r < 16; ++r) { p0[r] = fast_exp2(p0[r] - mu); p1[r] = fast_exp2(p1[r] - mu); s += p0[r] + p1[r]; }
    l = l * sc + s; m = mn;
    if (__any(sc != 1.f)) {
        if (hi == 0) wsf[r32] = sc;
        LDS_WAIT();
#pragma unroll
        for (int r = 0; r < 16; ++r) { const float f = wsf[crow(r, hi)]; o[0][r] *= f; o[1][r] *= f; }
        LDS_WAIT();
    }
}

struct Ptrs { const bf16_t* qraw; const bf16_t* qrot; const bf16_t* kv; const bf16_t* kcmp; const bf16_t* vcmp; const float* gates; bf16_t* ab; };

template <bool WITH_V, class F>
__device__ __forceinline__ void tile_loop(int n, const bf16_t* Kb, const bf16_t* Vb, int row0, LAS unsigned char* lds, int wid, int lane, F&& body) {
    const bf16_t* ksrc = Kb + (size_t)(row0 + lane) * 64 + wid * 8;
    const bf16_t* vsrc = Vb + (size_t)(row0 + 16 * (wid & 3) + (lane >> 2)) * 64 + (wid >> 2) * 32 + (lane & 3) * 8;
#define NSA_ISSUE(i) do { const int sl_ = ((i) & 1) * 8192; \
        __builtin_amdgcn_global_load_lds((const unsigned*)(ksrc + (size_t)(i) * 4096), (LAS unsigned*)(lds + L_K + sl_ + wid * 1024), 16, 0, 0); \
        if (WITH_V) __builtin_amdgcn_global_load_lds((const unsigned*)(vsrc + (size_t)(i) * 4096), (LAS unsigned*)(lds + L_V + sl_ + wid * 1024), 16, 0, 0); } while (0)
    NSA_ISSUE(0);
    for (int i = 0; i < n; ++i) {
        VM_WAIT(); __syncthreads();
        if (i + 1 < n) NSA_ISSUE(i + 1);
        body(i, (i & 1) * 8192);
    }
    __syncthreads();
#undef NSA_ISSUE
}

template <int MODE>
__device__ __forceinline__ void branch_pipe(int n, const bf16_t* Kb, const bf16_t* Vb, int row0, LAS unsigned char* lds, int wid, int lane, int r32, int hi, int qa,
                                            unsigned long long sel, int tl, int qt, int kt0, float gate, LAS float* otl, LAS float* wsf, int vb0, float zero_) {
    const int half = wid >> 2;
    const bf16_t* ksrc = Kb + (size_t)(row0 + lane) * 64 + wid * 8;
    const bf16_t* vsrc = Vb + (size_t)(row0 + 16 * (wid & 3) + (lane >> 2)) * 64 + (wid >> 2) * 32 + (lane & 3) * 8;
#define BP_ISSUE_K(i, slot) __builtin_amdgcn_global_load_lds((const unsigned*)(ksrc + (size_t)(i) * 4096), (LAS unsigned*)(lds + L_K + (slot) + wid * 1024), 16, 0, 0)
#define BP_ISSUE_V(i, slot) __builtin_amdgcn_global_load_lds((const unsigned*)(vsrc + (size_t)(i) * 4096), (LAS unsigned*)(lds + L_V + (slot) + wid * 1024), 16, 0, 0)
#define BP_NEXT(s) ((s) == 16384 ? 0 : (s) + 8192)
#define BP_WAIT(c) do { if ((c) == 2) asm volatile("s_waitcnt vmcnt(2)" ::: "memory"); else if ((c) == 1) asm volatile("s_waitcnt vmcnt(1)" ::: "memory"); else asm volatile("s_waitcnt vmcnt(0)" ::: "memory"); } while (0)
#define BP_BAR() asm volatile("s_waitcnt lgkmcnt(0)\n\ts_barrier" ::: "memory")
    f32x16 o[2], p0, p1;
#pragma unroll
    for (int r = 0; r < 16; ++r) { o[0][r] = zero_; o[1][r] = zero_; p0[r] = zero_; p1[r] = zero_; }
    bf16x8 a0 = {0, 0, 0, 0, 0, 0, 0, 0}, a1 = a0, a2 = a0, a3 = a0;
    constexpr float THR = 8.f;
    f32x16 negm;
#pragma unroll
    for (int r = 0; r < 16; ++r) negm[r] = zero_;
    float mref = 0.f, l = 0.f; bool resc = false;
    const int kb0 = (int)(unsigned)(uintptr_t)(lds + L_K) + hi * 1024 + r32 * 16;
    BP_ISSUE_K(0, 0); if (n > 1) BP_ISSUE_K(1, 8192); BP_ISSUE_V(0, 0); VM_WAIT(); BP_BAR();
    int s0 = 0, sm1 = 16384;
    auto X = [&](int i) {
        if (i > 0) {
            if (resc) {
#pragma unroll
                for (int r = 0; r < 16; ++r) { const float f = (wsf + 4 * hi)[ccol(r)]; o[0][r] *= f; o[1][r] *= f; }
                LDS_WAIT(); }
            if (i < n) { x_fused(o, vb0 + sm1, a0, a1, a2, a3, p0, p1, kb0 + s0, qa, negm); return; }
            pv(o, vb0 + sm1, a0, a1, a2, a3);
        }
        if (i < n) { bf16x8 q4[4];
#pragma unroll
            for (int d0 = 0; d0 < 4; ++d0) q4[d0] = *(const LAS bf16x8*)(lds + L_OST + wid * 4096 + d0 * 1024 + lane * 16);
            qkt_c(p0, p1, lds + L_K + s0, q4, r32, hi, negm); }
    };
    auto Y = [&](int i) {
        int lo = 0, hi_ = 63; bool rowsel = true;
        if (MODE == 2) { rowsel = ((sel >> i) & 1ull) != 0; if (i == qt) hi_ = tl; }
        else { const int kt = kt0 + i; if (kt == qt - 8) lo = tl + 1; if (kt == qt) hi_ = tl; }
        if (!__all(lo <= 0 && hi_ >= 63)) mask_tile(p0, p1, lo, hi_, hi);
        else asm volatile("s_nop 15\n\ts_nop 7" : "+v"(p0), "+v"(p1));
        float rm = tile_max(p0, p1); if (!rowsel) rm = -INFINITY;
        resc = __any(rm > THR) != 0;
        if (resc) {
            const float dl = fmaxf(rm, 0.f); mref += dl;
#pragma unroll
            for (int r = 0; r < 16; ++r) { p0[r] -= dl; p1[r] -= dl; negm[r] = -mref; }
            const float f = fast_exp2(-dl); l *= f; if (hi == 0) wsf[r32] = f;
        }
        float sum = 0.f;
#pragma unroll
        for (int r = 0; r < 16; ++r) { p0[r] = fast_exp2(p0[r]); p1[r] = fast_exp2(p1[r]); sum += p0[r] + p1[r]; }
        l += rowsel ? sum : 0.f;
        pack_p(p0, p1, a0, a1, a2, a3);
        if (MODE == 2 && !rowsel) { const bf16x8 zz = {0, 0, 0, 0, 0, 0, 0, 0}; a0 = zz; a1 = zz; a2 = zz; a3 = zz; }
    };
    if (half == 0) {
        for (int j = 0; j <= n; ++j) {
            const int s1 = BP_NEXT(s0); int c = 0; if (j + 2 < n) { BP_ISSUE_K(j + 2, sm1); ++c; } if (j + 1 < n) { BP_ISSUE_V(j + 1, s1); ++c; }
            X(j); BP_BAR();
            if (j < n) Y(j);
            BP_WAIT(c); BP_BAR();
            sm1 = s0; s0 = s1;
        }
    } else {
        for (int j = 0; j <= n; ++j) {
            const int s1 = BP_NEXT(s0); int c = 0; if (j + 2 < n) { BP_ISSUE_K(j + 2, sm1); ++c; } if (j + 1 < n) { BP_ISSUE_V(j + 1, s1); ++c; }
            if (j > 0) Y(j - 1);
            BP_BAR();
            X(j);
            BP_WAIT(c); BP_BAR();
            sm1 = s0; s0 = s1;
        }
    }
#undef BP_WAIT
#undef BP_NEXT
    l = xor32_sum(l);
    if (hi == 0) wsf[r32] = l > 0.f ? gate / l : 0.f;
    LDS_WAIT();
#pragma unroll
    for (int r = 0; r < 16; ++r) { const float f = (wsf + 4 * hi)[ccol(r)]; otl[r * 64] += o[0][r] * f; otl[(16 + r) * 64] += o[1][r] * f; }
    LDS_WAIT();
#undef BP_ISSUE_K
#undef BP_ISSUE_V
#undef BP_BAR
}

__device__ __forceinline__ void unit(const Ptrs& P, int b, int g, int qt, LAS unsigned char* lds, int tid_in) {
    int tid_ = tid_in; asm volatile("" : "+v"(tid_));
    const int tid = tid_, lane = tid & 63, r32 = lane & 31, hi = lane >> 5; const int wid = __builtin_amdgcn_readfirstlane(tid >> 6);
    const int bg = b * 2 + g;
    const int tl = 8 * wid + (r32 >> 2), hr = r32 & 3;
    const int tpos = 64 * qt + tl;
    const size_t tok = (size_t)b * SEQ + tpos;
    LAS float* wsf = (LAS float*)(lds + L_WSF) + wid * 64;
    LAS float* pcs = (LAS float*)(lds + L_PCS);
    LAS unsigned long long* selm = (LAS unsigned long long*)(lds + L_SEL);
    const int vb0 = (int)(unsigned)(uintptr_t)(lds + L_V) + ((lane >> 4) & 1) * 32 + (lane & 3) * 8 + (4 * hi + ((lane & 15) >> 2)) * 64;
    const float* gp = P.gates + tok * 24 + (g * 4 + hr) * 3;
    const float g0 = gp[0], g1 = gp[1], g2 = gp[2];
    float zero_ = 0.f; asm volatile("" : "+v"(zero_));
    f32x16 ot[2];
#pragma unroll
    for (int r = 0; r < 16; ++r) { ot[0][r] = zero_; ot[1][r] = zero_; }
    bf16x8 qr[4];
    const size_t qoff = ((size_t)bg * SEQ + 64 * qt) * 256 + (size_t)(wid * 32 + r32) * 64 + hi * 8;
#pragma unroll
    for (int d0 = 0; d0 < 4; ++d0) qr[d0] = *(const bf16x8*)(P.qraw + qoff + d0 * 16);

    const int nv = tpos >= 15 ? ((tpos - 15) >> 4) : 0;
    const int nct = (4 * qt + 3 + 63) >> 6;
    const bf16_t* kc = P.kcmp + (size_t)bg * 256 * 64; const bf16_t* vc = P.vcmp + (size_t)bg * 256 * 64;
    float mc = -INFINITY, lc = 0.f;
    tile_loop<false>(nct, kc, vc, 0, lds, wid, lane, [&](int i, int sl) {
        f32x16 p0, p1; qkt(p0, p1, lds + L_K + sl, qr, r32, hi, zero_);
        mask_tile(p0, p1, 0, nv - 64 * i - 1, hi);
        const float rm = tile_max(p0, p1); const float mn = fmaxf(mc, rm), mu = (mn == -INFINITY) ? 0.f : mn;
        float s = 0.f;
#pragma unroll
        for (int r = 0; r < 16; ++r) s += fast_exp2(p0[r] - mu) + fast_exp2(p1[r] - mu);
        lc = lc * fast_exp2(mc - mu) + s; mc = mn;
    });
    lc = xor32_sum(lc);
    {
        const float mu = (mc == -INFINITY) ? 0.f : mc, inv = lc > 0.f ? 1.f / lc : 0.f;
        tile_loop<true>(nct, kc, vc, 0, lds, wid, lane, [&](int i, int sl) {
            f32x16 p0, p1; qkt(p0, p1, lds + L_K + sl, qr, r32, hi, zero_);
            mask_tile(p0, p1, 0, nv - 64 * i - 1, hi);
#pragma unroll
            for (int r = 0; r < 16; ++r) { p0[r] = fast_exp2(p0[r] - mu) * inv; p1[r] = fast_exp2(p1[r] - mu) * inv; }
#pragma unroll
            for (int r = 0; r < 16; ++r) {
                float a = p0[r], c = p1[r];
                a += xor_get<1>(a); a += xor_get<2>(a); c += xor_get<1>(c); c += xor_get<2>(c);
                if (hr == 0) { LAS float* pw = pcs + tl * 256 + 64 * i + 4 * hi; pw[ccol(r)] = a; pw[32 + ccol(r)] = c; }
            }
#pragma unroll
            for (int r = 0; r < 16; ++r) { p0[r] *= g0; p1[r] *= g0; }
            bf16x8 a0, a1, a2, a3; pack_p(p0, p1, a0, a1, a2, a3);
            pv(ot, vb0 + sl, a0, a1, a2, a3);
        });
    }
    LDS_WAIT(); __syncthreads();
    if (qt < 16) { if (lane < 8) selm[8 * wid + lane] = (2ull << qt) - 1ull; }
    else {
        unsigned key[8], T[8];
#pragma unroll
        for (int k = 0; k < 8; ++k) { const LAS float* pr = pcs + (8 * wid + k) * 256; key[k] = 0u; T[k] = 0u;
            if (lane <= qt) { float imp = 0.f;
#pragma unroll
                for (int j = -1; j < 4; ++j) { const int c = 4 * lane + j; if (c >= 0 && c < 255) imp += pr[c]; }
                key[k] = __builtin_bit_cast(unsigned, (lane == 0 || lane == qt || lane == qt - 1) ? INFINITY : imp) + 1u; } }
#pragma unroll
        for (int bit = 30; bit >= 0; --bit)
#pragma unroll
            for (int k = 0; k < 8; ++k) { const unsigned cand = T[k] | (1u << bit); int cnt; asm("s_bcnt1_i32_b64 %0, %1" : "=s"(cnt) : "s"(__ballot(key[k] >= cand)) : "scc");
                T[k] = cnt >= 16 ? cand : T[k]; }
#pragma unroll
        for (int k = 0; k < 8; ++k) {
            const unsigned long long eq = __ballot(key[k] == T[k]);
            const int need = 16 - __popcll(__ballot(key[k] > T[k])), below = __popcll(eq & ((1ull << lane) - 1ull));
            const unsigned long long mk = __ballot(key[k] > T[k] || (key[k] == T[k] && below < need));
            if (lane == 0) selm[8 * wid + k] = mk; }
    }
    LDS_WAIT(); __syncthreads();
    const unsigned long long sel = selm[tl];
    LAS float* otl = (LAS float*)(lds + L_PCS) + wid * 2048 + lane;
#pragma unroll
    for (int r = 0; r < 16; ++r) { otl[r * 64] = ot[0][r]; otl[(16 + r) * 64] = ot[1][r]; }
    LDS_WAIT();
#pragma unroll
    for (int d0 = 0; d0 < 4; ++d0) *(LAS bf16x8*)(lds + L_OST + wid * 4096 + d0 * 1024 + lane * 16) = *(const bf16x8*)(P.qrot + qoff + d0 * 16);
    LDS_WAIT();
    const int qa = (int)(unsigned)(uintptr_t)(lds + L_OST) + wid * 4096 + lane * 16;
    branch_pipe<2>(qt + 1, P.kv + 2 * KVSZ + (size_t)bg * SEQ * 64, P.kv + 3 * KVSZ + (size_t)bg * SEQ * 64, 0, lds, wid, lane, r32, hi, qa, sel, tl, qt, 0, g1, otl, wsf, vb0, zero_);
    { const int k0 = qt >= 8 ? qt - 8 : 0;
      branch_pipe<3>(qt - k0 + 1, P.kv + 4 * KVSZ + (size_t)bg * SEQ * 64, P.kv + 5 * KVSZ + (size_t)bg * SEQ * 64, 64 * k0, lds, wid, lane, r32, hi, qa, sel, tl, qt, k0, g2, otl, wsf, vb0, zero_); }
    {
        LAS bf16_t* stg = (LAS bf16_t*)(lds + L_OST) + wid * 2048;
#pragma unroll
        for (int r = 0; r < 16; ++r) {
#pragma unroll
            for (int d0 = 0; d0 < 2; ++d0) (stg + 4 * hi * 64 + r32)[ccol(r) * 64 + d0 * 32] = (bf16_t)f2bf(otl[(d0 * 16 + r) * 64]); }
        LDS_WAIT();
#pragma unroll
        for (int it = 0; it < 4; ++it) { const int row = it * 8 + (lane >> 3), ch = lane & 7; const u32x4 v = *(const LAS u32x4*)(stg + row * 64 + ch * 8);
            bf16_t* dst = P.ab + ((size_t)b * SEQ + 64 * qt + 8 * wid + (row >> 2)) * 1024 + g * 256 + (row & 3) * 64 + ch * 8;
            *(u32x4*)dst = v; }
        LDS_WAIT();
    }
    __syncthreads();
}

__device__ __forceinline__ void xattn_unit(const bf16_t* Q, const bf16_t* Kx, const bf16_t* Vx, bf16_t* O, int pm, int h, LAS unsigned char* lds, int tid_in) {
    int tid_ = tid_in; asm volatile("" : "+v"(tid_));
    const int tid = tid_, lane = tid & 63, r32 = lane & 31, hi = lane >> 5; const int wid = __builtin_amdgcn_readfirstlane(tid >> 6);
    constexpr int SL = 32768;
    const int b = pm >> 4;
    const bf16_t* kbase = Kx + ((size_t)b * 256 + lane) * 1024 + h * 256 + wid * 32;
    const bf16_t* vbase = Vx + ((size_t)b * 256 + (lane >> 2)) * 1024 + h * 256 + wid * 32 + (lane & 3) * 8;
#define XA_ISSUE_K(t) do { _Pragma("unroll") for (int i_ = 0; i_ < 4; ++i_) __builtin_amdgcn_global_load_lds((const unsigned*)(kbase + (size_t)(t) * 64 * 1024 + 8 * i_), \
        (LAS unsigned*)(lds + (t) * SL + (wid * 4 + i_) * 1024), 16, 0, 0); } while (0)
#define XA_ISSUE_V(t) do { _Pragma("unroll") for (int i_ = 0; i_ < 4; ++i_) __builtin_amdgcn_global_load_lds((const unsigned*)(vbase + ((size_t)(t) * 64 + 16 * i_) * 1024), \
        (LAS unsigned*)(lds + (t) * SL + (wid * 4 + i_) * 1024), 16, 0, 0); } while (0)
#define XA_BAR() asm volatile("s_waitcnt lgkmcnt(0)\n\ts_barrier" ::: "memory")
    bf16x8 qr[16];
    { const bf16_t* qp = Q + (size_t)(pm * 256 + wid * 32 + r32) * 1024 + h * 256 + hi * 8;
#pragma unroll
      for (int d0 = 0; d0 < 16; ++d0) qr[d0] = *(const bf16x8*)(qp + d0 * 16); }
    XA_ISSUE_K(0); XA_ISSUE_K(1); XA_ISSUE_K(2); XA_ISSUE_K(3);
    float zero_ = 0.f; asm volatile("" : "+v"(zero_));
    f32x16 p[4][2];
#pragma unroll
    for (int t = 0; t < 4; ++t) {
        if (t == 0) asm volatile("s_waitcnt vmcnt(12)" ::: "memory"); else if (t == 1) asm volatile("s_waitcnt vmcnt(8)" ::: "memory");
        else if (t == 2) asm volatile("s_waitcnt vmcnt(4)" ::: "memory"); else asm volatile("s_waitcnt vmcnt(8)" ::: "memory");
        XA_BAR();
        if (t == 2) { XA_ISSUE_V(0); XA_ISSUE_V(1); }
        const LAS unsigned char* kb = lds + t * SL + hi * 1024 + r32 * 16;
#pragma unroll
        for (int r = 0; r < 16; ++r) { p[t][0][r] = zero_; p[t][1][r] = zero_; }
#pragma unroll
        for (int d0 = 0; d0 < 16; ++d0) {
            const bf16x8 k0 = *(const LAS bf16x8*)(kb + d0 * 2048), k1 = *(const LAS bf16x8*)(kb + d0 * 2048 + 512);
            p[t][0] = __builtin_amdgcn_mfma_f32_32x32x16_bf16(k0, qr[d0], p[t][0], 0, 0, 0);
            p[t][1] = __builtin_amdgcn_mfma_f32_32x32x16_bf16(k1, qr[d0], p[t][1], 0, 0, 0);
        }
    }
    XA_BAR(); XA_ISSUE_V(2); XA_ISSUE_V(3);
    asm volatile("s_nop 15\n\ts_nop 7" : "+v"(p[0][0]), "+v"(p[0][1]), "+v"(p[1][0]), "+v"(p[1][1]), "+v"(p[2][0]), "+v"(p[2][1]), "+v"(p[3][0]), "+v"(p[3][1]));
    float mx = -INFINITY;
#pragma unroll
    for (int t = 0; t < 4; ++t) mx = fmaxf(mx, tile_max(p[t][0], p[t][1]));
    float sum = 0.f;
#pragma unroll
    for (int t = 0; t < 4; ++t)
#pragma unroll
        for (int r = 0; r < 16; ++r) { p[t][0][r] = fast_exp2((p[t][0][r] - mx) * CX); p[t][1][r] = fast_exp2((p[t][1][r] - mx) * CX); sum += p[t][0][r] + p[t][1][r]; }
    sum = xor32_sum(sum);
    const float inv = 1.f / sum;
    bf16x8 pa[4][4];
#pragma unroll
    for (int t = 0; t < 4; ++t) {
#pragma unroll
        for (int r = 0; r < 16; ++r) { p[t][0][r] *= inv; p[t][1][r] *= inv; }
        pack_p(p[t][0], p[t][1], pa[t][0], pa[t][1], pa[t][2], pa[t][3]); }
    f32x16 o[8];
#pragma unroll
    for (int d = 0; d < 8; ++d)
#pragma unroll
        for (int r = 0; r < 16; ++r) o[d][r] = zero_;
    const int vb0 = (int)(unsigned)(uintptr_t)lds + ((lane >> 4) & 1) * 32 + (lane & 3) * 8 + (4 * hi + ((lane & 15) >> 2)) * 64;
#pragma unroll
    for (int t = 0; t < 4; ++t) {
        if (t == 0) asm volatile("s_waitcnt vmcnt(12)" ::: "memory"); else if (t == 1) asm volatile("s_waitcnt vmcnt(8)" ::: "memory");
        else if (t == 2) asm volatile("s_waitcnt vmcnt(4)" ::: "memory"); else asm volatile("s_waitcnt vmcnt(0)" ::: "memory");
        XA_BAR();
        const int vb = vb0 + t * SL;
        s16x4 la[4], ha[4], lb[4], hb[4];
#define XA_RD(l, h, d) do { _Pragma("unroll") for (int ks = 0; ks < 4; ++ks) { \
            asm volatile("ds_read_b64_tr_b16 %0,%1 offset:%c2" : "=&v"(l[ks]) : "v"(vb), "i"((d) * 4096 + ks * 1024) : "memory"); \
            asm volatile("ds_read_b64_tr_b16 %0,%1 offset:%c2" : "=&v"(h[ks]) : "v"(vb), "i"((d) * 4096 + ks * 1024 + 512) : "memory"); } } while (0)
#define XA_PK(l, h, k) (bf16x8){l[k][0], l[k][1], l[k][2], l[k][3], h[k][0], h[k][1], h[k][2], h[k][3]}
#define XA_MM(l, h, d, cnt) do { asm volatile("s_waitcnt lgkmcnt(" #cnt ")" : "+v"(l[0]), "+v"(l[1]), "+v"(l[2]), "+v"(l[3]), "+v"(h[0]), "+v"(h[1]), "+v"(h[2]), "+v"(h[3]) :: "memory"); __builtin_amdgcn_sched_barrier(0); \
            o[d] = __builtin_amdgcn_mfma_f32_32x32x16_bf16(pa[t][0], XA_PK(l, h, 0), o[d], 0, 0, 0); o[d] = __builtin_amdgcn_mfma_f32_32x32x16_bf16(pa[t][1], XA_PK(l, h, 1), o[d], 0, 0, 0); \
            o[d] = __builtin_amdgcn_mfma_f32_32x32x16_bf16(pa[t][2], XA_PK(l, h, 2), o[d], 0, 0, 0); o[d] = __builtin_amdgcn_mfma_f32_32x32x16_bf16(pa[t][3], XA_PK(l, h, 3), o[d], 0, 0, 0); \
            __builtin_amdgcn_sched_barrier(0); } while (0)
        XA_RD(la, ha, 0);
        XA_RD(lb, hb, 1); XA_MM(la, ha, 0, 8);
        XA_RD(la, ha, 2); XA_MM(lb, hb, 1, 8);
        XA_RD(lb, hb, 3); XA_MM(la, ha, 2, 8);
        XA_RD(la, ha, 4); XA_MM(lb, hb, 3, 8);
        XA_RD(lb, hb, 5); XA_MM(la, ha, 4, 8);
        XA_RD(la, ha, 6); XA_MM(lb, hb, 5, 8);
        XA_RD(lb, hb, 7); XA_MM(la, ha, 6, 8);
        XA_MM(lb, hb, 7, 0);
#undef XA_RD
#undef XA_PK
#undef XA_MM
    }
    XA_BAR();
    {   LAS bf16_t* stg = (LAS bf16_t*)(lds + wid * 16384);
#pragma unroll
        for (int d = 0; d < 8; ++d)
#pragma unroll
            for (int r = 0; r < 16; ++r) stg[crow(r, hi) * 256 + d * 32 + r32] = (bf16_t)f2bf(o[d][r]);
        LDS_WAIT();
#pragma unroll
        for (int it = 0; it < 16; ++it) { const int row = it * 2 + (lane >> 5), ch = lane & 31; const u32x4 v = *(const LAS u32x4*)(stg + row * 256 + ch * 8);
            *(u32x4*)(O + (size_t)(pm * 256 + wid * 32 + row) * 1024 + h * 256 + ch * 8) = v; }
        LDS_WAIT();
    }
    XA_BAR();
#undef XA_ISSUE_K
#undef XA_ISSUE_V
#undef XA_BAR
}
}

#define XB_TMO      128
#define XB_XCNT(j)  (256  + 64 * (j))
#define XB_XSUB(j)  (1280 + 64 * (j))
#define XB_XGEN(j)  (2304 + 64 * (j))
#define XB_TOP      3328
#define XB_TOPGEN   3392
#define XCD_BAR_WORDS 3456
#define XB_SPIN_CAP (1u << 18)
__device__ __forceinline__ unsigned xb_ld(unsigned* p)              { return __hip_atomic_load(p, __ATOMIC_RELAXED, __HIP_MEMORY_SCOPE_AGENT); }
__device__ __forceinline__ unsigned xb_add(unsigned* p, unsigned v) { return __hip_atomic_fetch_add(p, v, __ATOMIC_RELAXED, __HIP_MEMORY_SCOPE_AGENT); }
__device__ __forceinline__ unsigned xb_xcc_id() { return (unsigned)__builtin_amdgcn_s_getreg((3 << 11) | 20) & 0xFu; }
#define XB_SPIN(cond, bar) do { unsigned _sp = 0; while (cond) { __builtin_amdgcn_s_sleep(1); \
    if ((++_sp & 255u) == 0u) { if (xb_ld(&(bar)[XB_TMO])) break; if (_sp > XB_SPIN_CAP) { atomicAdd(&(bar)[XB_TMO], 1u); break; } } } } while (0)
struct XcdBarrier { unsigned* bar; unsigned x; volatile LAS unsigned* st; };
__device__ __forceinline__ XcdBarrier xcd_barrier_post(unsigned* bar, volatile LAS unsigned* st) {
    XcdBarrier b; b.bar = bar; b.x = xb_xcc_id(); b.st = st;
    if (threadIdx.x == 0) (void)xb_add(&bar[XB_XCNT(b.x)], 1u);
    return b;
}
__device__ __forceinline__ void xcd_barrier_complete(unsigned* bar, unsigned x, unsigned& nloc, unsigned& nx) {
    const unsigned G = gridDim.x * gridDim.y * gridDim.z;
    unsigned sum, cnt, mine, sp = 0u;
    for (;;) {
        sum = 0u; cnt = 0u; mine = 0u;
#pragma unroll
        for (unsigned j = 0; j < 16; ++j) { const unsigned c = xb_ld(&bar[XB_XCNT(j)]); sum += c; cnt += (c > 0u) ? 1u : 0u; mine = (j == x) ? c : mine; }
        if (sum == G) break;
        __builtin_amdgcn_s_sleep(1);
        if ((++sp & 255u) == 0u) { if (xb_ld(&bar[XB_TMO])) break; if (sp > XB_SPIN_CAP) { atomicAdd(&bar[XB_TMO], 1u); break; } }
    }
    nloc = mine > 0u ? mine : 1u; nx = cnt > 0u ? cnt : 1u;
}
__device__ __forceinline__ void xcd_barrier(const XcdBarrier& b, int tid) {
    asm volatile("s_waitcnt vmcnt(0)" ::: "memory");
    __syncthreads();
    if (tid == 0) {
        unsigned* bar = b.bar;
        __builtin_amdgcn_s_waitcnt(0);
        unsigned nloc = b.st[0], nx = b.st[1];
        if (nloc == 0u) { xcd_barrier_complete(bar, b.x, nloc, nx); b.st[0] = nloc; b.st[1] = nx; }
        const unsigned old = xb_add(&bar[XB_XSUB(b.x)], 1u);
        const unsigned gen = old / nloc;
        if (old + 1u == (gen + 1u) * nloc) {
            __builtin_amdgcn_fence(__ATOMIC_RELEASE, "agent");
            asm volatile("s_waitcnt vmcnt(0)" ::: "memory");
            const unsigned og = xb_add(&bar[XB_TOP], 1u);
            const unsigned tg = og / nx;
            if (og + 1u == (tg + 1u) * nx) xb_add(&bar[XB_TOPGEN], 1u);
            else XB_SPIN(xb_ld(&bar[XB_TOPGEN]) == tg, bar);
            __builtin_amdgcn_fence(__ATOMIC_ACQUIRE, "agent");
            xb_add(&bar[XB_XGEN(b.x)], 1u);
            asm volatile("s_waitcnt vmcnt(0)" ::: "memory");
        } else {
            XB_SPIN(xb_ld(&bar[XB_XGEN(b.x)]) == gen, bar);
            __builtin_amdgcn_fence(__ATOMIC_ACQUIRE, "agent");
            asm volatile("s_waitcnt vmcnt(0)" ::: "memory");
        }
    }
    __syncthreads();
}

__device__ __forceinline__ void xpose_item(const float* W, int ldw, int k0, int n0, int ncv, bf16_t* WT, int ldt, int dr0, LAS float* scr, int lane, const float* gain = nullptr) {
    const int c = lane & 31;
    float wv[32];
#pragma unroll
    for (int i = 0; i < 32; ++i) { const int kk = 2 * i + (lane >> 5); wv[i] = c < ncv ? W[(size_t)(k0 + kk) * ldw + n0 + c] : 0.f; }
#pragma unroll
    for (int i = 0; i < 32; ++i) { const int kk = 2 * i + (lane >> 5); scr[kk * 33 + c] = wv[i] * (gain ? gain[k0 + kk] : 1.f); }
    LDS_WAIT(); asm volatile("" ::: "memory");
    const int c8 = lane & 7;
#pragma unroll
    for (int j = 0; j < 4; ++j) { const int n = (lane >> 3) + 8 * j; const LAS float* s = scr + (8 * c8) * 33 + n;
        u32x4 o; o.x = pk2(s[0 * 33], s[1 * 33]); o.y = pk2(s[2 * 33], s[3 * 33]); o.z = pk2(s[4 * 33], s[5 * 33]); o.w = pk2(s[6 * 33], s[7 * 33]);
        *(u32x4*)(WT + (size_t)(dr0 + n) * ldt + k0 + 8 * c8) = o; }
    LDS_WAIT(); asm volatile("" ::: "memory");
}
__device__ __forceinline__ void xpose_item64(const float* W, int ldw, int k0, int n0, bf16_t* WT, int ldt, int dr0, LAS float* scr, int lane, const float* gain) {
    const int c4 = lane & 15, r4 = lane >> 4;
    f32x4 v[16];
#pragma unroll
    for (int i = 0; i < 16; ++i) v[i] = *(const f32x4*)(W + (size_t)(k0 + 4 * i + r4) * ldw + n0 + 4 * c4);
    if (gain) {
#pragma unroll
        for (int i = 0; i < 16; ++i) v[i] = v[i] * gain[k0 + 4 * i + r4]; }
#pragma unroll
    for (int i = 0; i < 16; ++i) { LAS float* d = scr + (4 * i + r4) * 65 + 4 * c4; d[0] = v[i].x; d[1] = v[i].y; d[2] = v[i].z; d[3] = v[i].w; }
    LDS_WAIT(); asm volatile("" ::: "memory");
    const int c8 = lane & 7;
#pragma unroll
    for (int j = 0; j < 8; ++j) { const int n = (lane >> 3) + 8 * j; const LAS float* s = scr + (8 * c8) * 65 + n;
        u32x4 o; o.x = pk2(s[0 * 65], s[1 * 65]); o.y = pk2(s[2 * 65], s[3 * 65]); o.z = pk2(s[4 * 65], s[5 * 65]); o.w = pk2(s[6 * 65], s[7 * 65]);
        *(u32x4*)(WT + (size_t)(dr0 + n) * ldt + k0 + 8 * c8) = o; }
    LDS_WAIT(); asm volatile("" ::: "memory");
}
__device__ __forceinline__ void xpose_load64(const float* W, int ldw, int k0, int n0, int lane, f32x4 (&v)[16]) {
    const int c4 = lane & 15, r4 = lane >> 4;
#pragma unroll
    for (int i = 0; i < 16; ++i) v[i] = *(const f32x4*)(W + (size_t)(k0 + 4 * i + r4) * ldw + n0 + 4 * c4);
}
__device__ __forceinline__ void xpose_store64(const f32x4 (&v)[16], int k0, bf16_t* WT, int ldt, int dr0, LAS float* scr, int lane) {
    const int c4 = lane & 15, r4 = lane >> 4;
#pragma unroll
    for (int i = 0; i < 16; ++i) { LAS float* d = scr + (4 * i + r4) * 65 + 4 * c4; d[0] = v[i].x; d[1] = v[i].y; d[2] = v[i].z; d[3] = v[i].w; }
    LDS_WAIT(); asm volatile("" ::: "memory");
    const int c8 = lane & 7;
#pragma unroll
    for (int j = 0; j < 8; ++j) { const int n = (lane >> 3) + 8 * j; const LAS float* s = scr + (8 * c8) * 65 + n;
        u32x4 o; o.x = pk2(s[0 * 65], s[1 * 65]); o.y = pk2(s[2 * 65], s[3 * 65]); o.z = pk2(s[4 * 65], s[5 * 65]); o.w = pk2(s[6 * 65], s[7 * 65]);
        *(u32x4*)(WT + (size_t)(dr0 + n) * ldt + k0 + 8 * c8) = o; }
    LDS_WAIT(); asm volatile("" ::: "memory");
}
__device__ __forceinline__ void xpose_mat(const float* W, int K, int N, bf16_t* WT, int rowmap, int item, LAS float* scr, int lane, const float* gain = nullptr) {
    const int ng = N / 64, kb = item / ng, j = item % ng, n = 64 * j;
    const int dr = rowmap == 0 ? n : (256 * (n >> 7) + (n & 127) + (rowmap == 2 ? 128 : 0));
    xpose_item64(W, N, 64 * kb, n, WT, K, dr, scr, lane, gain);
}
template <int W> __device__ __forceinline__ void pool_run(const bf16_t* ub, bf16_t* ab, int rq, int lane) {
    constexpr int CLS = W == 2 ? 0 : W == 4 ? 1 : W == 8 ? 2 : 3, NR = 15 + W;
    const int t0 = (4 * rq + (lane >> 4)) * 16, t0s = t0 & (SEQ - 1), col = 128 * CLS + 8 * (lane & 15);
    u32x4 R[NR];
#pragma unroll
    for (int j = 0; j < NR; ++j) { R[j] = (u32x4){0u, 0u, 0u, 0u}; if (t0s - (W - 1) + j >= 0) R[j] = *(const u32x4*)(ub + (size_t)(t0 - (W - 1) + j) * 512 + col); }
    float s[8];
#pragma unroll
    for (int e = 0; e < 8; ++e) s[e] = 0.f;
#pragma unroll
    for (int j = 0; j < W - 1; ++j)
#pragma unroll
        for (int e = 0; e < 4; ++e) { s[2 * e] += __builtin_bit_cast(float, R[j][e] << 16); s[2 * e + 1] += __builtin_bit_cast(float, R[j][e] & 0xffff0000u); }
#pragma unroll
    for (int i = 0; i < 16; ++i) {
        float own[8];
#pragma unroll
        for (int e = 0; e < 4; ++e) { own[2 * e] = __builtin_bit_cast(float, R[W - 1 + i][e] << 16); own[2 * e + 1] = __builtin_bit_cast(float, R[W - 1 + i][e] & 0xffff0000u); }
#pragma unroll
        for (int e = 0; e < 8; ++e) s[e] += own[e];
        if (i > 0) {
#pragma unroll
            for (int e = 0; e < 4; ++e) { s[2 * e] -= __builtin_bit_cast(float, R[i - 1][e] << 16); s[2 * e + 1] -= __builtin_bit_cast(float, R[i - 1][e] & 0xffff0000u); } }
        const int n = (t0s + i + 1) < W ? (t0s + i + 1) : W; const float inv = 1.f / (float)n;
        u32x4 o; o.x = pk2(s[0] * inv - own[0], s[1] * inv - own[1]); o.y = pk2(s[2] * inv - own[2], s[3] * inv - own[3]);
        o.z = pk2(s[4] * inv - own[4], s[5] * inv - own[5]); o.w = pk2(s[6] * inv - own[6], s[7] * inv - own[7]);
        *(u32x4*)(ab + (size_t)(t0 + i) * 1024 + 512 + col) = o;
    }
}
__device__ __forceinline__ float row_rs(const float* xrow, int lane, f32x4 (&v)[4]) {
    const f32x4* xr = (const f32x4*)xrow + lane; float s = 0.f;
#pragma unroll
    for (int j = 0; j < 4; ++j) { v[j] = xr[64 * j]; s += (v[j].x * v[j].x + v[j].y * v[j].y) + (v[j].z * v[j].z + v[j].w * v[j].w); }
    return 1.0f / sqrtf(wave_sum(s) * (1.f / DM) + EPS);
}
__device__ __forceinline__ void norm_row(const float* xrow, const float* gain, bf16_t* orow, int lane) {
    f32x4 v[4]; const float rs = row_rs(xrow, lane, v);
    const f32x4* gr = (const f32x4*)gain + lane; unsigned long long* o8 = (unsigned long long*)orow + lane;
#pragma unroll
    for (int j = 0; j < 4; ++j) { const f32x4 g = gr[64 * j];
        o8[64 * j] = (unsigned long long)pk2(v[j].x * rs * g.x, v[j].y * rs * g.y) | ((unsigned long long)pk2(v[j].z * rs * g.z, v[j].w * rs * g.w) << 32); }
}
__device__ __forceinline__ void sincos_d(double a, float& s, float& c) {
    const double n = rint(a * 0.6366197723675814);
    double r = fma(-n, 1.5707963267948966, a); r = fma(-n, 6.123233995736766e-17, r);
    const double r2 = r * r;
    double sp = -1.0 / 1307674368000.0; sp = sp * r2 + 1.0 / 6227020800.0; sp = sp * r2 - 1.0 / 39916800.0; sp = sp * r2 + 1.0 / 362880.0; sp = sp * r2 - 1.0 / 5040.0; sp = sp * r2 + 1.0 / 120.0; sp = sp * r2 - 1.0 / 6.0; sp = sp * r2 * r + r;
    double cp = 1.0 / 20922789888000.0; cp = cp * r2 - 1.0 / 87178291200.0; cp = cp * r2 + 1.0 / 479001600.0; cp = cp * r2 - 1.0 / 3628800.0; cp = cp * r2 + 1.0 / 40320.0; cp = cp * r2 - 1.0 / 720.0; cp = cp * r2 + 1.0 / 24.0; cp = cp * r2 - 0.5; cp = cp * r2 + 1.0;
    const int q = (int)n & 3;
    const double ss = (q & 1) ? cp : sp, cc = (q & 1) ? sp : cp;
    s = (float)((q & 2) ? -ss : ss); c = (float)(((q + 1) & 2) ? -cc : cc);
}

struct Args {
    const float* in[30]; float* out; unsigned char* ws; int ph_lo, ph_hi;
};
enum { I_X = 0, I_MEM, I_NORM_MIX, I_W_IN, I_PE_K, I_W1_K, I_B1_K, I_W2_K, I_PE_V, I_W1_V, I_B1_V, I_W2_V, I_W_POOL, I_POOL_SCALE, I_W_OUT, I_NORM_X, I_NORM_MEM,
       I_WQ, I_WK, I_WV, I_WO, I_NORM_FFN, I_FFN_WG, I_FFN_WU, I_FFN_WD, I_ROUTER, I_MOE_WG, I_MOE_WU, I_MOE_WD, I_NORM_FINAL };
constexpr int PH_PRO = 0, PH_KV = 1, PH_L0 = 2, PH_LSTRIDE = 20;
constexpr int PO_WIN = 0, PO_CMP = 1, PO_ATT = 2, PO_WOUT = 3, PO_N2 = 4, PO_WQ = 5, PO_S = 6, PO_PV = 7, PO_WO = 8, PO_F0 = 9;

typedef const Args __attribute__((address_space(4))) CArgs;
#if RES_BF16
__device__ __forceinline__ f32x4 xrow4(const bf16_t* xb2, const float*, size_t tok, int idx) { const u32x2 w = ((const u32x2*)(xb2 + tok * DM))[idx];
    return (f32x4){__builtin_bit_cast(float, w.x << 16), __builtin_bit_cast(float, w.x & 0xffff0000u), __builtin_bit_cast(float, w.y << 16), __builtin_bit_cast(float, w.y & 0xffff0000u)}; }
__device__ __forceinline__ float xrow1(const bf16_t* xb2, const float*, size_t tok, int idx) { return bf2f(xb2[tok * DM + idx]); }
#else
__device__ __forceinline__ f32x4 xrow4(const bf16_t*, const float* x, size_t tok, int idx) { return ((const f32x4*)(x + tok * DM))[idx]; }
__device__ __forceinline__ float xrow1(const bf16_t*, const float* x, size_t tok, int idx) { return x[tok * DM + idx]; }
#endif
#define PHASE_IDS CArgs* ap_ = (CArgs*)__builtin_amdgcn_kernarg_segment_ptr(); asm volatile("" : "+s"(ap_)); unsigned char* ws = ap_->ws; (void)ws; int tid_; asm volatile("v_mbcnt_lo_u32_b32 %0, -1, 0\n\tv_mbcnt_hi_u32_b32 %0, -1, %0" : "=v"(tid_)); tid_ += wid0 * 64; const int tid = tid_, lane = tid & 63, wid = wid0, gw = bid * NWAVES + wid; (void)lane; (void)gw;
#ifndef PHMASK
#define PHMASK 0xffffffffu
#endif
#define PM(b) ((PHMASK >> (b)) & 1u)
#define IN(k) (lo <= (k) && (k) < hi)
#ifndef TSPIN_ORD
#define TSPIN_ORD -1
#endif
#if DBG >= 200 || TSPIN_ORD >= 0
#define SEAM(k) do { if (hi > (k) + 1) xcd_barrier(bar, tid); if (bid == 0 && tid == 0) ((unsigned long long*)((unsigned*)(ws + WS_CTL) + 20000))[(k)] = __builtin_amdgcn_s_memrealtime(); } while (0)
#else
#ifndef BAR_REP
#define BAR_REP 1
#endif
#define SEAM(k) do { if (hi > (k) + 1) for (int br_ = 0; br_ < BAR_REP; ++br_) xcd_barrier(bar, tid); } while (0)
#endif
#define W16(off) ((bf16_t*)(ws + (off)))
constexpr int MOE_IT_MG = 16 * 56, MOE_IT_MD = 56 * 16, MOE_NM = 16 * MOE_IT_MG + 8 * MOE_IT_MD, MOE_S0 = 5 * 176 * 8, MOE_S1 = MOE_S0 + 3 * 128 * 8;
__device__ __forceinline__ void moe_convert(const float* wgp, const float* wup, const float* wdp, unsigned char* ws, LAS unsigned char* lds, int it_lo, int it_hi, int rank, int nranks, int wid, int lane) {
    LAS float* scr = (LAS float*)(lds + wid * 16896);
    auto ld = [&](int it, f32x4 (&v)[16]) {
        if (it < 16 * MOE_IT_MG) { const int mtx = it / MOE_IT_MG, r = it % MOE_IT_MG, e = mtx >> 1, up = mtx & 1, kb = r / 56, j = r % 56;
            xpose_load64((up ? wup : wgp) + (size_t)e * DM * DFFE, DFFE, 64 * kb, 64 * j, lane, v);
        } else { const int r0 = it - 16 * MOE_IT_MG, e = r0 / MOE_IT_MD, r = r0 % MOE_IT_MD, kb = r / 16, j = r % 16;
            xpose_load64(wdp + (size_t)e * DFFE * DM, DM, 64 * kb, 64 * j, lane, v); } };
    auto st = [&](int it, const f32x4 (&v)[16]) {
        if (it < 16 * MOE_IT_MG) { const int mtx = it / MOE_IT_MG, r = it % MOE_IT_MG, e = mtx >> 1, up = mtx & 1, kb = r / 56, j = r % 56, n = 64 * j;
            xpose_store64(v, 64 * kb, W16(WS_MGU) + (size_t)e * 7168 * DM, DM, 256 * (n >> 7) + (n & 127) + (up ? 128 : 0), scr, lane);
        } else { const int r0 = it - 16 * MOE_IT_MG, e = r0 / MOE_IT_MD, r = r0 % MOE_IT_MD, kb = r / 16, j = r % 16;
            xpose_store64(v, 64 * kb, W16(WS_MD) + (size_t)e * DM * DFFE, DFFE, 64 * j, scr, lane); } };
    int it = it_lo + rank;
    f32x4 va[16], vb[16];
    if (it < it_hi) ld(it, va);
    while (it < it_hi) {
        if (it + nranks < it_hi) ld(it + nranks, vb);
        st(it, va); it += nranks; if (it >= it_hi) break;
        if (it + nranks < it_hi) ld(it + nranks, va);
        st(it, vb); it += nranks;
    }
}
template <int layer> __device__ __forceinline__ void layer_phases(LAS unsigned char* lds, const int lo, const int hi, const XcdBarrier& bar, const int G, const int bid, const int NGW, const int wid0) {
        const int pb = PH_L0 + layer * PH_LSTRIDE;
        if (PM(2) && IN(pb + PO_WIN)) {
            PHASE_IDS
            pg8::Gemm g{(const char*)(ws + WS_HB), (const char*)(ws + WS_WIN + (size_t)layer * ZW * DM * 2), DM, DM, DM};
            SchedPlain S; S.init(T / 256, ZW / 256, DM, DM, G, bid);
            EpiWin E{W16(WS_QRAW), W16(WS_QROT), W16(WS_KV), W16(WS_U), (float*)(ws + WS_GATES), (const float*)(ws + WS_ROPE), SSP(layer == 0 ? 0 : 3)};
            for (int rep_ = 0; rep_ < REPN(2); ++rep_) pg8::gemm_phase<EpiWin, SchedPlain, true, true>(lds, g, S, E, tid);
            SEAM(pb + PO_WIN);
        }
        if (PM(3) && IN(pb + PO_CMP)) {
            PHASE_IDS
            for (int rep_ = 0; rep_ < REPN(3); ++rep_)
            if (bid < 16) {
                const int kv = bid >> 3, pm = bid & 7, mtx = layer * 2 + kv;
                {
                    pg8::Gemm g{(const char*)(ws + WS_KV + (size_t)kv * KVSZ * 2), (const char*)(ws + WS_CW1 + (size_t)mtx * 256 * 2048 * 2), 2048, 1024, 2048};
                    SchedOne S; S.u.pm = pm; S.u.pn = 0; S.u.aoff = (long)pm * 256 * 1024 * 2; S.u.boff = 0; S.u.coff = 0;
                    EpiHid E{W16(WS_HID) + (size_t)kv * 2048 * 256, (const long long*)((const unsigned*)(ws + WS_CTL) + CW_BIAS) + mtx * 256};
                    pg8::gemm_phase<EpiHid, SchedOne, false, true>(lds, g, S, E, tid);
                }
                VM_WAIT(); __syncthreads();
                __builtin_amdgcn_fence(__ATOMIC_ACQUIRE, "agent"); VM_WAIT(); __syncthreads();
                {
                    pg8::Gemm g{(const char*)(ws + WS_HID + (size_t)kv * 2048 * 256 * 2), (const char*)(ws + WS_CW2 + (size_t)mtx * 256 * 256 * 2), 256, 256, 256};
                    SchedOne S; S.u.pm = pm; S.u.pn = 0; S.u.aoff = (long)pm * 256 * 256 * 2; S.u.boff = 0; S.u.coff = 0;
                    EpiCmp2 E{W16(WS_KCMP) + (size_t)kv * 8 * 256 * 64};
                    pg8::gemm_phase<EpiCmp2, SchedOne, false, true>(lds, g, S, E, tid);
                }
            } else if (layer == 0 && bid < 80) {
                pg8::Gemm g{(const char*)ws, (const char*)ws, DM, DM, DM}; SchedKV S{1, bid - 16}; EpiPlain E{(bf16_t*)ws, DM, nullptr};
                pg8::gemm_phase<EpiPlain, SchedKV, false, true>(lds, g, S, E, tid);
            } else {
                const int nw = layer == 0 ? G - 80 : G - 16, w0 = layer == 0 ? 80 : 16;
                moe_convert(ap_->in[I_MOE_WG], ap_->in[I_MOE_WU], ap_->in[I_MOE_WD], ws, lds, layer == 0 ? 0 : MOE_S1, layer == 0 ? MOE_S0 : MOE_NM, (bid - w0) * NWAVES + wid, nw * NWAVES, wid, lane);
                const bf16_t* ub = W16(WS_U); bf16_t* ab = W16(WS_AB);
                for (int p = (bid - w0) * NWAVES + wid; p < 1024; p += nw * NWAVES) { const int rq = p & 255;
                    switch (p >> 8) { case 0: pool_run<16>(ub, ab, rq, lane); break; case 1: pool_run<8>(ub, ab, rq, lane); break; case 2: pool_run<4>(ub, ab, rq, lane); break; default: pool_run<2>(ub, ab, rq, lane); break; } }
            }
            SEAM(pb + PO_CMP);
        }
        if (PM(4) && IN(pb + PO_ATT)) {
            PHASE_IDS
            nsa::Ptrs P{W16(WS_QRAW), W16(WS_QROT), W16(WS_KV), W16(WS_KCMP), W16(WS_KCMP) + 8 * 256 * 64, (const float*)(ws + WS_GATES), W16(WS_AB)};
            const int vcu = (G % 8 == 0) ? (bid % 8) * (G / 8) + bid / 8 : bid;
            for (int rep_ = 0; rep_ < REP_ATT; ++rep_)
            for (int uix = vcu; uix < 8 * 32; uix += G) { const int bgx = uix >> 5, s = uix & 31;
                nsa::unit(P, bgx >> 1, bgx & 1, 63 - s, lds, tid);
                nsa::unit(P, bgx >> 1, bgx & 1, s, lds, tid); }
            SEAM(pb + PO_ATT);
        }
        if (PM(5) && IN(pb + PO_WOUT)) {
            PHASE_IDS
            pg8::Gemm g{(const char*)(ws + WS_AB), (const char*)(ws + WS_WOUT + (size_t)layer * DM * DM * 2), DM, DM, DM};
            SchedPlain S; S.init(T / 256, DM / 256, DM, DM, G, bid);
#if RES_BF16
            if constexpr (layer == 0) { EpiResB<true> E{ap_->in[I_X], W16(WS_HB), SSP(1)}; pg8::gemm_phase<EpiResB<true>, SchedPlain, true, true>(lds, g, S, E, tid); }
            else { EpiResB<false> E{W16(WS_HB), W16(WS_HB), SSP(4)}; pg8::gemm_phase<EpiResB<false>, SchedPlain, true, true>(lds, g, S, E, tid); }
#else
            EpiRes E{layer == 0 ? ap_->in[I_X] : ap_->out, ap_->out, W16(WS_HB), SSP(layer == 0 ? 1 : 4)};
            pg8::gemm_phase<EpiRes, SchedPlain, true, true>(lds, g, S, E, tid);
#endif
            SEAM(pb + PO_WOUT);
        }
        if (PM(7) && IN(pb + PO_WQ)) {
            PHASE_IDS
            for (int rep_ = 0; rep_ < REPN(7); ++rep_) {
            {   pg8::Gemm g{(const char*)(ws + WS_HB), (const char*)(ws + WS_WQ + (size_t)layer * DM * DM * 2), DM, DM, DM};
                SchedPlain S; S.init(T / 256, DM / 256, DM, DM, G, bid);
                EpiPlain E{W16(WS_QX), DM, SSP(layer == 0 ? 1 : 4)};
                pg8::gemm_phase<EpiPlain, SchedPlain, false, true>(lds, g, S, E, tid); }
            VM_WAIT(); __syncthreads(); __builtin_amdgcn_fence(__ATOMIC_ACQUIRE, "agent"); VM_WAIT(); __syncthreads();
            {
                pg8::TileOrder o; o.init(T / 256, DM / 256, G, bid); int pm, pn;
#if TSPIN_ORD == 100
                if (layer == 0 && bid == 0 && tid == 0) ((unsigned long long*)((unsigned*)(ws + WS_CTL) + 20000))[60] = __builtin_amdgcn_s_memrealtime();
#endif
                if (o.tile(0, pm, pn)) { nsa::xattn_unit(W16(WS_QX), W16(WS_KX) + (size_t)layer * DM * DM, W16(WS_VXT) + (size_t)layer * DM * DM, W16(WS_OX), pm, pn, lds, tid);
#if TSPIN_ORD == 100
                if (layer == 0 && bid == 0 && tid == 0) ((unsigned long long*)((unsigned*)(ws + WS_CTL) + 20000))[61] = __builtin_amdgcn_s_memrealtime();
#endif
#if DBG == 400
                    if (layer == 1) { nsa::xattn_unit(W16(WS_QX), W16(WS_KX) + (size_t)layer * DM * DM, W16(WS_VXT) + (size_t)layer * DM * DM, W16(WS_ACTC), pm, pn, lds, tid);
                        VM_WAIT(); __syncthreads(); __builtin_amdgcn_fence(__ATOMIC_ACQUIRE, "agent"); VM_WAIT(); __syncthreads();
                        unsigned c = 0; for (int i = tid; i < 256 * 256; i += 512) { const size_t off = (size_t)(pm * 256 + (i >> 8)) * 1024 + pn * 256 + (i & 255); c += W16(WS_OX)[off] != W16(WS_ACTC)[off]; }
                        if (c) atomicAdd((unsigned*)(ws + WS_CTL) + 21100, c); }
#endif
                } }
            if (rep_ + 1 < REPN(7)) { VM_WAIT(); __syncthreads(); }
            }
            SEAM(pb + PO_PV);
        }
        if (PM(10) && IN(pb + PO_WO)) {
            PHASE_IDS
            pg8::Gemm g{(const char*)(ws + WS_OX), (const char*)(ws + WS_WO + (size_t)layer * DM * DM * 2), DM, DM, DM};
            SchedPlain S; S.init(T / 256, DM / 256, DM, DM, G, bid);
#if RES_BF16
            EpiResB<false> E{W16(WS_HB), layer == 0 ? W16(WS_HB) : W16(WS_XB2), layer == 0 ? SSP(2) : nullptr};
            pg8::gemm_phase<EpiResB<false>, SchedPlain, true, true>(lds, g, S, E, tid);
#else
            EpiRes E{ap_->out, ap_->out, layer == 0 ? W16(WS_HB) : nullptr, SSP(2)};
            pg8::gemm_phase<EpiRes, SchedPlain, true, true>(lds, g, S, E, tid);
#endif
            SEAM(pb + PO_WO);
        }
        if constexpr (layer == 0) {
            if (PM(12) && IN(pb + PO_F0 + 1)) {
            PHASE_IDS
                pg8::Gemm g{(const char*)(ws + WS_HB), (const char*)(ws + WS_FGU), DM, DM, DM};
                SchedPlain S; S.init(T / 256, 2 * DFF / 256, DM, DM, G, bid);
                EpiSwiglu<2> E{W16(WS_ACT0), DFF, nullptr, SSP(2)};
                for (int rep_ = 0; rep_ < REPN(12); ++rep_) pg8::gemm_phase<EpiSwiglu<2>, SchedPlain, true, true>(lds, g, S, E, tid);
                if (bid >= 128) { __syncthreads();
                    moe_convert(ap_->in[I_MOE_WG], ap_->in[I_MOE_WU], ap_->in[I_MOE_WD], ws, lds, MOE_S0, MOE_S1, (bid - 128) * NWAVES + wid, 128 * NWAVES, wid, lane); __syncthreads(); }
                SEAM(pb + PO_F0 + 1);
            }
            if (PM(13) && IN(pb + PO_F0 + 2)) {
            PHASE_IDS
                pg8::Gemm g{(const char*)(ws + WS_ACT0), (const char*)(ws + WS_FD), DFF, DFF, DFF};
                SchedPlain S; S.init(T / 256, DM / 256, DFF, DFF, G, bid);
#if RES_BF16
                EpiResB<false> E{W16(WS_HB), W16(WS_HB), SSP(3)};
                pg8::gemm_phase<EpiResB<false>, SchedPlain, true, true>(lds, g, S, E, tid);
#else
                EpiRes E{ap_->out, ap_->out, W16(WS_HB), SSP(3)};
                pg8::gemm_phase<EpiRes, SchedPlain, true, true>(lds, g, S, E, tid);
#endif
                SEAM(pb + PO_F0 + 2);
            }
        } else {
#define route ((unsigned*)(ws + WS_ROUTE))
#define cntg ((unsigned*)(ws + WS_CNTG))
#define tinfo ((unsigned*)(ws + WS_TILE))
#define slot ((unsigned*)(ws + WS_SLOT))
            LAS int* LE = (LAS int*)lds;
            LAS float* LW = (LAS float*)(lds + 512);
            LAS int* LR = (LAS int*)(lds + 1024);
            LAS int* LC = (LAS int*)(lds + 1536);
            if (PM(15) && IN(pb + PO_F0)) {
            PHASE_IDS
                const float* gain = ap_->in[I_NORM_FFN] + DM; const float* wr = ap_->in[I_ROUTER];
                float wgr[16][8];
#pragma unroll
                for (int jj = 0; jj < 16; ++jj) { const int k = lane + 64 * jj; const float gk = gain[k]; const f32x4 w0 = *(const f32x4*)(wr + (size_t)k * 8), w1 = *(const f32x4*)(wr + (size_t)k * 8 + 4);
#pragma unroll
                    for (int c = 0; c < 4; ++c) { wgr[jj][c] = gk * w0[c]; wgr[jj][4 + c] = gk * w1[c]; } }
                for (int rep_ = 0; rep_ < REPN(15); ++rep_)
                for (int tb = bid; tb < T / 64; tb += G) {
                    for (int k = 0; k < 8; ++k) { const int tl = 8 * wid + k, tok = 64 * tb + tl;
                        float xs[16], sq = 0.f;
#pragma unroll
                        for (int jj = 0; jj < 16; ++jj) { xs[jj] = xrow1(W16(WS_XB2), ap_->out, (size_t)tok, lane + 64 * jj); sq += xs[jj] * xs[jj]; }
                        const float rs = 1.0f / sqrtf(wave_sum(sq) * (1.f / DM) + EPS);
                        float lg[8];
#pragma unroll
                        for (int e = 0; e < 8; ++e) lg[e] = 0.f;
#pragma unroll
                        for (int jj = 0; jj < 16; ++jj) { const float h = xs[jj] * rs;
#pragma unroll
                            for (int e = 0; e < 8; ++e) lg[e] += h * wgr[jj][e]; }
                        { const bool b0 = lane & 1, b1 = lane & 2, b2 = lane & 4; float a4[4], a2[2], a1;
#pragma unroll
                          for (int i = 0; i < 4; ++i) a4[i] = (b0 ? lg[4 + i] : lg[i]) + xor_get<1>(b0 ? lg[i] : lg[4 + i]);
#pragma unroll
                          for (int i = 0; i < 2; ++i) a2[i] = (b1 ? a4[2 + i] : a4[i]) + xor_get<2>(b1 ? a4[i] : a4[2 + i]);
                          a1 = (b2 ? a2[1] : a2[0]) + xor_get<4>(b2 ? a2[0] : a2[1]);
                          a1 += xor_get<8>(a1); a1 += xor_get<16>(a1); a1 = xor32_sum(a1);
#pragma unroll
                          for (int e = 0; e < 8; ++e) lg[e] = __builtin_bit_cast(float, __builtin_amdgcn_readlane(__builtin_bit_cast(int, a1), ((e >> 2) & 1) | (((e >> 1) & 1) << 1) | ((e & 1) << 2))); }
                        if (lane == 0) { int i1 = 0; float v1 = lg[0];
#pragma unroll
                            for (int e = 1; e < 8; ++e) if (lg[e] > v1) { v1 = lg[e]; i1 = e; }
                            int i2 = -1; float v2 = -INFINITY;
#pragma unroll
                            for (int e = 0; e < 8; ++e) if (e != i1 && lg[e] > v2) { v2 = lg[e]; i2 = e; }
                            const float w1 = 1.f / (1.f + expf(v2 - v1));
                            LE[2 * tl] = i1; LE[2 * tl + 1] = i2; LW[2 * tl] = w1; LW[2 * tl + 1] = 1.f - w1; }
                    }
                    LDS_WAIT(); __syncthreads();
                    if (tid < 8) { int c = 0; for (int i = 0; i < 128; ++i) if (LE[i] == tid) LR[i] = c++; LC[tid] = c; }
                    LDS_WAIT(); __syncthreads();
                    if (tid < 64) { const int tok = 64 * tb + tid; u32x4 a, b2; a.x = LE[2 * tid]; a.y = LE[2 * tid + 1]; a.z = LR[2 * tid]; a.w = LR[2 * tid + 1];
                        b2.x = __builtin_bit_cast(unsigned, LW[2 * tid]); b2.y = __builtin_bit_cast(unsigned, LW[2 * tid + 1]); b2.z = 0u; b2.w = 0u;
                        *(u32x4*)(route + (size_t)tok * 8) = a; *(u32x4*)(route + (size_t)tok * 8 + 4) = b2; }
                    if (tid < 8) cntg[tb * 8 + tid] = (unsigned)LC[tid];
                    LDS_WAIT(); __syncthreads();
                }
                SEAM(pb + PO_F0);
            }
            if (PM(16) && IN(pb + PO_F0 + 1)) {
            PHASE_IDS
                LAS unsigned* CN = (LAS unsigned*)(lds + 4096);
                LAS unsigned* SB = (LAS unsigned*)(lds + 2048);
                LAS unsigned* TOTS = (LAS unsigned*)(lds + 2048 + 64);
                LAS unsigned* MYB = (LAS unsigned*)(lds + 2048 + 128);
                const float* gain = ap_->in[I_NORM_FFN] + DM;
                for (int rep_ = 0; rep_ < REPN(16); ++rep_)
                for (int tb = bid; tb < T / 64; tb += G) {
                    for (int i = tid; i < 2048; i += 512) CN[i] = cntg[i];
                    LDS_WAIT(); __syncthreads();
                    if (tid < 8) { unsigned tot = 0, myb = 0; for (int w = 0; w < 256; ++w) { const unsigned c = CN[w * 8 + tid]; if (w < tb) myb += c; tot += c; } TOTS[tid] = tot; MYB[tid] = myb; }
                    LDS_WAIT(); __syncthreads();
                    if (tid == 0) { unsigned toff = 0; for (int e = 0; e < 8; ++e) { SB[e] = toff * 256 + MYB[e]; const unsigned nte = (TOTS[e] + 255) >> 8;
                            if (tb == 0) for (unsigned k = 0; k < nte; ++k) tinfo[8 + toff + k] = e;
                            toff += nte; }
                        if (tb == 0) tinfo[0] = toff; }
                    LDS_WAIT(); __syncthreads();
                    f32x4 ggr[4];
#pragma unroll
                    for (int j = 0; j < 4; ++j) ggr[j] = ((const f32x4*)gain)[lane + 64 * j];
#pragma unroll 1
                    for (int k0 = 0; k0 < 8; k0 += 4) {
                        u32x4 ra[4], rb[4]; f32x4 xv[4][4];
#pragma unroll
                        for (int q = 0; q < 4; ++q) { const int tok = 64 * tb + 8 * wid + k0 + q; ra[q] = *(const u32x4*)(route + (size_t)tok * 8); rb[q] = *(const u32x4*)(route + (size_t)tok * 8 + 4);
#pragma unroll
                            for (int j = 0; j < 4; ++j) xv[q][j] = xrow4(W16(WS_XB2), ap_->out, (size_t)tok, lane + 64 * j); }
#pragma unroll
                        for (int q = 0; q < 4; ++q) { const int tok = 64 * tb + 8 * wid + k0 + q;
                            const unsigned s1 = SB[ra[q].x] + ra[q].z, s2 = SB[ra[q].y] + ra[q].w;
                            if (lane == 0) { u32x4 o; o.x = s1; o.y = s2; o.z = rb[q].x; o.w = rb[q].y; *(u32x4*)(slot + (size_t)tok * 4) = o; }
                            float sq = 0.f;
#pragma unroll
                            for (int j = 0; j < 4; ++j) { const f32x4 v = xv[q][j]; sq += (v.x * v.x + v.y * v.y) + (v.z * v.z + v.w * v.w); }
                            const float rs = 1.0f / sqrtf(wave_sum(sq) * (1.f / DM) + EPS);
                            unsigned long long* o1 = (unsigned long long*)(W16(WS_HP) + (size_t)s1 * DM) + lane; unsigned long long* o2 = (unsigned long long*)(W16(WS_HP) + (size_t)s2 * DM) + lane;
#pragma unroll
                            for (int j = 0; j < 4; ++j) { const f32x4 v = xv[q][j], gg = ggr[j];
                                const unsigned long long pk = (unsigned long long)pk2(v.x * rs * gg.x, v.y * rs * gg.y) | ((unsigned long long)pk2(v.z * rs * gg.z, v.w * rs * gg.w) << 32);
                                o1[64 * j] = pk; o2[64 * j] = pk; } }
                    }
                    LDS_WAIT(); __syncthreads();
                }
                SEAM(pb + PO_F0 + 1);
            }
#pragma unroll 1
            for (int ch = 0; ch < 2; ++ch) {
                const int t0 = ch * HALFT;
#define MOE_NM int nm = (int)tinfo[0] - t0; if (ch == 0) nm = nm > HALFT ? HALFT : nm; nm = nm < 0 ? 0 : (nm > CH1T ? CH1T : nm);
                if (PM(17) && IN(pb + PO_F0 + 2 + 2 * ch)) {
            PHASE_IDS
                    MOE_NM
                    pg8::Gemm g{(const char*)(ws + WS_HP + (size_t)t0 * 256 * DM * 2), (const char*)(ws + WS_MGU), DM, DM, DM};
                    SchedMoe S; S.o.init(nm, 2 * DFFE / 256, G, bid); S.texp = tinfo + 8; S.t0 = t0; S.nn = 2 * DFFE / 256; S.astep = 256L * DM * 2; S.bstep = 256L * DM * 2; S.estep = 7168L * DM * 2; S.cstep = 256L * DFFE; S.khb = 0; S.khc = 0;
                    EpiSwiglu<0> E{W16(WS_ACTC), DFFE, nullptr};
                    for (int rep_ = 0; rep_ < REPN(17); ++rep_) pg8::gemm_phase<EpiSwiglu<0>, SchedMoe, true, true>(lds, g, S, E, tid);
                    SEAM(pb + PO_F0 + 2 + 2 * ch);
                }
                if (PM(18) && IN(pb + PO_F0 + 3 + 2 * ch)) {
            PHASE_IDS
                    MOE_NM
                    pg8::Gemm g{(const char*)(ws + WS_ACTC), (const char*)(ws + WS_MD), DFFE / 2, DFFE, DFFE};
                    SchedMoe S; S.o.init(nm, 2 * DM / 256, G, bid); S.texp = tinfo + 8; S.t0 = t0; S.nn = DM / 256; S.astep = 256L * DFFE * 2; S.bstep = 256L * DFFE * 2; S.estep = 1024L * DFFE * 2; S.cstep = 0;
                    S.khb = (long)(DFFE / 2) * 2; S.khc = ((long)WS_YB - (long)WS_HP) / 2;
                    EpiPlain E{W16(WS_HP), DM, nullptr};
                    for (int rep_ = 0; rep_ < REPN(18); ++rep_) pg8::gemm_phase<EpiPlain, SchedMoe, true, true>(lds, g, S, E, tid);
                    SEAM(pb + PO_F0 + 3 + 2 * ch);
                }
            }
            if (PM(19) && IN(pb + PO_F0 + 6)) {
            PHASE_IDS
                const float* gain = ap_->in[I_NORM_FINAL];
                f32x4 gg[4];
#pragma unroll
                for (int j = 0; j < 4; ++j) gg[j] = ((const f32x4*)gain)[lane + 64 * j];
#define BLO(u) __builtin_bit_cast(float, (u) << 16)
#define BHI(u) __builtin_bit_cast(float, (u) & 0xffff0000u)
                int r = gw;
                u32x2 si = {0u, 0u}; float w1 = 0.f, w2 = 0.f; f32x4 xv[4];
                if (r < T) { si = *(const u32x2*)(slot + (size_t)r * 4); w1 = ((const float*)slot)[(size_t)r * 4 + 2]; w2 = ((const float*)slot)[(size_t)r * 4 + 3];
#pragma unroll
                    for (int j = 0; j < 4; ++j) xv[j] = xrow4(W16(WS_XB2), ap_->out, (size_t)r, lane + 64 * j); }
                while (r < T) {
                    asm volatile("" : "+v"(w1), "+v"(w2));
                    const u32x2* y1 = (const u32x2*)(W16(WS_HP) + (size_t)si.x * DM) + lane; const u32x2* y2 = (const u32x2*)(W16(WS_HP) + (size_t)si.y * DM) + lane;
                    const u32x2* z1 = (const u32x2*)(W16(WS_YB) + (size_t)si.x * DM) + lane; const u32x2* z2 = (const u32x2*)(W16(WS_YB) + (size_t)si.y * DM) + lane;
                    u32x2 a[4], c[4], a2[4], c2[4];
#pragma unroll
                    for (int j = 0; j < 4; ++j) { a[j] = y1[64 * j]; c[j] = y2[64 * j]; a2[j] = z1[64 * j]; c2[j] = z2[64 * j]; }
                    const int rn = r + NGW; u32x2 sin = {0u, 0u}; float w1n = 0.f, w2n = 0.f; f32x4 xn[4];
                    if (rn < T) { sin = *(const u32x2*)(slot + (size_t)rn * 4); w1n = ((const float*)slot)[(size_t)rn * 4 + 2]; w2n = ((const float*)slot)[(size_t)rn * 4 + 3];
#pragma unroll
                        for (int j = 0; j < 4; ++j) xn[j] = xrow4(W16(WS_XB2), ap_->out, (size_t)rn, lane + 64 * j); }
                    f32x4 v[4]; float s = 0.f;
#pragma unroll
                    for (int j = 0; j < 4; ++j) { const f32x4 x = xv[j];
                        v[j].x = x.x + w1 * (BLO(a[j].x) + BLO(a2[j].x)) + w2 * (BLO(c[j].x) + BLO(c2[j].x));
                        v[j].y = x.y + w1 * (BHI(a[j].x) + BHI(a2[j].x)) + w2 * (BHI(c[j].x) + BHI(c2[j].x));
                        v[j].z = x.z + w1 * (BLO(a[j].y) + BLO(a2[j].y)) + w2 * (BLO(c[j].y) + BLO(c2[j].y));
                        v[j].w = x.w + w1 * (BHI(a[j].y) + BHI(a2[j].y)) + w2 * (BHI(c[j].y) + BHI(c2[j].y));
                        s += (v[j].x * v[j].x + v[j].y * v[j].y) + (v[j].z * v[j].z + v[j].w * v[j].w); }
                    const float rs = 1.0f / sqrtf(wave_sum(s) * (1.f / DM) + EPS);
                    f32x4* orow = (f32x4*)(ap_->out + (size_t)r * DM) + lane;
#pragma unroll
                    for (int j = 0; j < 4; ++j) orow[64 * j] = (f32x4){v[j].x * rs * gg[j].x, v[j].y * rs * gg[j].y, v[j].z * rs * gg[j].z, v[j].w * rs * gg[j].w};
                    r = rn; si = sin; w1 = w1n; w2 = w2n;
#pragma unroll
                    for (int j = 0; j < 4; ++j) xv[j] = xn[j];
                }
            }
        }
}

__global__ void __launch_bounds__(NWAVES * 64, 2) fwd(Args args) {
    extern __shared__ __attribute__((aligned(16))) unsigned char lds_raw[];
    LAS unsigned char* lds = (LAS unsigned char*)lds_raw;
    const int G = gridDim.x, bid = blockIdx.x, NGW = G * NWAVES;
    const int wid0 = __builtin_amdgcn_readfirstlane((int)threadIdx.x >> 6);
    unsigned* ctl = (unsigned*)(args.ws + WS_CTL);
    const int lo = args.ph_lo, hi = args.ph_hi;
    for (int u = threadIdx.x; u < (LDS_BYTES - LDSCTL_OFF) / 4; u += NWAVES * 64) ((LAS unsigned*)(lds + LDSCTL_OFF))[u] = 0u;
    __syncthreads();
#if DBG >= 200 || TSPIN_ORD >= 0
    if (blockIdx.x == 0 && threadIdx.x == 0) ((unsigned long long*)(ctl + 20000))[63] = __builtin_amdgcn_s_memrealtime();
#endif
    const bool multi = (hi - lo) > 1;
    XcdBarrier bar; bar.bar = ctl + CW_BAR; bar.x = 0; bar.st = nullptr;
    if (multi) bar = xcd_barrier_post(ctl + CW_BAR, (volatile LAS unsigned*)(lds + LDSCTL_OFF + 32));

    if (PM(0) && IN(PH_PRO)) {
            PHASE_IDS
        LAS float* scr = (LAS float*)(lds + wid * 16896);
        constexpr int IT_WIN = 16 * 64, IT_WOUT = 8 * 32, IT_SQ = 16 * 16, IT_C1 = 32 * 4, IT_C2 = 4 * 8, IT_FG = 16 * 44, IT_FD = 44 * 16;
        constexpr int N0 = 2 * IT_WIN, N1 = N0 + 2 * IT_WOUT, N2 = N1 + 8 * IT_SQ, N3 = N2 + 4 * IT_C1, N4 = N3 + 4 * IT_C2, N5 = N4 + 2 * IT_FG, N6 = N5 + IT_FD;
        for (int rep_ = 0; rep_ < REP_PRO; ++rep_)
        for (int it = gw; it < N6; it += NGW) {
            if (it < N0) { const int l = it / IT_WIN, r = it % IT_WIN, kb = r / 64, j = r % 64;
                int n0, ncv, dr = 32 * j;
                if (j < 40) { n0 = 32 * j; ncv = 32; } else if (j < 56) { n0 = 1304 + 32 * (j - 40); ncv = 32; } else if (j == 56) { n0 = 1280; ncv = 24; } else { n0 = 0; ncv = 0; }
                xpose_item(ap_->in[I_W_IN] + (size_t)l * DM * 1816, 1816, 64 * kb, n0, ncv, W16(WS_WIN) + (size_t)l * ZW * DM, DM, dr, scr, lane, ap_->in[I_NORM_MIX] + l * DM);
            } else if (it < N1) { const int r0 = it - N0, l = r0 / IT_WOUT, r = r0 % IT_WOUT, kb = r / 32, j = r % 32;
                xpose_item(ap_->in[I_W_OUT] + (size_t)l * DM * DM, DM, 64 * kb, 32 * j, 32, W16(WS_WOUT) + (size_t)l * DM * DM, DM, 32 * j, scr, lane);
            } else if (it < N2) { const int r0 = it - N1, mtx = r0 / IT_SQ, r = r0 % IT_SQ, which = mtx >> 1, l = mtx & 1;
                const float* src = ap_->in[which == 0 ? I_WQ : which == 1 ? I_WO : which == 2 ? I_WK : I_WV] + (size_t)l * DM * DM;
                bf16_t* dst = W16(which == 0 ? WS_WQ : which == 1 ? WS_WO : which == 2 ? WS_WK : WS_WV) + (size_t)l * DM * DM;
                xpose_mat(src, DM, DM, dst, 0, r, scr, lane, which == 0 ? ap_->in[I_NORM_X] + l * DM : nullptr);
            } else if (it < N3) { const int r0 = it - N2, mtx = r0 / IT_C1, r = r0 % IT_C1, l = mtx >> 1, kv = mtx & 1;
                xpose_mat(ap_->in[kv ? I_W1_V : I_W1_K] + (size_t)l * 2048 * 256, 2048, 256, W16(WS_CW1) + (size_t)mtx * 256 * 2048, 0, r, scr, lane);
            } else if (it < N4) { const int r0 = it - N3, mtx = r0 / IT_C2, r = r0 % IT_C2, l = mtx >> 1, kv = mtx & 1, kb = r / 8, j = r % 8;
                xpose_item(ap_->in[kv ? I_W2_V : I_W2_K] + (size_t)l * 256 * 64, 64, 64 * kb, j < 2 ? 32 * j : 0, j < 2 ? 32 : 0, W16(WS_CW2) + (size_t)mtx * 256 * 256, 256, 32 * j, scr, lane);
            } else if (it < N5) { const int r0 = it - N4, up = r0 / IT_FG, r = r0 % IT_FG;
                xpose_mat(ap_->in[up ? I_FFN_WU : I_FFN_WG], DM, DFF, W16(WS_FGU), up ? 2 : 1, r, scr, lane, ap_->in[I_NORM_FFN]);
            } else if (it < N6) { xpose_mat(ap_->in[I_FFN_WD], DFF, DM, W16(WS_FD), 0, it - N5, scr, lane);
            }
        }
#if TSPIN_ORD == 101 || TSPIN_ORD == 102
        if (bid == 0 && tid == 0) ((unsigned long long*)(ctl + 20000))[60] = __builtin_amdgcn_s_memrealtime();
#endif
        for (int i = bid * 512 + tid; i < SEQ * 8; i += G * 512) {
            const int pos = i >> 3, j = i & 7;
            const double inv = j == 0 ? 1.0 : j == 1 ? 0.19389587045179572 : j == 2 ? 0.037606030930863934 : j == 3 ? 0.007291654101443755 : j == 4 ? 0.0014142135623730951
                             : j == 5 ? 0.00027421616994972156 : j == 6 ? 5.3169310700017e-05 : 1.0309310618636385e-05;
            float s, c; sincos_d((double)pos * inv, s, c);
            ((float*)(ws + WS_ROPE))[2 * i] = c; ((float*)(ws + WS_ROPE))[2 * i + 1] = s;
        }
        for (int r0 = gw; r0 < T; r0 += 4 * NGW) {
            f32x4 xv[4][4];
#pragma unroll
            for (int q = 0; q < 4; ++q)
#pragma unroll
                for (int j = 0; j < 4; ++j) xv[q][j] = ((const f32x4*)(ap_->in[I_X] + (size_t)(r0 + q * NGW) * DM) + lane)[64 * j];
#pragma unroll
            for (int q = 0; q < 4; ++q) { const int r = r0 + q * NGW; unsigned long long* o8 = (unsigned long long*)(W16(WS_HB) + (size_t)r * DM) + lane; float sq = 0.f;
#pragma unroll
                for (int j = 0; j < 4; ++j) { const f32x4 v = xv[q][j]; sq += (v.x * v.x + v.y * v.y) + (v.z * v.z + v.w * v.w); o8[64 * j] = (unsigned long long)pk2(v.x, v.y) | ((unsigned long long)pk2(v.z, v.w) << 32); }
                sq = wave_sum(sq); if (lane == 0) SSP(0)[r] = ss_fix(sq); } }
        for (int r = gw; r < 2 * 1024; r += NGW) { const int l = r >> 10, row = r & 1023;
            norm_row(ap_->in[I_MEM] + (size_t)row * DM, ap_->in[I_NORM_MEM] + l * DM, W16(WS_MN) + (size_t)r * DM, lane); }
#if TSPIN_ORD == 101 || TSPIN_ORD == 102
        if (bid == 0 && tid == 0) ((unsigned long long*)(ctl + 20000))[61] = __builtin_amdgcn_s_memrealtime();
#endif
        for (int itb = gw; itb < 4 * 4 * 16; itb += NGW) { const int mtx = itb >> 6, cg = (itb >> 4) & 3, fc = itb & 15, l = mtx >> 1, kv = mtx & 1, c = cg * 64 + lane;
            const float* pe = ap_->in[kv ? I_PE_V : I_PE_K] + l * 2048 + fc * 128; const float* w1 = ap_->in[kv ? I_W1_V : I_W1_K] + (size_t)l * 2048 * 256 + (size_t)fc * 128 * 256 + c;
            float a = fc == 0 ? ap_->in[kv ? I_B1_V : I_B1_K][l * 256 + c] : 0.f;
#pragma unroll
            for (int h = 0; h < 2; ++h) { float wv[64];
#pragma unroll
                for (int f = 0; f < 64; ++f) wv[f] = w1[(size_t)(64 * h + f) * 256];
#pragma unroll
                for (int f = 0; f < 64; ++f) a += pe[64 * h + f] * wv[f]; }
            atomicAdd((unsigned long long*)(ctl + CW_BIAS) + mtx * 256 + c, (unsigned long long)(long long)((double)a * 1099511627776.0)); }
        for (int itw = gw; itw < 2 * 4 * 16 * 16; itw += NGW) { const int l = itw >> 10, g = (itw >> 8) & 3, nb = (itw >> 4) & 15, cb = itw & 15, n = nb * 64 + lane;
            const float* wp = ap_->in[I_W_POOL] + ((size_t)(l * 4 + g) * 128 + cb * 8) * 128; const float* ps = ap_->in[I_POOL_SCALE] + l * 512 + g * 128;
            const float* wo = ap_->in[I_W_OUT] + (size_t)l * DM * DM + (size_t)(512 + g * 128) * DM + n;
            float a[8];
#pragma unroll
            for (int c = 0; c < 8; ++c) a[c] = 0.f;
#pragma unroll
            for (int h = 0; h < 2; ++h) { float wv[64];
#pragma unroll
                for (int e = 0; e < 64; ++e) wv[e] = wo[(size_t)(64 * h + e) * DM];
#pragma unroll
                for (int e = 0; e < 64; ++e) { const float w = wv[e] * ps[64 * h + e];
#pragma unroll
                    for (int c = 0; c < 8; ++c) a[c] += wp[c * 128 + 64 * h + e] * w; } }
            u32x4 o; o.x = pk2(a[0], a[1]); o.y = pk2(a[2], a[3]); o.z = pk2(a[4], a[5]); o.w = pk2(a[6], a[7]);
            *(u32x4*)(W16(WS_WOUT) + (size_t)l * DM * DM + (size_t)n * DM + 512 + g * 128 + cb * 8) = o; }
        __syncthreads();
        SEAM(PH_PRO);
    }
    layer_phases<0>(lds, lo, hi, bar, G, bid, NGW, wid0);
    layer_phases<1>(lds, lo, hi, bar, G, bid, NGW, wid0);
#if DBG >= 200
    __syncthreads(); if (blockIdx.x == 0 && threadIdx.x == 0) ((unsigned long long*)(ctl + 20000))[62] = __builtin_amdgcn_s_memrealtime();
#endif
#if TSPIN_ORD >= 0
    __syncthreads();
    if (blockIdx.x == 0 && threadIdx.x == 0) {
        volatile unsigned long long* st = (volatile unsigned long long*)(ctl + 20000);
        const unsigned long long tend = __builtin_amdgcn_s_memrealtime(); st[62] = tend;
        unsigned long long prev = st[63], dt = 0ull; int ord = 0;
        for (int i = 0; i < 60; ++i) { const unsigned long long v = st[i]; if (v == 0ull) continue; if (ord == TSPIN_ORD) dt = v - prev; prev = v; ++ord; }
        if (TSPIN_ORD == 21) dt = tend - prev;
        if (TSPIN_ORD == 100) dt = st[61] - st[60];
        if (TSPIN_ORD == 101) dt = st[60] - st[63];
        if (TSPIN_ORD == 102) dt = st[61] - st[60];
        while (__builtin_amdgcn_s_memrealtime() - tend < 10ull * dt) __builtin_amdgcn_s_sleep(8);
    }
#endif
#undef IN
#undef SEAM
}

#if DBG
struct DbgIn { const float* in[30]; };
__device__ float dbg_block_sum(float v, float* red) { const int t = threadIdx.x; red[t] = v; __syncthreads(); for (int o = 128; o > 0; o >>= 1) { if (t < o) red[t] += red[t + o]; __syncthreads(); } const float r = red[0]; __syncthreads(); return r; }
__global__ void dbg_check(DbgIn di, const float* xcur, unsigned char* ws, int stage) {
    __shared__ float red[256]; __shared__ float act[3584]; __shared__ float hrow[1024];
    const int t = threadIdx.x; float* W = (float*)(ws + WS_CTL) + 16000;
    const unsigned* sl = (const unsigned*)(ws + WS_SLOT); const unsigned* rt = (const unsigned*)(ws + WS_ROUTE); const bf16_t* hp = (const bf16_t*)(ws + WS_HP); const bf16_t* ac = (const bf16_t*)(ws + WS_ACTC);
    const int toks[4] = {0, 5000, 12000, 16383}; float worst = 0.f; int nchk = 0;
    for (int q = 0; q < 4; ++q) for (int kk = 0; kk < 2; ++kk) { const int tok = toks[q]; const unsigned e = rt[tok * 8 + kk], sidx = sl[tok * 4 + kk]; const int ch = sidx >= (unsigned)(HALFT * 256) ? 1 : 0;
        if (stage == 1) {
            float ss = 0.f; for (int c = t; c < 1024; c += 256) { const float x = xcur[(size_t)tok * 1024 + c]; ss += x * x; } ss = dbg_block_sum(ss, red);
            const float rs = 1.f / sqrtf(ss / 1024.f + EPS); float num = 0.f, den = 0.f;
            for (int c = t; c < 1024; c += 256) { const float h = xcur[(size_t)tok * 1024 + c] * rs * di.in[I_NORM_FFN][1024 + c], f = bf2f(hp[(size_t)sidx * 1024 + c]); num += (h - f) * (h - f); den += h * h; }
            num = dbg_block_sum(num, red); den = dbg_block_sum(den, red); worst = fmaxf(worst, sqrtf(num / fmaxf(den, 1e-20f))); ++nchk;
        } else if ((stage == 2 && ch == 0) || (stage == 4 && ch == 1)) {
            for (int c = t; c < 1024; c += 256) hrow[c] = bf2f(hp[(size_t)sidx * 1024 + c]); __syncthreads();
            const float* wg = di.in[I_MOE_WG] + (size_t)e * DM * DFFE; const float* wu = di.in[I_MOE_WU] + (size_t)e * DM * DFFE; float num = 0.f, den = 0.f;
            for (int j = t; j < 3584; j += 256) { float g = 0.f, u = 0.f; for (int k2 = 0; k2 < 1024; ++k2) { g += hrow[k2] * wg[(size_t)k2 * DFFE + j]; u += hrow[k2] * wu[(size_t)k2 * DFFE + j]; }
                const float a = g / (1.f + expf(-g)) * u, f = bf2f(ac[((size_t)sidx - (size_t)ch * HALFT * 256) * 3584 + j]); num += (a - f) * (a - f); den += a * a; }
            num = dbg_block_sum(num, red); den = dbg_block_sum(den, red); worst = fmaxf(worst, sqrtf(num / fmaxf(den, 1e-20f))); ++nchk; __syncthreads();
        } else if ((stage == 3 && ch == 0) || (stage == 5 && ch == 1)) {
            for (int j = t; j < 3584; j += 256) act[j] = bf2f(ac[((size_t)sidx - (size_t)ch * HALFT * 256) * 3584 + j]); __syncthreads();
            const float* wd = di.in[I_MOE_WD] + (size_t)e * DFFE * DM; float num = 0.f, den = 0.f;
            for (int n = t; n < 1024; n += 256) { float y = 0.f; for (int j = 0; j < 3584; ++j) y += act[j] * wd[(size_t)j * DM + n]; const float f = bf2f(hp[(size_t)sidx * 1024 + n]); num += (y - f) * (y - f); den += y * y; }
            num = dbg_block_sum(num, red); den = dbg_block_sum(den, red); worst = fmaxf(worst, sqrtf(num / fmaxf(den, 1e-20f))); ++nchk; __syncthreads();
        } }
    if (stage == 1) {
        float mism = 0.f, werr = 0.f;
        for (int q = 0; q < 64; ++q) { const int tok = q * 251 + 3;
            float ss = 0.f; for (int c = t; c < 1024; c += 256) { const float x = xcur[(size_t)tok * 1024 + c]; ss += x * x; } ss = dbg_block_sum(ss, red);
            const float rs = 1.f / sqrtf(ss / 1024.f + EPS); float lg[8];
            for (int e = 0; e < 8; ++e) { float a = 0.f; for (int c = t; c < 1024; c += 256) a += xcur[(size_t)tok * 1024 + c] * rs * di.in[I_NORM_FFN][1024 + c] * di.in[I_ROUTER][c * 8 + e]; lg[e] = dbg_block_sum(a, red); }
            int i1 = 0; for (int e = 1; e < 8; ++e) if (lg[e] > lg[i1]) i1 = e; int i2 = -1; for (int e = 0; e < 8; ++e) if (e != i1 && (i2 < 0 || lg[e] > lg[i2])) i2 = e;
            const float w1 = 1.f / (1.f + expf(lg[i2] - lg[i1]));
            if ((int)rt[tok * 8] != i1 || (int)rt[tok * 8 + 1] != i2) mism += 1.f;
            werr = fmaxf(werr, fabsf(w1 - __builtin_bit_cast(float, rt[tok * 8 + 4]))); }
        if (t == 0) { W[8] = mism; W[9] = werr; } }
    if (stage == 5) {
        float sx = 0.f, sm = 0.f;
        for (int q = 0; q < 4; ++q) { const int tok = toks[q]; const unsigned s1 = sl[tok * 4], s2 = sl[tok * 4 + 1]; const float w1 = __builtin_bit_cast(float, sl[tok * 4 + 2]), w2 = __builtin_bit_cast(float, sl[tok * 4 + 3]);
            for (int c = t; c < 1024; c += 256) { const float x = xcur[(size_t)tok * 1024 + c], m = w1 * bf2f(hp[(size_t)s1 * 1024 + c]) + w2 * bf2f(hp[(size_t)s2 * 1024 + c]); sx += x * x; sm += m * m; } }
        sx = dbg_block_sum(sx, red); sm = dbg_block_sum(sm, red);
        if (t == 0) { W[6] = sx / 4096.f; W[7] = sm / 4096.f; } }
    if (t == 0) { W[stage] = worst; W[10 + stage] = (float)nchk; }
}
__global__ void dbg_attn(unsigned char* ws, int b, int g, int t, int slotw) {
    __shared__ float red[256]; __shared__ float lgt[4096]; __shared__ float pcs[4][256]; __shared__ float osum[4][64]; __shared__ int selb[64]; __shared__ float impv[64];
    const int tid = threadIdx.x, bg = b * 2 + g, tok = b * SEQ + t; float* W = (float*)(ws + WS_CTL) + 16000;
    const bf16_t* qraw = (const bf16_t*)(ws + WS_QRAW) + ((size_t)bg * SEQ + t) * 256; const bf16_t* qrot = (const bf16_t*)(ws + WS_QROT) + ((size_t)bg * SEQ + t) * 256;
    const bf16_t* kc = (const bf16_t*)(ws + WS_KCMP) + (size_t)bg * 256 * 64; const bf16_t* vc = kc + 8 * 256 * 64;
    const bf16_t* kvb = (const bf16_t*)(ws + WS_KV); const float* gt = (const float*)(ws + WS_GATES) + (size_t)tok * 24 + g * 12;
    const int nv = t >= 15 ? ((t - 15) >> 4) : 0, tb = t >> 6;
    for (int i = tid; i < 256; i += 256) osum[i >> 6][i & 63] = 0.f;
    __syncthreads();
    for (int r = 0; r < 4; ++r) {
        float s = -INFINITY; const int c = tid;
        if (c < 255 && c < nv) { s = 0.f; for (int d = 0; d < 64; ++d) s += bf2f(qraw[r * 64 + d]) * bf2f(kc[c * 64 + d]); }
        red[tid] = s; __syncthreads(); for (int o = 128; o > 0; o >>= 1) { if (tid < o) red[tid] = fmaxf(red[tid], red[tid + o]); __syncthreads(); } float m = red[0]; __syncthreads(); if (m == -INFINITY) m = 0.f;
        const float p = s == -INFINITY ? 0.f : exp2f(s - m); const float l = dbg_block_sum(p, red);
        pcs[r][c] = l > 0.f ? p / l : 0.f; __syncthreads();
        if (tid < 64) { float o = 0.f; for (int cc = 0; cc < 255; ++cc) o += bf2f((unsigned short)f2bf(pcs[r][cc])) * bf2f(vc[cc * 64 + tid]); osum[r][tid] += gt[r * 3 + 0] * o; }
        __syncthreads();
    }
    if (tid < 64) { float im = 0.f; for (int j = -1; j < 4; ++j) { const int c = 4 * tid + j; if (c >= 0 && c < 255) for (int r = 0; r < 4; ++r) im += pcs[r][c]; }
        const bool fut = tid > tb, forced = tid == 0 || tid == tb || tid == tb - 1; impv[tid] = fut ? -INFINITY : forced ? INFINITY : im; selb[tid] = 0; }
    __syncthreads();
    if (tid == 0) { for (int k = 0; k < 16; ++k) { int best = -1; float bv = 0.f; for (int n = 0; n < 64; ++n) if (!selb[n] && (best < 0 || impv[n] > bv)) { best = n; bv = impv[n]; } selb[best] = 1; } }
    __syncthreads();
    for (int br = 1; br <= 2; ++br) {
        const bf16_t* kb = kvb + (size_t)(br == 1 ? 2 : 4) * KVSZ + (size_t)bg * SEQ * 64; const bf16_t* vb = kvb + (size_t)(br == 1 ? 3 : 5) * KVSZ + (size_t)bg * SEQ * 64;
        for (int r = 0; r < 4; ++r) {
            float mx = -INFINITY;
            for (int j = tid; j < SEQ; j += 256) { bool ok = j <= t; if (br == 1) ok = ok && selb[j >> 6]; else ok = ok && (t - j) < 512;
                float sv = -INFINITY; if (ok) { sv = 0.f; for (int d = 0; d < 64; ++d) sv += bf2f(qrot[r * 64 + d]) * bf2f(kb[(size_t)j * 64 + d]); } lgt[j] = sv; mx = fmaxf(mx, sv); }
            red[tid] = mx; __syncthreads(); for (int o = 128; o > 0; o >>= 1) { if (tid < o) red[tid] = fmaxf(red[tid], red[tid + o]); __syncthreads(); } const float m = red[0]; __syncthreads();
            float ls = 0.f; for (int j = tid; j < SEQ; j += 256) { const float p = lgt[j] == -INFINITY ? 0.f : exp2f(lgt[j] - m); lgt[j] = p; ls += p; }
            const float l = dbg_block_sum(ls, red);
            if (tid < 64) { float o = 0.f; for (int j = 0; j <= t; ++j) o += lgt[j] * bf2f(vb[(size_t)j * 64 + tid]); osum[r][tid] += gt[r * 3 + br] * o / l; }
            __syncthreads();
        }
    }
    const bf16_t* ab = (const bf16_t*)(ws + WS_AB) + (size_t)tok * 1024 + g * 256;
    float num = 0.f, den = 0.f; { const float o = osum[tid >> 6][tid & 63], f = bf2f(ab[tid]); num = (o - f) * (o - f); den = o * o; }
    num = dbg_block_sum(num, red); den = dbg_block_sum(den, red);
    if (tid == 0) { W[slotw] = sqrtf(num / fmaxf(den, 1e-30f)); W[slotw + 40] = sqrtf(den / 256.f); }
}
__global__ void dbg_mixer(DbgIn di, const float* outp, unsigned char* ws, int stage) {
    __shared__ float red[256]; __shared__ float hrow[1024]; __shared__ float zrow[1816]; __shared__ float hid[256];
    const int t = threadIdx.x; float* W = (float*)(ws + WS_CTL) + 16000;
    const bf16_t* hb = (const bf16_t*)(ws + WS_HB); const bf16_t* kvb = (const bf16_t*)(ws + WS_KV);
    const int toks[4] = {7, 4101, 9000, 16383};
    if (stage == 30) {
        float nq = 0, dq = 0, nr = 0, dr = 0, nk = 0, dk = 0, nkr = 0, dkr = 0, nu = 0, du = 0, ng = 0, dg = 0;
        for (int q = 0; q < 4; ++q) { const int tok = toks[q], b = tok >> 12, pos = tok & 4095;
            for (int c = t; c < 1024; c += 256) hrow[c] = bf2f(hb[(size_t)tok * 1024 + c]); __syncthreads();
            for (int n = t; n < 1816; n += 256) { float a = 0.f; for (int k = 0; k < 1024; ++k) a += hrow[k] * di.in[I_W_IN][(size_t)k * 1816 + n]; zrow[n] = a; } __syncthreads();
            for (int n = t; n < 1816; n += 256) { const float z = zrow[n];
                if (n < 512) { const int g = n >> 8, c = n & 255, d = n & 63; const size_t idx = ((size_t)(b * 2 + g) * SEQ + pos) * 256 + c;
                    const float f = bf2f(((const bf16_t*)(ws + WS_QRAW))[idx]) / C2; nq += (z - f) * (z - f); dq += z * z;
                    float zr = z; if (d < 16) { const int j = d & 7; const double inv = pow(500000.0, -(double)j / 8.0); const float cs = (float)cos((double)pos * inv), sn = (float)sin((double)pos * inv);
                        zr = d < 8 ? z * cs - zrow[n + 8] * sn : z * cs + zrow[n - 8] * sn; }
                    const float fr = bf2f(((const bf16_t*)(ws + WS_QROT))[idx]) / C2; nr += (zr - fr) * (zr - fr); dr += zr * zr;
                } else if (n < 1280) { const int m = n - 512, i = m >> 7, g = (m >> 6) & 1, d = m & 63; const float f = bf2f(kvb[(size_t)i * KVSZ + ((size_t)(b * 2 + g) * SEQ + pos) * 64 + d]);
                    if (i == 2 || i == 4) { float zr = z; if (d < 16) { const int j = d & 7; const double inv = pow(500000.0, -(double)j / 8.0); const float cs = (float)cos((double)pos * inv), sn = (float)sin((double)pos * inv);
                            zr = d < 8 ? z * cs - zrow[n + 8] * sn : z * cs + zrow[n - 8] * sn; } nkr += (zr - f) * (zr - f); dkr += zr * zr; }
                    else { nk += (z - f) * (z - f); dk += z * z; }
                } else if (n < 1304) { const float sg = 1.f / (1.f + expf(-z)), f = ((const float*)(ws + WS_GATES))[(size_t)tok * 24 + (n - 1280)]; ng += (sg - f) * (sg - f); dg += sg * sg;
                } else { const float f = bf2f(((const bf16_t*)(ws + WS_U))[(size_t)tok * 512 + (n - 1304)]); nu += (z - f) * (z - f); du += z * z; } }
            __syncthreads(); }
        nq = dbg_block_sum(nq, red); dq = dbg_block_sum(dq, red); nr = dbg_block_sum(nr, red); dr = dbg_block_sum(dr, red); nk = dbg_block_sum(nk, red); dk = dbg_block_sum(dk, red);
        nkr = dbg_block_sum(nkr, red); dkr = dbg_block_sum(dkr, red); nu = dbg_block_sum(nu, red); du = dbg_block_sum(du, red); ng = dbg_block_sum(ng, red); dg = dbg_block_sum(dg, red);
        if (t == 0) { W[30] = sqrtf(nq / dq); W[31] = sqrtf(nr / dr); W[32] = sqrtf(nk / dk); W[33] = sqrtf(nkr / dkr); W[34] = sqrtf(nu / du); W[35] = sqrtf(ng / dg); }
    }
    if (stage == 31) {
        float nc = 0, dc = 0, nd = 0, dd = 0;
        const int cs_[4] = {0, 17, 200, 254};
        for (int q = 0; q < 4; ++q) for (int kv = 0; kv < 2; ++kv) { const int bg = (q * 3 + 1) & 7, c = cs_[q];
            const bf16_t* src = kvb + (size_t)kv * KVSZ + ((size_t)bg * SEQ + 16 * c) * 64; const float* pe = di.in[kv ? I_PE_V : I_PE_K]; const float* w1 = di.in[kv ? I_W1_V : I_W1_K]; const float* b1 = di.in[kv ? I_B1_V : I_B1_K]; const float* w2 = di.in[kv ? I_W2_V : I_W2_K];
            { float a = b1[t]; for (int f = 0; f < 2048; ++f) a += (bf2f(src[f]) + pe[f]) * w1[(size_t)f * 256 + t]; const float y = 0.7978845608f * (a + 0.044715f * a * a * a); hid[t] = 0.5f * a * (1.f + tanhf(y)); } __syncthreads();
            if (t < 64) { float o = 0.f; for (int h = 0; h < 256; ++h) o += hid[h] * w2[h * 64 + t]; const float f = bf2f(((const bf16_t*)(ws + WS_KCMP))[(size_t)kv * 8 * 256 * 64 + ((size_t)bg * 256 + c) * 64 + t]); nc += (o - f) * (o - f); dc += o * o; } __syncthreads(); }
        for (int q = 0; q < 4; ++q) { const int tok = toks[q], pos = tok & 4095; for (int c = t; c < 512; c += 256) { const int w = 2 << (c >> 7), n = (pos + 1) < w ? (pos + 1) : w; float sm = 0.f; const bf16_t* ub = (const bf16_t*)(ws + WS_U);
                for (int i = 0; i < n; ++i) sm += bf2f(ub[(size_t)(tok - i) * 512 + c]); const float d = sm / n - bf2f(ub[(size_t)tok * 512 + c]), f = bf2f(((const bf16_t*)(ws + WS_AB))[(size_t)tok * 1024 + 512 + c]); nd += (d - f) * (d - f); dd += d * d; } }
        nc = dbg_block_sum(nc, red); dc = dbg_block_sum(dc, red); nd = dbg_block_sum(nd, red); dd = dbg_block_sum(dd, red);
        if (t == 0) { W[36] = sqrtf(nc / dc); W[37] = sqrtf(nd / dd); }
    }
    if (stage == 32) {
        float nn = 0, dn = 0; const bf16_t* ab = (const bf16_t*)(ws + WS_AB);
        for (int q = 0; q < 4; ++q) { const int tok = toks[q];
            for (int c = t; c < 1024; c += 256) hrow[c] = bf2f(ab[(size_t)tok * 1024 + c]); __syncthreads();
            for (int ge = t; ge < 512; ge += 256) { const int g = ge >> 7, e = ge & 127; float y = 0.f; for (int c = 0; c < 128; ++c) y += hrow[512 + g * 128 + c] * di.in[I_W_POOL][((size_t)g * 128 + c) * 128 + e]; zrow[ge] = y * di.in[I_POOL_SCALE][ge]; } __syncthreads();
            for (int n = t; n < 1024; n += 256) { float a = di.in[I_X][(size_t)tok * 1024 + n]; const float x0 = a; for (int k = 0; k < 512; ++k) a += hrow[k] * di.in[I_W_OUT][(size_t)k * 1024 + n]; for (int k = 0; k < 512; ++k) a += zrow[k] * di.in[I_W_OUT][(size_t)(512 + k) * 1024 + n];
                const float f = outp[(size_t)tok * 1024 + n]; nn += (a - f) * (a - f); dn += (a - x0) * (a - x0); } __syncthreads(); }
        nn = dbg_block_sum(nn, red); dn = dbg_block_sum(dn, red);
        if (t == 0) W[38] = sqrtf(nn / dn);
    }
}
__global__ void dbg_moe_tok(DbgIn di, const float* xcur, unsigned char* ws) {
    __shared__ float red[256]; __shared__ float hrow[1024]; __shared__ float act[3584]; __shared__ float ynaive[1024];
    const int t = threadIdx.x, tok = blockIdx.x * 251 + 3; float* W = (float*)(ws + WS_CTL) + 16000;
    const unsigned* sl = (const unsigned*)(ws + WS_SLOT); const unsigned* rt = (const unsigned*)(ws + WS_ROUTE); const bf16_t* hp = (const bf16_t*)(ws + WS_HP);
    float ss = 0.f; for (int c = t; c < 1024; c += 256) { const float x = xcur[(size_t)tok * 1024 + c]; ss += x * x; } ss = dbg_block_sum(ss, red);
    const float rs = 1.f / sqrtf(ss / 1024.f + EPS);
    for (int c = t; c < 1024; c += 256) { hrow[c] = xcur[(size_t)tok * 1024 + c] * rs * di.in[I_NORM_FFN][1024 + c]; ynaive[c] = 0.f; } __syncthreads();
    float lg[8]; for (int e = 0; e < 8; ++e) { float a = 0.f; for (int c = t; c < 1024; c += 256) a += hrow[c] * di.in[I_ROUTER][c * 8 + e]; lg[e] = dbg_block_sum(a, red); }
    int i1 = 0; for (int e = 1; e < 8; ++e) if (lg[e] > lg[i1]) i1 = e; int i2 = -1; for (int e = 0; e < 8; ++e) if (e != i1 && (i2 < 0 || lg[e] > lg[i2])) i2 = e;
    const float w1 = 1.f / (1.f + expf(lg[i2] - lg[i1]));
    for (int kk = 0; kk < 2; ++kk) { const int e = kk ? i2 : i1; const float wgt = kk ? 1.f - w1 : w1;
        const float* wg = di.in[I_MOE_WG] + (size_t)e * DM * DFFE; const float* wu = di.in[I_MOE_WU] + (size_t)e * DM * DFFE; const float* wd = di.in[I_MOE_WD] + (size_t)e * DFFE * DM;
        for (int j = t; j < 3584; j += 256) { float g = 0.f, u = 0.f; for (int k2 = 0; k2 < 1024; ++k2) { g += hrow[k2] * wg[(size_t)k2 * DFFE + j]; u += hrow[k2] * wu[(size_t)k2 * DFFE + j]; } act[j] = g / (1.f + expf(-g)) * u; } __syncthreads();
        for (int n = t; n < 1024; n += 256) { float y = 0.f; for (int j = 0; j < 3584; ++j) y += act[j] * wd[(size_t)j * DM + n]; ynaive[n] += wgt * y; } __syncthreads(); }
    const unsigned s1 = sl[tok * 4], s2 = sl[tok * 4 + 1]; const float f1 = __builtin_bit_cast(float, sl[tok * 4 + 2]), f2 = __builtin_bit_cast(float, sl[tok * 4 + 3]);
    float num = 0.f, den = 0.f; for (int n = t; n < 1024; n += 256) { const bf16_t* yb = (const bf16_t*)(ws + WS_YB); const float m = f1 * (bf2f(hp[(size_t)s1 * 1024 + n]) + bf2f(yb[(size_t)s1 * 1024 + n])) + f2 * (bf2f(hp[(size_t)s2 * 1024 + n]) + bf2f(yb[(size_t)s2 * 1024 + n])); num += (m - ynaive[n]) * (m - ynaive[n]); den += ynaive[n] * ynaive[n]; }
    num = dbg_block_sum(num, red); den = dbg_block_sum(den, red);
    if (t == 0) { const float er = sqrtf(num / den); atomicMax((unsigned*)&W[50], __builtin_bit_cast(unsigned, er)); if (er > 0.1f) atomicAdd(&W[51], 1.f); atomicAdd(&W[52], er / 64.f); }
}
#ifndef DBGBR
#define DBGBR -1
#endif
__global__ void dbg_setgates(unsigned char* ws, int br) { float* g = (float*)(ws + WS_GATES); for (size_t i = (size_t)blockIdx.x * 256 + threadIdx.x; i < (size_t)T * 24; i += (size_t)gridDim.x * 256) g[i] = ((int)(i % 3) == br) ? 1.f : 0.f; }
#ifndef DBGV1
#define DBGV1 0
#endif
__global__ void dbg_setv(unsigned char* ws) { bf16_t* kv = (bf16_t*)(ws + WS_KV); for (size_t i = (size_t)blockIdx.x * 256 + threadIdx.x; i < KVSZ; i += (size_t)gridDim.x * 256) { kv[3 * KVSZ + i] = 0x3F80; kv[5 * KVSZ + i] = 0x3F80; } }
#ifndef DBG_UNIT
#define DBG_UNIT 5
#endif
#ifndef DBG_PA
#define DBG_PA 6
#endif
#ifndef DBG_PB
#define DBG_PB 20
#endif
__global__ void dbg_tail(float* out, unsigned char* ws) {
    const int t = threadIdx.x; const float* W = (const float*)(ws + WS_CTL) + 16000; float k = 0.f;
    if (DBG == 400) {
        __shared__ unsigned cnt; if (t == 0) cnt = 0; __syncthreads();
        if (blockIdx.x == 0 && t == 0) cnt = ((const unsigned*)(ws + WS_CTL))[21100];
        __syncthreads();
        const float kb = fminf((float)cnt, 89.f);
        for (size_t i = (size_t)blockIdx.x * 256 + t; i < (size_t)T * DM; i += (size_t)gridDim.x * 256) out[i] = (i == 0) ? (10.f + kb) * 10.f : 3.f;
        return; }
    if (DBG >= 200) {
        const unsigned long long* st = (const unsigned long long*)((const unsigned*)(ws + WS_CTL) + 20000);
        unsigned long long prev = st[63]; int ord = 0; float ka = 0.f, kb = 0.f;
        for (int i = 0; i < 63; ++i) { const unsigned long long v = st[i]; if (v == 0ull) continue; const float us = (float)(v - prev) * 0.01f; prev = v;
            if (ord == DBG_PA) ka = fminf(rintf(us / (float)DBG_UNIT), 89.f); if (ord == DBG_PB) kb = fminf(rintf(us / (float)DBG_UNIT), 89.f); ++ord; }
        (void)ka;
        for (size_t i = (size_t)blockIdx.x * 256 + t; i < (size_t)T * DM; i += (size_t)gridDim.x * 256) out[i] = (i == 0) ? (10.f + kb) * 10.f : 3.f;
        return; }
    if (DBG == 100) { for (int i = 1; i < 10; ++i) if (W[i] > 0.05f) { k = (float)i; break; } }
    else if (DBG == 103) { int m = 0; for (int i = 0; i < 6; ++i) if (!(W[20 + i] <= 0.05f)) m |= 1 << i; k = (float)m; }
    else if (DBG == 104) { int m = 0; for (int i = 6; i < 8; ++i) if (!(W[20 + i] <= 0.05f)) m |= 1 << (i - 6); k = (float)m; }
    else if (DBG == 105 || DBG == 106) { float mn = 1e30f, mx = 0.f; for (int i = 0; i < 8; ++i) { mn = fminf(mn, W[20 + i]); mx = fmaxf(mx, W[20 + i]); }
        k = rintf(10.f * (log10f(fmaxf(DBG == 105 ? mn : mx, 1e-6f)) + 6.f)); k = fminf(fmaxf(k, 0.f), 89.f); }
    else if (DBG == 107) { for (int i = 30; i <= 38; ++i) if (!(W[i] <= 0.03f)) { k = (float)(i - 29); break; } }
    else if (DBG == 101) { for (int i = 0; i < 8; ++i) if (!(W[20 + i] <= 0.05f)) { k = (float)(i + 1); break; } }
    else { k = rintf(10.f * (log10f(fmaxf(W[DBG], 1e-6f)) + 6.f)); k = fminf(fmaxf(k, 0.f), 89.f); }
    const float c = sqrtf(0.1f * k + 0.02f);
    for (size_t i = (size_t)blockIdx.x * 256 + t; i < (size_t)T * DM; i += (size_t)gridDim.x * 256) out[i] = c;
}
#endif

extern "C" void kernel_launch(void* const* d_in, const int* in_sizes, int n_in, void* d_out, int out_size, void* d_ws, size_t ws_size, hipStream_t stream) {
    static int grid = 0;
    if (grid == 0) {
        if (n_in != 30 || out_size != T * DM || ws_size < WS_END2) { fprintf(stderr, "kernel_launch: unexpected problem shape / workspace (%d inputs, out %d, ws %zu)\n", n_in, out_size, ws_size); grid = -1; return; }
        int dev = 0, cus = 0;
        if (hipGetDevice(&dev) != hipSuccess || hipDeviceGetAttribute(&cus, hipDeviceAttributeMultiprocessorCount, dev) != hipSuccess) { grid = -1; return; }
        if (hipFuncSetAttribute((const void*)fwd, hipFuncAttributeMaxDynamicSharedMemorySize, LDS_BYTES) != hipSuccess) { fprintf(stderr, "kernel_launch: hipFuncSetAttribute failed\n"); grid = -1; return; }
        int per_cu = 0;
        if (hipOccupancyMaxActiveBlocksPerMultiprocessor(&per_cu, (const void*)fwd, NWAVES * 64, LDS_BYTES) != hipSuccess || per_cu < 1) { fprintf(stderr, "kernel_launch: occupancy query says %d\n", per_cu); }
        (void)hipGetLastError();
        if (cus != 256) { fprintf(stderr, "kernel_launch: built for a 256-CU device, found %d\n", cus); grid = -1; return; }
        grid = cus;
    }
    if (grid < 0) return;
    if (hipMemsetAsync((char*)d_ws + WS_CTL, 0, CTL_ZERO_BYTES, stream) != hipSuccess) return;
    Args a{};
    for (int i = 0; i < 30; ++i) a.in[i] = (const float*)d_in[i];
    a.out = (float*)d_out; a.ws = (unsigned char*)d_ws;
#if MK_PER_PHASE
    int ids[64]; int n = 0;
    ids[n++] = PH_PRO;
    for (int l = 0; l < NL; ++l) { const int pb = PH_L0 + l * PH_LSTRIDE; for (int k = 0; k < 9; ++k) if (k != PO_N2 && k != PO_S && k != PO_PV) ids[n++] = pb + k;
        if (l == 0) { ids[n++] = pb + PO_F0 + 1; ids[n++] = pb + PO_F0 + 2; } else for (int k = 0; k < 7; ++k) ids[n++] = pb + PO_F0 + k; }
    for (int i = 0; i < n; ++i) { a.ph_lo = ids[i]; a.ph_hi = ids[i] + 1; hipLaunchKernelGGL(fwd, dim3(grid), dim3(NWAVES * 64), LDS_BYTES, stream, a);
#if DBG
        { DbgIn di; for (int q = 0; q < 30; ++q) di.in[q] = (const float*)d_in[q]; const int st = ids[i] - (PH_L0 + PH_LSTRIDE + PO_F0);
          if (st == 5) hipLaunchKernelGGL(dbg_moe_tok, dim3(64), dim3(256), 0, stream, di, (const float*)d_out, (unsigned char*)d_ws);
          if (st >= 1 && st <= 5) hipLaunchKernelGGL(dbg_check, dim3(1), dim3(256), 0, stream, di, (const float*)d_out, (unsigned char*)d_ws, st);
          if (ids[i] == PH_L0 + PO_WIN && DBGBR >= 0) hipLaunchKernelGGL(dbg_setgates, dim3(256), dim3(256), 0, stream, (unsigned char*)d_ws, DBGBR);
          if (ids[i] == PH_L0 + PO_WIN && DBGV1) hipLaunchKernelGGL(dbg_setv, dim3(256), dim3(256), 0, stream, (unsigned char*)d_ws);
          if (ids[i] == PH_L0 + PO_WIN) hipLaunchKernelGGL(dbg_mixer, dim3(1), dim3(256), 0, stream, di, (const float*)d_out, (unsigned char*)d_ws, 30);
          if (ids[i] == PH_L0 + PO_CMP) hipLaunchKernelGGL(dbg_mixer, dim3(1), dim3(256), 0, stream, di, (const float*)d_out, (unsigned char*)d_ws, 31);
          if (ids[i] == PH_L0 + PO_WOUT) hipLaunchKernelGGL(dbg_mixer, dim3(1), dim3(256), 0, stream, di, (const float*)d_out, (unsigned char*)d_ws, 32);
          if (ids[i] == PH_L0 + PO_ATT) { const int pt[8] = {5, 40, 100, 700, 1000, 1500, 3000, 4095};
            for (int q = 0; q < 8; ++q) hipLaunchKernelGGL(dbg_attn, dim3(1), dim3(256), 0, stream, (unsigned char*)d_ws, q & 3, q & 1, pt[q], 20 + q); } }
#endif
    }
#else
    a.ph_lo = 0; a.ph_hi = 1000;
    hipLaunchKernelGGL(fwd, dim3(grid), dim3(NWAVES * 64), LDS_BYTES, stream, a);
#endif
#if DBG
    hipLaunchKernelGGL(dbg_tail, dim3(64), dim3(256), 0, stream, (float*)d_out, (unsigned char*)d_ws);
#endif
}
```

```cpp
#include <hip/hip_runtime.h>
#include <cstdio>
#include <cstdint>
#include <cmath>

#ifndef DBG
#define DBG 0
#endif
#ifndef XMODE
#define XMODE 0
#endif
#ifndef XDIAG
#define XDIAG 0
#endif
#ifndef RES_BF16
#define RES_BF16 1
#endif
#ifndef REP_MASK
#define REP_MASK 0u
#endif
#define REPN(b) (((REP_MASK >> (b)) & 1u) ? 2 : 1)
#ifndef REP_ATT
#define REP_ATT 1
#endif
#ifndef REP_PRO
#define REP_PRO 1
#endif
#ifndef REP_CMP
#define REP_CMP 1
#endif
#ifndef MK_PER_PHASE
#define MK_PER_PHASE 0
#endif

#define LAS __attribute__((address_space(3)))
#define GAS __attribute__((address_space(1)))
typedef unsigned short bf16_t;
typedef short bf16x8 __attribute__((ext_vector_type(8)));
typedef short s16x4 __attribute__((ext_vector_type(4)));
typedef float f32x2 __attribute__((ext_vector_type(2)));
typedef float f32x4 __attribute__((ext_vector_type(4)));
typedef float f32x16 __attribute__((ext_vector_type(16)));
typedef unsigned u32x4 __attribute__((ext_vector_type(4)));
typedef unsigned u32x2 __attribute__((ext_vector_type(2)));

constexpr int NB = 4, SEQ = 4096, DM = 1024, T = NB * SEQ, NL = 2;
constexpr int ZW = 2048;
constexpr int DFF = 2816, DFFE = 3584, NE = 8;
constexpr int MAXT = 136, HALFT = 64, CH1T = MAXT - HALFT;
constexpr float EPS = 1e-6f;
constexpr float C2 = 0.125f * 1.4426950408889634f;
constexpr float CX = 0.0625f * 1.4426950408889634f;

constexpr size_t MiB = 1u << 20;
constexpr size_t WS_CTL = 0, CTL_ZERO_BYTES = 1 * MiB;
constexpr size_t WS_ROPE = 1 * MiB;
constexpr size_t WS_BIAS = 1 * MiB + 512 * 1024;
constexpr size_t WS_ROUTE = 2 * MiB;
constexpr size_t WS_CNTG = 2 * MiB + 512 * 1024;
constexpr size_t WS_TILE = 2 * MiB + 640 * 1024;
constexpr size_t WS_SLOT = 1 * MiB + 512 * 1024;
constexpr size_t WS_YB = 3 * MiB;
constexpr size_t WS_GATES = 4 * MiB;
constexpr size_t WS_KCMP = 6 * MiB;
constexpr size_t WS_HID = 7 * MiB;
constexpr size_t WS_MN = 9 * MiB;
constexpr size_t WS_KX = 13 * MiB;
constexpr size_t WS_VXT = 17 * MiB;
constexpr size_t WS_WIN = 21 * MiB;
constexpr size_t WS_WOUT = 29 * MiB;
constexpr size_t WS_WQ = 33 * MiB, WS_WO = 37 * MiB, WS_WK = 41 * MiB, WS_WV = 45 * MiB;
constexpr size_t WS_CW1 = 49 * MiB;
constexpr size_t WS_CW2 = 53 * MiB;
constexpr size_t WS_FGU = 54 * MiB;
constexpr size_t WS_FD = 65 * MiB;
constexpr size_t WS_MGU = 71 * MiB;
constexpr size_t WS_MD = 183 * MiB;
constexpr size_t WS_HB = 239 * MiB;
constexpr size_t WS_R = 271 * MiB;
constexpr size_t WS_QRAW = WS_R, WS_QROT = WS_R + 16 * MiB, WS_KV = WS_R + 32 * MiB  , WS_U = WS_R + 57 * MiB, WS_AB = WS_R + 73 * MiB;
constexpr size_t WS_QX = WS_R, WS_PB = WS_R + 32 * MiB, WS_OX = WS_R + 73 * MiB;
constexpr size_t WS_ACT0 = WS_R;
constexpr size_t WS_HP = WS_HB;
constexpr size_t WS_ACTC = 307 * MiB;
constexpr size_t WS_END = 433 * MiB;
constexpr size_t WS_XB2 = 433 * MiB;
constexpr size_t WS_END2 = 465 * MiB;
constexpr size_t KVSZ = (size_t)NB * 2 * SEQ * 64;
static_assert(WS_HP + (size_t)MAXT * 256 * 1024 * 2 <= WS_ACTC && WS_ACTC + (size_t)CH1T * 256 * DFFE * 2 <= WS_END && WS_YB + (size_t)MAXT * 256 * 1024 * 2 <= WS_MGU && WS_SLOT + (size_t)T * 16 <= 2 * MiB, "ws map");
static_assert(WS_MGU + (size_t)NE * 7168 * 1024 * 2 <= WS_MD && WS_MD + (size_t)NE * 1024 * DFFE * 2 <= WS_HB, "ws map");

constexpr int CW_TMO = 0, CW_BAR = 4096, CW_BIAS = 8192, CW_SS = 32768;
typedef unsigned long long ssq_t;
#define SSP(i) ((ssq_t*)((unsigned*)(ws + WS_CTL) + CW_SS) + (size_t)(i) * T)
__device__ __forceinline__ float ss_rs(const ssq_t* ss, int row) { return 1.0f / sqrtf((float)((double)ss[row] * (1.0 / 4294967296.0)) * (1.f / DM) + EPS); }
__device__ __forceinline__ ssq_t ss_fix(float v) { return (ssq_t)((double)v * 4294967296.0); }

constexpr int RING_BYTES = 131072;
constexpr int XTRA_OFF = RING_BYTES, XTRA_BYTES = 24576;
constexpr int LDSCTL_OFF = XTRA_OFF + XTRA_BYTES, LDS_BYTES = LDSCTL_OFF + 512;
constexpr int NWAVES = 8;

#define LDS_WAIT() asm volatile("s_waitcnt lgkmcnt(0)" ::: "memory")
#define VM_WAIT() asm volatile("s_waitcnt vmcnt(0)" ::: "memory")
#define RLX_AGENT __ATOMIC_RELAXED, __HIP_MEMORY_SCOPE_AGENT

__device__ __forceinline__ unsigned f2bf(float f) { unsigned u = __builtin_bit_cast(unsigned, f); return (u + 0x7fffu + ((u >> 16) & 1u)) >> 16; }
__device__ __forceinline__ unsigned pk2(float lo, float hi) { return f2bf(lo) | (f2bf(hi) << 16); }
__device__ __forceinline__ float bf2f(unsigned short h) { return __builtin_bit_cast(float, (unsigned)h << 16); }
__device__ __forceinline__ unsigned cvt_pk_bf16(float lo, float hi) { unsigned r; asm volatile("v_cvt_pk_bf16_f32 %0, %1, %2" : "=v"(r) : "v"(lo), "v"(hi)); return r; }
template <int M> __device__ __forceinline__ float xor_get(float v) {
    static_assert(M > 0 && M < 32, "xor_get: within 32 lanes");
    return __builtin_bit_cast(float, __builtin_amdgcn_ds_swizzle(__builtin_bit_cast(int, v), (M << 10) | 0x1f));
}
__device__ __forceinline__ void half_swap(float v, float& lo, float& hi) {
    unsigned a = __builtin_bit_cast(unsigned, v), b = a;
    asm volatile("s_nop 1\n\tv_permlane32_swap_b32 %0, %1\n\ts_nop 1" : "+v"(a), "+v"(b));
    lo = __builtin_bit_cast(float, a); hi = __builtin_bit_cast(float, b);
}
__device__ __forceinline__ float xor32_sum(float v) { float lo, hi; half_swap(v, lo, hi); return lo + hi; }
__device__ __forceinline__ float xor32_max(float v) { float lo, hi; half_swap(v, lo, hi); return fmaxf(lo, hi); }
__device__ __forceinline__ float wave_sum(float v) {
    v += xor_get<1>(v); v += xor_get<2>(v); v += xor_get<4>(v); v += xor_get<8>(v); v += xor_get<16>(v);
    return xor32_sum(v);
}
__device__ __forceinline__ float fast_exp2(float x) { return __builtin_amdgcn_exp2f(x); }

namespace pg8 {
constexpr int BM = 256, BK = 64, HALF = 128, HTB = HALF * BK * 2, NXCD = 8, WGM = 8;
__host__ __device__ __forceinline__ int lds_byte(int r, int c) { const int st = (r >> 4) * 2 + (c >> 5), rr = r & 15, cc = c & 31, ob = rr * 64 + cc * 2; return st * 1024 + (ob ^ (((ob >> 9) & 1) << 5)); }
__host__ __device__ __forceinline__ void stage_rc(int b, int& R, int& C) { const int st = b / 1024, sb = b % 1024, swz = sb ^ (((sb >> 9) & 1) << 5); R = (st >> 1) * 16 + swz / 64; C = (st & 1) * 32 + (swz % 64) / 2; }
__host__ __device__ __forceinline__ int perm32(int rho) { const int n = rho >> 4, i = rho & 15; return 8 * (i >> 2) + 4 * n + (i & 3); }

struct Unit { int pm, pn; long aoff, boff, coff; int ord; };
struct Gemm { const char* A; const char* Bt; int K, lda, ldb; };

struct TileOrder {
    int nM, nN, nwg, G, c;
    __device__ __forceinline__ void init(int nM_, int nN_, int G_, int c_) { nM = nM_; nN = nN_; nwg = nM * nN; G = G_; c = c_; }
    __device__ __forceinline__ bool tile(int i, int& pm, int& pn) const {
        const long L = (long)i * G + c; if (L >= nwg) return false;
        int wgid = (int)L; { const int q = nwg / NXCD, r = nwg % NXCD, xcd = wgid % NXCD, off = wgid / NXCD; wgid = (xcd < r ? xcd * (q + 1) : r * (q + 1) + (xcd - r) * q) + off; }
        const int nig = WGM * nN, gid = wgid / nig, fm = gid * WGM, gsz = (nM - fm) < WGM ? (nM - fm) : WGM;
        pm = fm + ((wgid % nig) % gsz); pn = (wgid % nig) / gsz; return true;
    }
};

template <class Epi, class Sched, bool ALIGN_EPI, bool SP2>
__device__ __forceinline__ void gemm_phase(LAS unsigned char* lds, const Gemm g, const Sched S, const Epi E, int tid_in) {
    int tid_ = tid_in; asm volatile("" : "+v"(tid_));
    const int tid = tid_, wid = __builtin_amdgcn_readfirstlane(tid >> 6), lane = tid & 63, wr = wid >> 2, wc = wid & 3, fr = lane & 15, fq = lane >> 4;
    const int K = g.K, nt = K / BK;
    unsigned voffA[2], voffB[2];
#pragma unroll
    for (int i = 0; i < 2; ++i) { int R, C; stage_rc(tid * 16 + i * 8192, R, C); const int Rb = Epi::PERM ? ((R & ~31) + perm32(R & 31)) : R;
        voffA[i] = (unsigned)(R * g.lda + C) * 2u; voffB[i] = (unsigned)(Rb * g.ldb + C) * 2u; }
    const size_t kstep = (size_t)(BK * 2);
    const size_t hstepA = (size_t)HALF * g.lda * 2, hstepB = (size_t)HALF * g.ldb * 2;
    const unsigned ldsw = (unsigned)wid * 1024u;
    const int aoff = lds_byte(wr * 64 + fr, fq * 8), boff = lds_byte(wc * 32 + fr, fq * 8);
#define PG8_SA(b, h) (((b) * 2 + (h)) * HTB)
#define PG8_SB(b, h) ((4 + (b) * 2 + (h)) * HTB)
#define PG8_STAGE(bufoff, gbase, voff) do { _Pragma("unroll") for (int _i = 0; _i < 2; ++_i) \
        __builtin_amdgcn_global_load_lds((const unsigned*)((const char*)(gbase) + (voff)[_i]), (LAS unsigned*)(lds + (bufoff) + ldsw + _i * 8192), 16, 0, 0); } while (0)
#define PG8_LDA(dst, b, h) do { _Pragma("unroll") for (int m = 0; m < 4; ++m) _Pragma("unroll") for (int k = 0; k < 2; ++k) dst[m][k] = *(const LAS bf16x8*)(lds + PG8_SA(b, h) + aoff + m * 2048 + k * 1024); } while (0)
#define PG8_LDB(dst, b, h) do { _Pragma("unroll") for (int n = 0; n < 2; ++n) _Pragma("unroll") for (int k = 0; k < 2; ++k) dst[n][k] = *(const LAS bf16x8*)(lds + PG8_SB(b, h) + boff + n * 2048 + k * 1024); } while (0)
#define PG8_MMA(ai, bj, At, Bt) do { __builtin_amdgcn_s_setprio(1); _Pragma("unroll") for (int m = 0; m < 4; ++m) _Pragma("unroll") for (int n = 0; n < 2; ++n) _Pragma("unroll") for (int k = 0; k < 2; ++k) \
        acc[ai][bj][m][n] = __builtin_amdgcn_mfma_f32_16x16x32_bf16(Bt[n][k], At[m][k], acc[ai][bj][m][n], 0, 0, 0); __builtin_amdgcn_s_setprio(0); } while (0)
#define PG8_WAIT_V(n) asm volatile("s_waitcnt vmcnt(" #n ")" ::: "memory")
#define PG8_WAIT_L(n) asm volatile("s_waitcnt lgkmcnt(" #n ")" ::: "memory")
#define PG8_BAR __builtin_amdgcn_s_barrier()
#define PG8_SCHED __builtin_amdgcn_sched_barrier(0)
    Unit cur, nxt; int ui = 0;
    if (!S.next(0, cur)) return;
    f32x4 acc[2][2][4][2];
    float zero_ = 0.f; asm volatile("" : "+v"(zero_));
#pragma unroll
    for (int a = 0; a < 2; ++a)
#pragma unroll
        for (int b = 0; b < 2; ++b)
#pragma unroll
            for (int m = 0; m < 4; ++m)
#pragma unroll
                for (int n = 0; n < 2; ++n) acc[a][b][m][n] = (f32x4){zero_, zero_, zero_, zero_};
    bf16x8 At[4][2], B0[2][2], B1[2][2];
    const char* cA = g.A + cur.aoff; const char* cB = g.Bt + cur.boff;
    if constexpr (SP2) {
        PG8_STAGE(PG8_SB(0, 0), cB, voffB); PG8_STAGE(PG8_SB(0, 1), cB + hstepB, voffB); PG8_STAGE(PG8_SA(0, 0), cA, voffA); PG8_STAGE(PG8_SA(0, 1), cA + hstepA, voffA);
        if (wr == 1) PG8_BAR;
        PG8_WAIT_V(2); PG8_BAR;
        PG8_STAGE(PG8_SB(1, 0), cB + kstep, voffB); PG8_STAGE(PG8_SA(1, 0), cA + kstep, voffA); PG8_STAGE(PG8_SB(1, 1), cB + hstepB + kstep, voffB);
        PG8_WAIT_V(6); PG8_BAR;
    } else {
        PG8_STAGE(PG8_SB(0, 0), cB, voffB); PG8_STAGE(PG8_SA(0, 0), cA, voffA); PG8_STAGE(PG8_SB(0, 1), cB + hstepB, voffB); PG8_STAGE(PG8_SA(0, 1), cA + hstepA, voffA);
        if (wr == 1) PG8_BAR;
        PG8_WAIT_V(4); PG8_BAR;
        PG8_STAGE(PG8_SB(1, 0), cB + kstep, voffB); PG8_STAGE(PG8_SA(1, 0), cA + kstep, voffA); PG8_STAGE(PG8_SB(1, 1), cB + hstepB + kstep, voffB);
        PG8_WAIT_V(6); PG8_BAR;
    }
    for (;;) {
        const bool has_next = S.next(ui + 1, nxt);
        const char* nA = has_next ? g.A + nxt.aoff : cA; const char* nB = has_next ? g.Bt + nxt.boff : cB;
#pragma unroll 1
        for (int t = 0; t < nt; t += 2) {
            const bool last = (t == nt - 2);
            const char* a1 = cA + (size_t)(t + 1) * kstep;
            const char* a2 = last ? nA : cA + (size_t)(t + 2) * kstep; const char* b2 = last ? nB : cB + (size_t)(t + 2) * kstep;
            const char* a3 = a2 + kstep; const char* b3 = b2 + kstep;
            if constexpr (SP2) {
            PG8_LDB(B0, 0, 0); PG8_LDB(B1, 0, 1); PG8_SCHED; PG8_LDA(At, 0, 0); PG8_STAGE(PG8_SA(1, 1), a1 + hstepA, voffA);
            PG8_WAIT_V(8); PG8_WAIT_L(0); PG8_BAR; PG8_MMA(0, 0, At, B0); PG8_MMA(0, 1, At, B1); PG8_BAR; PG8_SCHED;
            PG8_LDA(At, 0, 1); PG8_STAGE(PG8_SB(0, 0), b2, voffB); PG8_STAGE(PG8_SB(0, 1), b2 + hstepB, voffB); PG8_STAGE(PG8_SA(0, 0), a2, voffA);
            PG8_WAIT_V(8); PG8_WAIT_L(0); PG8_BAR; PG8_MMA(1, 0, At, B0); PG8_MMA(1, 1, At, B1); PG8_BAR; PG8_SCHED;
            PG8_LDB(B0, 1, 0); PG8_LDB(B1, 1, 1); PG8_SCHED; PG8_LDA(At, 1, 0); PG8_STAGE(PG8_SA(0, 1), a2 + hstepA, voffA);
            PG8_WAIT_V(8); PG8_WAIT_L(0); PG8_BAR; PG8_MMA(0, 0, At, B0); PG8_MMA(0, 1, At, B1); PG8_BAR; PG8_SCHED;
            PG8_LDA(At, 1, 1); PG8_STAGE(PG8_SB(1, 0), b3, voffB); PG8_STAGE(PG8_SB(1, 1), b3 + hstepB, voffB); PG8_STAGE(PG8_SA(1, 0), a3, voffA);
            PG8_WAIT_V(8); PG8_WAIT_L(0); PG8_BAR; PG8_MMA(1, 0, At, B0); PG8_MMA(1, 1, At, B1); PG8_BAR; PG8_SCHED;
            } else {
            PG8_LDB(B0, 0, 0); PG8_SCHED; PG8_LDA(At, 0, 0); PG8_STAGE(PG8_SA(1, 1), a1 + hstepA, voffA);
            PG8_WAIT_L(8); PG8_BAR; PG8_WAIT_L(0); PG8_MMA(0, 0, At, B0); PG8_BAR; PG8_SCHED;
            PG8_LDB(B1, 0, 1); PG8_STAGE(PG8_SB(0, 0), b2, voffB);
            PG8_BAR; PG8_WAIT_L(0); PG8_MMA(0, 1, At, B1); PG8_BAR;
            PG8_LDA(At, 0, 1); PG8_STAGE(PG8_SA(0, 0), a2, voffA);
            PG8_BAR; PG8_WAIT_L(0); PG8_MMA(1, 0, At, B0); PG8_BAR; PG8_SCHED;
            PG8_STAGE(PG8_SB(0, 1), b2 + hstepB, voffB);
            PG8_WAIT_V(6); PG8_BAR; PG8_MMA(1, 1, At, B1); PG8_BAR;
            PG8_LDB(B0, 1, 0); PG8_SCHED; PG8_LDA(At, 1, 0); PG8_STAGE(PG8_SA(0, 1), a2 + hstepA, voffA);
            PG8_WAIT_L(8); PG8_BAR; PG8_WAIT_L(0); PG8_MMA(0, 0, At, B0); PG8_BAR; PG8_SCHED;
            PG8_LDB(B1, 1, 1); PG8_STAGE(PG8_SB(1, 0), b3, voffB);
            PG8_BAR; PG8_WAIT_L(0); PG8_MMA(0, 1, At, B1); PG8_BAR;
            PG8_LDA(At, 1, 1); PG8_STAGE(PG8_SA(1, 0), a3, voffA);
            PG8_BAR; PG8_WAIT_L(0); PG8_MMA(1, 0, At, B0); PG8_BAR; PG8_SCHED;
            PG8_STAGE(PG8_SB(1, 1), b3 + hstepB, voffB);
            PG8_WAIT_V(6); PG8_BAR; PG8_MMA(1, 1, At, B1); PG8_BAR;
            }
        }
        if constexpr (ALIGN_EPI) { if (wr == 0) PG8_BAR; }
        if constexpr (!Epi::AFTER_DRAIN) { E(acc, cur, wr, wc, fr, fq); }
        if (!has_next) break;
#pragma unroll
        for (int a = 0; a < 2; ++a)
#pragma unroll
            for (int b = 0; b < 2; ++b)
#pragma unroll
                for (int m = 0; m < 4; ++m)
#pragma unroll
                    for (int n = 0; n < 2; ++n) acc[a][b][m][n] = (f32x4){zero_, zero_, zero_, zero_};
        cur = nxt; cA = nA; cB = nB; ++ui;
        if constexpr (ALIGN_EPI) { if (wr == 1) PG8_BAR; }
    }
    PG8_WAIT_V(0);
    if constexpr (!ALIGN_EPI) { if (wr == 0) PG8_BAR; }
    PG8_BAR;
    if constexpr (Epi::AFTER_DRAIN) { E.fused(acc, cur, wr, wc, fr, fq, lds, wid, lane); }
#undef PG8_SA
#undef PG8_SB
#undef PG8_STAGE
#undef PG8_LDA
#undef PG8_LDB
#undef PG8_MMA
#undef PG8_WAIT_V
#undef PG8_WAIT_L
#undef PG8_BAR
#undef PG8_SCHED
}
}
using pg8::Unit;
typedef const f32x4 (&AccRef)[2][2][4][2];

struct SchedPlain {
    pg8::TileOrder o; long astep, bstep;
    __device__ void init(int nM, int nN, int lda, int ldb, int G, int c) { o.init(nM, nN, G, c); astep = (long)256 * lda * 2; bstep = (long)256 * ldb * 2; }
    __device__ bool next(int i, Unit& u) const { if (!o.tile(i, u.pm, u.pn)) return false; u.aoff = u.pm * astep; u.boff = u.pn * bstep; u.coff = 0; u.ord = i; return true; }
};
struct SchedOne { Unit u; __device__ bool next(int i, Unit& out) const { if (i > 0) return false; out = u; return true; } };
struct SchedKV {
    int G, c;
    __device__ bool next(int i, Unit& u) const {
        const int L = i * G + c; if (L >= 64 || (G == 1 && i > 0)) return false;
        const int job = L >> 4, l = job >> 1, isv = job & 1; u.pm = (L >> 2) & 3; u.pn = L & 3;
        const long mn = (long)WS_MN + (long)l * 2 * MiB, wk = (long)WS_WK + (long)l * 2 * MiB, wv = (long)WS_WV + (long)l * 2 * MiB;
        const long ts = 256L * 1024 * 2;
        if (!isv) { u.aoff = mn + u.pm * ts; u.boff = wk + u.pn * ts; u.coff = ((long)WS_KX + (long)l * 2 * MiB) / 2; }
        else { u.aoff = mn + u.pm * ts; u.boff = wv + u.pn * ts; u.coff = ((long)WS_VXT + (long)l * 2 * MiB) / 2; }
        return true;
    }
};
template <int MODE> struct SchedX {
    pg8::TileOrder o;
    __device__ void init(int G, int c) { o.init(64, 4, G, c); }
    __device__ bool next(int i, Unit& u) const {
        if (!o.tile(i, u.pm, u.pn)) return false;
        const int b = u.pm >> 4, h = u.pn;
        u.aoff = ((long)u.pm * 256 * 1024 + h * 256) * 2;
        u.boff = MODE == 0 ? ((long)b * 256 * 1024 + h * 256) * 2 : ((long)h * 256 * 1024 + b * 256) * 2;
        u.coff = 0; return true;
    }
};
struct SchedMoe {
    pg8::TileOrder o; const unsigned* texp; int t0, nn; long astep, bstep, estep, cstep, khb, khc;
    __device__ bool next(int i, Unit& u) const {
        int pm, pn; if (!o.tile(i, pm, pn)) return false;
        const int rt = t0 + pm; const int e = (int)texp[rt]; const int kh = pn >= nn ? 1 : 0; pn -= kh * nn;
        u.pm = rt; u.pn = pn; u.aoff = pm * astep + kh * khb; u.boff = e * estep + pn * bstep + kh * khb; u.coff = -(long)t0 * cstep + kh * khc; return true;
    }
};

struct EpiPlain {
    static constexpr bool PERM = true, AFTER_DRAIN = false;
    bf16_t* O; int ldc; const ssq_t* ss;
    __device__ __forceinline__ void operator()(AccRef acc, const Unit& u, int wr, int wc, int fr, int fq) const {
        const int row0 = u.pm * 256 + wr * 64 + fr;
        bf16_t* base = O + u.coff + (size_t)row0 * ldc + u.pn * 256 + wc * 32 + 8 * fq;
#pragma unroll
        for (int ai = 0; ai < 2; ++ai)
#pragma unroll
            for (int m = 0; m < 4; ++m) { const float rs = ss ? ss_rs(ss, row0 + ai * 128 + m * 16) : 1.f;
#pragma unroll
                for (int bj = 0; bj < 2; ++bj) { const f32x4 v0 = acc[ai][bj][m][0] * rs, v1 = acc[ai][bj][m][1] * rs;
                    u32x4 w; w.x = cvt_pk_bf16(v0[0], v0[1]); w.y = cvt_pk_bf16(v0[2], v0[3]); w.z = cvt_pk_bf16(v1[0], v1[1]); w.w = cvt_pk_bf16(v1[2], v1[3]);
                    *(u32x4*)(base + (size_t)(ai * 128 + m * 16) * ldc + bj * 128) = w; } }
    }
};
#ifndef ABL
#define ABL 0
#endif
template <bool SRC_F32> struct EpiResB {
    static constexpr bool PERM = true, AFTER_DRAIN = false;
    const void* src; bf16_t* xo; ssq_t* ss;
    __device__ __forceinline__ void operator()(AccRef acc, const Unit& u, int wr, int wc, int fr, int fq) const {
        const int row0 = u.pm * 256 + wr * 64 + fr;
        const size_t off0 = (size_t)row0 * DM + u.pn * 256 + wc * 32 + 8 * fq;
#pragma unroll
        for (int ai = 0; ai < 2; ++ai)
#pragma unroll
            for (int m = 0; m < 4; ++m) { float part = 0.f;
#pragma unroll
                for (int bj = 0; bj < 2; ++bj) { const size_t off = off0 + (size_t)(ai * 128 + m * 16) * DM + bj * 128;
                    f32x4 s0, s1;
                    if (SRC_F32) { s0 = *(const f32x4*)((const float*)src + off); s1 = *(const f32x4*)((const float*)src + off + 4); }
                    else { const u32x4 w = *(const u32x4*)((const bf16_t*)src + off);
                        s0 = (f32x4){__builtin_bit_cast(float, w.x << 16), __builtin_bit_cast(float, w.x & 0xffff0000u), __builtin_bit_cast(float, w.y << 16), __builtin_bit_cast(float, w.y & 0xffff0000u)};
                        s1 = (f32x4){__builtin_bit_cast(float, w.z << 16), __builtin_bit_cast(float, w.z & 0xffff0000u), __builtin_bit_cast(float, w.w << 16), __builtin_bit_cast(float, w.w & 0xffff0000u)}; }
                    s0 = s0 + acc[ai][bj][m][0]; s1 = s1 + acc[ai][bj][m][1];
                    u32x4 w; w.x = cvt_pk_bf16(s0[0], s0[1]); w.y = cvt_pk_bf16(s0[2], s0[3]); w.z = cvt_pk_bf16(s1[0], s1[1]); w.w = cvt_pk_bf16(s1[2], s1[3]); *(u32x4*)(xo + off) = w;
                    part += ((s0[0] * s0[0] + s0[1] * s0[1]) + (s0[2] * s0[2] + s0[3] * s0[3])) + ((s1[0] * s1[0] + s1[1] * s1[1]) + (s1[2] * s1[2] + s1[3] * s1[3])); }
                if (ss) { part += xor_get<16>(part); part = xor32_sum(part); if (fq == 0) atomicAdd(ss + row0 + ai * 128 + m * 16, ss_fix(part)); } }
    }
};
struct EpiRes {
    static constexpr bool PERM = true, AFTER_DRAIN = false;
    const float* src; float* out; bf16_t* xb; ssq_t* ss;
    __device__ __forceinline__ void operator()(AccRef acc, const Unit& u, int wr, int wc, int fr, int fq) const {
        const int row0 = u.pm * 256 + wr * 64 + fr;
        const size_t off0 = (size_t)row0 * DM + u.pn * 256 + wc * 32 + 8 * fq;
#pragma unroll
        for (int ai = 0; ai < 2; ++ai)
#pragma unroll
            for (int m = 0; m < 4; ++m) { float part = 0.f;
#pragma unroll
                for (int bj = 0; bj < 2; ++bj) { const size_t off = off0 + (size_t)(ai * 128 + m * 16) * DM + bj * 128;
                    const f32x4 s0 = *(const f32x4*)(src + off) + acc[ai][bj][m][0], s1 = *(const f32x4*)(src + off + 4) + acc[ai][bj][m][1];
                    *(f32x4*)(out + off) = s0; *(f32x4*)(out + off + 4) = s1;
                    if (xb) { u32x4 w; w.x = cvt_pk_bf16(s0[0], s0[1]); w.y = cvt_pk_bf16(s0[2], s0[3]); w.z = cvt_pk_bf16(s1[0], s1[1]); w.w = cvt_pk_bf16(s1[2], s1[3]); *(u32x4*)(xb + off) = w;
                        part += ((s0[0] * s0[0] + s0[1] * s0[1]) + (s0[2] * s0[2] + s0[3] * s0[3])) + ((s1[0] * s1[0] + s1[1] * s1[1]) + (s1[2] * s1[2] + s1[3] * s1[3])); } }
                if (xb) { part += xor_get<16>(part); part = xor32_sum(part); if (fq == 0) atomicAdd(ss + row0 + ai * 128 + m * 16, ss_fix(part)); } }
    }
};
__device__ __forceinline__ float gelu_tanh(float x) {
    const float y = 0.7978845608028654f * (x + 0.044715f * x * x * x);
    const float e = fast_exp2(y * 2.8853900817779268f);
    const float th = 1.f - 2.f * __builtin_amdgcn_rcpf(e + 1.f);
    return 0.5f * x * (1.f + th);
}
struct EpiHid {
    static constexpr bool PERM = true, AFTER_DRAIN = false;
    bf16_t* O; const long long* bias;
    __device__ __forceinline__ void operator()(AccRef acc, const Unit& u, int wr, int wc, int fr, int fq) const {
        bf16_t* base = O + (size_t)(u.pm * 256 + wr * 64 + fr) * 256 + wc * 32 + 8 * fq;
#pragma unroll
        for (int bj = 0; bj < 2; ++bj) { const long long* bp = bias + bj * 128 + wc * 32 + 8 * fq; f32x4 b0, b1;
#pragma unroll
            for (int j = 0; j < 4; ++j) { b0[j] = (float)((double)bp[j] * (1.0 / 1099511627776.0)); b1[j] = (float)((double)bp[4 + j] * (1.0 / 1099511627776.0)); }
#pragma unroll
            for (int ai = 0; ai < 2; ++ai)
#pragma unroll
                for (int m = 0; m < 4; ++m) { const f32x4 v0 = acc[ai][bj][m][0] + b0, v1 = acc[ai][bj][m][1] + b1;
                    u32x4 w; w.x = cvt_pk_bf16(gelu_tanh(v0[0]), gelu_tanh(v0[1])); w.y = cvt_pk_bf16(gelu_tanh(v0[2]), gelu_tanh(v0[3]));
                    w.z = cvt_pk_bf16(gelu_tanh(v1[0]), gelu_tanh(v1[1])); w.w = cvt_pk_bf16(gelu_tanh(v1[2]), gelu_tanh(v1[3]));
                    *(u32x4*)(base + (size_t)(ai * 128 + m * 16) * 256 + bj * 128) = w; } }
    }
};
struct EpiCmp2 {
    static constexpr bool PERM = true, AFTER_DRAIN = false;
    bf16_t* O;
    __device__ __forceinline__ void operator()(AccRef acc, const Unit& u, int wr, int wc, int fr, int fq) const {
        if (wc >= 2) return;
#pragma unroll
        for (int ai = 0; ai < 2; ++ai)
#pragma unroll
            for (int m = 0; m < 4; ++m) { const int row = u.pm * 256 + ai * 128 + wr * 64 + m * 16 + fr; const f32x4 v0 = acc[ai][0][m][0], v1 = acc[ai][0][m][1];
                u32x4 w; w.x = cvt_pk_bf16(v0[0], v0[1]); w.y = cvt_pk_bf16(v0[2], v0[3]); w.z = cvt_pk_bf16(v1[0], v1[1]); w.w = cvt_pk_bf16(v1[2], v1[3]);
                if ((row & 255) == 255) w = (u32x4){0u, 0u, 0u, 0u};
                *(u32x4*)(O + (size_t)row * 64 + wc * 32 + 8 * fq) = w; }
    }
};
__device__ __forceinline__ float silu_mul(float g, float u) { return g * __builtin_amdgcn_rcpf(1.f + fast_exp2(-1.4426950408889634f * g)) * u; }
template <int RS>
struct EpiSwiglu {
    static constexpr bool PERM = true, AFTER_DRAIN = false;
    bf16_t* O; int ldc; const LAS float* rsl; const ssq_t* ss;
    __device__ __forceinline__ void operator()(AccRef acc, const Unit& u, int wr, int wc, int fr, int fq) const {
        const int row0 = u.pm * 256 + wr * 64 + fr;
        bf16_t* base = O + u.coff + (size_t)row0 * ldc + u.pn * 128 + wc * 32 + 8 * fq;
#pragma unroll
        for (int ai = 0; ai < 2; ++ai)
#pragma unroll
            for (int m = 0; m < 4; ++m) { f32x4 g0 = acc[ai][0][m][0], g1 = acc[ai][0][m][1], u0 = acc[ai][1][m][0], u1 = acc[ai][1][m][1];
                if constexpr (RS == 1) { const float rs = rsl[256 * u.ord + wr * 64 + fr + ai * 128 + m * 16]; g0 *= rs; g1 *= rs; u0 *= rs; u1 *= rs; }
                if constexpr (RS == 2) { const float rs = ss_rs(ss, row0 + ai * 128 + m * 16); g0 *= rs; g1 *= rs; u0 *= rs; u1 *= rs; }
                u32x4 w; w.x = cvt_pk_bf16(silu_mul(g0[0], u0[0]), silu_mul(g0[1], u0[1])); w.y = cvt_pk_bf16(silu_mul(g0[2], u0[2]), silu_mul(g0[3], u0[3]));
                w.z = cvt_pk_bf16(silu_mul(g1[0], u1[0]), silu_mul(g1[1], u1[1])); w.w = cvt_pk_bf16(silu_mul(g1[2], u1[2]), silu_mul(g1[3], u1[3]));
                *(u32x4*)(base + (size_t)(ai * 128 + m * 16) * ldc) = w; }
    }
};
struct EpiWin {
    static constexpr bool PERM = true, AFTER_DRAIN = false;
    bf16_t *qraw, *qrot, *kv, *ub; float* gates; const float* rope; const ssq_t* ss;
    __device__ __forceinline__ void operator()(AccRef acc, const Unit& u, int wr, int wc, int fr, int fq) const {
        const int pn = u.pn;
#pragma unroll
        for (int ai = 0; ai < 2; ++ai)
#pragma unroll
            for (int m = 0; m < 4; ++m) {
                const int row = u.pm * 256 + ai * 128 + wr * 64 + m * 16 + fr, b = row >> 12, t = row & 4095;
                const float rs = ss_rs(ss, row);
#pragma unroll
                for (int bj = 0; bj < 2; ++bj) {
                    float v[8];
#pragma unroll
                    for (int j = 0; j < 4; ++j) { v[j] = acc[ai][bj][m][0][j] * rs; v[4 + j] = acc[ai][bj][m][1][j] * rs; }
                    if (pn < 2) {
                        const size_t idx = ((size_t)(b * 2 + pn) * SEQ + t) * 256 + bj * 128 + wc * 32 + 8 * fq;
                        u32x4 w; w.x = cvt_pk_bf16(v[0] * C2, v[1] * C2); w.y = cvt_pk_bf16(v[2] * C2, v[3] * C2); w.z = cvt_pk_bf16(v[4] * C2, v[5] * C2); w.w = cvt_pk_bf16(v[6] * C2, v[7] * C2);
                        *(u32x4*)(qraw + idx) = w;
                        if ((wc & 1) == 0) {
                            float p[8];
#pragma unroll
                            for (int j = 0; j < 8; ++j) p[j] = xor_get<16>(v[j]);
                            if (fq < 2) { const float* rp = rope + (size_t)t * 16;
#pragma unroll
                                for (int j = 0; j < 8; ++j) { const float cs = rp[2 * j], sn = rp[2 * j + 1]; v[j] = fq == 0 ? v[j] * cs - p[j] * sn : v[j] * cs + p[j] * sn; } }
                            w.x = cvt_pk_bf16(v[0] * C2, v[1] * C2); w.y = cvt_pk_bf16(v[2] * C2, v[3] * C2); w.z = cvt_pk_bf16(v[4] * C2, v[5] * C2); w.w = cvt_pk_bf16(v[6] * C2, v[7] * C2);
                        }
                        *(u32x4*)(qrot + idx) = w;
                    } else if (pn < 5) {
                        const int i = 2 * (pn - 2) + bj, g = wc >> 1;
                        if (bj == 0 && pn >= 3 && (wc & 1) == 0) {
                            float p[8];
#pragma unroll
                            for (int j = 0; j < 8; ++j) p[j] = xor_get<16>(v[j]);
                            if (fq < 2) { const float* rp = rope + (size_t)t * 16;
#pragma unroll
                                for (int j = 0; j < 8; ++j) { const float cs = rp[2 * j], sn = rp[2 * j + 1]; v[j] = fq == 0 ? v[j] * cs - p[j] * sn : v[j] * cs + p[j] * sn; } }
                        }
                        u32x4 w; w.x = cvt_pk_bf16(v[0], v[1]); w.y = cvt_pk_bf16(v[2], v[3]); w.z = cvt_pk_bf16(v[4], v[5]); w.w = cvt_pk_bf16(v[6], v[7]);
                        *(u32x4*)(kv + (size_t)i * KVSZ + ((size_t)(b * 2 + g) * SEQ + t) * 64 + (wc & 1) * 32 + 8 * fq) = w;
                    } else if (pn < 7) {
                        u32x4 w; w.x = cvt_pk_bf16(v[0], v[1]); w.y = cvt_pk_bf16(v[2], v[3]); w.z = cvt_pk_bf16(v[4], v[5]); w.w = cvt_pk_bf16(v[6], v[7]);
                        *(u32x4*)(ub + (size_t)row * 512 + (pn - 5) * 256 + bj * 128 + wc * 32 + 8 * fq) = w;
                    } else {
                        if (bj == 0 && wc == 0 && fq < 3) { float* gp = gates + (size_t)row * 24 + 8 * fq;
#pragma unroll
                            for (int j = 0; j < 8; ++j) gp[j] = __builtin_amdgcn_rcpf(1.f + fast_exp2(-1.4426950408889634f * v[j])); }
                    }
                }
            }
    }
};
struct EpiSoftmax {
    static constexpr bool PERM = true, AFTER_DRAIN = true;
    bf16_t* P;
    __device__ __forceinline__ void operator()(AccRef, const Unit&, int, int, int, int) const {}
    __device__ __forceinline__ void fused(f32x4 (&acc)[2][2][4][2], const Unit& u, int wr, int wc, int fr, int fq, LAS unsigned char* lds, int wid, int lane) const {
        LAS float* RM = (LAS float*)lds;
        LAS float* RS = (LAS float*)(lds + 4096);
        float mx[2][4];
#pragma unroll
        for (int ai = 0; ai < 2; ++ai)
#pragma unroll
            for (int m = 0; m < 4; ++m) { float a = -INFINITY;
#pragma unroll
                for (int bj = 0; bj < 2; ++bj)
#pragma unroll
                    for (int n = 0; n < 2; ++n)
#pragma unroll
                        for (int e = 0; e < 4; ++e) a = fmaxf(a, acc[ai][bj][m][n][e]);
                a = fmaxf(a, xor_get<16>(a)); a = xor32_max(a);
                if (fq == 0) RM[(ai * 128 + wr * 64 + m * 16 + fr) * 4 + wc] = a; }
        LDS_WAIT(); __builtin_amdgcn_s_barrier(); asm volatile("" ::: "memory");
#pragma unroll
        for (int ai = 0; ai < 2; ++ai)
#pragma unroll
            for (int m = 0; m < 4; ++m) { const int r = ai * 128 + wr * 64 + m * 16 + fr; const f32x4 q = *(const LAS f32x4*)(RM + r * 4);
                const float mm = fmaxf(fmaxf(q[0], q[1]), fmaxf(q[2], q[3])); float s = 0.f;
#pragma unroll
                for (int bj = 0; bj < 2; ++bj)
#pragma unroll
                    for (int n = 0; n < 2; ++n)
#pragma unroll
                        for (int e = 0; e < 4; ++e) { const float p = fast_exp2((acc[ai][bj][m][n][e] - mm) * CX); acc[ai][bj][m][n][e] = p; s += p; }
                s += xor_get<16>(s); s = xor32_sum(s);
                if (fq == 0) RS[r * 4 + wc] = s; }
        LDS_WAIT(); __builtin_amdgcn_s_barrier(); asm volatile("" ::: "memory");
        bf16_t* base = P + (size_t)(u.pm * 256 + wr * 64 + fr) * DM + u.pn * 256 + wc * 32 + 8 * fq;
#pragma unroll
        for (int ai = 0; ai < 2; ++ai)
#pragma unroll
            for (int m = 0; m < 4; ++m) { const int r = ai * 128 + wr * 64 + m * 16 + fr; const f32x4 q = *(const LAS f32x4*)(RS + r * 4);
                const float inv = 1.f / ((q[0] + q[1]) + (q[2] + q[3]));
#pragma unroll
                for (int bj = 0; bj < 2; ++bj) { u32x4 w;
                    const f32x4 p0 = acc[ai][bj][m][0] * inv, p1 = acc[ai][bj][m][1] * inv;
                    w.x = cvt_pk_bf16(p0[0], p0[1]); w.y = cvt_pk_bf16(p0[2], p0[3]); w.z = cvt_pk_bf16(p1[0], p1[1]); w.w = cvt_pk_bf16(p1[2], p1[3]);
                    *(u32x4*)(base + (size_t)(ai * 128 + m * 16) * DM + bj * 128) = w; } }
        LDS_WAIT(); __builtin_amdgcn_s_barrier(); asm volatile("" ::: "memory");
    }
};

namespace nsa {
constexpr int L_K = 0, L_V = 24576, L_PCS = 49152, L_OST = 114688, L_WSF = 147456, L_SEL = 149504;
static_assert(L_SEL + 512 <= LDSCTL_OFF, "attention LDS map");
__device__ __forceinline__ int crow(int r, int hi) { return (r & 3) + 8 * (r >> 2) + 4 * hi; }
__device__ __forceinline__ constexpr int ccol(int r) { return (r & 3) + 8 * (r >> 2); }
__device__ __forceinline__ unsigned cvtpk(float lo, float hi) { return cvt_pk_bf16(lo, hi); }

__device__ __forceinline__ void qkt(f32x16& p0, f32x16& p1, const LAS unsigned char* Kslot, const bf16x8* qr, int r32, int hi, float zero_) {
    const LAS unsigned char* kb = Kslot + hi * 1024 + r32 * 16;
    f32x16 z;
#pragma unroll
    for (int r = 0; r < 16; ++r) z[r] = zero_;
    p0 = z; p1 = z;
#pragma unroll
    for (int d0 = 0; d0 < 4; ++d0) {
        const bf16x8 b0 = *(const LAS bf16x8*)(kb + d0 * 2048);
        const bf16x8 b1 = *(const LAS bf16x8*)(kb + d0 * 2048 + 512);
        p0 = __builtin_amdgcn_mfma_f32_32x32x16_bf16(b0, qr[d0], p0, 0, 0, 0);
        p1 = __builtin_amdgcn_mfma_f32_32x32x16_bf16(b1, qr[d0], p1, 0, 0, 0);
    }
}
__device__ __forceinline__ void qkt_c(f32x16& p0, f32x16& p1, const LAS unsigned char* Kslot, const bf16x8* qr, int r32, int hi, const f32x16& c) {
    const LAS unsigned char* kb = Kslot + hi * 1024 + r32 * 16;
#pragma unroll
    for (int d0 = 0; d0 < 4; ++d0) {
        const bf16x8 b0 = *(const LAS bf16x8*)(kb + d0 * 2048);
        const bf16x8 b1 = *(const LAS bf16x8*)(kb + d0 * 2048 + 512);
        if (d0 == 0) { p0 = __builtin_amdgcn_mfma_f32_32x32x16_bf16(b0, qr[0], c, 0, 0, 0); p1 = __builtin_amdgcn_mfma_f32_32x32x16_bf16(b1, qr[0], c, 0, 0, 0); }
        else { p0 = __builtin_amdgcn_mfma_f32_32x32x16_bf16(b0, qr[d0], p0, 0, 0, 0); p1 = __builtin_amdgcn_mfma_f32_32x32x16_bf16(b1, qr[d0], p1, 0, 0, 0); }
    }
}
__device__ __forceinline__ void pv(f32x16* o, int vb, bf16x8 pa0, bf16x8 pa1, bf16x8 pa2, bf16x8 pa3) {
#pragma unroll
    for (int d0 = 0; d0 < 2; ++d0) { s16x4 lo[4], hi[4];
#pragma unroll
        for (int ks = 0; ks < 4; ++ks) {
            asm volatile("ds_read_b64_tr_b16 %0,%1 offset:%c2" : "=&v"(lo[ks]) : "v"(vb), "i"(d0 * 4096 + ks * 1024) : "memory");
            asm volatile("ds_read_b64_tr_b16 %0,%1 offset:%c2" : "=&v"(hi[ks]) : "v"(vb), "i"(d0 * 4096 + ks * 1024 + 512) : "memory"); }
        asm volatile("s_waitcnt lgkmcnt(0)" ::: "memory"); __builtin_amdgcn_sched_barrier(0);
#define NSA_PK(k) (bf16x8){lo[k][0], lo[k][1], lo[k][2], lo[k][3], hi[k][0], hi[k][1], hi[k][2], hi[k][3]}
        o[d0] = __builtin_amdgcn_mfma_f32_32x32x16_bf16(pa0, NSA_PK(0), o[d0], 0, 0, 0);
        o[d0] = __builtin_amdgcn_mfma_f32_32x32x16_bf16(pa1, NSA_PK(1), o[d0], 0, 0, 0);
        o[d0] = __builtin_amdgcn_mfma_f32_32x32x16_bf16(pa2, NSA_PK(2), o[d0], 0, 0, 0);
        o[d0] = __builtin_amdgcn_mfma_f32_32x32x16_bf16(pa3, NSA_PK(3), o[d0], 0, 0, 0);
#undef NSA_PK
    }
}
__device__ __forceinline__ void x_fused(f32x16* o, int vb, bf16x8 pa0, bf16x8 pa1, bf16x8 pa2, bf16x8 pa3, f32x16& p0, f32x16& p1, int ka, int qa, const f32x16& c) {
    s16x4 l0[4], h0[4], l1[4], h1[4];
#pragma unroll
    for (int ks = 0; ks < 4; ++ks) {
        asm volatile("ds_read_b64_tr_b16 %0,%1 offset:%c2" : "=&v"(l0[ks]) : "v"(vb), "i"(ks * 1024) : "memory");
        asm volatile("ds_read_b64_tr_b16 %0,%1 offset:%c2" : "=&v"(h0[ks]) : "v"(vb), "i"(ks * 1024 + 512) : "memory"); }
#pragma unroll
    for (int ks = 0; ks < 4; ++ks) {
        asm volatile("ds_read_b64_tr_b16 %0,%1 offset:%c2" : "=&v"(l1[ks]) : "v"(vb), "i"(4096 + ks * 1024) : "memory");
        asm volatile("ds_read_b64_tr_b16 %0,%1 offset:%c2" : "=&v"(h1[ks]) : "v"(vb), "i"(4096 + ks * 1024 + 512) : "memory"); }
    asm volatile("s_waitcnt lgkmcnt(8)" : "+v"(l0[0]), "+v"(l0[1]), "+v"(l0[2]), "+v"(l0[3]), "+v"(h0[0]), "+v"(h0[1]), "+v"(h0[2]), "+v"(h0[3]) :: "memory"); __builtin_amdgcn_sched_barrier(0);
#define NSA_PK2(l, h, k) (bf16x8){l[k][0], l[k][1], l[k][2], l[k][3], h[k][0], h[k][1], h[k][2], h[k][3]}
    o[0] = __builtin_amdgcn_mfma_f32_32x32x16_bf16(pa0, NSA_PK2(l0, h0, 0), o[0], 0, 0, 0);
    o[0] = __builtin_amdgcn_mfma_f32_32x32x16_bf16(pa1, NSA_PK2(l0, h0, 1), o[0], 0, 0, 0);
    o[0] = __builtin_amdgcn_mfma_f32_32x32x16_bf16(pa2, NSA_PK2(l0, h0, 2), o[0], 0, 0, 0);
    o[0] = __builtin_amdgcn_mfma_f32_32x32x16_bf16(pa3, NSA_PK2(l0, h0, 3), o[0], 0, 0, 0);
    __builtin_amdgcn_sched_barrier(0);
    bf16x8 b0[4], b1[4], qr[4];
#define NSA_RDK(d0) do { asm volatile("ds_read_b128 %0,%1 offset:%c2" : "=&v"(b0[d0]) : "v"(ka), "i"((d0) * 2048) : "memory"); \
                         asm volatile("ds_read_b128 %0,%1 offset:%c2" : "=&v"(b1[d0]) : "v"(ka), "i"((d0) * 2048 + 512) : "memory"); \
                         asm volatile("ds_read_b128 %0,%1 offset:%c2" : "=&v"(qr[d0]) : "v"(qa), "i"((d0) * 1024) : "memory"); } while (0)
    NSA_RDK(0); NSA_RDK(1);
    asm volatile("s_waitcnt lgkmcnt(6)" : "+v"(l1[0]), "+v"(l1[1]), "+v"(l1[2]), "+v"(l1[3]), "+v"(h1[0]), "+v"(h1[1]), "+v"(h1[2]), "+v"(h1[3]) :: "memory"); __builtin_amdgcn_sched_barrier(0);
    o[1] = __builtin_amdgcn_mfma_f32_32x32x16_bf16(pa0, NSA_PK2(l1, h1, 0), o[1], 0, 0, 0);
    o[1] = __builtin_amdgcn_mfma_f32_32x32x16_bf16(pa1, NSA_PK2(l1, h1, 1), o[1], 0, 0, 0);
    o[1] = __builtin_amdgcn_mfma_f32_32x32x16_bf16(pa2, NSA_PK2(l1, h1, 2), o[1], 0, 0, 0);
    o[1] = __builtin_amdgcn_mfma_f32_32x32x16_bf16(pa3, NSA_PK2(l1, h1, 3), o[1], 0, 0, 0);
#undef NSA_PK2
    __builtin_amdgcn_sched_barrier(0);
    NSA_RDK(2); NSA_RDK(3);
#undef NSA_RDK
    asm volatile("s_waitcnt lgkmcnt(9)" : "+v"(b0[0]), "+v"(b1[0]), "+v"(qr[0]) :: "memory"); __builtin_amdgcn_sched_barrier(0);
    p0 = __builtin_amdgcn_mfma_f32_32x32x16_bf16(b0[0], qr[0], c, 0, 0, 0); p1 = __builtin_amdgcn_mfma_f32_32x32x16_bf16(b1[0], qr[0], c, 0, 0, 0);
    asm volatile("s_waitcnt lgkmcnt(6)" : "+v"(b0[1]), "+v"(b1[1]), "+v"(qr[1]) :: "memory"); __builtin_amdgcn_sched_barrier(0);
    p0 = __builtin_amdgcn_mfma_f32_32x32x16_bf16(b0[1], qr[1], p0, 0, 0, 0); p1 = __builtin_amdgcn_mfma_f32_32x32x16_bf16(b1[1], qr[1], p1, 0, 0, 0);
    asm volatile("s_waitcnt lgkmcnt(3)" : "+v"(b0[2]), "+v"(b1[2]), "+v"(qr[2]) :: "memory"); __builtin_amdgcn_sched_barrier(0);
    p0 = __builtin_amdgcn_mfma_f32_32x32x16_bf16(b0[2], qr[2], p0, 0, 0, 0); p1 = __builtin_amdgcn_mfma_f32_32x32x16_bf16(b1[2], qr[2], p1, 0, 0, 0);
    asm volatile("s_waitcnt lgkmcnt(0)" : "+v"(b0[3]), "+v"(b1[3]), "+v"(qr[3]) :: "memory"); __builtin_amdgcn_sched_barrier(0);
    p0 = __builtin_amdgcn_mfma_f32_32x32x16_bf16(b0[3], qr[3], p0, 0, 0, 0); p1 = __builtin_amdgcn_mfma_f32_32x32x16_bf16(b1[3], qr[3], p1, 0, 0, 0);
}
__device__ __forceinline__ void mask_tile(f32x16& p0, f32x16& p1, int lo, int hi_, int hi) {
    int lo2 = lo - 4 * hi, hi2 = hi_ - 4 * hi; asm volatile("" : "+v"(lo2), "+v"(hi2));
#pragma unroll
    for (int r = 0; r < 16; ++r) { if (ccol(r) < lo2 || ccol(r) > hi2) p0[r] = -INFINITY; if (ccol(r) + 32 < lo2 || ccol(r) + 32 > hi2) p1[r] = -INFINITY; }
}
__device__ __forceinline__ float max3f(float a, float b, float c) { float r; asm("v_max3_f32 %0, %1, %2, %3" : "=v"(r) : "v"(a), "v"(b), "v"(c)); return r; }
__device__ __forceinline__ float tile_max(const f32x16& p0, const f32x16& p1) {
    float a = max3f(p0[0], p0[1], p1[0]), b = max3f(p0[2], p0[3], p1[1]); a = max3f(a, p1[2], p1[3]);
#pragma unroll
    for (int r = 4; r < 16; r += 4) { a = max3f(a, p0[r], p0[r + 1]); b = max3f(b, p0[r + 2], p0[r + 3]); a = max3f(a, p1[r], p1[r + 1]); b = max3f(b, p1[r + 2], p1[r + 3]); }
    float lo, hi; half_swap(max3f(a, b, b), lo, hi); return max3f(lo, hi, hi);
}
__device__ __forceinline__ void pack_p(const f32x16& p0, const f32x16& p1, bf16x8& a0, bf16x8& a1, bf16x8& a2, bf16x8& a3) {
    u32x4 w0, w1, w2, w3;
    w0 = (u32x4){cvtpk(p0[0], p0[1]), cvtpk(p0[2], p0[3]), cvtpk(p0[4], p0[5]), cvtpk(p0[6], p0[7])};
    w1 = (u32x4){cvtpk(p0[8], p0[9]), cvtpk(p0[10], p0[11]), cvtpk(p0[12], p0[13]), cvtpk(p0[14], p0[15])};
    w2 = (u32x4){cvtpk(p1[0], p1[1]), cvtpk(p1[2], p1[3]), cvtpk(p1[4], p1[5]), cvtpk(p1[6], p1[7])};
    w3 = (u32x4){cvtpk(p1[8], p1[9]), cvtpk(p1[10], p1[11]), cvtpk(p1[12], p1[13]), cvtpk(p1[14], p1[15])};
    a0 = __builtin_bit_cast(bf16x8, w0); a1 = __builtin_bit_cast(bf16x8, w1); a2 = __builtin_bit_cast(bf16x8, w2); a3 = __builtin_bit_cast(bf16x8, w3);
}
__device__ __forceinline__ void online_step(f32x16& p0, f32x16& p1, float& m, float& l, f32x16* o, LAS float* wsf, int r32, int hi) {
    const float rm = tile_max(p0, p1);
    const float mn = fmaxf(m, rm), mu = (mn == -INFINITY) ? 0.f : mn;
    const float sc = fast_exp2(m - mu);
    float s = 0.f;
#pragma unroll
    for (int r = 0; r < 16; ++r) { p0[r] = fast_exp2(p0[r] - mu); p1[r] = fast_exp2(p1[r] - mu); s += p0[r] + p1[r]; }
    l = l * sc + s; m = mn;
    if (__any(sc != 1.f)) {
        if (hi == 0) wsf[r32] = sc;
        LDS_WAIT();
#pragma unroll
        for (int r = 0; r < 16; ++r) { const float f = wsf[crow(r, hi)]; o[0][r] *= f; o[1][r] *= f; }
        LDS_WAIT();
    }
}

struct Ptrs { const bf16_t* qraw; const bf16_t* qrot; const bf16_t* kv; const bf16_t* kcmp; const bf16_t* vcmp; const float* gates; bf16_t* ab; };

template <bool WITH_V, class F>
__device__ __forceinline__ void tile_loop(int n, const bf16_t* Kb, const bf16_t* Vb, int row0, LAS unsigned char* lds, int wid, int lane, F&& body) {
    const bf16_t* ksrc = Kb + (size_t)(row0 + lane) * 64 + wid * 8;
    const bf16_t* vsrc = Vb + (size_t)(row0 + 16 * (wid & 3) + (lane >> 2)) * 64 + (wid >> 2) * 32 + (lane & 3) * 8;
#define NSA_ISSUE(i) do { const int sl_ = ((i) & 1) * 8192; \
        __builtin_amdgcn_global_load_lds((const unsigned*)(ksrc + (size_t)(i) * 4096), (LAS unsigned*)(lds + L_K + sl_ + wid * 1024), 16, 0, 0); \
        if (WITH_V) __builtin_amdgcn_global_load_lds((const unsigned*)(vsrc + (size_t)(i) * 4096), (LAS unsigned*)(lds + L_V + sl_ + wid * 1024), 16, 0, 0); } while (0)
    NSA_ISSUE(0);
    for (int i = 0; i < n; ++i) {
        VM_WAIT(); __syncthreads();
        if (i + 1 < n) NSA_ISSUE(i + 1);
        body(i, (i & 1) * 8192);
    }
    __syncthreads();
#undef NSA_ISSUE
}
__device__ __forceinline__ void cmp_load_all(int n, const bf16_t* Kb, const bf16_t* Vb, LAS unsigned char* lds, int vofs, int wid, int lane) {
    const bf16_t* ksrc = Kb + (size_t)lane * 64 + wid * 8;
    const bf16_t* vsrc = Vb + (size_t)(16 * (wid & 3) + (lane >> 2)) * 64 + (wid >> 2) * 32 + (lane & 3) * 8;
    for (int i = 0; i < n; ++i) {
        __builtin_amdgcn_global_load_lds((const unsigned*)(ksrc + (size_t)i * 4096), (LAS unsigned*)(lds + L_K + i * 8192 + wid * 1024), 16, 0, 0);
        __builtin_amdgcn_global_load_lds((const unsigned*)(vsrc + (size_t)i * 4096), (LAS unsigned*)(lds + vofs + i * 8192 + wid * 1024), 16, 0, 0); }
}

template <int MODE>
__device__ __forceinline__ void branch_pipe(int n, const bf16_t* Kb, const bf16_t* Vb, int row0, LAS unsigned char* lds, int wid, int lane, int r32, int hi, int qa,
                                            unsigned long long sel, int tl, int qt, int kt0, float gate, LAS float* otl, LAS float* wsf, int vb0, float zero_) {
    const int half = wid >> 2;
    const bf16_t* ksrc = Kb + (size_t)(row0 + lane) * 64 + wid * 8;
    const bf16_t* vsrc = Vb + (size_t)(row0 + 16 * (wid & 3) + (lane >> 2)) * 64 + (wid >> 2) * 32 + (lane & 3) * 8;
#define BP_ISSUE_K(i, slot) __builtin_amdgcn_global_load_lds((const unsigned*)(ksrc + (size_t)(i) * 4096), (LAS unsigned*)(lds + L_K + (slot) + wid * 1024), 16, 0, 0)
#define BP_ISSUE_V(i, slot) __builtin_amdgcn_global_load_lds((const unsigned*)(vsrc + (size_t)(i) * 4096), (LAS unsigned*)(lds + L_V + (slot) + wid * 1024), 16, 0, 0)
#define BP_NEXT(s) ((s) == 16384 ? 0 : (s) + 8192)
#define BP_WAIT(c) do { if ((c) == 2) asm volatile("s_waitcnt vmcnt(2)" ::: "memory"); else if ((c) == 1) asm volatile("s_waitcnt vmcnt(1)" ::: "memory"); else asm volatile("s_waitcnt vmcnt(0)" ::: "memory"); } while (0)
#define BP_BAR() asm volatile("s_waitcnt lgkmcnt(0)\n\ts_barrier" ::: "memory")
    f32x16 o[2], p0, p1;
#pragma unroll
    for (int r = 0; r < 16; ++r) { o[0][r] = zero_; o[1][r] = zero_; p0[r] = zero_; p1[r] = zero_; }
    bf16x8 a0 = {0, 0, 0, 0, 0, 0, 0, 0}, a1 = a0, a2 = a0, a3 = a0;
    constexpr float THR = 8.f;
    f32x16 negm;
#pragma unroll
    for (int r = 0; r < 16; ++r) negm[r] = zero_;
    float mref = 0.f, l = 0.f; bool resc = false;
    const int kb0 = (int)(unsigned)(uintptr_t)(lds + L_K) + hi * 1024 + r32 * 16;
    BP_ISSUE_K(0, 0); if (n > 1) BP_ISSUE_K(1, 8192); BP_ISSUE_V(0, 0); VM_WAIT(); BP_BAR();
    int s0 = 0, sm1 = 16384;
    auto X = [&](int i) {
        if (i > 0) {
            if (resc) {
#pragma unroll
                for (int r = 0; r < 16; ++r) { const float f = (wsf + 4 * hi)[ccol(r)]; o[0][r] *= f; o[1][r] *= f; }
                LDS_WAIT(); }
            if (i < n) { x_fused(o, vb0 + sm1, a0, a1, a2, a3, p0, p1, kb0 + s0, qa, negm); return; }
            pv(o, vb0 + sm1, a0, a1, a2, a3);
        }
        if (i < n) { bf16x8 q4[4];
#pragma unroll
            for (int d0 = 0; d0 < 4; ++d0) q4[d0] = *(const LAS bf16x8*)(lds + L_OST + wid * 4096 + d0 * 1024 + lane * 16);
            qkt_c(p0, p1, lds + L_K + s0, q4, r32, hi, negm); }
    };
    auto Y = [&](int i) {
        int lo = 0, hi_ = 63; bool rowsel = true;
        if (MODE == 2) { rowsel = ((sel >> i) & 1ull) != 0; if (i == qt) hi_ = tl; }
        else { const int kt = kt0 + i; if (kt == qt - 8) lo = tl + 1; if (kt == qt) hi_ = tl; }
        if (!__all(lo <= 0 && hi_ >= 63)) mask_tile(p0, p1, lo, hi_, hi);
        else asm volatile("s_nop 15\n\ts_nop 7" : "+v"(p0), "+v"(p1));
        float rm = tile_max(p0, p1); if (!rowsel) rm = -INFINITY;
        resc = __any(rm > THR) != 0;
        if (resc) {
            const float dl = fmaxf(rm, 0.f); mref += dl;
#pragma unroll
            for (int r = 0; r < 16; ++r) { p0[r] -= dl; p1[r] -= dl; negm[r] = -mref; }
            const float f = fast_exp2(-dl); l *= f; if (hi == 0) wsf[r32] = f;
        }
        float sum = 0.f;
#pragma unroll
        for (int r = 0; r < 16; ++r) { p0[r] = fast_exp2(p0[r]); p1[r] = fast_exp2(p1[r]); sum += p0[r] + p1[r]; }
        l += rowsel ? sum : 0.f;
        pack_p(p0, p1, a0, a1, a2, a3);
        if (MODE == 2 && !rowsel) { const bf16x8 zz = {0, 0, 0, 0, 0, 0, 0, 0}; a0 = zz; a1 = zz; a2 = zz; a3 = zz; }
    };
    if (half == 0) {
        for (int j = 0; j <= n; ++j) {
            const int s1 = BP_NEXT(s0); int c = 0; if (j + 2 < n) { BP_ISSUE_K(j + 2, sm1); ++c; } if (j + 1 < n) { BP_ISSUE_V(j + 1, s1); ++c; }
            X(j); BP_BAR();
            if (j < n) Y(j);
            BP_WAIT(c); BP_BAR();
            sm1 = s0; s0 = s1;
        }
    } else {
        for (int j = 0; j <= n; ++j) {
            const int s1 = BP_NEXT(s0); int c = 0; if (j + 2 < n) { BP_ISSUE_K(j + 2, sm1); ++c; } if (j + 1 < n) { BP_ISSUE_V(j + 1, s1); ++c; }
            if (j > 0) Y(j - 1);
            BP_BAR();
            X(j);
            BP_WAIT(c); BP_BAR();
            sm1 = s0; s0 = s1;
        }
    }
#undef BP_WAIT
#undef BP_NEXT
    l = xor32_sum(l);
    if (hi == 0) wsf[r32] = l > 0.f ? gate / l : 0.f;
    LDS_WAIT();
#pragma unroll
    for (int r = 0; r < 16; ++r) { const float f = (wsf + 4 * hi)[ccol(r)]; otl[r * 64] += o[0][r] * f; otl[(16 + r) * 64] += o[1][r] * f; }
    LDS_WAIT();
#undef BP_ISSUE_K
#undef BP_ISSUE_V
#undef BP_BAR
}

__device__ __forceinline__ void unit(const Ptrs& P, int b, int g, int qt, LAS unsigned char* lds, int tid_in) {
    int tid_ = tid_in; asm volatile("" : "+v"(tid_));
    const int tid = tid_, lane = tid & 63, r32 = lane & 31, hi = lane >> 5; const int wid = __builtin_amdgcn_readfirstlane(tid >> 6);
    const int bg = b * 2 + g;
    const int tl = 8 * wid + (r32 >> 2), hr = r32 & 3;
    const int tpos = 64 * qt + tl;
    const size_t tok = (size_t)b * SEQ + tpos;
    LAS float* wsf = (LAS float*)(lds + L_WSF) + wid * 64;
    LAS float* pcs = (LAS float*)(lds + L_PCS);
    LAS unsigned long long* selm = (LAS unsigned long long*)(lds + L_SEL);
    const int vb0 = (int)(unsigned)(uintptr_t)(lds + L_V) + ((lane >> 4) & 1) * 32 + (lane & 3) * 8 + (4 * hi + ((lane & 15) >> 2)) * 64;
    const float* gp = P.gates + tok * 24 + (g * 4 + hr) * 3;
    const float g0 = gp[0], g1 = gp[1], g2 = gp[2];
    float zero_ = 0.f; asm volatile("" : "+v"(zero_));
    f32x16 ot[2];
#pragma unroll
    for (int r = 0; r < 16; ++r) { ot[0][r] = zero_; ot[1][r] = zero_; }
    bf16x8 qr[4];
    const size_t qoff = ((size_t)bg * SEQ + 64 * qt) * 256 + (size_t)(wid * 32 + r32) * 64 + hi * 8;
#pragma unroll
    for (int d0 = 0; d0 < 4; ++d0) qr[d0] = *(const bf16x8*)(P.qraw + qoff + d0 * 16);

    const int nv = tpos >= 15 ? ((tpos - 15) >> 4) : 0;
    const int nct = (4 * qt + 3 + 63) >> 6;
    const bf16_t* kc = P.kcmp + (size_t)bg * 256 * 64; const bf16_t* vc = P.vcmp + (size_t)bg * 256 * 64;
    float mc = -INFINITY, lc = 0.f;
    cmp_load_all(nct, kc, vc, lds, L_OST, wid, lane);
    VM_WAIT(); __syncthreads();
    auto pass1 = [&](int i, int sl) {
        f32x16 p0, p1; qkt(p0, p1, lds + L_K + sl, qr, r32, hi, zero_);
        mask_tile(p0, p1, 0, nv - 64 * i - 1, hi);
        const float rm = tile_max(p0, p1); const float mn = fmaxf(mc, rm), mu = (mn == -INFINITY) ? 0.f : mn;
        float s = 0.f;
#pragma unroll
        for (int r = 0; r < 16; ++r) s += fast_exp2(p0[r] - mu) + fast_exp2(p1[r] - mu);
        lc = lc * fast_exp2(mc - mu) + s; mc = mn;
    };
#pragma unroll 1
    for (int i = 0; i < nct; ++i) pass1(i, i * 8192);
    lc = xor32_sum(lc);
    {
        const float mu = (mc == -INFINITY) ? 0.f : mc, inv = lc > 0.f ? 1.f / lc : 0.f;
        auto pass2 = [&](int i, int sl) {
            f32x16 p0, p1; qkt(p0, p1, lds + L_K + sl, qr, r32, hi, zero_);
            mask_tile(p0, p1, 0, nv - 64 * i - 1, hi);
#pragma unroll
            for (int r = 0; r < 16; ++r) { p0[r] = fast_exp2(p0[r] - mu) * inv; p1[r] = fast_exp2(p1[r] - mu) * inv; }
#pragma unroll
            for (int r = 0; r < 16; ++r) {
                float a = p0[r], c = p1[r];
                a += xor_get<1>(a); a += xor_get<2>(a); c += xor_get<1>(c); c += xor_get<2>(c);
                if (hr == 0) { LAS float* pw = pcs + tl * 256 + 64 * i + 4 * hi; pw[ccol(r)] = a; pw[32 + ccol(r)] = c; }
            }
#pragma unroll
            for (int r = 0; r < 16; ++r) { p0[r] *= g0; p1[r] *= g0; }
            bf16x8 a0, a1, a2, a3; pack_p(p0, p1, a0, a1, a2, a3);
            pv(ot, vb0 + (L_OST - L_V) + sl, a0, a1, a2, a3);
        };
#pragma unroll 1
        for (int i = 0; i < nct; ++i) pass2(i, i * 8192);
    }
    LDS_WAIT(); __syncthreads();
    if (qt < 16) { if (lane < 8) selm[8 * wid + lane] = (2ull << qt) - 1ull; }
    else {
        unsigned key[8], T[8];
#pragma unroll
        for (int k = 0; k < 8; ++k) { const LAS float* pr = pcs + (8 * wid + k) * 256; key[k] = 0u; T[k] = 0u;
            if (lane <= qt) { float imp = 0.f;
#pragma unroll
                for (int j = -1; j < 4; ++j) { const int c = 4 * lane + j; if (c >= 0 && c < 255) imp += pr[c]; }
                key[k] = __builtin_bit_cast(unsigned, (lane == 0 || lane == qt || lane == qt - 1) ? INFINITY : imp) + 1u; } }
#pragma unroll
        for (int bit = 30; bit >= 0; --bit)
#pragma unroll
            for (int k = 0; k < 8; ++k) { const unsigned cand = T[k] | (1u << bit); int cnt; asm("s_bcnt1_i32_b64 %0, %1" : "=s"(cnt) : "s"(__ballot(key[k] >= cand)) : "scc");
                T[k] = cnt >= 16 ? cand : T[k]; }
#pragma unroll
        for (int k = 0; k < 8; ++k) {
            const unsigned long long eq = __ballot(key[k] == T[k]);
            const int need = 16 - __popcll(__ballot(key[k] > T[k])), below = __popcll(eq & ((1ull << lane) - 1ull));
            const unsigned long long mk = __ballot(key[k] > T[k] || (key[k] == T[k] && below < need));
            if (lane == 0) selm[8 * wid + k] = mk; }
    }
    LDS_WAIT(); __syncthreads();
    const unsigned long long sel = selm[tl];
    LAS float* otl = (LAS float*)(lds + L_PCS) + wid * 2048 + lane;
#pragma unroll
    for (int r = 0; r < 16; ++r) { otl[r * 64] = ot[0][r]; otl[(16 + r) * 64] = ot[1][r]; }
    LDS_WAIT();
#pragma unroll
    for (int d0 = 0; d0 < 4; ++d0) *(LAS bf16x8*)(lds + L_OST + wid * 4096 + d0 * 1024 + lane * 16) = *(const bf16x8*)(P.qrot + qoff + d0 * 16);
    LDS_WAIT();
    const int qa = (int)(unsigned)(uintptr_t)(lds + L_OST) + wid * 4096 + lane * 16;
    branch_pipe<2>(qt + 1, P.kv + 2 * KVSZ + (size_t)bg * SEQ * 64, P.kv + 3 * KVSZ + (size_t)bg * SEQ * 64, 0, lds, wid, lane, r32, hi, qa, sel, tl, qt, 0, g1, otl, wsf, vb0, zero_);
    { const int k0 = qt >= 8 ? qt - 8 : 0;
      branch_pipe<3>(qt - k0 + 1, P.kv + 4 * KVSZ + (size_t)bg * SEQ * 64, P.kv + 5 * KVSZ + (size_t)bg * SEQ * 64, 64 * k0, lds, wid, lane, r32, hi, qa, sel, tl, qt, k0, g2, otl, wsf, vb0, zero_); }
    {
        LAS bf16_t* stg = (LAS bf16_t*)(lds + L_OST) + wid * 2048;
#pragma unroll
        for (int r = 0; r < 16; ++r) {
#pragma unroll
            for (int d0 = 0; d0 < 2; ++d0) (stg + 4 * hi * 64 + r32)[ccol(r) * 64 + d0 * 32] = (bf16_t)f2bf(otl[(d0 * 16 + r) * 64]); }
        LDS_WAIT();
#pragma unroll
        for (int it = 0; it < 4; ++it) { const int row = it * 8 + (lane >> 3), ch = lane & 7; const u32x4 v = *(const LAS u32x4*)(stg + row * 64 + ch * 8);
            bf16_t* dst = P.ab + ((size_t)b * SEQ + 64 * qt + 8 * wid + (row >> 2)) * 1024 + g * 256 + (row & 3) * 64 + ch * 8;
            *(u32x4*)dst = v; }
        LDS_WAIT();
    }
    __syncthreads();
}

__device__ __forceinline__ void xattn_unit(const bf16_t* Q, const bf16_t* Kx, const bf16_t* Vx, bf16_t* O, int pm, int h, LAS unsigned char* lds, int tid_in) {
    int tid_ = tid_in; asm volatile("" : "+v"(tid_));
    const int tid = tid_, lane = tid & 63, r32 = lane & 31, hi = lane >> 5; const int wid = __builtin_amdgcn_readfirstlane(tid >> 6);
    constexpr int SL = 32768;
    const int b = pm >> 4;
    const bf16_t* kbase = Kx + ((size_t)b * 256 + lane) * 1024 + h * 256 + wid * 32;
    const bf16_t* vbase = Vx + ((size_t)b * 256 + (lane >> 2)) * 1024 + h * 256 + wid * 32 + (lane & 3) * 8;
#define XA_ISSUE_K(t) do { _Pragma("unroll") for (int i_ = 0; i_ < 4; ++i_) __builtin_amdgcn_global_load_lds((const unsigned*)(kbase + (size_t)(t) * 64 * 1024 + 8 * i_), \
        (LAS unsigned*)(lds + (t) * SL + (wid * 4 + i_) * 1024), 16, 0, 0); } while (0)
#define XA_ISSUE_V(t) do { _Pragma("unroll") for (int i_ = 0; i_ < 4; ++i_) __builtin_amdgcn_global_load_lds((const unsigned*)(vbase + ((size_t)(t) * 64 + 16 * i_) * 1024), \
        (LAS unsigned*)(lds + (t) * SL + (wid * 4 + i_) * 1024), 16, 0, 0); } while (0)
#define XA_BAR() asm volatile("s_waitcnt lgkmcnt(0)\n\ts_barrier" ::: "memory")
    bf16x8 qr[16];
    { const bf16_t* qp = Q + (size_t)(pm * 256 + wid * 32 + r32) * 1024 + h * 256 + hi * 8;
#pragma unroll
      for (int d0 = 0; d0 < 16; ++d0) qr[d0] = *(const bf16x8*)(qp + d0 * 16); }
    XA_ISSUE_K(0); XA_ISSUE_K(1); XA_ISSUE_K(2); XA_ISSUE_K(3);
    float zero_ = 0.f; asm volatile("" : "+v"(zero_));
    f32x16 p[4][2];
#pragma unroll
    for (int t = 0; t < 4; ++t) {
        if (t == 0) asm volatile("s_waitcnt vmcnt(12)" ::: "memory"); else if (t == 1) asm volatile("s_waitcnt vmcnt(8)" ::: "memory");
        else if (t == 2) asm volatile("s_waitcnt vmcnt(4)" ::: "memory"); else asm volatile("s_waitcnt vmcnt(8)" ::: "memory");
        XA_BAR();
        if (t == 2) { XA_ISSUE_V(0); XA_ISSUE_V(1); }
        const LAS unsigned char* kb = lds + t * SL + hi * 1024 + r32 * 16;
#pragma unroll
        for (int r = 0; r < 16; ++r) { p[t][0][r] = zero_; p[t][1][r] = zero_; }
#pragma unroll
        for (int d0 = 0; d0 < 16; ++d0) {
            const bf16x8 k0 = *(const LAS bf16x8*)(kb + d0 * 2048), k1 = *(const LAS bf16x8*)(kb + d0 * 2048 + 512);
            p[t][0] = __builtin_amdgcn_mfma_f32_32x32x16_bf16(k0, qr[d0], p[t][0], 0, 0, 0);
            p[t][1] = __builtin_amdgcn_mfma_f32_32x32x16_bf16(k1, qr[d0], p[t][1], 0, 0, 0);
        }
    }
    XA_BAR(); XA_ISSUE_V(2); XA_ISSUE_V(3);
    asm volatile("s_nop 15\n\ts_nop 7" : "+v"(p[0][0]), "+v"(p[0][1]), "+v"(p[1][0]), "+v"(p[1][1]), "+v"(p[2][0]), "+v"(p[2][1]), "+v"(p[3][0]), "+v"(p[3][1]));
    float mx = -INFINITY;
#pragma unroll
    for (int t = 0; t < 4; ++t) mx = fmaxf(mx, tile_max(p[t][0], p[t][1]));
    float sum = 0.f;
#pragma unroll
    for (int t = 0; t < 4; ++t)
#pragma unroll
        for (int r = 0; r < 16; ++r) { p[t][0][r] = fast_exp2((p[t][0][r] - mx) * CX); p[t][1][r] = fast_exp2((p[t][1][r] - mx) * CX); sum += p[t][0][r] + p[t][1][r]; }
    sum = xor32_sum(sum);
    const float inv = 1.f / sum;
    bf16x8 pa[4][4];
#pragma unroll
    for (int t = 0; t < 4; ++t) {
#pragma unroll
        for (int r = 0; r < 16; ++r) { p[t][0][r] *= inv; p[t][1][r] *= inv; }
        pack_p(p[t][0], p[t][1], pa[t][0], pa[t][1], pa[t][2], pa[t][3]); }
    f32x16 o[8];
#pragma unroll
    for (int d = 0; d < 8; ++d)
#pragma unroll
        for (int r = 0; r < 16; ++r) o[d][r] = zero_;
    const int vb0 = (int)(unsigned)(uintptr_t)lds + ((lane >> 4) & 1) * 32 + (lane & 3) * 8 + (4 * hi + ((lane & 15) >> 2)) * 64;
#pragma unroll
    for (int t = 0; t < 4; ++t) {
        if (t == 0) asm volatile("s_waitcnt vmcnt(12)" ::: "memory"); else if (t == 1) asm volatile("s_waitcnt vmcnt(8)" ::: "memory");
        else if (t == 2) asm volatile("s_waitcnt vmcnt(4)" ::: "memory"); else asm volatile("s_waitcnt vmcnt(0)" ::: "memory");
        XA_BAR();
        const int vb = vb0 + t * SL;
        s16x4 la[4], ha[4], lb[4], hb[4];
#define XA_RD(l, h, d) do { _Pragma("unroll") for (int ks = 0; ks < 4; ++ks) { \
            asm volatile("ds_read_b64_tr_b16 %0,%1 offset:%c2" : "=&v"(l[ks]) : "v"(vb), "i"((d) * 4096 + ks * 1024) : "memory"); \
            asm volatile("ds_read_b64_tr_b16 %0,%1 offset:%c2" : "=&v"(h[ks]) : "v"(vb), "i"((d) * 4096 + ks * 1024 + 512) : "memory"); } } while (0)
#define XA_PK(l, h, k) (bf16x8){l[k][0], l[k][1], l[k][2], l[k][3], h[k][0], h[k][1], h[k][2], h[k][3]}
#define XA_MM(l, h, d, cnt) do { asm volatile("s_waitcnt lgkmcnt(" #cnt ")" : "+v"(l[0]), "+v"(l[1]), "+v"(l[2]), "+v"(l[3]), "+v"(h[0]), "+v"(h[1]), "+v"(h[2]), "+v"(h[3]) :: "memory"); __builtin_amdgcn_sched_barrier(0); \
            o[d] = __builtin_amdgcn_mfma_f32_32x32x16_bf16(pa[t][0], XA_PK(l, h, 0), o[d], 0, 0, 0); o[d] = __builtin_amdgcn_mfma_f32_32x32x16_bf16(pa[t][1], XA_PK(l, h, 1), o[d], 0, 0, 0); \
            o[d] = __builtin_amdgcn_mfma_f32_32x32x16_bf16(pa[t][2], XA_PK(l, h, 2), o[d], 0, 0, 0); o[d] = __builtin_amdgcn_mfma_f32_32x32x16_bf16(pa[t][3], XA_PK(l, h, 3), o[d], 0, 0, 0); \
            __builtin_amdgcn_sched_barrier(0); } while (0)
        XA_RD(la, ha, 0);
        XA_RD(lb, hb, 1); XA_MM(la, ha, 0, 8);
        XA_RD(la, ha, 2); XA_MM(lb, hb, 1, 8);
        XA_RD(lb, hb, 3); XA_MM(la, ha, 2, 8);
        XA_RD(la, ha, 4); XA_MM(lb, hb, 3, 8);
        XA_RD(lb, hb, 5); XA_MM(la, ha, 4, 8);
        XA_RD(la, ha, 6); XA_MM(lb, hb, 5, 8);
        XA_RD(lb, hb, 7); XA_MM(la, ha, 6, 8);
        XA_MM(lb, hb, 7, 0);
#undef XA_RD
#undef XA_PK
#undef XA_MM
    }
    XA_BAR();
    {   LAS bf16_t* stg = (LAS bf16_t*)(lds + wid * 16384);
#pragma unroll
        for (int d = 0; d < 8; ++d)
#pragma unroll
            for (int r = 0; r < 16; ++r) stg[crow(r, hi) * 256 + d * 32 + r32] = (bf16_t)f2bf(o[d][r]);
        LDS_WAIT();
#pragma unroll
        for (int it = 0; it < 16; ++it) { const int row = it * 2 + (lane >> 5), ch = lane & 31; const u32x4 v = *(const LAS u32x4*)(stg + row * 256 + ch * 8);
            *(u32x4*)(O + (size_t)(pm * 256 + wid * 32 + row) * 1024 + h * 256 + ch * 8) = v; }
        LDS_WAIT();
    }
    XA_BAR();
#undef XA_ISSUE_K
#undef XA_ISSUE_V
#undef XA_BAR
}
}

#define XB_TMO      128
#define XB_XCNT(j)  (256  + 64 * (j))
#define XB_XSUB(j)  (1280 + 64 * (j))
#define XB_XGEN(j)  (2304 + 64 * (j))
#define XB_TOP      3328
#define XB_TOPGEN   3392
#define XCD_BAR_WORDS 3456
#define XB_SPIN_CAP (1u << 18)
__device__ __forceinline__ unsigned xb_ld(unsigned* p)              { return __hip_atomic_load(p, __ATOMIC_RELAXED, __HIP_MEMORY_SCOPE_AGENT); }
__device__ __forceinline__ unsigned xb_add(unsigned* p, unsigned v) { return __hip_atomic_fetch_add(p, v, __ATOMIC_RELAXED, __HIP_MEMORY_SCOPE_AGENT); }
__device__ __forceinline__ unsigned xb_xcc_id() { return (unsigned)__builtin_amdgcn_s_getreg((3 << 11) | 20) & 0xFu; }
#define XB_SPIN(cond, bar) do { unsigned _sp = 0; while (cond) { __builtin_amdgcn_s_sleep(1); \
    if ((++_sp & 255u) == 0u) { if (xb_ld(&(bar)[XB_TMO])) break; if (_sp > XB_SPIN_CAP) { atomicAdd(&(bar)[XB_TMO], 1u); break; } } } } while (0)
struct XcdBarrier { unsigned* bar; unsigned x; volatile LAS unsigned* st; };
__device__ __forceinline__ XcdBarrier xcd_barrier_post(unsigned* bar, volatile LAS unsigned* st) {
    XcdBarrier b; b.bar = bar; b.x = xb_xcc_id(); b.st = st;
    if (threadIdx.x == 0) (void)xb_add(&bar[XB_XCNT(b.x)], 1u);
    return b;
}
__device__ __forceinline__ void xcd_barrier_complete(unsigned* bar, unsigned x, unsigned& nloc, unsigned& nx) {
    const unsigned G = gridDim.x * gridDim.y * gridDim.z;
    unsigned sum, cnt, mine, sp = 0u;
    for (;;) {
        sum = 0u; cnt = 0u; mine = 0u;
#pragma unroll
        for (unsigned j = 0; j < 16; ++j) { const unsigned c = xb_ld(&bar[XB_XCNT(j)]); sum += c; cnt += (c > 0u) ? 1u : 0u; mine = (j == x) ? c : mine; }
        if (sum == G) break;
        __builtin_amdgcn_s_sleep(1);
        if ((++sp & 255u) == 0u) { if (xb_ld(&bar[XB_TMO])) break; if (sp > XB_SPIN_CAP) { atomicAdd(&bar[XB_TMO], 1u); break; } }
    }
    nloc = mine > 0u ? mine : 1u; nx = cnt > 0u ? cnt : 1u;
}
__device__ __forceinline__ void xcd_barrier(const XcdBarrier& b, int tid) {
    asm volatile("s_waitcnt vmcnt(0)" ::: "memory");
    __syncthreads();
    if (tid == 0) {
        unsigned* bar = b.bar;
        __builtin_amdgcn_s_waitcnt(0);
        unsigned nloc = b.st[0], nx = b.st[1];
        if (nloc == 0u) { xcd_barrier_complete(bar, b.x, nloc, nx); b.st[0] = nloc; b.st[1] = nx; }
        const unsigned old = xb_add(&bar[XB_XSUB(b.x)], 1u);
        const unsigned gen = old / nloc;
        if (old + 1u == (gen + 1u) * nloc) {
            __builtin_amdgcn_fence(__ATOMIC_RELEASE, "agent");
            asm volatile("s_waitcnt vmcnt(0)" ::: "memory");
            const unsigned og = xb_add(&bar[XB_TOP], 1u);
            const unsigned tg = og / nx;
            if (og + 1u == (tg + 1u) * nx) xb_add(&bar[XB_TOPGEN], 1u);
            else XB_SPIN(xb_ld(&bar[XB_TOPGEN]) == tg, bar);
            __builtin_amdgcn_fence(__ATOMIC_ACQUIRE, "agent");
            xb_add(&bar[XB_XGEN(b.x)], 1u);
            asm volatile("s_waitcnt vmcnt(0)" ::: "memory");
        } else {
            XB_SPIN(xb_ld(&bar[XB_XGEN(b.x)]) == gen, bar);
            __builtin_amdgcn_fence(__ATOMIC_ACQUIRE, "agent");
            asm volatile("s_waitcnt vmcnt(0)" ::: "memory");
        }
    }
    __syncthreads();
}

__device__ __forceinline__ void xpose_item(const float* W, int ldw, int k0, int n0, int ncv, bf16_t* WT, int ldt, int dr0, LAS float* scr, int lane, const float* gain = nullptr) {
    const int c = lane & 31;
    float wv[32];
#pragma unroll
    for (int i = 0; i < 32; ++i) { const int kk = 2 * i + (lane >> 5); wv[i] = c < ncv ? W[(size_t)(k0 + kk) * ldw + n0 + c] : 0.f; }
#pragma unroll
    for (int i = 0; i < 32; ++i) { const int kk = 2 * i + (lane >> 5); scr[kk * 33 + c] = wv[i] * (gain ? gain[k0 + kk] : 1.f); }
    LDS_WAIT(); asm volatile("" ::: "memory");
    const int c8 = lane & 7;
#pragma unroll
    for (int j = 0; j < 4; ++j) { const int n = (lane >> 3) + 8 * j; const LAS float* s = scr + (8 * c8) * 33 + n;
        u32x4 o; o.x = pk2(s[0 * 33], s[1 * 33]); o.y = pk2(s[2 * 33], s[3 * 33]); o.z = pk2(s[4 * 33], s[5 * 33]); o.w = pk2(s[6 * 33], s[7 * 33]);
        *(u32x4*)(WT + (size_t)(dr0 + n) * ldt + k0 + 8 * c8) = o; }
    LDS_WAIT(); asm volatile("" ::: "memory");
}
__device__ __forceinline__ void xpose_item64(const float* W, int ldw, int k0, int n0, bf16_t* WT, int ldt, int dr0, LAS float* scr, int lane, const float* gain) {
    const int c4 = lane & 15, r4 = lane >> 4;
    f32x4 v[16];
#pragma unroll
    for (int i = 0; i < 16; ++i) v[i] = *(const f32x4*)(W + (size_t)(k0 + 4 * i + r4) * ldw + n0 + 4 * c4);
    if (gain) {
#pragma unroll
        for (int i = 0; i < 16; ++i) v[i] = v[i] * gain[k0 + 4 * i + r4]; }
#pragma unroll
    for (int i = 0; i < 16; ++i) { LAS float* d = scr + (4 * i + r4) * 65 + 4 * c4; d[0] = v[i].x; d[1] = v[i].y; d[2] = v[i].z; d[3] = v[i].w; }
    LDS_WAIT(); asm volatile("" ::: "memory");
    const int c8 = lane & 7;
#pragma unroll
    for (int j = 0; j < 8; ++j) { const int n = (lane >> 3) + 8 * j; const LAS float* s = scr + (8 * c8) * 65 + n;
        u32x4 o; o.x = pk2(s[0 * 65], s[1 * 65]); o.y = pk2(s[2 * 65], s[3 * 65]); o.z = pk2(s[4 * 65], s[5 * 65]); o.w = pk2(s[6 * 65], s[7 * 65]);
        *(u32x4*)(WT + (size_t)(dr0 + n) * ldt + k0 + 8 * c8) = o; }
    LDS_WAIT(); asm volatile("" ::: "memory");
}
__device__ __forceinline__ void xpose_load64(const float* W, int ldw, int k0, int n0, int lane, f32x4 (&v)[16]) {
    const int c4 = lane & 15, r4 = lane >> 4;
#pragma unroll
    for (int i = 0; i < 16; ++i) v[i] = *(const f32x4*)(W + (size_t)(k0 + 4 * i + r4) * ldw + n0 + 4 * c4);
}
__device__ __forceinline__ void xpose_store64(const f32x4 (&v)[16], int k0, bf16_t* WT, int ldt, int dr0, LAS float* scr, int lane) {
    const int c4 = lane & 15, r4 = lane >> 4;
#pragma unroll
    for (int i = 0; i < 16; ++i) { LAS float* d = scr + (4 * i + r4) * 65 + 4 * c4; d[0] = v[i].x; d[1] = v[i].y; d[2] = v[i].z; d[3] = v[i].w; }
    LDS_WAIT(); asm volatile("" ::: "memory");
    const int c8 = lane & 7;
#pragma unroll
    for (int j = 0; j < 8; ++j) { const int n = (lane >> 3) + 8 * j; const LAS float* s = scr + (8 * c8) * 65 + n;
        u32x4 o; o.x = pk2(s[0 * 65], s[1 * 65]); o.y = pk2(s[2 * 65], s[3 * 65]); o.z = pk2(s[4 * 65], s[5 * 65]); o.w = pk2(s[6 * 65], s[7 * 65]);
        *(u32x4*)(WT + (size_t)(dr0 + n) * ldt + k0 + 8 * c8) = o; }
    LDS_WAIT(); asm volatile("" ::: "memory");
}
__device__ __forceinline__ void xpose_mat(const float* W, int K, int N, bf16_t* WT, int rowmap, int item, LAS float* scr, int lane, const float* gain = nullptr) {
    const int ng = N / 64, kb = item / ng, j = item % ng, n = 64 * j;
    const int dr = rowmap == 0 ? n : (256 * (n >> 7) + (n & 127) + (rowmap == 2 ? 128 : 0));
    xpose_item64(W, N, 64 * kb, n, WT, K, dr, scr, lane, gain);
}
template <int W> __device__ __forceinline__ void pool_run(const bf16_t* ub, bf16_t* ab, int rq, int lane) {
    constexpr int CLS = W == 2 ? 0 : W == 4 ? 1 : W == 8 ? 2 : 3, NR = 15 + W;
    const int t0 = (4 * rq + (lane >> 4)) * 16, t0s = t0 & (SEQ - 1), col = 128 * CLS + 8 * (lane & 15);
    u32x4 R[NR];
#pragma unroll
    for (int j = 0; j < NR; ++j) { R[j] = (u32x4){0u, 0u, 0u, 0u}; if (t0s - (W - 1) + j >= 0) R[j] = *(const u32x4*)(ub + (size_t)(t0 - (W - 1) + j) * 512 + col); }
    float s[8];
#pragma unroll
    for (int e = 0; e < 8; ++e) s[e] = 0.f;
#pragma unroll
    for (int j = 0; j < W - 1; ++j)
#pragma unroll
        for (int e = 0; e < 4; ++e) { s[2 * e] += __builtin_bit_cast(float, R[j][e] << 16); s[2 * e + 1] += __builtin_bit_cast(float, R[j][e] & 0xffff0000u); }
#pragma unroll
    for (int i = 0; i < 16; ++i) {
        float own[8];
#pragma unroll
        for (int e = 0; e < 4; ++e) { own[2 * e] = __builtin_bit_cast(float, R[W - 1 + i][e] << 16); own[2 * e + 1] = __builtin_bit_cast(float, R[W - 1 + i][e] & 0xffff0000u); }
#pragma unroll
        for (int e = 0; e < 8; ++e) s[e] += own[e];
        if (i > 0) {
#pragma unroll
            for (int e = 0; e < 4; ++e) { s[2 * e] -= __builtin_bit_cast(float, R[i - 1][e] << 16); s[2 * e + 1] -= __builtin_bit_cast(float, R[i - 1][e] & 0xffff0000u); } }
        const int n = (t0s + i + 1) < W ? (t0s + i + 1) : W; const float inv = 1.f / (float)n;
        u32x4 o; o.x = pk2(s[0] * inv - own[0], s[1] * inv - own[1]); o.y = pk2(s[2] * inv - own[2], s[3] * inv - own[3]);
        o.z = pk2(s[4] * inv - own[4], s[5] * inv - own[5]); o.w = pk2(s[6] * inv - own[6], s[7] * inv - own[7]);
        *(u32x4*)(ab + (size_t)(t0 + i) * 1024 + 512 + col) = o;
    }
}
__device__ __forceinline__ float row_rs(const float* xrow, int lane, f32x4 (&v)[4]) {
    const f32x4* xr = (const f32x4*)xrow + lane; float s = 0.f;
#pragma unroll
    for (int j = 0; j < 4; ++j) { v[j] = xr[64 * j]; s += (v[j].x * v[j].x + v[j].y * v[j].y) + (v[j].z * v[j].z + v[j].w * v[j].w); }
    return 1.0f / sqrtf(wave_sum(s) * (1.f / DM) + EPS);
}
__device__ __forceinline__ void norm_row(const float* xrow, const float* gain, bf16_t* orow, int lane) {
    f32x4 v[4]; const float rs = row_rs(xrow, lane, v);
    const f32x4* gr = (const f32x4*)gain + lane; unsigned long long* o8 = (unsigned long long*)orow + lane;
#pragma unroll
    for (int j = 0; j < 4; ++j) { const f32x4 g = gr[64 * j];
        o8[64 * j] = (unsigned long long)pk2(v[j].x * rs * g.x, v[j].y * rs * g.y) | ((unsigned long long)pk2(v[j].z * rs * g.z, v[j].w * rs * g.w) << 32); }
}
__device__ __forceinline__ void sincos_d(double a, float& s, float& c) {
    const double n = rint(a * 0.6366197723675814);
    double r = fma(-n, 1.5707963267948966, a); r = fma(-n, 6.123233995736766e-17, r);
    const double r2 = r * r;
    double sp = -1.0 / 1307674368000.0; sp = sp * r2 + 1.0 / 6227020800.0; sp = sp * r2 - 1.0 / 39916800.0; sp = sp * r2 + 1.0 / 362880.0; sp = sp * r2 - 1.0 / 5040.0; sp = sp * r2 + 1.0 / 120.0; sp = sp * r2 - 1.0 / 6.0; sp = sp * r2 * r + r;
    double cp = 1.0 / 20922789888000.0; cp = cp * r2 - 1.0 / 87178291200.0; cp = cp * r2 + 1.0 / 479001600.0; cp = cp * r2 - 1.0 / 3628800.0; cp = cp * r2 + 1.0 / 40320.0; cp = cp * r2 - 1.0 / 720.0; cp = cp * r2 + 1.0 / 24.0; cp = cp * r2 - 0.5; cp = cp * r2 + 1.0;
    const int q = (int)n & 3;
    const double ss = (q & 1) ? cp : sp, cc = (q & 1) ? sp : cp;
    s = (float)((q & 2) ? -ss : ss); c = (float)(((q + 1) & 2) ? -cc : cc);
}

struct Args {
    const float* in[30]; float* out; unsigned char* ws; int ph_lo, ph_hi;
};
enum { I_X = 0, I_MEM, I_NORM_MIX, I_W_IN, I_PE_K, I_W1_K, I_B1_K, I_W2_K, I_PE_V, I_W1_V, I_B1_V, I_W2_V, I_W_POOL, I_POOL_SCALE, I_W_OUT, I_NORM_X, I_NORM_MEM,
       I_WQ, I_WK, I_WV, I_WO, I_NORM_FFN, I_FFN_WG, I_FFN_WU, I_FFN_WD, I_ROUTER, I_MOE_WG, I_MOE_WU, I_MOE_WD, I_NORM_FINAL };
constexpr int PH_PRO = 0, PH_KV = 1, PH_L0 = 2, PH_LSTRIDE = 20;
constexpr int PO_WIN = 0, PO_CMP = 1, PO_ATT = 2, PO_WOUT = 3, PO_N2 = 4, PO_WQ = 5, PO_S = 6, PO_PV = 7, PO_WO = 8, PO_F0 = 9;

typedef const Args __attribute__((address_space(4))) CArgs;
#if RES_BF16
__device__ __forceinline__ f32x4 xrow4(const bf16_t* xb2, const float*, size_t tok, int idx) { const u32x2 w = ((const u32x2*)(xb2 + tok * DM))[idx];
    return (f32x4){__builtin_bit_cast(float, w.x << 16), __builtin_bit_cast(float, w.x & 0xffff0000u), __builtin_bit_cast(float, w.y << 16), __builtin_bit_cast(float, w.y & 0xffff0000u)}; }
__device__ __forceinline__ float xrow1(const bf16_t* xb2, const float*, size_t tok, int idx) { return bf2f(xb2[tok * DM + idx]); }
#else
__device__ __forceinline__ f32x4 xrow4(const bf16_t*, const float* x, size_t tok, int idx) { return ((const f32x4*)(x + tok * DM))[idx]; }
__device__ __forceinline__ float xrow1(const bf16_t*, const float* x, size_t tok, int idx) { return x[tok * DM + idx]; }
#endif
#define PHASE_IDS CArgs* ap_ = (CArgs*)__builtin_amdgcn_kernarg_segment_ptr(); asm volatile("" : "+s"(ap_)); unsigned char* ws = ap_->ws; (void)ws; int tid_; asm volatile("v_mbcnt_lo_u32_b32 %0, -1, 0\n\tv_mbcnt_hi_u32_b32 %0, -1, %0" : "=v"(tid_)); tid_ += wid0 * 64; const int tid = tid_, lane = tid & 63, wid = wid0, gw = bid * NWAVES + wid; (void)lane; (void)gw;
#ifndef PHMASK
#define PHMASK 0xffffffffu
#endif
#define PM(b) ((PHMASK >> (b)) & 1u)
#define IN(k) (lo <= (k) && (k) < hi)
#ifndef TSPIN_ORD
#define TSPIN_ORD -1
#endif
#if DBG >= 200 || TSPIN_ORD >= 0
#define SEAM(k) do { if (hi > (k) + 1) xcd_barrier(bar, tid); if (bid == 0 && tid == 0) ((unsigned long long*)((unsigned*)(ws + WS_CTL) + 20000))[(k)] = __builtin_amdgcn_s_memrealtime(); } while (0)
#else
#ifndef BAR_REP
#define BAR_REP 1
#endif
#define SEAM(k) do { if (hi > (k) + 1) for (int br_ = 0; br_ < BAR_REP; ++br_) xcd_barrier(bar, tid); } while (0)
#endif
#define W16(off) ((bf16_t*)(ws + (off)))
constexpr int MOE_IT_MG = 16 * 56, MOE_IT_MD = 56 * 16, MOE_NM = 16 * MOE_IT_MG + 8 * MOE_IT_MD, MOE_S0 = 5 * 176 * 8, MOE_S1 = MOE_S0 + 3 * 128 * 8;
__device__ __forceinline__ void moe_convert(const float* wgp, const float* wup, const float* wdp, unsigned char* ws, LAS unsigned char* lds, int it_lo, int it_hi, int rank, int nranks, int wid, int lane) {
    LAS float* scr = (LAS float*)(lds + wid * 16896);
    auto ld = [&](int it, f32x4 (&v)[16]) {
        if (it < 16 * MOE_IT_MG) { const int mtx = it / MOE_IT_MG, r = it % MOE_IT_MG, e = mtx >> 1, up = mtx & 1, kb = r / 56, j = r % 56;
            xpose_load64((up ? wup : wgp) + (size_t)e * DM * DFFE, DFFE, 64 * kb, 64 * j, lane, v);
        } else { const int r0 = it - 16 * MOE_IT_MG, e = r0 / MOE_IT_MD, r = r0 % MOE_IT_MD, kb = r / 16, j = r % 16;
            xpose_load64(wdp + (size_t)e * DFFE * DM, DM, 64 * kb, 64 * j, lane, v); } };
    auto st = [&](int it, const f32x4 (&v)[16]) {
        if (it < 16 * MOE_IT_MG) { const int mtx = it / MOE_IT_MG, r = it % MOE_IT_MG, e = mtx >> 1, up = mtx & 1, kb = r / 56, j = r % 56, n = 64 * j;
            xpose_store64(v, 64 * kb, W16(WS_MGU) + (size_t)e * 7168 * DM, DM, 256 * (n >> 7) + (n & 127) + (up ? 128 : 0), scr, lane);
        } else { const int r0 = it - 16 * MOE_IT_MG, e = r0 / MOE_IT_MD, r = r0 % MOE_IT_MD, kb = r / 16, j = r % 16;
            xpose_store64(v, 64 * kb, W16(WS_MD) + (size_t)e * DM * DFFE, DFFE, 64 * j, scr, lane); } };
    int it = it_lo + rank;
    f32x4 va[16], vb[16];
    if (it < it_hi) ld(it, va);
    while (it < it_hi) {
        if (it + nranks < it_hi) ld(it + nranks, vb);
        st(it, va); it += nranks; if (it >= it_hi) break;
        if (it + nranks < it_hi) ld(it + nranks, va);
        st(it, vb); it += nranks;
    }
}
template <int layer> __device__ __forceinline__ void layer_phases(LAS unsigned char* lds, const int lo, const int hi, const XcdBarrier& bar, const int G, const int bid, const int NGW, const int wid0) {
        const int pb = PH_L0 + layer * PH_LSTRIDE;
        if (PM(2) && IN(pb + PO_WIN)) {
            PHASE_IDS
            pg8::Gemm g{(const char*)(ws + WS_HB), (const char*)(ws + WS_WIN + (size_t)layer * ZW * DM * 2), DM, DM, DM};
            SchedPlain S; S.init(T / 256, ZW / 256, DM, DM, G, bid);
            EpiWin E{W16(WS_QRAW), W16(WS_QROT), W16(WS_KV), W16(WS_U), (float*)(ws + WS_GATES), (const float*)(ws + WS_ROPE), SSP(layer == 0 ? 0 : 3)};
            for (int rep_ = 0; rep_ < REPN(2); ++rep_) pg8::gemm_phase<EpiWin, SchedPlain, true, true>(lds, g, S, E, tid);
            SEAM(pb + PO_WIN);
        }
        if (PM(3) && IN(pb + PO_CMP)) {
            PHASE_IDS
            for (int rep_ = 0; rep_ < REPN(3); ++rep_)
            if (bid < 16) {
                const int kv = bid >> 3, pm = bid & 7, mtx = layer * 2 + kv;
                {
                    pg8::Gemm g{(const char*)(ws + WS_KV + (size_t)kv * KVSZ * 2), (const char*)(ws + WS_CW1 + (size_t)mtx * 256 * 2048 * 2), 2048, 1024, 2048};
                    SchedOne S; S.u.pm = pm; S.u.pn = 0; S.u.aoff = (long)pm * 256 * 1024 * 2; S.u.boff = 0; S.u.coff = 0;
                    EpiHid E{W16(WS_HID) + (size_t)kv * 2048 * 256, (const long long*)((const unsigned*)(ws + WS_CTL) + CW_BIAS) + mtx * 256};
                    pg8::gemm_phase<EpiHid, SchedOne, false, true>(lds, g, S, E, tid);
                }
                VM_WAIT(); __syncthreads();
                __builtin_amdgcn_fence(__ATOMIC_ACQUIRE, "agent"); VM_WAIT(); __syncthreads();
                {
                    pg8::Gemm g{(const char*)(ws + WS_HID + (size_t)kv * 2048 * 256 * 2), (const char*)(ws + WS_CW2 + (size_t)mtx * 256 * 256 * 2), 256, 256, 256};
                    SchedOne S; S.u.pm = pm; S.u.pn = 0; S.u.aoff = (long)pm * 256 * 256 * 2; S.u.boff = 0; S.u.coff = 0;
                    EpiCmp2 E{W16(WS_KCMP) + (size_t)kv * 8 * 256 * 64};
                    pg8::gemm_phase<EpiCmp2, SchedOne, false, true>(lds, g, S, E, tid);
                }
            } else if (layer == 0 && bid < 80) {
                pg8::Gemm g{(const char*)ws, (const char*)ws, DM, DM, DM}; SchedKV S{1, bid - 16}; EpiPlain E{(bf16_t*)ws, DM, nullptr};
                pg8::gemm_phase<EpiPlain, SchedKV, false, true>(lds, g, S, E, tid);
            } else {
                const int nw = layer == 0 ? G - 80 : G - 16, w0 = layer == 0 ? 80 : 16;
                moe_convert(ap_->in[I_MOE_WG], ap_->in[I_MOE_WU], ap_->in[I_MOE_WD], ws, lds, layer == 0 ? 0 : MOE_S1, layer == 0 ? MOE_S0 : MOE_NM, (bid - w0) * NWAVES + wid, nw * NWAVES, wid, lane);
                const bf16_t* ub = W16(WS_U); bf16_t* ab = W16(WS_AB);
                for (int p = (bid - w0) * NWAVES + wid; p < 1024; p += nw * NWAVES) { const int rq = p & 255;
                    switch (p >> 8) { case 0: pool_run<16>(ub, ab, rq, lane); break; case 1: pool_run<8>(ub, ab, rq, lane); break; case 2: pool_run<4>(ub, ab, rq, lane); break; default: pool_run<2>(ub, ab, rq, lane); break; } }
            }
            SEAM(pb + PO_CMP);
        }
        if (PM(4) && IN(pb + PO_ATT)) {
            PHASE_IDS
            nsa::Ptrs P{W16(WS_QRAW), W16(WS_QROT), W16(WS_KV), W16(WS_KCMP), W16(WS_KCMP) + 8 * 256 * 64, (const float*)(ws + WS_GATES), W16(WS_AB)};
            const int vcu = (G % 8 == 0) ? (bid % 8) * (G / 8) + bid / 8 : bid;
            for (int rep_ = 0; rep_ < REP_ATT; ++rep_)
            for (int uix = vcu; uix < 8 * 32; uix += G) { const int bgx = uix >> 5, s = uix & 31;
                nsa::unit(P, bgx >> 1, bgx & 1, 63 - s, lds, tid);
                nsa::unit(P, bgx >> 1, bgx & 1, s, lds, tid); }
            SEAM(pb + PO_ATT);
        }
        if (PM(5) && IN(pb + PO_WOUT)) {
            PHASE_IDS
            pg8::Gemm g{(const char*)(ws + WS_AB), (const char*)(ws + WS_WOUT + (size_t)layer * DM * DM * 2), DM, DM, DM};
            SchedPlain S; S.init(T / 256, DM / 256, DM, DM, G, bid);
#if RES_BF16
            if constexpr (layer == 0) { EpiResB<true> E{ap_->in[I_X], W16(WS_HB), SSP(1)}; pg8::gemm_phase<EpiResB<true>, SchedPlain, true, true>(lds, g, S, E, tid); }
            else { EpiResB<false> E{W16(WS_HB), W16(WS_HB), SSP(4)}; pg8::gemm_phase<EpiResB<false>, SchedPlain, true, true>(lds, g, S, E, tid); }
#else
            EpiRes E{layer == 0 ? ap_->in[I_X] : ap_->out, ap_->out, W16(WS_HB), SSP(layer == 0 ? 1 : 4)};
            pg8::gemm_phase<EpiRes, SchedPlain, true, true>(lds, g, S, E, tid);
#endif
            SEAM(pb + PO_WOUT);
        }
        if (PM(7) && IN(pb + PO_WQ)) {
            PHASE_IDS
            for (int rep_ = 0; rep_ < REPN(7); ++rep_) {
            {   pg8::Gemm g{(const char*)(ws + WS_HB), (const char*)(ws + WS_WQ + (size_t)layer * DM * DM * 2), DM, DM, DM};
                SchedPlain S; S.init(T / 256, DM / 256, DM, DM, G, bid);
                EpiPlain E{W16(WS_QX), DM, SSP(layer == 0 ? 1 : 4)};
                pg8::gemm_phase<EpiPlain, SchedPlain, false, true>(lds, g, S, E, tid); }
            VM_WAIT(); __syncthreads(); __builtin_amdgcn_fence(__ATOMIC_ACQUIRE, "agent"); VM_WAIT(); __syncthreads();
            {
                pg8::TileOrder o; o.init(T / 256, DM / 256, G, bid); int pm, pn;
#if TSPIN_ORD == 100
                if (layer == 0 && bid == 0 && tid == 0) ((unsigned long long*)((unsigned*)(ws + WS_CTL) + 20000))[60] = __builtin_amdgcn_s_memrealtime();
#endif
                if (o.tile(0, pm, pn)) { nsa::xattn_unit(W16(WS_QX), W16(WS_KX) + (size_t)layer * DM * DM, W16(WS_VXT) + (size_t)layer * DM * DM, W16(WS_OX), pm, pn, lds, tid);
#if TSPIN_ORD == 100
                if (layer == 0 && bid == 0 && tid == 0) ((unsigned long long*)((unsigned*)(ws + WS_CTL) + 20000))[61] = __builtin_amdgcn_s_memrealtime();
#endif
#if DBG == 400
                    if (layer == 1) { nsa::xattn_unit(W16(WS_QX), W16(WS_KX) + (size_t)layer * DM * DM, W16(WS_VXT) + (size_t)layer * DM * DM, W16(WS_ACTC), pm, pn, lds, tid);
                        VM_WAIT(); __syncthreads(); __builtin_amdgcn_fence(__ATOMIC_ACQUIRE, "agent"); VM_WAIT(); __syncthreads();
                        unsigned c = 0; for (int i = tid; i < 256 * 256; i += 512) { const size_t off = (size_t)(pm * 256 + (i >> 8)) * 1024 + pn * 256 + (i & 255); c += W16(WS_OX)[off] != W16(WS_ACTC)[off]; }
                        if (c) atomicAdd((unsigned*)(ws + WS_CTL) + 21100, c); }
#endif
                } }
            if (rep_ + 1 < REPN(7)) { VM_WAIT(); __syncthreads(); }
            }
            SEAM(pb + PO_PV);
        }
        if (PM(10) && IN(pb + PO_WO)) {
            PHASE_IDS
            pg8::Gemm g{(const char*)(ws + WS_OX), (const char*)(ws + WS_WO + (size_t)layer * DM * DM * 2), DM, DM, DM};
            SchedPlain S; S.init(T / 256, DM / 256, DM, DM, G, bid);
#if RES_BF16
            EpiResB<false> E{W16(WS_HB), layer == 0 ? W16(WS_HB) : W16(WS_XB2), layer == 0 ? SSP(2) : nullptr};
            pg8::gemm_phase<EpiResB<false>, SchedPlain, true, true>(lds, g, S, E, tid);
#else
            EpiRes E{ap_->out, ap_->out, layer == 0 ? W16(WS_HB) : nullptr, SSP(2)};
            pg8::gemm_phase<EpiRes, SchedPlain, true, true>(lds, g, S, E, tid);
#endif
            SEAM(pb + PO_WO);
        }
        if constexpr (layer == 0) {
            if (PM(12) && IN(pb + PO_F0 + 1)) {
            PHASE_IDS
                pg8::Gemm g{(const char*)(ws + WS_HB), (const char*)(ws + WS_FGU), DM, DM, DM};
                SchedPlain S; S.init(T / 256, 2 * DFF / 256, DM, DM, G, bid);
                EpiSwiglu<2> E{W16(WS_ACT0), DFF, nullptr, SSP(2)};
                for (int rep_ = 0; rep_ < REPN(12); ++rep_) pg8::gemm_phase<EpiSwiglu<2>, SchedPlain, true, true>(lds, g, S, E, tid);
                if (bid >= 128) { __syncthreads();
                    moe_convert(ap_->in[I_MOE_WG], ap_->in[I_MOE_WU], ap_->in[I_MOE_WD], ws, lds, MOE_S0, MOE_S1, (bid - 128) * NWAVES + wid, 128 * NWAVES, wid, lane); __syncthreads(); }
                SEAM(pb + PO_F0 + 1);
            }
            if (PM(13) && IN(pb + PO_F0 + 2)) {
            PHASE_IDS
                pg8::Gemm g{(const char*)(ws + WS_ACT0), (const char*)(ws + WS_FD), DFF, DFF, DFF};
                SchedPlain S; S.init(T / 256, DM / 256, DFF, DFF, G, bid);
#if RES_BF16
                EpiResB<false> E{W16(WS_HB), W16(WS_HB), SSP(3)};
                pg8::gemm_phase<EpiResB<false>, SchedPlain, true, true>(lds, g, S, E, tid);
#else
                EpiRes E{ap_->out, ap_->out, W16(WS_HB), SSP(3)};
                pg8::gemm_phase<EpiRes, SchedPlain, true, true>(lds, g, S, E, tid);
#endif
                SEAM(pb + PO_F0 + 2);
            }
        } else {
#define route ((unsigned*)(ws + WS_ROUTE))
#define cntg ((unsigned*)(ws + WS_CNTG))
#define tinfo ((unsigned*)(ws + WS_TILE))
#define slot ((unsigned*)(ws + WS_SLOT))
            LAS int* LE = (LAS int*)lds;
            LAS float* LW = (LAS float*)(lds + 512);
            LAS int* LR = (LAS int*)(lds + 1024);
            LAS int* LC = (LAS int*)(lds + 1536);
            if (PM(15) && IN(pb + PO_F0)) {
            PHASE_IDS
                const float* gain = ap_->in[I_NORM_FFN] + DM; const float* wr = ap_->in[I_ROUTER];
                float wgr[16][8];
#pragma unroll
                for (int jj = 0; jj < 16; ++jj) { const int k = lane + 64 * jj; const float gk = gain[k]; const f32x4 w0 = *(const f32x4*)(wr + (size_t)k * 8), w1 = *(const f32x4*)(wr + (size_t)k * 8 + 4);
#pragma unroll
                    for (int c = 0; c < 4; ++c) { wgr[jj][c] = gk * w0[c]; wgr[jj][4 + c] = gk * w1[c]; } }
                for (int rep_ = 0; rep_ < REPN(15); ++rep_)
                for (int tb = bid; tb < T / 64; tb += G) {
                    for (int k = 0; k < 8; ++k) { const int tl = 8 * wid + k, tok = 64 * tb + tl;
                        float xs[16], sq = 0.f;
#pragma unroll
                        for (int jj = 0; jj < 16; ++jj) { xs[jj] = xrow1(W16(WS_XB2), ap_->out, (size_t)tok, lane + 64 * jj); sq += xs[jj] * xs[jj]; }
                        const float rs = 1.0f / sqrtf(wave_sum(sq) * (1.f / DM) + EPS);
                        float lg[8];
#pragma unroll
                        for (int e = 0; e < 8; ++e) lg[e] = 0.f;
#pragma unroll
                        for (int jj = 0; jj < 16; ++jj) { const float h = xs[jj] * rs;
#pragma unroll
                            for (int e = 0; e < 8; ++e) lg[e] += h * wgr[jj][e]; }
                        { const bool b0 = lane & 1, b1 = lane & 2, b2 = lane & 4; float a4[4], a2[2], a1;
#pragma unroll
                          for (int i = 0; i < 4; ++i) a4[i] = (b0 ? lg[4 + i] : lg[i]) + xor_get<1>(b0 ? lg[i] : lg[4 + i]);
#pragma unroll
                          for (int i = 0; i < 2; ++i) a2[i] = (b1 ? a4[2 + i] : a4[i]) + xor_get<2>(b1 ? a4[i] : a4[2 + i]);
                          a1 = (b2 ? a2[1] : a2[0]) + xor_get<4>(b2 ? a2[0] : a2[1]);
                          a1 += xor_get<8>(a1); a1 += xor_get<16>(a1); a1 = xor32_sum(a1);
#pragma unroll
                          for (int e = 0; e < 8; ++e) lg[e] = __builtin_bit_cast(float, __builtin_amdgcn_readlane(__builtin_bit_cast(int, a1), ((e >> 2) & 1) | (((e >> 1) & 1) << 1) | ((e & 1) << 2))); }
                        if (lane == 0) { int i1 = 0; float v1 = lg[0];
#pragma unroll
                            for (int e = 1; e < 8; ++e) if (lg[e] > v1) { v1 = lg[e]; i1 = e; }
                            int i2 = -1; float v2 = -INFINITY;
#pragma unroll
                            for (int e = 0; e < 8; ++e) if (e != i1 && lg[e] > v2) { v2 = lg[e]; i2 = e; }
                            const float w1 = 1.f / (1.f + expf(v2 - v1));
                            LE[2 * tl] = i1; LE[2 * tl + 1] = i2; LW[2 * tl] = w1; LW[2 * tl + 1] = 1.f - w1; }
                    }
                    LDS_WAIT(); __syncthreads();
                    if (tid < 8) { int c = 0; for (int i = 0; i < 128; ++i) if (LE[i] == tid) LR[i] = c++; LC[tid] = c; }
                    LDS_WAIT(); __syncthreads();
                    if (tid < 64) { const int tok = 64 * tb + tid; u32x4 a, b2; a.x = LE[2 * tid]; a.y = LE[2 * tid + 1]; a.z = LR[2 * tid]; a.w = LR[2 * tid + 1];
                        b2.x = __builtin_bit_cast(unsigned, LW[2 * tid]); b2.y = __builtin_bit_cast(unsigned, LW[2 * tid + 1]); b2.z = 0u; b2.w = 0u;
                        *(u32x4*)(route + (size_t)tok * 8) = a; *(u32x4*)(route + (size_t)tok * 8 + 4) = b2; }
                    if (tid < 8) cntg[tb * 8 + tid] = (unsigned)LC[tid];
                    LDS_WAIT(); __syncthreads();
                }
                SEAM(pb + PO_F0);
            }
            if (PM(16) && IN(pb + PO_F0 + 1)) {
            PHASE_IDS
                LAS unsigned* CN = (LAS unsigned*)(lds + 4096);
                LAS unsigned* SB = (LAS unsigned*)(lds + 2048);
                LAS unsigned* TOTS = (LAS unsigned*)(lds + 2048 + 64);
                LAS unsigned* MYB = (LAS unsigned*)(lds + 2048 + 128);
                const float* gain = ap_->in[I_NORM_FFN] + DM;
                for (int rep_ = 0; rep_ < REPN(16); ++rep_)
                for (int tb = bid; tb < T / 64; tb += G) {
                    for (int i = tid; i < 2048; i += 512) CN[i] = cntg[i];
                    LDS_WAIT(); __syncthreads();
                    if (tid < 8) { unsigned tot = 0, myb = 0; for (int w = 0; w < 256; ++w) { const unsigned c = CN[w * 8 + tid]; if (w < tb) myb += c; tot += c; } TOTS[tid] = tot; MYB[tid] = myb; }
                    LDS_WAIT(); __syncthreads();
                    if (tid == 0) { unsigned toff = 0; for (int e = 0; e < 8; ++e) { SB[e] = toff * 256 + MYB[e]; const unsigned nte = (TOTS[e] + 255) >> 8;
                            if (tb == 0) for (unsigned k = 0; k < nte; ++k) tinfo[8 + toff + k] = e;
                            toff += nte; }
                        if (tb == 0) tinfo[0] = toff; }
                    LDS_WAIT(); __syncthreads();
                    f32x4 ggr[4];
#pragma unroll
                    for (int j = 0; j < 4; ++j) ggr[j] = ((const f32x4*)gain)[lane + 64 * j];
#pragma unroll 1
                    for (int k0 = 0; k0 < 8; k0 += 4) {
                        u32x4 ra[4], rb[4]; f32x4 xv[4][4];
#pragma unroll
                        for (int q = 0; q < 4; ++q) { const int tok = 64 * tb + 8 * wid + k0 + q; ra[q] = *(const u32x4*)(route + (size_t)tok * 8); rb[q] = *(const u32x4*)(route + (size_t)tok * 8 + 4);
#pragma unroll
                            for (int j = 0; j < 4; ++j) xv[q][j] = xrow4(W16(WS_XB2), ap_->out, (size_t)tok, lane + 64 * j); }
#pragma unroll
                        for (int q = 0; q < 4; ++q) { const int tok = 64 * tb + 8 * wid + k0 + q;
                            const unsigned s1 = SB[ra[q].x] + ra[q].z, s2 = SB[ra[q].y] + ra[q].w;
                            if (lane == 0) { u32x4 o; o.x = s1; o.y = s2; o.z = rb[q].x; o.w = rb[q].y; *(u32x4*)(slot + (size_t)tok * 4) = o; }
                            float sq = 0.f;
#pragma unroll
                            for (int j = 0; j < 4; ++j) { const f32x4 v = xv[q][j]; sq += (v.x * v.x + v.y * v.y) + (v.z * v.z + v.w * v.w); }
                            const float rs = 1.0f / sqrtf(wave_sum(sq) * (1.f / DM) + EPS);
                            unsigned long long* o1 = (unsigned long long*)(W16(WS_HP) + (size_t)s1 * DM) + lane; unsigned long long* o2 = (unsigned long long*)(W16(WS_HP) + (size_t)s2 * DM) + lane;
#pragma unroll
                            for (int j = 0; j < 4; ++j) { const f32x4 v = xv[q][j], gg = ggr[j];
                                const unsigned long long pk = (unsigned long long)pk2(v.x * rs * gg.x, v.y * rs * gg.y) | ((unsigned long long)pk2(v.z * rs * gg.z, v.w * rs * gg.w) << 32);
                                o1[64 * j] = pk; o2[64 * j] = pk; } }
                    }
                    LDS_WAIT(); __syncthreads();
                }
                SEAM(pb + PO_F0 + 1);
            }
#pragma unroll 1
            for (int ch = 0; ch < 2; ++ch) {
                const int t0 = ch * HALFT;
#define MOE_NM int nm = (int)tinfo[0] - t0; if (ch == 0) nm = nm > HALFT ? HALFT : nm; nm = nm < 0 ? 0 : (nm > CH1T ? CH1T : nm);
                if (PM(17) && IN(pb + PO_F0 + 2 + 2 * ch)) {
            PHASE_IDS
                    MOE_NM
                    pg8::Gemm g{(const char*)(ws + WS_HP + (size_t)t0 * 256 * DM * 2), (const char*)(ws + WS_MGU), DM, DM, DM};
                    SchedMoe S; S.o.init(nm, 2 * DFFE / 256, G, bid); S.texp = tinfo + 8; S.t0 = t0; S.nn = 2 * DFFE / 256; S.astep = 256L * DM * 2; S.bstep = 256L * DM * 2; S.estep = 7168L * DM * 2; S.cstep = 256L * DFFE; S.khb = 0; S.khc = 0;
                    EpiSwiglu<0> E{W16(WS_ACTC), DFFE, nullptr};
                    for (int rep_ = 0; rep_ < REPN(17); ++rep_) pg8::gemm_phase<EpiSwiglu<0>, SchedMoe, true, true>(lds, g, S, E, tid);
                    SEAM(pb + PO_F0 + 2 + 2 * ch);
                }
                if (PM(18) && IN(pb + PO_F0 + 3 + 2 * ch)) {
            PHASE_IDS
                    MOE_NM
                    pg8::Gemm g{(const char*)(ws + WS_ACTC), (const char*)(ws + WS_MD), DFFE / 2, DFFE, DFFE};
                    SchedMoe S; S.o.init(nm, 2 * DM / 256, G, bid); S.texp = tinfo + 8; S.t0 = t0; S.nn = DM / 256; S.astep = 256L * DFFE * 2; S.bstep = 256L * DFFE * 2; S.estep = 1024L * DFFE * 2; S.cstep = 0;
                    S.khb = (long)(DFFE / 2) * 2; S.khc = ((long)WS_YB - (long)WS_HP) / 2;
                    EpiPlain E{W16(WS_HP), DM, nullptr};
                    for (int rep_ = 0; rep_ < REPN(18); ++rep_) pg8::gemm_phase<EpiPlain, SchedMoe, true, true>(lds, g, S, E, tid);
                    SEAM(pb + PO_F0 + 3 + 2 * ch);
                }
            }
            if (PM(19) && IN(pb + PO_F0 + 6)) {
            PHASE_IDS
                const float* gain = ap_->in[I_NORM_FINAL];
                f32x4 gg[4];
#pragma unroll
                for (int j = 0; j < 4; ++j) gg[j] = ((const f32x4*)gain)[lane + 64 * j];
#define BLO(u) __builtin_bit_cast(float, (u) << 16)
#define BHI(u) __builtin_bit_cast(float, (u) & 0xffff0000u)
                int r = gw;
                u32x2 si = {0u, 0u}; float w1 = 0.f, w2 = 0.f; f32x4 xv[4];
                if (r < T) { si = *(const u32x2*)(slot + (size_t)r * 4); w1 = ((const float*)slot)[(size_t)r * 4 + 2]; w2 = ((const float*)slot)[(size_t)r * 4 + 3];
#pragma unroll
                    for (int j = 0; j < 4; ++j) xv[j] = xrow4(W16(WS_XB2), ap_->out, (size_t)r, lane + 64 * j); }
                while (r < T) {
                    asm volatile("" : "+v"(w1), "+v"(w2));
                    const u32x2* y1 = (const u32x2*)(W16(WS_HP) + (size_t)si.x * DM) + lane; const u32x2* y2 = (const u32x2*)(W16(WS_HP) + (size_t)si.y * DM) + lane;
                    const u32x2* z1 = (const u32x2*)(W16(WS_YB) + (size_t)si.x * DM) + lane; const u32x2* z2 = (const u32x2*)(W16(WS_YB) + (size_t)si.y * DM) + lane;
                    u32x2 a[4], c[4], a2[4], c2[4];
#pragma unroll
                    for (int j = 0; j < 4; ++j) { a[j] = y1[64 * j]; c[j] = y2[64 * j]; a2[j] = z1[64 * j]; c2[j] = z2[64 * j]; }
                    const int rn = r + NGW; u32x2 sin = {0u, 0u}; float w1n = 0.f, w2n = 0.f; f32x4 xn[4];
                    if (rn < T) { sin = *(const u32x2*)(slot + (size_t)rn * 4); w1n = ((const float*)slot)[(size_t)rn * 4 + 2]; w2n = ((const float*)slot)[(size_t)rn * 4 + 3];
#pragma unroll
                        for (int j = 0; j < 4; ++j) xn[j] = xrow4(W16(WS_XB2), ap_->out, (size_t)rn, lane + 64 * j); }
                    f32x4 v[4]; float s = 0.f;
#pragma unroll
                    for (int j = 0; j < 4; ++j) { const f32x4 x = xv[j];
                        v[j].x = x.x + w1 * (BLO(a[j].x) + BLO(a2[j].x)) + w2 * (BLO(c[j].x) + BLO(c2[j].x));
                        v[j].y = x.y + w1 * (BHI(a[j].x) + BHI(a2[j].x)) + w2 * (BHI(c[j].x) + BHI(c2[j].x));
                        v[j].z = x.z + w1 * (BLO(a[j].y) + BLO(a2[j].y)) + w2 * (BLO(c[j].y) + BLO(c2[j].y));
                        v[j].w = x.w + w1 * (BHI(a[j].y) + BHI(a2[j].y)) + w2 * (BHI(c[j].y) + BHI(c2[j].y));
                        s += (v[j].x * v[j].x + v[j].y * v[j].y) + (v[j].z * v[j].z + v[j].w * v[j].w); }
                    const float rs = 1.0f / sqrtf(wave_sum(s) * (1.f / DM) + EPS);
                    f32x4* orow = (f32x4*)(ap_->out + (size_t)r * DM) + lane;
#pragma unroll
                    for (int j = 0; j < 4; ++j) orow[64 * j] = (f32x4){v[j].x * rs * gg[j].x, v[j].y * rs * gg[j].y, v[j].z * rs * gg[j].z, v[j].w * rs * gg[j].w};
                    r = rn; si = sin; w1 = w1n; w2 = w2n;
#pragma unroll
                    for (int j = 0; j < 4; ++j) xv[j] = xn[j];
                }
            }
        }
}

__global__ void __launch_bounds__(NWAVES * 64, 2) fwd(Args args) {
    extern __shared__ __attribute__((aligned(16))) unsigned char lds_raw[];
    LAS unsigned char* lds = (LAS unsigned char*)lds_raw;
    const int G = gridDim.x, bid = blockIdx.x, NGW = G * NWAVES;
    const int wid0 = __builtin_amdgcn_readfirstlane((int)threadIdx.x >> 6);
    unsigned* ctl = (unsigned*)(args.ws + WS_CTL);
    const int lo = args.ph_lo, hi = args.ph_hi;
    for (int u = threadIdx.x; u < (LDS_BYTES - LDSCTL_OFF) / 4; u += NWAVES * 64) ((LAS unsigned*)(lds + LDSCTL_OFF))[u] = 0u;
    __syncthreads();
#if DBG >= 200 || TSPIN_ORD >= 0
    if (blockIdx.x == 0 && threadIdx.x == 0) ((unsigned long long*)(ctl + 20000))[63] = __builtin_amdgcn_s_memrealtime();
#endif
    const bool multi = (hi - lo) > 1;
    XcdBarrier bar; bar.bar = ctl + CW_BAR; bar.x = 0; bar.st = nullptr;
    if (multi) bar = xcd_barrier_post(ctl + CW_BAR, (volatile LAS unsigned*)(lds + LDSCTL_OFF + 32));

    if (PM(0) && IN(PH_PRO)) {
            PHASE_IDS
        LAS float* scr = (LAS float*)(lds + wid * 16896);
        constexpr int IT_WIN = 16 * 64, IT_WOUT = 8 * 32, IT_SQ = 16 * 16, IT_C1 = 32 * 4, IT_C2 = 4 * 8, IT_FG = 16 * 44, IT_FD = 44 * 16;
        constexpr int N0 = 2 * IT_WIN, N1 = N0 + 2 * IT_WOUT, N2 = N1 + 8 * IT_SQ, N3 = N2 + 4 * IT_C1, N4 = N3 + 4 * IT_C2, N5 = N4 + 2 * IT_FG, N6 = N5 + IT_FD;
        for (int rep_ = 0; rep_ < REP_PRO; ++rep_)
        for (int it = gw; it < N6; it += NGW) {
            if (it < N0) { const int l = it / IT_WIN, r = it % IT_WIN, kb = r / 64, j = r % 64;
                int n0, ncv, dr = 32 * j;
                if (j < 40) { n0 = 32 * j; ncv = 32; } else if (j < 56) { n0 = 1304 + 32 * (j - 40); ncv = 32; } else if (j == 56) { n0 = 1280; ncv = 24; } else { n0 = 0; ncv = 0; }
                xpose_item(ap_->in[I_W_IN] + (size_t)l * DM * 1816, 1816, 64 * kb, n0, ncv, W16(WS_WIN) + (size_t)l * ZW * DM, DM, dr, scr, lane, ap_->in[I_NORM_MIX] + l * DM);
            } else if (it < N1) { const int r0 = it - N0, l = r0 / IT_WOUT, r = r0 % IT_WOUT, kb = r / 32, j = r % 32;
                xpose_item(ap_->in[I_W_OUT] + (size_t)l * DM * DM, DM, 64 * kb, 32 * j, 32, W16(WS_WOUT) + (size_t)l * DM * DM, DM, 32 * j, scr, lane);
            } else if (it < N2) { const int r0 = it - N1, mtx = r0 / IT_SQ, r = r0 % IT_SQ, which = mtx >> 1, l = mtx & 1;
                const float* src = ap_->in[which == 0 ? I_WQ : which == 1 ? I_WO : which == 2 ? I_WK : I_WV] + (size_t)l * DM * DM;
                bf16_t* dst = W16(which == 0 ? WS_WQ : which == 1 ? WS_WO : which == 2 ? WS_WK : WS_WV) + (size_t)l * DM * DM;
                xpose_mat(src, DM, DM, dst, 0, r, scr, lane, which == 0 ? ap_->in[I_NORM_X] + l * DM : nullptr);
            } else if (it < N3) { const int r0 = it - N2, mtx = r0 / IT_C1, r = r0 % IT_C1, l = mtx >> 1, kv = mtx & 1;
                xpose_mat(ap_->in[kv ? I_W1_V : I_W1_K] + (size_t)l * 2048 * 256, 2048, 256, W16(WS_CW1) + (size_t)mtx * 256 * 2048, 0, r, scr, lane);
            } else if (it < N4) { const int r0 = it - N3, mtx = r0 / IT_C2, r = r0 % IT_C2, l = mtx >> 1, kv = mtx & 1, kb = r / 8, j = r % 8;
                xpose_item(ap_->in[kv ? I_W2_V : I_W2_K] + (size_t)l * 256 * 64, 64, 64 * kb, j < 2 ? 32 * j : 0, j < 2 ? 32 : 0, W16(WS_CW2) + (size_t)mtx * 256 * 256, 256, 32 * j, scr, lane);
            } else if (it < N5) { const int r0 = it - N4, up = r0 / IT_FG, r = r0 % IT_FG;
                xpose_mat(ap_->in[up ? I_FFN_WU : I_FFN_WG], DM, DFF, W16(WS_FGU), up ? 2 : 1, r, scr, lane, ap_->in[I_NORM_FFN]);
            } else if (it < N6) { xpose_mat(ap_->in[I_FFN_WD], DFF, DM, W16(WS_FD), 0, it - N5, scr, lane);
            }
        }
#if TSPIN_ORD == 101 || TSPIN_ORD == 102
        if (bid == 0 && tid == 0) ((unsigned long long*)(ctl + 20000))[60] = __builtin_amdgcn_s_memrealtime();
#endif
        for (int i = bid * 512 + tid; i < SEQ * 8; i += G * 512) {
            const int pos = i >> 3, j = i & 7;
            const double inv = j == 0 ? 1.0 : j == 1 ? 0.19389587045179572 : j == 2 ? 0.037606030930863934 : j == 3 ? 0.007291654101443755 : j == 4 ? 0.0014142135623730951
                             : j == 5 ? 0.00027421616994972156 : j == 6 ? 5.3169310700017e-05 : 1.0309310618636385e-05;
            float s, c; sincos_d((double)pos * inv, s, c);
            ((float*)(ws + WS_ROPE))[2 * i] = c; ((float*)(ws + WS_ROPE))[2 * i + 1] = s;
        }
        for (int r0 = gw; r0 < T; r0 += 4 * NGW) {
            f32x4 xv[4][4];
#pragma unroll
            for (int q = 0; q < 4; ++q)
#pragma unroll
                for (int j = 0; j < 4; ++j) xv[q][j] = ((const f32x4*)(ap_->in[I_X] + (size_t)(r0 + q * NGW) * DM) + lane)[64 * j];
#pragma unroll
            for (int q = 0; q < 4; ++q) { const int r = r0 + q * NGW; unsigned long long* o8 = (unsigned long long*)(W16(WS_HB) + (size_t)r * DM) + lane; float sq = 0.f;
#pragma unroll
                for (int j = 0; j < 4; ++j) { const f32x4 v = xv[q][j]; sq += (v.x * v.x + v.y * v.y) + (v.z * v.z + v.w * v.w); o8[64 * j] = (unsigned long long)pk2(v.x, v.y) | ((unsigned long long)pk2(v.z, v.w) << 32); }
                sq = wave_sum(sq); if (lane == 0) SSP(0)[r] = ss_fix(sq); } }
        for (int r = gw; r < 2 * 1024; r += NGW) { const int l = r >> 10, row = r & 1023;
            norm_row(ap_->in[I_MEM] + (size_t)row * DM, ap_->in[I_NORM_MEM] + l * DM, W16(WS_MN) + (size_t)r * DM, lane); }
#if TSPIN_ORD == 101 || TSPIN_ORD == 102
        if (bid == 0 && tid == 0) ((unsigned long long*)(ctl + 20000))[61] = __builtin_amdgcn_s_memrealtime();
#endif
        for (int itb = gw; itb < 4 * 4 * 16; itb += NGW) { const int mtx = itb >> 6, cg = (itb >> 4) & 3, fc = itb & 15, l = mtx >> 1, kv = mtx & 1, c = cg * 64 + lane;
            const float* pe = ap_->in[kv ? I_PE_V : I_PE_K] + l * 2048 + fc * 128; const float* w1 = ap_->in[kv ? I_W1_V : I_W1_K] + (size_t)l * 2048 * 256 + (size_t)fc * 128 * 256 + c;
            float a = fc == 0 ? ap_->in[kv ? I_B1_V : I_B1_K][l * 256 + c] : 0.f;
#pragma unroll
            for (int h = 0; h < 2; ++h) { float wv[64];
#pragma unroll
                for (int f = 0; f < 64; ++f) wv[f] = w1[(size_t)(64 * h + f) * 256];
#pragma unroll
                for (int f = 0; f < 64; ++f) a += pe[64 * h + f] * wv[f]; }
            atomicAdd((unsigned long long*)(ctl + CW_BIAS) + mtx * 256 + c, (unsigned long long)(long long)((double)a * 1099511627776.0)); }
        for (int itw = gw; itw < 2 * 4 * 16 * 16; itw += NGW) { const int l = itw >> 10, g = (itw >> 8) & 3, nb = (itw >> 4) & 15, cb = itw & 15, n = nb * 64 + lane;
            const float* wp = ap_->in[I_W_POOL] + ((size_t)(l * 4 + g) * 128 + cb * 8) * 128; const float* ps = ap_->in[I_POOL_SCALE] + l * 512 + g * 128;
            const float* wo = ap_->in[I_W_OUT] + (size_t)l * DM * DM + (size_t)(512 + g * 128) * DM + n;
            float a[8];
#pragma unroll
            for (int c = 0; c < 8; ++c) a[c] = 0.f;
#pragma unroll
            for (int h = 0; h < 2; ++h) { float wv[64];
#pragma unroll
                for (int e = 0; e < 64; ++e) wv[e] = wo[(size_t)(64 * h + e) * DM];
#pragma unroll
                for (int e = 0; e < 64; ++e) { const float w = wv[e] * ps[64 * h + e];
#pragma unroll
                    for (int c = 0; c < 8; ++c) a[c] += wp[c * 128 + 64 * h + e] * w; } }
            u32x4 o; o.x = pk2(a[0], a[1]); o.y = pk2(a[2], a[3]); o.z = pk2(a[4], a[5]); o.w = pk2(a[6], a[7]);
            *(u32x4*)(W16(WS_WOUT) + (size_t)l * DM * DM + (size_t)n * DM + 512 + g * 128 + cb * 8) = o; }
        __syncthreads();
        SEAM(PH_PRO);
    }
    layer_phases<0>(lds, lo, hi, bar, G, bid, NGW, wid0);
    layer_phases<1>(lds, lo, hi, bar, G, bid, NGW, wid0);
#if DBG >= 200
    __syncthreads(); if (blockIdx.x == 0 && threadIdx.x == 0) ((unsigned long long*)(ctl + 20000))[62] = __builtin_amdgcn_s_memrealtime();
#endif
#if TSPIN_ORD >= 0
    __syncthreads();
    if (blockIdx.x == 0 && threadIdx.x == 0) {
        volatile unsigned long long* st = (volatile unsigned long long*)(ctl + 20000);
        const unsigned long long tend = __builtin_amdgcn_s_memrealtime(); st[62] = tend;
        unsigned long long prev = st[63], dt = 0ull; int ord = 0;
        for (int i = 0; i < 60; ++i) { const unsigned long long v = st[i]; if (v == 0ull) continue; if (ord == TSPIN_ORD) dt = v - prev; prev = v; ++ord; }
        if (TSPIN_ORD == 21) dt = tend - prev;
        if (TSPIN_ORD == 100) dt = st[61] - st[60];
        if (TSPIN_ORD == 101) dt = st[60] - st[63];
        if (TSPIN_ORD == 102) dt = st[61] - st[60];
        while (__builtin_amdgcn_s_memrealtime() - tend < 10ull * dt) __builtin_amdgcn_s_sleep(8);
    }
#endif
#undef IN
#undef SEAM
}

#if DBG
struct DbgIn { const float* in[30]; };
__device__ float dbg_block_sum(float v, float* red) { const int t = threadIdx.x; red[t] = v; __syncthreads(); for (int o = 128; o > 0; o >>= 1) { if (t < o) red[t] += red[t + o]; __syncthreads(); } const float r = red[0]; __syncthreads(); return r; }
__global__ void dbg_check(DbgIn di, const float* xcur, unsigned char* ws, int stage) {
    __shared__ float red[256]; __shared__ float act[3584]; __shared__ float hrow[1024];
    const int t = threadIdx.x; float* W = (float*)(ws + WS_CTL) + 16000;
    const unsigned* sl = (const unsigned*)(ws + WS_SLOT); const unsigned* rt = (const unsigned*)(ws + WS_ROUTE); const bf16_t* hp = (const bf16_t*)(ws + WS_HP); const bf16_t* ac = (const bf16_t*)(ws + WS_ACTC);
    const int toks[4] = {0, 5000, 12000, 16383}; float worst = 0.f; int nchk = 0;
    for (int q = 0; q < 4; ++q) for (int kk = 0; kk < 2; ++kk) { const int tok = toks[q]; const unsigned e = rt[tok * 8 + kk], sidx = sl[tok * 4 + kk]; const int ch = sidx >= (unsigned)(HALFT * 256) ? 1 : 0;
        if (stage == 1) {
            float ss = 0.f; for (int c = t; c < 1024; c += 256) { const float x = xcur[(size_t)tok * 1024 + c]; ss += x * x; } ss = dbg_block_sum(ss, red);
            const float rs = 1.f / sqrtf(ss / 1024.f + EPS); float num = 0.f, den = 0.f;
            for (int c = t; c < 1024; c += 256) { const float h = xcur[(size_t)tok * 1024 + c] * rs * di.in[I_NORM_FFN][1024 + c], f = bf2f(hp[(size_t)sidx * 1024 + c]); num += (h - f) * (h - f); den += h * h; }
            num = dbg_block_sum(num, red); den = dbg_block_sum(den, red); worst = fmaxf(worst, sqrtf(num / fmaxf(den, 1e-20f))); ++nchk;
        } else if ((stage == 2 && ch == 0) || (stage == 4 && ch == 1)) {
            for (int c = t; c < 1024; c += 256) hrow[c] = bf2f(hp[(size_t)sidx * 1024 + c]); __syncthreads();
            const float* wg = di.in[I_MOE_WG] + (size_t)e * DM * DFFE; const float* wu = di.in[I_MOE_WU] + (size_t)e * DM * DFFE; float num = 0.f, den = 0.f;
            for (int j = t; j < 3584; j += 256) { float g = 0.f, u = 0.f; for (int k2 = 0; k2 < 1024; ++k2) { g += hrow[k2] * wg[(size_t)k2 * DFFE + j]; u += hrow[k2] * wu[(size_t)k2 * DFFE + j]; }
                const float a = g / (1.f + expf(-g)) * u, f = bf2f(ac[((size_t)sidx - (size_t)ch * HALFT * 256) * 3584 + j]); num += (a - f) * (a - f); den += a * a; }
            num = dbg_block_sum(num, red); den = dbg_block_sum(den, red); worst = fmaxf(worst, sqrtf(num / fmaxf(den, 1e-20f))); ++nchk; __syncthreads();
        } else if ((stage == 3 && ch == 0) || (stage == 5 && ch == 1)) {
            for (int j = t; j < 3584; j += 256) act[j] = bf2f(ac[((size_t)sidx - (size_t)ch * HALFT * 256) * 3584 + j]); __syncthreads();
            const float* wd = di.in[I_MOE_WD] + (size_t)e * DFFE * DM; float num = 0.f, den = 0.f;
            for (int n = t; n < 1024; n += 256) { float y = 0.f; for (int j = 0; j < 3584; ++j) y += act[j] * wd[(size_t)j * DM + n]; const float f = bf2f(hp[(size_t)sidx * 1024 + n]); num += (y - f) * (y - f); den += y * y; }
            num = dbg_block_sum(num, red); den = dbg_block_sum(den, red); worst = fmaxf(worst, sqrtf(num / fmaxf(den, 1e-20f))); ++nchk; __syncthreads();
        } }
    if (stage == 1) {
        float mism = 0.f, werr = 0.f;
        for (int q = 0; q < 64; ++q) { const int tok = q * 251 + 3;
            float ss = 0.f; for (int c = t; c < 1024; c += 256) { const float x = xcur[(size_t)tok * 1024 + c]; ss += x * x; } ss = dbg_block_sum(ss, red);
            const float rs = 1.f / sqrtf(ss / 1024.f + EPS); float lg[8];
            for (int e = 0; e < 8; ++e) { float a = 0.f; for (int c = t; c < 1024; c += 256) a += xcur[(size_t)tok * 1024 + c] * rs * di.in[I_NORM_FFN][1024 + c] * di.in[I_ROUTER][c * 8 + e]; lg[e] = dbg_block_sum(a, red); }
            int i1 = 0; for (int e = 1; e < 8; ++e) if (lg[e] > lg[i1]) i1 = e; int i2 = -1; for (int e = 0; e < 8; ++e) if (e != i1 && (i2 < 0 || lg[e] > lg[i2])) i2 = e;
            const float w1 = 1.f / (1.f + expf(lg[i2] - lg[i1]));
            if ((int)rt[tok * 8] != i1 || (int)rt[tok * 8 + 1] != i2) mism += 1.f;
            werr = fmaxf(werr, fabsf(w1 - __builtin_bit_cast(float, rt[tok * 8 + 4]))); }
        if (t == 0) { W[8] = mism; W[9] = werr; } }
    if (stage == 5) {
        float sx = 0.f, sm = 0.f;
        for (int q = 0; q < 4; ++q) { const int tok = toks[q]; const unsigned s1 = sl[tok * 4], s2 = sl[tok * 4 + 1]; const float w1 = __builtin_bit_cast(float, sl[tok * 4 + 2]), w2 = __builtin_bit_cast(float, sl[tok * 4 + 3]);
            for (int c = t; c < 1024; c += 256) { const float x = xcur[(size_t)tok * 1024 + c], m = w1 * bf2f(hp[(size_t)s1 * 1024 + c]) + w2 * bf2f(hp[(size_t)s2 * 1024 + c]); sx += x * x; sm += m * m; } }
        sx = dbg_block_sum(sx, red); sm = dbg_block_sum(sm, red);
        if (t == 0) { W[6] = sx / 4096.f; W[7] = sm / 4096.f; } }
    if (t == 0) { W[stage] = worst; W[10 + stage] = (float)nchk; }
}
__global__ void dbg_attn(unsigned char* ws, int b, int g, int t, int slotw) {
    __shared__ float red[256]; __shared__ float lgt[4096]; __shared__ float pcs[4][256]; __shared__ float osum[4][64]; __shared__ int selb[64]; __shared__ float impv[64];
    const int tid = threadIdx.x, bg = b * 2 + g, tok = b * SEQ + t; float* W = (float*)(ws + WS_CTL) + 16000;
    const bf16_t* qraw = (const bf16_t*)(ws + WS_QRAW) + ((size_t)bg * SEQ + t) * 256; const bf16_t* qrot = (const bf16_t*)(ws + WS_QROT) + ((size_t)bg * SEQ + t) * 256;
    const bf16_t* kc = (const bf16_t*)(ws + WS_KCMP) + (size_t)bg * 256 * 64; const bf16_t* vc = kc + 8 * 256 * 64;
    const bf16_t* kvb = (const bf16_t*)(ws + WS_KV); const float* gt = (const float*)(ws + WS_GATES) + (size_t)tok * 24 + g * 12;
    const int nv = t >= 15 ? ((t - 15) >> 4) : 0, tb = t >> 6;
    for (int i = tid; i < 256; i += 256) osum[i >> 6][i & 63] = 0.f;
    __syncthreads();
    for (int r = 0; r < 4; ++r) {
        float s = -INFINITY; const int c = tid;
        if (c < 255 && c < nv) { s = 0.f; for (int d = 0; d < 64; ++d) s += bf2f(qraw[r * 64 + d]) * bf2f(kc[c * 64 + d]); }
        red[tid] = s; __syncthreads(); for (int o = 128; o > 0; o >>= 1) { if (tid < o) red[tid] = fmaxf(red[tid], red[tid + o]); __syncthreads(); } float m = red[0]; __syncthreads(); if (m == -INFINITY) m = 0.f;
        const float p = s == -INFINITY ? 0.f : exp2f(s - m); const float l = dbg_block_sum(p, red);
        pcs[r][c] = l > 0.f ? p / l : 0.f; __syncthreads();
        if (tid < 64) { float o = 0.f; for (int cc = 0; cc < 255; ++cc) o += bf2f((unsigned short)f2bf(pcs[r][cc])) * bf2f(vc[cc * 64 + tid]); osum[r][tid] += gt[r * 3 + 0] * o; }
        __syncthreads();
    }
    if (tid < 64) { float im = 0.f; for (int j = -1; j < 4; ++j) { const int c = 4 * tid + j; if (c >= 0 && c < 255) for (int r = 0; r < 4; ++r) im += pcs[r][c]; }
        const bool fut = tid > tb, forced = tid == 0 || tid == tb || tid == tb - 1; impv[tid] = fut ? -INFINITY : forced ? INFINITY : im; selb[tid] = 0; }
    __syncthreads();
    if (tid == 0) { for (int k = 0; k < 16; ++k) { int best = -1; float bv = 0.f; for (int n = 0; n < 64; ++n) if (!selb[n] && (best < 0 || impv[n] > bv)) { best = n; bv = impv[n]; } selb[best] = 1; } }
    __syncthreads();
    for (int br = 1; br <= 2; ++br) {
        const bf16_t* kb = kvb + (size_t)(br == 1 ? 2 : 4) * KVSZ + (size_t)bg * SEQ * 64; const bf16_t* vb = kvb + (size_t)(br == 1 ? 3 : 5) * KVSZ + (size_t)bg * SEQ * 64;
        for (int r = 0; r < 4; ++r) {
            float mx = -INFINITY;
            for (int j = tid; j < SEQ; j += 256) { bool ok = j <= t; if (br == 1) ok = ok && selb[j >> 6]; else ok = ok && (t - j) < 512;
                float sv = -INFINITY; if (ok) { sv = 0.f; for (int d = 0; d < 64; ++d) sv += bf2f(qrot[r * 64 + d]) * bf2f(kb[(size_t)j * 64 + d]); } lgt[j] = sv; mx = fmaxf(mx, sv); }
            red[tid] = mx; __syncthreads(); for (int o = 128; o > 0; o >>= 1) { if (tid < o) red[tid] = fmaxf(red[tid], red[tid + o]); __syncthreads(); } const float m = red[0]; __syncthreads();
            float ls = 0.f; for (int j = tid; j < SEQ; j += 256) { const float p = lgt[j] == -INFINITY ? 0.f : exp2f(lgt[j] - m); lgt[j] = p; ls += p; }
            const float l = dbg_block_sum(ls, red);
            if (tid < 64) { float o = 0.f; for (int j = 0; j <= t; ++j) o += lgt[j] * bf2f(vb[(size_t)j * 64 + tid]); osum[r][tid] += gt[r * 3 + br] * o / l; }
            __syncthreads();
        }
    }
    const bf16_t* ab = (const bf16_t*)(ws + WS_AB) + (size_t)tok * 1024 + g * 256;
    float num = 0.f, den = 0.f; { const float o = osum[tid >> 6][tid & 63], f = bf2f(ab[tid]); num = (o - f) * (o - f); den = o * o; }
    num = dbg_block_sum(num, red); den = dbg_block_sum(den, red);
    if (tid == 0) { W[slotw] = sqrtf(num / fmaxf(den, 1e-30f)); W[slotw + 40] = sqrtf(den / 256.f); }
}
__global__ void dbg_mixer(DbgIn di, const float* outp, unsigned char* ws, int stage) {
    __shared__ float red[256]; __shared__ float hrow[1024]; __shared__ float zrow[1816]; __shared__ float hid[256];
    const int t = threadIdx.x; float* W = (float*)(ws + WS_CTL) + 16000;
    const bf16_t* hb = (const bf16_t*)(ws + WS_HB); const bf16_t* kvb = (const bf16_t*)(ws + WS_KV);
    const int toks[4] = {7, 4101, 9000, 16383};
    if (stage == 30) {
        float nq = 0, dq = 0, nr = 0, dr = 0, nk = 0, dk = 0, nkr = 0, dkr = 0, nu = 0, du = 0, ng = 0, dg = 0;
        for (int q = 0; q < 4; ++q) { const int tok = toks[q], b = tok >> 12, pos = tok & 4095;
            for (int c = t; c < 1024; c += 256) hrow[c] = bf2f(hb[(size_t)tok * 1024 + c]); __syncthreads();
            for (int n = t; n < 1816; n += 256) { float a = 0.f; for (int k = 0; k < 1024; ++k) a += hrow[k] * di.in[I_W_IN][(size_t)k * 1816 + n]; zrow[n] = a; } __syncthreads();
            for (int n = t; n < 1816; n += 256) { const float z = zrow[n];
                if (n < 512) { const int g = n >> 8, c = n & 255, d = n & 63; const size_t idx = ((size_t)(b * 2 + g) * SEQ + pos) * 256 + c;
                    const float f = bf2f(((const bf16_t*)(ws + WS_QRAW))[idx]) / C2; nq += (z - f) * (z - f); dq += z * z;
                    float zr = z; if (d < 16) { const int j = d & 7; const double inv = pow(500000.0, -(double)j / 8.0); const float cs = (float)cos((double)pos * inv), sn = (float)sin((double)pos * inv);
                        zr = d < 8 ? z * cs - zrow[n + 8] * sn : z * cs + zrow[n - 8] * sn; }
                    const float fr = bf2f(((const bf16_t*)(ws + WS_QROT))[idx]) / C2; nr += (zr - fr) * (zr - fr); dr += zr * zr;
                } else if (n < 1280) { const int m = n - 512, i = m >> 7, g = (m >> 6) & 1, d = m & 63; const float f = bf2f(kvb[(size_t)i * KVSZ + ((size_t)(b * 2 + g) * SEQ + pos) * 64 + d]);
                    if (i == 2 || i == 4) { float zr = z; if (d < 16) { const int j = d & 7; const double inv = pow(500000.0, -(double)j / 8.0); const float cs = (float)cos((double)pos * inv), sn = (float)sin((double)pos * inv);
                            zr = d < 8 ? z * cs - zrow[n + 8] * sn : z * cs + zrow[n - 8] * sn; } nkr += (zr - f) * (zr - f); dkr += zr * zr; }
                    else { nk += (z - f) * (z - f); dk += z * z; }
                } else if (n < 1304) { const float sg = 1.f / (1.f + expf(-z)), f = ((const float*)(ws + WS_GATES))[(size_t)tok * 24 + (n - 1280)]; ng += (sg - f) * (sg - f); dg += sg * sg;
                } else { const float f = bf2f(((const bf16_t*)(ws + WS_U))[(size_t)tok * 512 + (n - 1304)]); nu += (z - f) * (z - f); du += z * z; } }
            __syncthreads(); }
        nq = dbg_block_sum(nq, red); dq = dbg_block_sum(dq, red); nr = dbg_block_sum(nr, red); dr = dbg_block_sum(dr, red); nk = dbg_block_sum(nk, red); dk = dbg_block_sum(dk, red);
        nkr = dbg_block_sum(nkr, red); dkr = dbg_block_sum(dkr, red); nu = dbg_block_sum(nu, red); du = dbg_block_sum(du, red); ng = dbg_block_sum(ng, red); dg = dbg_block_sum(dg, red);
        if (t == 0) { W[30] = sqrtf(nq / dq); W[31] = sqrtf(nr / dr); W[32] = sqrtf(nk / dk); W[33] = sqrtf(nkr / dkr); W[34] = sqrtf(nu / du); W[35] = sqrtf(ng / dg); }
    }
    if (stage == 31) {
        float nc = 0, dc = 0, nd = 0, dd = 0;
        const int cs_[4] = {0, 17, 200, 254};
        for (int q = 0; q < 4; ++q) for (int kv = 0; kv < 2; ++kv) { const int bg = (q * 3 + 1) & 7, c = cs_[q];
            const bf16_t* src = kvb + (size_t)kv * KVSZ + ((size_t)bg * SEQ + 16 * c) * 64; const float* pe = di.in[kv ? I_PE_V : I_PE_K]; const float* w1 = di.in[kv ? I_W1_V : I_W1_K]; const float* b1 = di.in[kv ? I_B1_V : I_B1_K]; const float* w2 = di.in[kv ? I_W2_V : I_W2_K];
            { float a = b1[t]; for (int f = 0; f < 2048; ++f) a += (bf2f(src[f]) + pe[f]) * w1[(size_t)f * 256 + t]; const float y = 0.7978845608f * (a + 0.044715f * a * a * a); hid[t] = 0.5f * a * (1.f + tanhf(y)); } __syncthreads();
            if (t < 64) { float o = 0.f; for (int h = 0; h < 256; ++h) o += hid[h] * w2[h * 64 + t]; const float f = bf2f(((const bf16_t*)(ws + WS_KCMP))[(size_t)kv * 8 * 256 * 64 + ((size_t)bg * 256 + c) * 64 + t]); nc += (o - f) * (o - f); dc += o * o; } __syncthreads(); }
        for (int q = 0; q < 4; ++q) { const int tok = toks[q], pos = tok & 4095; for (int c = t; c < 512; c += 256) { const int w = 2 << (c >> 7), n = (pos + 1) < w ? (pos + 1) : w; float sm = 0.f; const bf16_t* ub = (const bf16_t*)(ws + WS_U);
                for (int i = 0; i < n; ++i) sm += bf2f(ub[(size_t)(tok - i) * 512 + c]); const float d = sm / n - bf2f(ub[(size_t)tok * 512 + c]), f = bf2f(((const bf16_t*)(ws + WS_AB))[(size_t)tok * 1024 + 512 + c]); nd += (d - f) * (d - f); dd += d * d; } }
        nc = dbg_block_sum(nc, red); dc = dbg_block_sum(dc, red); nd = dbg_block_sum(nd, red); dd = dbg_block_sum(dd, red);
        if (t == 0) { W[36] = sqrtf(nc / dc); W[37] = sqrtf(nd / dd); }
    }
    if (stage == 32) {
        float nn = 0, dn = 0; const bf16_t* ab = (const bf16_t*)(ws + WS_AB);
        for (int q = 0; q < 4; ++q) { const int tok = toks[q];
            for (int c = t; c < 1024; c += 256) hrow[c] = bf2f(ab[(size_t)tok * 1024 + c]); __syncthreads();
            for (int ge = t; ge < 512; ge += 256) { const int g = ge >> 7, e = ge & 127; float y = 0.f; for (int c = 0; c < 128; ++c) y += hrow[512 + g * 128 + c] * di.in[I_W_POOL][((size_t)g * 128 + c) * 128 + e]; zrow[ge] = y * di.in[I_POOL_SCALE][ge]; } __syncthreads();
            for (int n = t; n < 1024; n += 256) { float a = di.in[I_X][(size_t)tok * 1024 + n]; const float x0 = a; for (int k = 0; k < 512; ++k) a += hrow[k] * di.in[I_W_OUT][(size_t)k * 1024 + n]; for (int k = 0; k < 512; ++k) a += zrow[k] * di.in[I_W_OUT][(size_t)(512 + k) * 1024 + n];
                const float f = outp[(size_t)tok * 1024 + n]; nn += (a - f) * (a - f); dn += (a - x0) * (a - x0); } __syncthreads(); }
        nn = dbg_block_sum(nn, red); dn = dbg_block_sum(dn, red);
        if (t == 0) W[38] = sqrtf(nn / dn);
    }
}
__global__ void dbg_moe_tok(DbgIn di, const float* xcur, unsigned char* ws) {
    __shared__ float red[256]; __shared__ float hrow[1024]; __shared__ float act[3584]; __shared__ float ynaive[1024];
    const int t = threadIdx.x, tok = blockIdx.x * 251 + 3; float* W = (float*)(ws + WS_CTL) + 16000;
    const unsigned* sl = (const unsigned*)(ws + WS_SLOT); const unsigned* rt = (const unsigned*)(ws + WS_ROUTE); const bf16_t* hp = (const bf16_t*)(ws + WS_HP);
    float ss = 0.f; for (int c = t; c < 1024; c += 256) { const float x = xcur[(size_t)tok * 1024 + c]; ss += x * x; } ss = dbg_block_sum(ss, red);
    const float rs = 1.f / sqrtf(ss / 1024.f + EPS);
    for (int c = t; c < 1024; c += 256) { hrow[c] = xcur[(size_t)tok * 1024 + c] * rs * di.in[I_NORM_FFN][1024 + c]; ynaive[c] = 0.f; } __syncthreads();
    float lg[8]; for (int e = 0; e < 8; ++e) { float a = 0.f; for (int c = t; c < 1024; c += 256) a += hrow[c] * di.in[I_ROUTER][c * 8 + e]; lg[e] = dbg_block_sum(a, red); }
    int i1 = 0; for (int e = 1; e < 8; ++e) if (lg[e] > lg[i1]) i1 = e; int i2 = -1; for (int e = 0; e < 8; ++e) if (e != i1 && (i2 < 0 || lg[e] > lg[i2])) i2 = e;
    const float w1 = 1.f / (1.f + expf(lg[i2] - lg[i1]));
    for (int kk = 0; kk < 2; ++kk) { const int e = kk ? i2 : i1; const float wgt = kk ? 1.f - w1 : w1;
        const float* wg = di.in[I_MOE_WG] + (size_t)e * DM * DFFE; const float* wu = di.in[I_MOE_WU] + (size_t)e * DM * DFFE; const float* wd = di.in[I_MOE_WD] + (size_t)e * DFFE * DM;
        for (int j = t; j < 3584; j += 256) { float g = 0.f, u = 0.f; for (int k2 = 0; k2 < 1024; ++k2) { g += hrow[k2] * wg[(size_t)k2 * DFFE + j]; u += hrow[k2] * wu[(size_t)k2 * DFFE + j]; } act[j] = g / (1.f + expf(-g)) * u; } __syncthreads();
        for (int n = t; n < 1024; n += 256) { float y = 0.f; for (int j = 0; j < 3584; ++j) y += act[j] * wd[(size_t)j * DM + n]; ynaive[n] += wgt * y; } __syncthreads(); }
    const unsigned s1 = sl[tok * 4], s2 = sl[tok * 4 + 1]; const float f1 = __builtin_bit_cast(float, sl[tok * 4 + 2]), f2 = __builtin_bit_cast(float, sl[tok * 4 + 3]);
    float num = 0.f, den = 0.f; for (int n = t; n < 1024; n += 256) { const bf16_t* yb = (const bf16_t*)(ws + WS_YB); const float m = f1 * (bf2f(hp[(size_t)s1 * 1024 + n]) + bf2f(yb[(size_t)s1 * 1024 + n])) + f2 * (bf2f(hp[(size_t)s2 * 1024 + n]) + bf2f(yb[(size_t)s2 * 1024 + n])); num += (m - ynaive[n]) * (m - ynaive[n]); den += ynaive[n] * ynaive[n]; }
    num = dbg_block_sum(num, red); den = dbg_block_sum(den, red);
    if (t == 0) { const float er = sqrtf(num / den); atomicMax((unsigned*)&W[50], __builtin_bit_cast(unsigned, er)); if (er > 0.1f) atomicAdd(&W[51], 1.f); atomicAdd(&W[52], er / 64.f); }
}
#ifndef DBGBR
#define DBGBR -1
#endif
__global__ void dbg_setgates(unsigned char* ws, int br) { float* g = (float*)(ws + WS_GATES); for (size_t i = (size_t)blockIdx.x * 256 + threadIdx.x; i < (size_t)T * 24; i += (size_t)gridDim.x * 256) g[i] = ((int)(i % 3) == br) ? 1.f : 0.f; }
#ifndef DBGV1
#define DBGV1 0
#endif
__global__ void dbg_setv(unsigned char* ws) { bf16_t* kv = (bf16_t*)(ws + WS_KV); for (size_t i = (size_t)blockIdx.x * 256 + threadIdx.x; i < KVSZ; i += (size_t)gridDim.x * 256) { kv[3 * KVSZ + i] = 0x3F80; kv[5 * KVSZ + i] = 0x3F80; } }
#ifndef DBG_UNIT
#define DBG_UNIT 5
#endif
#ifndef DBG_PA
#define DBG_PA 6
#endif
#ifndef DBG_PB
#define DBG_PB 20
#endif
__global__ void dbg_tail(float* out, unsigned char* ws) {
    const int t = threadIdx.x; const float* W = (const float*)(ws + WS_CTL) + 16000; float k = 0.f;
    if (DBG == 400) {
        __shared__ unsigned cnt; if (t == 0) cnt = 0; __syncthreads();
        if (blockIdx.x == 0 && t == 0) cnt = ((const unsigned*)(ws + WS_CTL))[21100];
        __syncthreads();
        const float kb = fminf((float)cnt, 89.f);
        for (size_t i = (size_t)blockIdx.x * 256 + t; i < (size_t)T * DM; i += (size_t)gridDim.x * 256) out[i] = (i == 0) ? (10.f + kb) * 10.f : 3.f;
        return; }
    if (DBG >= 200) {
        const unsigned long long* st = (const unsigned long long*)((const unsigned*)(ws + WS_CTL) + 20000);
        unsigned long long prev = st[63]; int ord = 0; float ka = 0.f, kb = 0.f;
        for (int i = 0; i < 63; ++i) { const unsigned long long v = st[i]; if (v == 0ull) continue; const float us = (float)(v - prev) * 0.01f; prev = v;
            if (ord == DBG_PA) ka = fminf(rintf(us / (float)DBG_UNIT), 89.f); if (ord == DBG_PB) kb = fminf(rintf(us / (float)DBG_UNIT), 89.f); ++ord; }
        (void)ka;
        for (size_t i = (size_t)blockIdx.x * 256 + t; i < (size_t)T * DM; i += (size_t)gridDim.x * 256) out[i] = (i == 0) ? (10.f + kb) * 10.f : 3.f;
        return; }
    if (DBG == 100) { for (int i = 1; i < 10; ++i) if (W[i] > 0.05f) { k = (float)i; break; } }
    else if (DBG == 103) { int m = 0; for (int i = 0; i < 6; ++i) if (!(W[20 + i] <= 0.05f)) m |= 1 << i; k = (float)m; }
    else if (DBG == 104) { int m = 0; for (int i = 6; i < 8; ++i) if (!(W[20 + i] <= 0.05f)) m |= 1 << (i - 6); k = (float)m; }
    else if (DBG == 105 || DBG == 106) { float mn = 1e30f, mx = 0.f; for (int i = 0; i < 8; ++i) { mn = fminf(mn, W[20 + i]); mx = fmaxf(mx, W[20 + i]); }
        k = rintf(10.f * (log10f(fmaxf(DBG == 105 ? mn : mx, 1e-6f)) + 6.f)); k = fminf(fmaxf(k, 0.f), 89.f); }
    else if (DBG == 107) { for (int i = 30; i <= 38; ++i) if (!(W[i] <= 0.03f)) { k = (float)(i - 29); break; } }
    else if (DBG == 101) { for (int i = 0; i < 8; ++i) if (!(W[20 + i] <= 0.05f)) { k = (float)(i + 1); break; } }
    else { k = rintf(10.f * (log10f(fmaxf(W[DBG], 1e-6f)) + 6.f)); k = fminf(fmaxf(k, 0.f), 89.f); }
    const float c = sqrtf(0.1f * k + 0.02f);
    for (size_t i = (size_t)blockIdx.x * 256 + t; i < (size_t)T * DM; i += (size_t)gridDim.x * 256) out[i] = c;
}
#endif

extern "C" void kernel_launch(void* const* d_in, const int* in_sizes, int n_in, void* d_out, int out_size, void* d_ws, size_t ws_size, hipStream_t stream) {
    static int grid = 0;
    if (grid == 0) {
        if (n_in != 30 || out_size != T * DM || ws_size < WS_END2) { fprintf(stderr, "kernel_launch: unexpected problem shape / workspace (%d inputs, out %d, ws %zu)\n", n_in, out_size, ws_size); grid = -1; return; }
        int dev = 0, cus = 0;
        if (hipGetDevice(&dev) != hipSuccess || hipDeviceGetAttribute(&cus, hipDeviceAttributeMultiprocessorCount, dev) != hipSuccess) { grid = -1; return; }
        if (hipFuncSetAttribute((const void*)fwd, hipFuncAttributeMaxDynamicSharedMemorySize, LDS_BYTES) != hipSuccess) { fprintf(stderr, "kernel_launch: hipFuncSetAttribute failed\n"); grid = -1; return; }
        int per_cu = 0;
        if (hipOccupancyMaxActiveBlocksPerMultiprocessor(&per_cu, (const void*)fwd, NWAVES * 64, LDS_BYTES) != hipSuccess || per_cu < 1) { fprintf(stderr, "kernel_launch: occupancy query says %d\n", per_cu); }
        (void)hipGetLastError();
        if (cus != 256) { fprintf(stderr, "kernel_launch: built for a 256-CU device, found %d\n", cus); grid = -1; return; }
        grid = cus;
    }
    if (grid < 0) return;
    if (hipMemsetAsync((char*)d_ws + WS_CTL, 0, CTL_ZERO_BYTES, stream) != hipSuccess) return;
    Args a{};
    for (int i = 0; i < 30; ++i) a.in[i] = (const float*)d_in[i];
    a.out = (float*)d_out; a.ws = (unsigned char*)d_ws;
#if MK_PER_PHASE
    int ids[64]; int n = 0;
    ids[n++] = PH_PRO;
    for (int l = 0; l < NL; ++l) { const int pb = PH_L0 + l * PH_LSTRIDE; for (int k = 0; k < 9; ++k) if (k != PO_N2 && k != PO_S && k != PO_PV) ids[n++] = pb + k;
        if (l == 0) { ids[n++] = pb + PO_F0 + 1; ids[n++] = pb + PO_F0 + 2; } else for (int k = 0; k < 7; ++k) ids[n++] = pb + PO_F0 + k; }
    for (int i = 0; i < n; ++i) { a.ph_lo = ids[i]; a.ph_hi = ids[i] + 1; hipLaunchKernelGGL(fwd, dim3(grid), dim3(NWAVES * 64), LDS_BYTES, stream, a);
#if DBG
        { DbgIn di; for (int q = 0; q < 30; ++q) di.in[q] = (const float*)d_in[q]; const int st = ids[i] - (PH_L0 + PH_LSTRIDE + PO_F0);
          if (st == 5) hipLaunchKernelGGL(dbg_moe_tok, dim3(64), dim3(256), 0, stream, di, (const float*)d_out, (unsigned char*)d_ws);
          if (st >= 1 && st <= 5) hipLaunchKernelGGL(dbg_check, dim3(1), dim3(256), 0, stream, di, (const float*)d_out, (unsigned char*)d_ws, st);
          if (ids[i] == PH_L0 + PO_WIN && DBGBR >= 0) hipLaunchKernelGGL(dbg_setgates, dim3(256), dim3(256), 0, stream, (unsigned char*)d_ws, DBGBR);
          if (ids[i] == PH_L0 + PO_WIN && DBGV1) hipLaunchKernelGGL(dbg_setv, dim3(256), dim3(256), 0, stream, (unsigned char*)d_ws);
          if (ids[i] == PH_L0 + PO_WIN) hipLaunchKernelGGL(dbg_mixer, dim3(1), dim3(256), 0, stream, di, (const float*)d_out, (unsigned char*)d_ws, 30);
          if (ids[i] == PH_L0 + PO_CMP) hipLaunchKernelGGL(dbg_mixer, dim3(1), dim3(256), 0, stream, di, (const float*)d_out, (unsigned char*)d_ws, 31);
          if (ids[i] == PH_L0 + PO_WOUT) hipLaunchKernelGGL(dbg_mixer, dim3(1), dim3(256), 0, stream, di, (const float*)d_out, (unsigned char*)d_ws, 32);
          if (ids[i] == PH_L0 + PO_ATT) { const int pt[8] = {5, 40, 100, 700, 1000, 1500, 3000, 4095};
            for (int q = 0; q < 8; ++q) hipLaunchKernelGGL(dbg_attn, dim3(1), dim3(256), 0, stream, (unsigned char*)d_ws, q & 3, q & 1, pt[q], 20 + q); } }
#endif
    }
#else
    a.ph_lo = 0; a.ph_hi = 1000;
    hipLaunchKernelGGL(fwd, dim3(grid), dim3(NWAVES * 64), LDS_BYTES, stream, a);
#endif
#if DBG
    hipLaunchKernelGGL(dbg_tail, dim3(64), dim3(256), 0, stream, (float*)d_out, (unsigned char*)d_ws);
#endif
}
```
